# Optimizing an MI355X kernel written in HIP

```python
import math
import jax, jax.numpy as jnp
from jax import lax
import numpy as np

D_MODEL = 1024
BATCH = 2
SEQ = 16384
DEPTH = 4

N_MEM = 256
EPS = 1e-5
N_EVEN = (DEPTH + 1) // 2
N_ODD = DEPTH // 2

SSD_HEADS = 16
SSD_HEAD_DIM = 64
SSD_INNER = SSD_HEADS * SSD_HEAD_DIM
SSD_GROUPS = 2
SSD_STATE = 64
SSD_CONV = 4
SSD_CHUNK = 128
SSD_XBC = SSD_INNER + 2 * SSD_GROUPS * SSD_STATE

GLA_HEADS = 4
GLA_KEY = D_MODEL // 2
GLA_VAL = D_MODEL
GLA_HK = GLA_KEY // GLA_HEADS
GLA_HV = GLA_VAL // GLA_HEADS
GLA_RANK = 16
GLA_TAU = 16.0
GLA_CHUNK = 64

IN_SPLITS = (SSD_INNER, SSD_XBC, SSD_HEADS, GLA_KEY, GLA_KEY, GLA_VAL, GLA_RANK, GLA_VAL)
IN_WIDTH = sum(IN_SPLITS)
MIX_WIDTH = SSD_INNER + GLA_VAL

DIFF_HEADS = 8
DIFF_HEAD_DIM = 64
DIFF_V_DIM = 2 * DIFF_HEAD_DIM
DIFF_QK = DIFF_HEADS * 2 * DIFF_HEAD_DIM
DIFF_QKV = 2 * DIFF_QK + DIFF_HEADS * DIFF_V_DIM
Q_BLOCK = 128

X_HEADS = 4
X_HEAD_DIM = D_MODEL // X_HEADS

D_FF = 4 * D_MODEL

kernel_name = "hybrid_ssd_gla_diffattn_trunk"


def rmsnorm(x, w):
    xf = x.astype(jnp.float32)
    y = xf * lax.rsqrt(jnp.mean(xf * xf, axis=-1, keepdims=True) + EPS)
    return (y * w.astype(jnp.float32)).astype(x.dtype)


def causal_dwconv(x, w, b):
    k = w.shape[0]
    y = lax.conv_general_dilated(
        x, w[:, None, :].astype(x.dtype), window_strides=(1,), padding=[(k - 1, 0)],
        dimension_numbers=("NWC", "WIO", "NWC"), feature_group_count=x.shape[-1])
    return y + b.astype(x.dtype)


def to_chunks(t, size):
    b, l = t.shape[:2]
    return jnp.moveaxis(t.reshape(b, l // size, size, *t.shape[2:]), 1, 0)


def from_chunks(t):
    nc, b, q = t.shape[:3]
    return jnp.moveaxis(t, 0, 1).reshape(b, nc * q, *t.shape[3:])


def ssd_chunked(x, dt, a, bmat, cmat):
    f32 = jnp.float32
    b, l, h, p = x.shape
    g, n = bmat.shape[2:]
    e = h // g
    xdt = (x.astype(f32) * dt.astype(f32)[..., None]).reshape(b, l, g, e, p)
    loga = (dt.astype(f32) * a.astype(f32)).reshape(b, l, g, e)
    mask = jnp.tril(jnp.ones((SSD_CHUNK, SSD_CHUNK), dtype=bool))[None, :, :, None, None]

    def step(state, inp):
        xc, ac, bc, cc = inp
        cum = jnp.cumsum(ac, axis=1)
        seg = cum[:, :, None] - cum[:, None, :]
        decay = jnp.exp(jnp.where(mask, seg, -jnp.inf))
        scores = jnp.einsum("bqgn,bsgn->bqsg", cc, bc)
        y = jnp.einsum("bqsg,bqsge,bsgep->bqgep", scores, decay, xc)
        y = y + jnp.einsum("bqgn,bgepn->bqgep", cc, state) * jnp.exp(cum)[..., None]
        last = cum[:, -1]
        wts = jnp.exp(last[:, None] - cum)
        state = state * jnp.exp(last)[..., None, None] + jnp.einsum("bsge,bsgep,bsgn->bgepn", wts, xc, bc)
        return state, y

    state0 = jnp.zeros((b, g, e, p, n), f32)
    inputs = (to_chunks(xdt, SSD_CHUNK), to_chunks(loga, SSD_CHUNK),
              to_chunks(bmat.astype(f32), SSD_CHUNK), to_chunks(cmat.astype(f32), SSD_CHUNK))
    _, ys = lax.scan(step, state0, inputs)
    return from_chunks(ys).reshape(b, l, h, p).astype(x.dtype)


def gla_chunked(q, k, v, logg):
    f32 = jnp.float32
    b, l, h, dk = q.shape
    dv = v.shape[-1]
    mask = jnp.tril(jnp.ones((GLA_CHUNK, GLA_CHUNK), dtype=bool))[None, :, :, None, None]

    def step(s_state, inp):
        qc, kc, vc, gc = inp
        cum = jnp.cumsum(gc, axis=1)
        seg = cum[:, :, None] - cum[:, None, :]
        decay = jnp.exp(jnp.where(mask, seg, -jnp.inf))
        scores = jnp.einsum("bqhk,bshk,bqshk->bqsh", qc, kc, decay)
        o = jnp.einsum("bqsh,bshv->bqhv", scores, vc)
        o = o + jnp.einsum("bqhk,bhkv->bqhv", qc * jnp.exp(cum), s_state)
        last = cum[:, -1]
        s_state = s_state * jnp.exp(last)[..., None] + jnp.einsum(
            "bshk,bshv->bhkv", kc * jnp.exp(last[:, None] - cum), vc)
        return s_state, o

    s0 = jnp.zeros((b, h, dk, dv), f32)
    inputs = tuple(to_chunks(t.astype(f32), GLA_CHUNK) for t in (q, k, v, logg))
    _, os_ = lax.scan(step, s0, inputs)
    return from_chunks(os_).astype(v.dtype)


def ssd_gla_mixer(h, w_in, conv_w, conv_b, dt_bias, a_log, d_skip, ssd_norm, gla_w2, gla_b, gla_norm, w_out):
    b, l, _ = h.shape
    proj = h @ w_in
    z, xbc, dt, q, k, v, glr, r = jnp.split(proj, list(np.cumsum(IN_SPLITS)[:-1]), axis=-1)

    xbc = jax.nn.silu(causal_dwconv(xbc, conv_w, conv_b))
    xs, bm, cm = jnp.split(xbc, [SSD_INNER, SSD_INNER + SSD_GROUPS * SSD_STATE], axis=-1)
    xs = xs.reshape(b, l, SSD_HEADS, SSD_HEAD_DIM)
    bm = bm.reshape(b, l, SSD_GROUPS, SSD_STATE)
    cm = cm.reshape(b, l, SSD_GROUPS, SSD_STATE)
    dt = jax.nn.softplus((dt + dt_bias).astype(jnp.float32))
    a = -jnp.exp(a_log.astype(jnp.float32))
    y = ssd_chunked(xs, dt, a, bm, cm) + d_skip[:, None] * xs
    y = y.reshape(b, l, SSD_INNER) * jax.nn.silu(z)
    y = rmsnorm(y.reshape(b, l, SSD_GROUPS, SSD_INNER // SSD_GROUPS),
                ssd_norm.reshape(SSD_GROUPS, SSD_INNER // SSD_GROUPS)).reshape(b, l, SSD_INNER)

    q = q.reshape(b, l, GLA_HEADS, GLA_HK) * (GLA_HK ** -0.5)
    k = k.reshape(b, l, GLA_HEADS, GLA_HK)
    v = v.reshape(b, l, GLA_HEADS, GLA_HV)
    logg = jax.nn.log_sigmoid((glr @ gla_w2 + gla_b).astype(jnp.float32)) / GLA_TAU
    logg = logg.reshape(b, l, GLA_HEADS, GLA_HK)
    o = gla_chunked(q, k, v, logg)
    o = rmsnorm(o, gla_norm).reshape(b, l, GLA_VAL) * jax.nn.silu(r)

    return jnp.concatenate([y, o], axis=-1) @ w_out


def alibi_slopes(n):
    start = 2.0 ** (-8.0 / n)
    return np.array([start ** (i + 1) for i in range(n)], dtype=np.float32)


def diff_attention(h, w_qkv, lam_q1, lam_k1, lam_q2, lam_k2, subln, w_o, lambda_init):
    f32 = jnp.float32
    b, l, _ = h.shape
    qkv = h @ w_qkv
    q, k, v = jnp.split(qkv, [DIFF_QK, 2 * DIFF_QK], axis=-1)
    q = q.reshape(b, l, DIFF_HEADS, 2, DIFF_HEAD_DIM) * (DIFF_HEAD_DIM ** -0.5)
    k = k.reshape(b, l, DIFF_HEADS, 2, DIFF_HEAD_DIM)
    v = v.reshape(b, l, DIFF_HEADS, DIFF_V_DIM)
    lam = (jnp.exp(jnp.sum(lam_q1.astype(f32) * lam_k1.astype(f32)))
           - jnp.exp(jnp.sum(lam_q2.astype(f32) * lam_k2.astype(f32))) + lambda_init)
    slopes = jnp.asarray(alibi_slopes(DIFF_HEADS))[:, None, None]
    nb = l // Q_BLOCK
    qb = jnp.moveaxis(q.reshape(b, nb, Q_BLOCK, DIFF_HEADS, 2, DIFF_HEAD_DIM), 1, 0)
    kpos = jnp.arange(l)

    def block(args):
        qblk, i = args
        qpos = i * Q_BLOCK + jnp.arange(Q_BLOCK)
        dist = (qpos[:, None] - kpos[None, :]).astype(f32)
        bias = jnp.where(dist >= 0, -slopes * dist, -jnp.inf)
        s = jnp.einsum("bqhmd,bkhmd->bhmqk", qblk, k).astype(f32) + bias[None, :, None]
        p = jax.nn.softmax(s, axis=-1)
        attn = p[:, :, 0] - lam * p[:, :, 1]
        return jnp.einsum("bhqk,bkhv->bqhv", attn.astype(v.dtype), v)

    o = from_chunks(lax.map(block, (qb, jnp.arange(nb))))
    o = rmsnorm(o, subln) * (1.0 - lambda_init)
    return o.reshape(b, l, DIFF_HEADS * DIFF_V_DIM) @ w_o


def cross_attention(h, mem_n, wq, wkv, wo):
    b, l, _ = h.shape
    m = mem_n.shape[1]
    q = (h @ wq).reshape(b, l, X_HEADS, X_HEAD_DIM)
    k, v = jnp.split(mem_n @ wkv, 2, axis=-1)
    k = k.reshape(b, m, X_HEADS, X_HEAD_DIM)
    v = v.reshape(b, m, X_HEADS, X_HEAD_DIM)
    s = jnp.einsum("bqhd,bmhd->bhqm", q, k).astype(jnp.float32) * (X_HEAD_DIM ** -0.5)
    p = jax.nn.softmax(s, axis=-1)
    o = jnp.einsum("bhqm,bmhd->bqhd", p.astype(v.dtype), v)
    return o.reshape(b, l, D_MODEL) @ wo


def sq_relu_mlp(h, w1, w2):
    return jnp.square(jax.nn.relu(h @ w1)) @ w2


def setup_inputs(seed: int = 0) -> dict:
    key = jax.random.key(seed)
    ks = iter(jax.random.split(key, 40))

    def nrm(shape, scale):
        return jax.random.normal(next(ks), shape, jnp.float32) * scale

    def gain(shape):
        return 1.0 + nrm(shape, 0.02)

    x = nrm((BATCH, SEQ, D_MODEL), 1.0)
    mem = nrm((BATCH, N_MEM, D_MODEL), 1.0)
    ev_norm = gain((N_EVEN, D_MODEL))
    ev_w_in = nrm((N_EVEN, D_MODEL, IN_WIDTH), D_MODEL ** -0.5)
    ev_conv_w = nrm((N_EVEN, SSD_CONV, SSD_XBC), SSD_CONV ** -0.5)
    ev_conv_b = nrm((N_EVEN, SSD_XBC), 0.01)
    dt0 = jnp.exp(jax.random.uniform(next(ks), (N_EVEN, SSD_HEADS), jnp.float32,
                                     minval=math.log(1e-3), maxval=math.log(1e-1)))
    ev_dt_bias = dt0 + jnp.log(-jnp.expm1(-dt0))
    ev_a_log = jnp.log(jax.random.uniform(next(ks), (N_EVEN, SSD_HEADS), jnp.float32, minval=1.0, maxval=16.0))
    ev_d_skip = gain((N_EVEN, SSD_HEADS))
    ev_ssd_norm = gain((N_EVEN, SSD_INNER))
    ev_gla_w2 = nrm((N_EVEN, GLA_RANK, GLA_KEY), GLA_RANK ** -0.5)
    ev_gla_b = nrm((N_EVEN, GLA_KEY), 0.1)
    ev_gla_norm = gain((N_EVEN, GLA_HV))
    ev_w_out = nrm((N_EVEN, MIX_WIDTH, D_MODEL), MIX_WIDTH ** -0.5)
    od_norm = gain((N_ODD, D_MODEL))
    od_w_qkv = nrm((N_ODD, D_MODEL, DIFF_QKV), D_MODEL ** -0.5)
    od_lam_q1 = nrm((N_ODD, DIFF_HEAD_DIM), 0.1)
    od_lam_k1 = nrm((N_ODD, DIFF_HEAD_DIM), 0.1)
    od_lam_q2 = nrm((N_ODD, DIFF_HEAD_DIM), 0.1)
    od_lam_k2 = nrm((N_ODD, DIFF_HEAD_DIM), 0.1)
    od_subln = gain((N_ODD, DIFF_V_DIM))
    od_w_o = nrm((N_ODD, DIFF_HEADS * DIFF_V_DIM, D_MODEL), (DIFF_HEADS * DIFF_V_DIM) ** -0.5)
    xa_norm = gain((DEPTH, D_MODEL))
    xa_mem_norm = gain((DEPTH, D_MODEL))
    xa_wq = nrm((DEPTH, D_MODEL, D_MODEL), D_MODEL ** -0.5)
    xa_wkv = nrm((DEPTH, D_MODEL, 2 * D_MODEL), D_MODEL ** -0.5)
    xa_wo = nrm((DEPTH, D_MODEL, D_MODEL), D_MODEL ** -0.5)
    mlp_norm = gain((DEPTH, D_MODEL))
    mlp_w1 = nrm((DEPTH, D_MODEL, D_FF), D_MODEL ** -0.5)
    mlp_w2 = nrm((DEPTH, D_FF, D_MODEL), D_FF ** -0.5)
    final_norm = gain((D_MODEL,))
    return {"x": x, "mem": mem,
            "ev_norm": ev_norm, "ev_w_in": ev_w_in, "ev_conv_w": ev_conv_w, "ev_conv_b": ev_conv_b,
            "ev_dt_bias": ev_dt_bias, "ev_a_log": ev_a_log, "ev_d_skip": ev_d_skip, "ev_ssd_norm": ev_ssd_norm,
            "ev_gla_w2": ev_gla_w2, "ev_gla_b": ev_gla_b, "ev_gla_norm": ev_gla_norm, "ev_w_out": ev_w_out,
            "od_norm": od_norm, "od_w_qkv": od_w_qkv, "od_lam_q1": od_lam_q1, "od_lam_k1": od_lam_k1,
            "od_lam_q2": od_lam_q2, "od_lam_k2": od_lam_k2, "od_subln": od_subln, "od_w_o": od_w_o,
            "xa_norm": xa_norm, "xa_mem_norm": xa_mem_norm, "xa_wq": xa_wq, "xa_wkv": xa_wkv, "xa_wo": xa_wo,
            "mlp_norm": mlp_norm, "mlp_w1": mlp_w1, "mlp_w2": mlp_w2, "final_norm": final_norm}


def reference(x, mem, ev_norm, ev_w_in, ev_conv_w, ev_conv_b, ev_dt_bias, ev_a_log, ev_d_skip, ev_ssd_norm,
              ev_gla_w2, ev_gla_b, ev_gla_norm, ev_w_out, od_norm, od_w_qkv, od_lam_q1, od_lam_k1, od_lam_q2,
              od_lam_k2, od_subln, od_w_o, xa_norm, xa_mem_norm, xa_wq, xa_wkv, xa_wo, mlp_norm, mlp_w1,
              mlp_w2, final_norm):
    for layer in range(DEPTH):
        i = layer // 2
        if layer % 2 == 0:
            x = x + ssd_gla_mixer(rmsnorm(x, ev_norm[i]), ev_w_in[i], ev_conv_w[i], ev_conv_b[i],
                                  ev_dt_bias[i], ev_a_log[i], ev_d_skip[i], ev_ssd_norm[i],
                                  ev_gla_w2[i], ev_gla_b[i], ev_gla_norm[i], ev_w_out[i])
        else:
            lambda_init = 0.8 - 0.6 * math.exp(-0.3 * layer)
            x = x + diff_attention(rmsnorm(x, od_norm[i]), od_w_qkv[i], od_lam_q1[i], od_lam_k1[i],
                                   od_lam_q2[i], od_lam_k2[i], od_subln[i], od_w_o[i], lambda_init)
        x = x + cross_attention(rmsnorm(x, xa_norm[layer]), rmsnorm(mem, xa_mem_norm[layer]),
                                xa_wq[layer], xa_wkv[layer], xa_wo[layer])
        x = x + sq_relu_mlp(rmsnorm(x, mlp_norm[layer]), mlp_w1[layer], mlp_w2[layer])
    return rmsnorm(x, final_norm)
```

```cpp
#include <hip/hip_runtime.h>
#include <hip/hip_cooperative_groups.h>
#include <cstdio>
#include <cstdint>
#include <cmath>
namespace cg = cooperative_groups;

namespace pg8 {
#define PG8_LAS __attribute__((address_space(3)))
typedef unsigned short bf16_t;
typedef short bf16x8 __attribute__((ext_vector_type(8)));
typedef float f32x4 __attribute__((ext_vector_type(4)));
typedef unsigned u32x4 __attribute__((ext_vector_type(4)));
constexpr int BM = 256, BK = 64, HALF = 128, HTB = HALF * BK * 2, STAGE_BYTES = 8 * HTB, NXCD = 8, WGM = 8;

__host__ __device__ __forceinline__ int lds_byte(int r, int c) { const int st = (r >> 4) * 2 + (c >> 5), rr = r & 15, cc = c & 31, ob = rr * 64 + cc * 2; return st * 1024 + (ob ^ (((ob >> 9) & 1) << 5)); }
__host__ __device__ __forceinline__ void stage_rc(int b, int& R, int& C) { const int st = b / 1024, sb = b % 1024, swz = sb ^ (((sb >> 9) & 1) << 5); R = (st >> 1) * 16 + swz / 64; C = (st & 1) * 32 + (swz % 64) / 2; }
__host__ __device__ __forceinline__ int perm32(int rho) { const int n = rho >> 4, i = rho & 15; return 8 * (i >> 2) + 4 * n + (i & 3); }

struct Unit { int pm, pn; };
struct Gemm { const bf16_t* A; const bf16_t* Bt; int M, N, K, lda, ldb; long a_pn, b_pn, b_b; int pm_per_b; };

struct StaticOrder {
    int nM, nN, nwg, G, c;
    __host__ __device__ void init(int M, int N, int G_, int c_) { nM = M / BM; nN = N / BM; nwg = nM * nN; G = G_; c = c_; }
    __host__ __device__ bool next(int i, Unit& u) const {
        const long L = (long)i * G + c; if (L >= nwg) return false;
        int wgid = (int)L; { const int q = nwg / NXCD, r = nwg % NXCD, xcd = wgid % NXCD, off = wgid / NXCD; wgid = (xcd < r ? xcd * (q + 1) : r * (q + 1) + (xcd - r) * q) + off; }
        const int nig = WGM * nN, gid = wgid / nig, fm = gid * WGM, gsz = (nM - fm) < WGM ? (nM - fm) : WGM;
        u.pm = fm + ((wgid % nig) % gsz); u.pn = (wgid % nig) / gsz; return true;
    }
    __device__ __forceinline__ void ptrs(const Unit& u, const Gemm& g, const char*& a, const char*& b) const {
        a = (const char*)(g.A + (size_t)u.pm * BM * g.lda + (size_t)u.pn * g.a_pn);
        b = (const char*)(g.Bt + (size_t)u.pn * g.b_pn + (size_t)(u.pm / g.pm_per_b) * g.b_b);
    }
    __device__ __forceinline__ void a_ready(const Unit&) const {}
    __device__ __forceinline__ void done(const Unit&) const {}
};

__device__ __forceinline__ unsigned cvt_pk_bf16(float lo, float hi) { unsigned r; asm volatile("v_cvt_pk_bf16_f32 %0, %1, %2" : "=v"(r) : "v"(lo), "v"(hi)); return r; }

struct EpiU {
    static constexpr bool PERM = true, AFTER_DRAIN = false;
    int mode;
    bf16_t* O; int ldc; int act; int scale_cols; float scale;
    float* small_out; int small_pn;
    const float* base; float* outf;
    __device__ __forceinline__ void operator()(const f32x4 (&acc)[2][2][4][2], const Unit& u, int wr, int wc, int fr, int fq) const {
        const int row0 = u.pm * BM + wr * 64 + fr; const int col0 = u.pn * BM + wc * 32 + 8 * fq;
        if (mode == 0) {
            if (small_out && u.pn == small_pn) {
                if (wc == 0) {
#pragma unroll
                    for (int ai = 0; ai < 2; ++ai)
#pragma unroll
                        for (int m = 0; m < 4; ++m) { float* p = small_out + (size_t)(row0 + ai * HALF + m * 16) * 32 + 8 * fq; *(f32x4*)p = acc[ai][0][m][0]; *(f32x4*)(p + 4) = acc[ai][0][m][1]; }
                }
                return;
            }
#pragma unroll
            for (int ai = 0; ai < 2; ++ai)
#pragma unroll
                for (int m = 0; m < 4; ++m) { bf16_t* rowp = O + (size_t)(row0 + ai * HALF + m * 16) * ldc + col0;
#pragma unroll
                    for (int bj = 0; bj < 2; ++bj) { f32x4 v0 = acc[ai][bj][m][0], v1 = acc[ai][bj][m][1];
                        if (act == 1) {
#pragma unroll
                            for (int e = 0; e < 4; ++e) { float t0 = fmaxf(v0[e], 0.f), t1 = fmaxf(v1[e], 0.f); v0[e] = t0 * t0; v1[e] = t1 * t1; } }
                        const float sc = (col0 + bj * HALF < scale_cols) ? scale : 1.f;
                        v0 = v0 * sc; v1 = v1 * sc; u32x4 w; w.x = cvt_pk_bf16(v0[0], v0[1]); w.y = cvt_pk_bf16(v0[2], v0[3]); w.z = cvt_pk_bf16(v1[0], v1[1]); w.w = cvt_pk_bf16(v1[2], v1[3]);
                        *(u32x4*)(rowp + bj * HALF) = w; } }
        } else {
#pragma unroll
            for (int ai = 0; ai < 2; ++ai)
#pragma unroll
                for (int m = 0; m < 4; ++m) { const size_t off = (size_t)(row0 + ai * HALF + m * 16) * ldc + col0;
#pragma unroll
                    for (int bj = 0; bj < 2; ++bj) { const float* bp = base + off + bj * HALF; float* op = outf + off + bj * HALF;
                        const f32x4 b0 = *(const f32x4*)bp, b1 = *(const f32x4*)(bp + 4);
                        *(f32x4*)op = b0 + acc[ai][bj][m][0]; *(f32x4*)(op + 4) = b1 + acc[ai][bj][m][1]; } }
        }
    }
};

template <class Epi, class Sched, bool ALIGN_EPI = false, bool SP2 = false>
__device__ __forceinline__ void gemm_phase(PG8_LAS unsigned char* lds, const Gemm g, const Sched& S, const Epi& E, const int tid) {
    const int wid = __builtin_amdgcn_readfirstlane(tid >> 6), lane = tid & 63, wr = wid >> 2, wc = wid & 3, fr = lane & 15, fq = lane >> 4;
    const int K = g.K, nt = K / BK;
    unsigned voffA[2], voffB[2];
#pragma unroll
    for (int i = 0; i < 2; ++i) { int R, C; stage_rc(tid * 16 + i * 8192, R, C); const int Rb = Epi::PERM ? ((R & ~31) + perm32(R & 31)) : R;
        voffA[i] = (unsigned)(R * g.lda + C) * 2u; voffB[i] = (unsigned)(Rb * g.ldb + C) * 2u; }
    const size_t kstep = (size_t)(BK * 2);
    const size_t hstepA = (size_t)HALF * g.lda * 2, hstepB = (size_t)HALF * g.ldb * 2;
    const unsigned ldsw = (unsigned)wid * 1024u;
    const int aoff = lds_byte(wr * 64 + fr, fq * 8), boff = lds_byte(wc * 32 + fr, fq * 8);
#define PG8_SA(b, h) (((b) * 2 + (h)) * HTB)
#define PG8_SB(b, h) ((4 + (b) * 2 + (h)) * HTB)
#define PG8_STAGE(bufoff, gbase, voff) do { _Pragma("unroll") for (int _i = 0; _i < 2; ++_i) \
        __builtin_amdgcn_global_load_lds((const unsigned*)((const char*)(gbase) + (voff)[_i]), (PG8_LAS unsigned*)(lds + (bufoff) + ldsw + _i * 8192), 16, 0, 0); } while (0)
#define PG8_LDA(dst, b, h) do { _Pragma("unroll") for (int m = 0; m < 4; ++m) _Pragma("unroll") for (int k = 0; k < 2; ++k) dst[m][k] = *(const PG8_LAS bf16x8*)(lds + PG8_SA(b, h) + aoff + m * 2048 + k * 1024); } while (0)
#define PG8_LDB(dst, b, h) do { _Pragma("unroll") for (int n = 0; n < 2; ++n) _Pragma("unroll") for (int k = 0; k < 2; ++k) dst[n][k] = *(const PG8_LAS bf16x8*)(lds + PG8_SB(b, h) + boff + n * 2048 + k * 1024); } while (0)
#define PG8_MMA(ai, bj, At, Bt) do { __builtin_amdgcn_s_setprio(1); _Pragma("unroll") for (int m = 0; m < 4; ++m) _Pragma("unroll") for (int n = 0; n < 2; ++n) _Pragma("unroll") for (int k = 0; k < 2; ++k) \
        acc[ai][bj][m][n] = __builtin_amdgcn_mfma_f32_16x16x32_bf16(Bt[n][k], At[m][k], acc[ai][bj][m][n], 0, 0, 0); __builtin_amdgcn_s_setprio(0); } while (0)
#define PG8_WAIT_V(n) asm volatile("s_waitcnt vmcnt(" #n ")" ::: "memory")
#define PG8_WAIT_L(n) asm volatile("s_waitcnt lgkmcnt(" #n ")" ::: "memory")
#define PG8_BAR __builtin_amdgcn_s_barrier()
#define PG8_SCHED __builtin_amdgcn_sched_barrier(0)
    Unit cur, nxt; int ui = 0;
    if (!S.next(0, cur)) return;
    f32x4 acc[2][2][4][2];
#pragma unroll
    for (int a = 0; a < 2; ++a)
#pragma unroll
        for (int b = 0; b < 2; ++b)
#pragma unroll
            for (int m = 0; m < 4; ++m)
#pragma unroll
                for (int n = 0; n < 2; ++n) acc[a][b][m][n] = (f32x4){0.f, 0.f, 0.f, 0.f};
    bf16x8 At[4][2], B0[2][2], B1[2][2];
    const char* cA; const char* cB; S.ptrs(cur, g, cA, cB);
    S.a_ready(cur);
    if constexpr (SP2) {
        PG8_STAGE(PG8_SB(0, 0), cB, voffB); PG8_STAGE(PG8_SB(0, 1), cB + hstepB, voffB); PG8_STAGE(PG8_SA(0, 0), cA, voffA); PG8_STAGE(PG8_SA(0, 1), cA + hstepA, voffA);
        if (wr == 1) PG8_BAR;
        PG8_WAIT_V(2); PG8_BAR;
        PG8_STAGE(PG8_SB(1, 0), cB + kstep, voffB); PG8_STAGE(PG8_SA(1, 0), cA + kstep, voffA); PG8_STAGE(PG8_SB(1, 1), cB + hstepB + kstep, voffB);
        PG8_WAIT_V(6); PG8_BAR;
    } else {
        PG8_STAGE(PG8_SB(0, 0), cB, voffB); PG8_STAGE(PG8_SA(0, 0), cA, voffA); PG8_STAGE(PG8_SB(0, 1), cB + hstepB, voffB); PG8_STAGE(PG8_SA(0, 1), cA + hstepA, voffA);
        if (wr == 1) PG8_BAR;
        PG8_WAIT_V(4); PG8_BAR;
        PG8_STAGE(PG8_SB(1, 0), cB + kstep, voffB); PG8_STAGE(PG8_SA(1, 0), cA + kstep, voffA); PG8_STAGE(PG8_SB(1, 1), cB + hstepB + kstep, voffB);
        PG8_WAIT_V(6); PG8_BAR;
    }
    for (;;) {
        const bool has_next = S.next(ui + 1, nxt);
        const char* nA = cA; const char* nB = cB; if (has_next) S.ptrs(nxt, g, nA, nB);
        for (int t = 0; t < nt; t += 2) {
            const bool last = (t == nt - 2);
            const char* a1 = cA + (size_t)(t + 1) * kstep;
            const char* a2 = last ? nA : cA + (size_t)(t + 2) * kstep; const char* b2 = last ? nB : cB + (size_t)(t + 2) * kstep;
            const char* a3 = a2 + kstep; const char* b3 = b2 + kstep;
            if (last && has_next) S.a_ready(nxt);
            if constexpr (SP2) {
            PG8_LDB(B0, 0, 0); PG8_LDB(B1, 0, 1); PG8_SCHED; PG8_LDA(At, 0, 0); PG8_STAGE(PG8_SA(1, 1), a1 + hstepA, voffA);
            PG8_WAIT_V(8); PG8_WAIT_L(0); PG8_BAR; PG8_MMA(0, 0, At, B0); PG8_MMA(0, 1, At, B1); PG8_BAR; PG8_SCHED;
            PG8_LDA(At, 0, 1); PG8_STAGE(PG8_SB(0, 0), b2, voffB); PG8_STAGE(PG8_SB(0, 1), b2 + hstepB, voffB); PG8_STAGE(PG8_SA(0, 0), a2, voffA);
            PG8_WAIT_V(8); PG8_WAIT_L(0); PG8_BAR; PG8_MMA(1, 0, At, B0); PG8_MMA(1, 1, At, B1); PG8_BAR; PG8_SCHED;
            PG8_LDB(B0, 1, 0); PG8_LDB(B1, 1, 1); PG8_SCHED; PG8_LDA(At, 1, 0); PG8_STAGE(PG8_SA(0, 1), a2 + hstepA, voffA);
            PG8_WAIT_V(8); PG8_WAIT_L(0); PG8_BAR; PG8_MMA(0, 0, At, B0); PG8_MMA(0, 1, At, B1); PG8_BAR; PG8_SCHED;
            PG8_LDA(At, 1, 1); PG8_STAGE(PG8_SB(1, 0), b3, voffB); PG8_STAGE(PG8_SB(1, 1), b3 + hstepB, voffB); PG8_STAGE(PG8_SA(1, 0), a3, voffA);
            PG8_WAIT_V(8); PG8_WAIT_L(0); PG8_BAR; PG8_MMA(1, 0, At, B0); PG8_MMA(1, 1, At, B1); PG8_BAR; PG8_SCHED;
            } else {
            PG8_LDB(B0, 0, 0); PG8_SCHED; PG8_LDA(At, 0, 0); PG8_STAGE(PG8_SA(1, 1), a1 + hstepA, voffA);
            PG8_WAIT_L(8); PG8_BAR; PG8_WAIT_L(0); PG8_MMA(0, 0, At, B0); PG8_BAR; PG8_SCHED;
            PG8_LDB(B1, 0, 1); PG8_STAGE(PG8_SB(0, 0), b2, voffB);
            PG8_BAR; PG8_WAIT_L(0); PG8_MMA(0, 1, At, B1); PG8_BAR;
            PG8_LDA(At, 0, 1); PG8_STAGE(PG8_SA(0, 0), a2, voffA);
            PG8_BAR; PG8_WAIT_L(0); PG8_MMA(1, 0, At, B0); PG8_BAR; PG8_SCHED;
            PG8_STAGE(PG8_SB(0, 1), b2 + hstepB, voffB);
            PG8_WAIT_V(6); PG8_BAR; PG8_MMA(1, 1, At, B1); PG8_BAR;
            PG8_LDB(B0, 1, 0); PG8_SCHED; PG8_LDA(At, 1, 0); PG8_STAGE(PG8_SA(0, 1), a2 + hstepA, voffA);
            PG8_WAIT_L(8); PG8_BAR; PG8_WAIT_L(0); PG8_MMA(0, 0, At, B0); PG8_BAR; PG8_SCHED;
            PG8_LDB(B1, 1, 1); PG8_STAGE(PG8_SB(1, 0), b3, voffB);
            PG8_BAR; PG8_WAIT_L(0); PG8_MMA(0, 1, At, B1); PG8_BAR;
            PG8_LDA(At, 1, 1); PG8_STAGE(PG8_SA(1, 0), a3, voffA);
            PG8_BAR; PG8_WAIT_L(0); PG8_MMA(1, 0, At, B0); PG8_BAR; PG8_SCHED;
            PG8_STAGE(PG8_SB(1, 1), b3 + hstepB, voffB);
            PG8_WAIT_V(6); PG8_BAR; PG8_MMA(1, 1, At, B1); PG8_BAR;
            }
        }
        if constexpr (ALIGN_EPI) { if (wr == 0) PG8_BAR; }
        if constexpr (!Epi::AFTER_DRAIN) { E(acc, cur, wr, wc, fr, fq); S.done(cur); }
        if (!has_next) break;
#pragma unroll
        for (int a = 0; a < 2; ++a)
#pragma unroll
            for (int b = 0; b < 2; ++b)
#pragma unroll
                for (int m = 0; m < 4; ++m)
#pragma unroll
                    for (int n = 0; n < 2; ++n) acc[a][b][m][n] = (f32x4){0.f, 0.f, 0.f, 0.f};
        cur = nxt; cA = nA; cB = nB; ++ui;
        if constexpr (ALIGN_EPI) { if (wr == 1) PG8_BAR; }
    }
    PG8_WAIT_V(0);
    if constexpr (!ALIGN_EPI) { if (wr == 0) PG8_BAR; }
    PG8_BAR;
    if constexpr (Epi::AFTER_DRAIN) { E.fused(acc, cur, wr, wc, fr, fq, lds, wid, lane); S.done(cur); }
#undef PG8_SA
#undef PG8_SB
#undef PG8_STAGE
#undef PG8_LDA
#undef PG8_LDB
#undef PG8_MMA
#undef PG8_WAIT_V
#undef PG8_WAIT_L
#undef PG8_BAR
#undef PG8_SCHED
}
}

#define LAS __attribute__((address_space(3)))
#define DI __device__ __forceinline__
typedef unsigned short bf16;
typedef short bf16x8 __attribute__((ext_vector_type(8)));
typedef short s16x4 __attribute__((ext_vector_type(4)));
typedef float f32x4 __attribute__((ext_vector_type(4)));
typedef float f32x16 __attribute__((ext_vector_type(16)));
typedef unsigned u32x4 __attribute__((ext_vector_type(4)));
typedef unsigned u32x2 __attribute__((ext_vector_type(2)));
typedef LAS unsigned char* ldsp;

constexpr int T_ = 32768, L_ = 16384, D_ = 1024;
constexpr float EPS_ = 1e-5f;
constexpr size_t MiB = (size_t)1 << 20;
constexpr size_t WS_W = 1 * MiB;
constexpr size_t WS_WA = WS_W, WS_WV = WS_W + 9 * MiB, WS_WOUT = WS_W + 11 * MiB, WS_WQ = WS_W + 15 * MiB, WS_WKV = WS_W + 17 * MiB,
                 WS_WXO = WS_W + 21 * MiB, WS_W1 = WS_W + 23 * MiB, WS_W2 = WS_W + 31 * MiB;
constexpr size_t WS_XN = 40 * MiB, WS_KT = WS_XN, WS_DG = WS_XN + 33 * MiB;
constexpr size_t WS_BIG = 104 * MiB, WS_VT = 376 * MiB, WS_ORAW = 441 * MiB, WS_SMALL = 505 * MiB, WS_MEMN = 509 * MiB, WS_KX = 510 * MiB, WS_VXT = 511 * MiB, WS_END = 512 * MiB;
constexpr int PROJ_LD = 4352;
constexpr int PC_Z = 0, PC_XBC = 1024, PC_Q = 2304, PC_K = 2816, PC_R = 3328;
constexpr int LDS_BYTES = 136 * 1024;
constexpr int VT_LD = T_ + 64, KT_LD = T_ + 64, QK_LD = 2048 + 64;

DI unsigned f2bf(float f) { unsigned u = __builtin_bit_cast(unsigned, f); return (u + 0x7fffu + ((u >> 16) & 1u)) >> 16; }
typedef float f32x2_t __attribute__((ext_vector_type(2))); typedef __bf16 bf16x2_t __attribute__((ext_vector_type(2)));
DI unsigned pk2(float lo, float hi) { f32x2_t v = {lo, hi}; bf16x2_t b = __builtin_convertvector(v, bf16x2_t); return __builtin_bit_cast(unsigned, b); }
DI float bf2f(unsigned h) { return __builtin_bit_cast(float, h << 16); }
DI float bflo(unsigned w) { return __builtin_bit_cast(float, w << 16); }
DI float bfhi(unsigned w) { return __builtin_bit_cast(float, w & 0xffff0000u); }
DI float wave_sum(float v) {
#pragma unroll
    for (int o = 1; o < 64; o <<= 1) v += __shfl_xor(v, o);
    return v;
}
DI float wave_max(float v) {
#pragma unroll
    for (int o = 1; o < 64; o <<= 1) v = fmaxf(v, __shfl_xor(v, o));
    return v;
}
DI float siluf(float x) { return x * __builtin_amdgcn_rcpf(1.f + __builtin_amdgcn_exp2f(-1.4426950408889634f * x)); }
DI float softplusf(float x) {
    const float e = __expf(-fabsf(x));
    const float l = (e < 0.01f) ? e * (1.f - e * (0.5f - e * (1.f / 3.f))) : __logf(1.f + e);
    return fmaxf(x, 0.f) + l;
}
DI bf16x8 lds16(ldsp p, int off) { return *(LAS bf16x8*)(p + off); }
DI s16x4 lds8(ldsp p, int off) { return *(LAS s16x4*)(p + off); }
DI bf16x8 cat8(s16x4 a, s16x4 b) { return __builtin_shufflevector(a, b, 0, 1, 2, 3, 4, 5, 6, 7); }
DI f32x4 mfma16(bf16x8 a, bf16x8 b, f32x4 c) { return __builtin_amdgcn_mfma_f32_16x16x32_bf16(a, b, c, 0, 0, 0); }
DI f32x16 mfma32(bf16x8 a, bf16x8 b, f32x16 c) { return __builtin_amdgcn_mfma_f32_32x32x16_bf16(a, b, c, 0, 0, 0); }
DI int crow(int r, int hi) { return (r & 3) + 8 * (r >> 2) + 4 * hi; }
DI float max3f(float a, float b, float c) { float r; asm("v_max3_f32 %0, %1, %2, %3" : "=v"(r) : "v"(a), "v"(b), "v"(c)); return r; }
#define LDS_FENCE() asm volatile("s_waitcnt lgkmcnt(0)" ::: "memory")

DI void rms_rows_bf16(const float* x, const float* w, bf16* out, int nrows, int gw, int NGW, int lane) {
    for (int m = 2 * gw; m < nrows; m += 2 * NGW) {
        const f32x4* xr0 = (const f32x4*)(x + (size_t)m * D_) + lane; const f32x4* xr1 = xr0 + D_ / 4;
        f32x4 v0[4], v1[4]; float s0 = 0.f, s1 = 0.f;
#pragma unroll
        for (int j = 0; j < 4; ++j) { v0[j] = xr0[64 * j]; v1[j] = xr1[64 * j]; }
#pragma unroll
        for (int j = 0; j < 4; ++j) { s0 += (v0[j].x * v0[j].x + v0[j].y * v0[j].y) + (v0[j].z * v0[j].z + v0[j].w * v0[j].w); s1 += (v1[j].x * v1[j].x + v1[j].y * v1[j].y) + (v1[j].z * v1[j].z + v1[j].w * v1[j].w); }
#pragma unroll
        for (int o = 1; o < 64; o <<= 1) { s0 += __shfl_xor(s0, o); s1 += __shfl_xor(s1, o); }
        const float r0 = rsqrtf(s0 * (1.f / D_) + EPS_), r1 = rsqrtf(s1 * (1.f / D_) + EPS_);
        u32x2* o0 = (u32x2*)(out + (size_t)m * D_) + lane; u32x2* o1 = o0 + D_ / 4;
#pragma unroll
        for (int j = 0; j < 4; ++j) { const f32x4 wv = ((const f32x4*)w)[lane + 64 * j];
            u32x2 a, b; a.x = pk2(v0[j].x * r0 * wv.x, v0[j].y * r0 * wv.y); a.y = pk2(v0[j].z * r0 * wv.z, v0[j].w * r0 * wv.w);
            b.x = pk2(v1[j].x * r1 * wv.x, v1[j].y * r1 * wv.y); b.y = pk2(v1[j].z * r1 * wv.z, v1[j].w * r1 * wv.w);
            o0[64 * j] = a; o1[64 * j] = b; }
    }
}
DI void rms_rows_f32_inplace(float* x, const float* w, int nrows, int gw, int NGW, int lane) {
    for (int m = gw; m < nrows; m += NGW) {
        f32x4* xr = (f32x4*)(x + (size_t)m * D_) + lane;
        f32x4 v[4]; float s = 0.f;
#pragma unroll
        for (int j = 0; j < 4; ++j) { v[j] = xr[64 * j]; s += (v[j].x * v[j].x + v[j].y * v[j].y) + (v[j].z * v[j].z + v[j].w * v[j].w); }
        const float rstd = rsqrtf(wave_sum(s) * (1.f / D_) + EPS_);
#pragma unroll
        for (int j = 0; j < 4; ++j) { const f32x4 wv = ((const f32x4*)w)[lane + 64 * j]; xr[64 * j] = v[j] * rstd * wv; }
    }
}

DI int map_plain(int d, int off) { return d + off; }
DI int map_win(int d) { if (d < 2304) return d; if (d < 3328) return d + 16; if (d < 4352) return d + 1056; if (d < 4368) return d - 4352 + 2304; if (d < 4384) return d; return -1; }
DI void conv_item(const float* W, int ldn, int K, bf16* WT, int nrows, int mode, int off, LAS float* scr, int item, int lane) {
    const int nblk = nrows / 32, kb = item / nblk, nb = item % nblk, k0 = 64 * kb, n0 = 32 * nb;
    const int d = n0 + (lane & 31); const int sc = mode ? map_win(d) : map_plain(d, off);
#pragma unroll 8
    for (int i = 0; i < 32; ++i) { const int kk = 2 * i + (lane >> 5); scr[kk * 33 + (lane & 31)] = sc >= 0 ? W[(size_t)(k0 + kk) * ldn + sc] : 0.f; }
    LDS_FENCE();
    const int c = lane & 7;
#pragma unroll
    for (int j = 0; j < 4; ++j) { const int n = (lane >> 3) + 8 * j; const LAS float* s = scr + (8 * c) * 33 + n;
        u32x4 o; o.x = pk2(s[0 * 33], s[1 * 33]); o.y = pk2(s[2 * 33], s[3 * 33]); o.z = pk2(s[4 * 33], s[5 * 33]); o.w = pk2(s[6 * 33], s[7 * 33]);
        *(u32x4*)(WT + (size_t)(n0 + n) * K + k0 + 8 * c) = o; }
    LDS_FENCE();
}

DI void prep_unit(int unit, bf16* PROJ, float* SMALL, bf16* KT, float* DG, bf16* TAIL, const float* gla_w2, const float* gla_b, const float* dt_bias, const float* a_log,
                  const float* conv_w, const float* conv_b, ldsp lds, int tid) {
    asm volatile("" : "+v"(tid));
    const int rowbase = unit * 128;
    LAS float* sm = (LAS float*)lds; LAS float* dtL = (LAS float*)(lds + 16384);
    for (int i = tid; i < 128 * 32 / 4; i += 512) ((LAS f32x4*)sm)[i] = ((const f32x4*)(SMALL + (size_t)rowbase * 32))[i];
    __syncthreads();
    if (tid < 16) {
        const int h = tid; const float a = -__expf(a_log[h]), bias = dt_bias[h]; float cum = 0.f;
        for (int tt = 0; tt < 128; ++tt) { const float dtv = softplusf(sm[tt * 32 + h] + bias); cum += dtv * a; dtL[tt * 16 + h] = dtv;
            SMALL[((size_t)rowbase + tt) * 32 + h] = dtv; SMALL[((size_t)rowbase + tt) * 32 + 16 + h] = cum; }
    }
    {   const int col = tid;
        float w2c[16];
#pragma unroll
        for (int r = 0; r < 16; ++r) w2c[r] = gla_w2[r * 512 + col];
        const float bcol = gla_b[col];
        for (int sub = 0; sub < 2; ++sub) {
            float cum = 0.f;
#pragma unroll 1
            for (int g8 = 0; g8 < 8; ++g8) {
                unsigned qk[8];
                { const bf16* pq = PROJ + ((size_t)rowbase + sub * 64 + g8 * 8) * PROJ_LD + col;
#pragma unroll
                  for (int e = 0; e < 8; ++e) qk[e] = (unsigned)pq[(size_t)e * PROJ_LD + PC_Q] | ((unsigned)pq[(size_t)e * PROJ_LD + PC_K] << 16); }
                float kt[8];
#pragma unroll
                for (int e = 0; e < 8; ++e) {
                    const int tt = sub * 64 + g8 * 8 + e; const size_t row = (size_t)rowbase + tt;
                    float x = bcol;
#pragma unroll
                    for (int r = 0; r < 16; ++r) x += sm[tt * 32 + 16 + r] * w2c[r];
                    const float lg = (fminf(x, 0.f) - __logf(1.f + __expf(-fabsf(x)))) * 0.0625f;
                    cum += lg;
                    const float qv = bflo(qk[e]), kv = bfhi(qk[e]);
                    PROJ[row * PROJ_LD + PC_Q + col] = (bf16)f2bf(qv * __expf(cum) * 0.08838834764831845f);
                    kt[e] = kv * __expf(-cum);
                    PROJ[row * PROJ_LD + PC_K + col] = (bf16)f2bf(kt[e]);
                }
                u32x4 o; o.x = pk2(kt[0], kt[1]); o.y = pk2(kt[2], kt[3]); o.z = pk2(kt[4], kt[5]); o.w = pk2(kt[6], kt[7]);
                *(u32x4*)(KT + (size_t)col * KT_LD + rowbase + sub * 64 + g8 * 8) = o;
            }
            DG[(size_t)((rowbase >> 6) + sub) * 512 + col] = __expf(cum);
        }
    }
    const int tin = rowbase & (L_ - 1);
    __syncthreads();
#pragma unroll 1
    for (int i = 4; i >= 0; --i) { const int it = tid + 512 * i, pair = it % 640, slab = it / 640, c0 = 2 * pair;
        unsigned rw[35];
        bf16* base = PROJ + ((size_t)rowbase + 32 * slab) * PROJ_LD + PC_XBC + c0;
#pragma unroll
        for (int j = 0; j < 35; ++j) rw[j] = (tin + 32 * slab - 3 + j >= 0) ? *(const unsigned*)(base + (ptrdiff_t)(j - 3) * PROJ_LD) : 0u;
        float cw0[4], cw1[4];
#pragma unroll
        for (int j = 0; j < 4; ++j) { cw0[j] = conv_w[j * 1280 + c0]; cw1[j] = conv_w[j * 1280 + c0 + 1]; }
        const float cb0 = conv_b[c0], cb1 = conv_b[c0 + 1];
        const bool isx = c0 < 1024; const int hh = (c0 >> 6) & 15;
        __syncthreads();
#pragma unroll
        for (int r = 0; r < 32; ++r) { float a0 = cb0, a1 = cb1;
#pragma unroll
            for (int j = 0; j < 4; ++j) { a0 += cw0[j] * bflo(rw[r + j]); a1 += cw1[j] * bfhi(rw[r + j]); }
            a0 = siluf(a0); a1 = siluf(a1);
            const int row = 32 * slab + r;
            if (isx) { const float d = dtL[row * 16 + hh]; a0 *= d; a1 *= d; }
            bf16* dst = (row >= 125) ? TAIL + ((size_t)unit * 3 + (row - 125)) * 1280 + c0 : base + (size_t)r * PROJ_LD;
            *(unsigned*)dst = pk2(a0, a1); }
    }
    __syncthreads();
}

#define BAR_LDS() asm volatile("s_waitcnt lgkmcnt(0)\n\ts_barrier" ::: "memory")
DI void ssd_chain(int b, int h, bf16* PROJ, const float* SMALL, const bf16* TAIL, const float* d_skip, ldsp lds, int tid) {
    constexpr int CS = 0, BS = 18432, BWT = 36864, XDT = 54272, MS = 71680, SS = 106496, CUML = 115712, DTL = 116224;
    asm volatile("" : "+v"(tid));
    const int lane = tid & 63, w = __builtin_amdgcn_readfirstlane(tid >> 6), quad = lane >> 4, l16 = lane & 15;
    const int g = h >> 3, cp = lane & 31, th = lane >> 5, tb = 16 * w + 8 * th;
    LAS float* cumL = (LAS float*)(lds + CUML); LAS float* dtL = (LAS float*)(lds + DTL);
    int ch[3]; ch[0] = h * 64 + 2 * cp; ch[1] = 1024 + g * 64 + 2 * cp; ch[2] = 1152 + g * 64 + 2 * cp;
    const float Dh = d_skip[h];
    const int pi = w >> 1, q = 16 * w + l16;
    f32x4 S[2]; S[0] = (f32x4){0.f, 0.f, 0.f, 0.f}; S[1] = S[0];
    unsigned raw[3][8]; float cmv[8], cum_last, cl_t = 0.f, dt_t = 0.f; u32x2 zz[4];
#define SSD_LOAD(c_) do { const size_t r0_ = (size_t)b * L_ + (size_t)(c_) * 128; \
        _Pragma("unroll") for (int i = 0; i < 8; ++i) cmv[i] = SMALL[(r0_ + tb + i) * 32 + 16 + h]; \
        cum_last = SMALL[(r0_ + 127) * 32 + 16 + h]; \
        if (tid < 128) { cl_t = SMALL[(r0_ + tid) * 32 + 16 + h]; dt_t = SMALL[(r0_ + tid) * 32 + h]; } \
        _Pragma("unroll") for (int arr = 0; arr < 3; ++arr) _Pragma("unroll") for (int i = 0; i < 8; ++i) { const int rr = tb + i; \
            const bf16* sp = (rr >= 125) ? TAIL + ((r0_ >> 7) * 3 + (rr - 125)) * 1280 + ch[arr] : PROJ + (r0_ + rr) * PROJ_LD + PC_XBC + ch[arr]; \
            raw[arr][i] = *(const unsigned*)sp; } \
        _Pragma("unroll") for (int pt = 0; pt < 4; ++pt) zz[pt] = *(const u32x2*)(PROJ + (r0_ + q) * PROJ_LD + PC_Z + h * 64 + 16 * pt + quad * 4); } while (0)
    SSD_LOAD(0);
    for (int c = 0; c < 128; ++c) {
        const size_t row0 = (size_t)b * L_ + (size_t)c * 128;
        if (tid < 128) { cumL[tid] = cl_t; dtL[tid] = dt_t; }
        {
            u32x4 v0, v1;
            v0.x = __builtin_amdgcn_perm(raw[0][1], raw[0][0], 0x05040100u); v0.y = __builtin_amdgcn_perm(raw[0][3], raw[0][2], 0x05040100u);
            v0.z = __builtin_amdgcn_perm(raw[0][5], raw[0][4], 0x05040100u); v0.w = __builtin_amdgcn_perm(raw[0][7], raw[0][6], 0x05040100u);
            v1.x = __builtin_amdgcn_perm(raw[0][1], raw[0][0], 0x07060302u); v1.y = __builtin_amdgcn_perm(raw[0][3], raw[0][2], 0x07060302u);
            v1.z = __builtin_amdgcn_perm(raw[0][5], raw[0][4], 0x07060302u); v1.w = __builtin_amdgcn_perm(raw[0][7], raw[0][6], 0x07060302u);
            *(LAS u32x4*)(lds + XDT + (2 * cp) * 272 + tb * 2) = v0; *(LAS u32x4*)(lds + XDT + (2 * cp + 1) * 272 + tb * 2) = v1;
        }
        {
            float o0[8], o1[8];
#pragma unroll
            for (int i = 0; i < 8; ++i) { *(LAS unsigned*)(lds + BS + (tb + i) * 144 + 4 * cp) = raw[1][i];
                const float wg = __expf(cum_last - cmv[i]); o0[i] = bflo(raw[1][i]) * wg; o1[i] = bfhi(raw[1][i]) * wg; }
            u32x4 v0, v1; v0.x = pk2(o0[0], o0[1]); v0.y = pk2(o0[2], o0[3]); v0.z = pk2(o0[4], o0[5]); v0.w = pk2(o0[6], o0[7]);
            v1.x = pk2(o1[0], o1[1]); v1.y = pk2(o1[2], o1[3]); v1.z = pk2(o1[4], o1[5]); v1.w = pk2(o1[6], o1[7]);
            *(LAS u32x4*)(lds + BWT + (2 * cp) * 272 + tb * 2) = v0; *(LAS u32x4*)(lds + BWT + (2 * cp + 1) * 272 + tb * 2) = v1;
        }
#pragma unroll
        for (int i = 0; i < 8; ++i) *(LAS unsigned*)(lds + CS + (tb + i) * 144 + 4 * cp) = raw[2][i];
        u32x2 zc[4];
#pragma unroll
        for (int pt = 0; pt < 4; ++pt) zc[pt] = zz[pt];
        if (c + 1 < 128) SSD_LOAD(c + 1);
        BAR_LDS();
        const float cq = cumL[q], dq = dtL[q];
        const int fo = quad * 16;
        {
            bf16x8 cb[2];
#pragma unroll
            for (int k = 0; k < 2; ++k) cb[k] = lds16(lds, CS + q * 144 + 64 * k + fo);
#pragma unroll
            for (int jh = 0; jh < 2; ++jh) {
                bf16x8 ba[4][2];
#pragma unroll
                for (int j4 = 0; j4 < 4; ++j4) if (4 * jh + j4 <= w) {
#pragma unroll
                    for (int k = 0; k < 2; ++k) ba[j4][k] = lds16(lds, BS + (16 * (4 * jh + j4) + l16) * 144 + 64 * k + fo); }
                __builtin_amdgcn_sched_barrier(0);
                f32x4 acc[4];
#pragma unroll
                for (int j4 = 0; j4 < 4; ++j4) { acc[j4] = (f32x4){0.f, 0.f, 0.f, 0.f};
                    if (4 * jh + j4 <= w) { acc[j4] = mfma16(ba[j4][0], cb[0], acc[j4]); acc[j4] = mfma16(ba[j4][1], cb[1], acc[j4]); } }
                __builtin_amdgcn_sched_barrier(0);
#pragma unroll
                for (int j4 = 0; j4 < 4; ++j4) {
                    const int s0 = 16 * (4 * jh + j4) + quad * 4;
                    const f32x4 cs = *(LAS f32x4*)(cumL + s0);
                    float v[4];
#pragma unroll
                    for (int jj = 0; jj < 4; ++jj) { const int s = s0 + jj; float t = (s <= q) ? acc[j4][jj] * __expf(cq - cs[jj]) : 0.f; if (s == q && dq > 0.f) t += Dh / dq; v[jj] = t; }
                    u32x2 o; o.x = pk2(v[0], v[1]); o.y = pk2(v[2], v[3]);
                    *(LAS u32x2*)(lds + MS + q * 272 + s0 * 2) = o;
                }
            }
        }
#pragma unroll
        for (int i = 0; i < 2; ++i) { const int ni = (w & 1) * 2 + i; u32x2 o; o.x = pk2(S[i][0], S[i][1]); o.y = pk2(S[i][2], S[i][3]);
            *(LAS u32x2*)(lds + SS + (16 * pi + l16) * 144 + (16 * ni + quad * 4) * 2) = o; }
        const float el = __expf(cumL[127]);
        BAR_LDS();
        const float eq = __expf(cq);
        {
            bf16x8 mb[4], cb[2];
#pragma unroll
            for (int ks = 0; ks < 4; ++ks) mb[ks] = lds16(lds, MS + q * 272 + 64 * ks + fo);
#pragma unroll
            for (int k = 0; k < 2; ++k) cb[k] = lds16(lds, CS + q * 144 + 64 * k + fo);
#pragma unroll
            for (int pt = 0; pt < 4; ++pt) {
                bf16x8 xa[4], sa[2];
#pragma unroll
                for (int ks = 0; ks < 4; ++ks) xa[ks] = lds16(lds, XDT + (16 * pt + l16) * 272 + 64 * ks + fo);
#pragma unroll
                for (int k = 0; k < 2; ++k) sa[k] = lds16(lds, SS + (16 * pt + l16) * 144 + 64 * k + fo);
                __builtin_amdgcn_sched_barrier(0);
                f32x4 y1 = (f32x4){0.f, 0.f, 0.f, 0.f}, y2 = y1;
#pragma unroll
                for (int ks = 0; ks < 4; ++ks) if (32 * ks < 16 * w + 16) y1 = mfma16(xa[ks], mb[ks], y1);
#pragma unroll
                for (int k = 0; k < 2; ++k) y2 = mfma16(sa[k], cb[k], y2);
                __builtin_amdgcn_sched_barrier(0);
                bf16* zp = PROJ + (row0 + q) * PROJ_LD + PC_Z + h * 64 + 16 * pt + quad * 4;
                const float z0 = bflo(zc[pt].x), z1 = bfhi(zc[pt].x), z2 = bflo(zc[pt].y), z3 = bfhi(zc[pt].y);
                u32x2 o; o.x = pk2((y1[0] + eq * y2[0]) * siluf(z0), (y1[1] + eq * y2[1]) * siluf(z1)); o.y = pk2((y1[2] + eq * y2[2]) * siluf(z2), (y1[3] + eq * y2[3]) * siluf(z3));
                *(u32x2*)zp = o;
            }
        }
        {
            bf16x8 xb[4], wa[2][4];
#pragma unroll
            for (int ks = 0; ks < 4; ++ks) xb[ks] = lds16(lds, XDT + (16 * pi + l16) * 272 + 64 * ks + fo);
#pragma unroll
            for (int i = 0; i < 2; ++i)
#pragma unroll
                for (int ks = 0; ks < 4; ++ks) wa[i][ks] = lds16(lds, BWT + (16 * ((w & 1) * 2 + i) + l16) * 272 + 64 * ks + fo);
            __builtin_amdgcn_sched_barrier(0);
            S[0] = S[0] * el; S[1] = S[1] * el;
#pragma unroll
            for (int ks = 0; ks < 4; ++ks) { S[0] = mfma16(wa[0][ks], xb[ks], S[0]); S[1] = mfma16(wa[1][ks], xb[ks], S[1]); }
        }
        BAR_LDS();
    }
#undef SSD_LOAD
}

DI void gla_chain(int b, int h, int vs, const bf16* PROJ, const bf16* KT, const bf16* VT, const float* DG, bf16* ORAW, ldsp lds, int tid) {
    constexpr int QS = 0, KS = 17408, KTS = 34816, VTS = 53248, PS = 62464, STS = 71680, DLO = 89088;
    asm volatile("" : "+v"(tid));
    const int lane = tid & 63, w = __builtin_amdgcn_readfirstlane(tid >> 6), quad = lane >> 4, l16 = lane & 15, qi = w >> 1;
    LAS float* dL = (LAS float*)(lds + DLO);
    f32x4 S[4];
#pragma unroll
    for (int i = 0; i < 4; ++i) S[i] = (f32x4){0.f, 0.f, 0.f, 0.f};
    u32x4 Aq[2], Ak[2], Akt[2], Av, Bq[2], Bk[2], Bkt[2], Bv; float Ad = 0.f, Bd = 0.f;
#define GLA_LOAD(c_, P) do { const size_t r0_ = (size_t)b * L_ + (size_t)(c_) * 64; \
        _Pragma("unroll") for (int i = 0; i < 2; ++i) { const int idx = tid + 512 * i, r = idx >> 4, cc = idx & 15; \
            P##q[i] = *(const u32x4*)(PROJ + (r0_ + r) * PROJ_LD + PC_Q + h * 128 + cc * 8); P##k[i] = *(const u32x4*)(PROJ + (r0_ + r) * PROJ_LD + PC_K + h * 128 + cc * 8); } \
        _Pragma("unroll") for (int i = 0; i < 2; ++i) { const int idx = tid + 512 * i, r = idx >> 3, cc = idx & 7; P##kt[i] = *(const u32x4*)(KT + (size_t)(h * 128 + r) * KT_LD + r0_ + cc * 8); } \
        { const int r = tid >> 3, cc = tid & 7; P##v = *(const u32x4*)(VT + (size_t)(h * 256 + vs * 64 + r) * VT_LD + r0_ + cc * 8); } \
        if (tid < 128) P##d = DG[(r0_ >> 6) * 512 + h * 128 + tid]; } while (0)
#define GLA_PUT(P) do { \
        _Pragma("unroll") for (int i = 0; i < 2; ++i) { const int idx = tid + 512 * i, r = idx >> 4, cc = idx & 15; \
            *(LAS u32x4*)(lds + QS + r * 272 + cc * 16) = P##q[i]; *(LAS u32x4*)(lds + KS + r * 272 + cc * 16) = P##k[i]; } \
        _Pragma("unroll") for (int i = 0; i < 2; ++i) { const int idx = tid + 512 * i, r = idx >> 3, cc = idx & 7; *(LAS u32x4*)(lds + KTS + r * 144 + cc * 16) = P##kt[i]; } \
        { const int r = tid >> 3, cc = tid & 7; *(LAS u32x4*)(lds + VTS + r * 144 + cc * 16) = P##v; } \
        if (tid < 128) dL[tid] = P##d; } while (0)
#define GLA_COMPUTE(c_) do { \
        const size_t row0 = (size_t)b * L_ + (size_t)(c_) * 64; \
        BAR_LDS(); \
        const int q = 16 * qi + l16; \
        const int fo = quad * 16; \
        { \
            bf16x8 fb[4], fa[2][4]; \
_Pragma("unroll") \
            for (int ks = 0; ks < 4; ++ks) fb[ks] = lds16(lds, QS + q * 272 + 64 * ks + fo); \
_Pragma("unroll") \
            for (int i = 0; i < 2; ++i) \
_Pragma("unroll") \
                for (int ks = 0; ks < 4; ++ks) fa[i][ks] = lds16(lds, KS + (16 * ((w & 1) * 2 + i) + l16) * 272 + 64 * ks + fo); \
            __builtin_amdgcn_sched_barrier(0); \
            f32x4 acc[2]; acc[0] = (f32x4){0.f, 0.f, 0.f, 0.f}; acc[1] = acc[0]; \
_Pragma("unroll") \
            for (int ks = 0; ks < 4; ++ks) { acc[0] = mfma16(fa[0][ks], fb[ks], acc[0]); acc[1] = mfma16(fa[1][ks], fb[ks], acc[1]); } \
            __builtin_amdgcn_sched_barrier(0); \
_Pragma("unroll") \
            for (int i = 0; i < 2; ++i) { const int s0 = 16 * ((w & 1) * 2 + i) + quad * 4; \
                u32x2 o; o.x = pk2(s0 <= q ? acc[i][0] : 0.f, s0 + 1 <= q ? acc[i][1] : 0.f); o.y = pk2(s0 + 2 <= q ? acc[i][2] : 0.f, s0 + 3 <= q ? acc[i][3] : 0.f); \
                *(LAS u32x2*)(lds + PS + q * 144 + s0 * 2) = o; } \
        } \
_Pragma("unroll") \
        for (int vt = 0; vt < 4; ++vt) { u32x2 o; o.x = pk2(S[vt][0], S[vt][1]); o.y = pk2(S[vt][2], S[vt][3]); \
            *(LAS u32x2*)(lds + STS + (16 * vt + l16) * 272 + (16 * w + quad * 4) * 2) = o; } \
        BAR_LDS(); \
        { \
            bf16x8 pb[2], qb4[4], va[2][2], sa[2][4], ka[2], vb[4][2]; \
_Pragma("unroll") \
            for (int ks = 0; ks < 2; ++ks) pb[ks] = lds16(lds, PS + q * 144 + 64 * ks + fo); \
_Pragma("unroll") \
            for (int ks = 0; ks < 4; ++ks) qb4[ks] = lds16(lds, QS + q * 272 + 64 * ks + fo); \
_Pragma("unroll") \
            for (int i = 0; i < 2; ++i) { const int vt = (w & 1) * 2 + i; \
_Pragma("unroll") \
                for (int ks = 0; ks < 2; ++ks) va[i][ks] = lds16(lds, VTS + (16 * vt + l16) * 144 + 64 * ks + fo); \
_Pragma("unroll") \
                for (int ks = 0; ks < 4; ++ks) sa[i][ks] = lds16(lds, STS + (16 * vt + l16) * 272 + 64 * ks + fo); } \
_Pragma("unroll") \
            for (int ks = 0; ks < 2; ++ks) ka[ks] = lds16(lds, KTS + (16 * w + l16) * 144 + 64 * ks + fo); \
_Pragma("unroll") \
            for (int vt = 0; vt < 4; ++vt) \
_Pragma("unroll") \
                for (int ks = 0; ks < 2; ++ks) vb[vt][ks] = lds16(lds, VTS + (16 * vt + l16) * 144 + 64 * ks + fo); \
            const f32x4 dv = *(LAS f32x4*)(dL + 16 * w + quad * 4); \
            __builtin_amdgcn_sched_barrier(0); \
            f32x4 o[2]; o[0] = (f32x4){0.f, 0.f, 0.f, 0.f}; o[1] = o[0]; \
_Pragma("unroll") \
            for (int ks = 0; ks < 2; ++ks) { o[0] = mfma16(va[0][ks], pb[ks], o[0]); o[1] = mfma16(va[1][ks], pb[ks], o[1]); } \
_Pragma("unroll") \
            for (int ks = 0; ks < 4; ++ks) { o[0] = mfma16(sa[0][ks], qb4[ks], o[0]); o[1] = mfma16(sa[1][ks], qb4[ks], o[1]); } \
_Pragma("unroll") \
            for (int ks = 0; ks < 2; ++ks) \
_Pragma("unroll") \
                for (int vt = 0; vt < 4; ++vt) S[vt] = mfma16(ka[ks], vb[vt][ks], S[vt]); \
            __builtin_amdgcn_sched_barrier(0); \
_Pragma("unroll") \
            for (int i = 0; i < 2; ++i) { const int vt = (w & 1) * 2 + i; u32x2 ov; ov.x = pk2(o[i][0], o[i][1]); ov.y = pk2(o[i][2], o[i][3]); \
                *(u32x2*)(ORAW + (row0 + q) * 1024 + h * 256 + vs * 64 + 16 * vt + quad * 4) = ov; } \
_Pragma("unroll") \
            for (int vt = 0; vt < 4; ++vt) S[vt] = S[vt] * dv; \
        } \
        BAR_LDS(); \
    } while (0)
    GLA_LOAD(0, A); GLA_LOAD(1, B);
    for (int c = 0; c < 256; c += 2) {
        GLA_PUT(A); if (c + 2 < 256) GLA_LOAD(c + 2, A); GLA_COMPUTE(c);
        GLA_PUT(B); if (c + 3 < 256) GLA_LOAD(c + 3, B); GLA_COMPUTE(c + 1);
    }
#undef GLA_PUT
#undef GLA_COMPUTE
#undef GLA_LOAD
}

#define UNPACK16(a, b, v) do { v[0] = bflo(a.x); v[1] = bfhi(a.x); v[2] = bflo(a.y); v[3] = bfhi(a.y); v[4] = bflo(a.z); v[5] = bfhi(a.z); v[6] = bflo(a.w); v[7] = bfhi(a.w); \
    v[8] = bflo(b.x); v[9] = bfhi(b.x); v[10] = bflo(b.y); v[11] = bfhi(b.y); v[12] = bflo(b.z); v[13] = bfhi(b.z); v[14] = bflo(b.w); v[15] = bfhi(b.w); } while (0)
DI void gate_rows(bf16* PROJ, bf16* ORAW, const float* ssd_norm, const float* gla_norm, int gw, int NGW, int lane) {
    for (int t0 = 2 * gw; t0 < T_; t0 += 2 * NGW) {
        u32x4 ya[2], yb[2], oa[2], ob[2], ra[2], rb[2];
#pragma unroll
        for (int u = 0; u < 2; ++u) { const size_t t = (size_t)t0 + u;
            const bf16* yp = PROJ + t * PROJ_LD + PC_Z + lane * 16; const bf16* op = ORAW + t * 1024 + lane * 16; const bf16* rp = PROJ + t * PROJ_LD + PC_R + lane * 16;
            ya[u] = *(const u32x4*)yp; yb[u] = *(const u32x4*)(yp + 8); oa[u] = *(const u32x4*)op; ob[u] = *(const u32x4*)(op + 8); ra[u] = *(const u32x4*)rp; rb[u] = *(const u32x4*)(rp + 8); }
#pragma unroll
        for (int u = 0; u < 2; ++u) { const size_t t = (size_t)t0 + u;
            {   float v[16]; UNPACK16(ya[u], yb[u], v);
                float s = 0.f;
#pragma unroll
                for (int i = 0; i < 16; ++i) s += v[i] * v[i];
#pragma unroll
                for (int o = 1; o < 32; o <<= 1) s += __shfl_xor(s, o);
                const float rstd = rsqrtf(s * (1.f / 512.f) + EPS_);
                const float* nw = ssd_norm + lane * 16;
#pragma unroll
                for (int i = 0; i < 16; ++i) v[i] = v[i] * rstd * nw[i];
                u32x4 a, b; a.x = pk2(v[0], v[1]); a.y = pk2(v[2], v[3]); a.z = pk2(v[4], v[5]); a.w = pk2(v[6], v[7]); b.x = pk2(v[8], v[9]); b.y = pk2(v[10], v[11]); b.z = pk2(v[12], v[13]); b.w = pk2(v[14], v[15]);
                bf16* yp = PROJ + t * PROJ_LD + PC_Z + lane * 16; *(u32x4*)yp = a; *(u32x4*)(yp + 8) = b; }
            {   float v[16], r[16]; UNPACK16(oa[u], ob[u], v); UNPACK16(ra[u], rb[u], r);
                float s = 0.f;
#pragma unroll
                for (int i = 0; i < 16; ++i) s += v[i] * v[i];
#pragma unroll
                for (int o = 1; o < 16; o <<= 1) s += __shfl_xor(s, o);
                const float rstd = rsqrtf(s * (1.f / 256.f) + EPS_);
                const float* nw = gla_norm + (lane & 15) * 16;
#pragma unroll
                for (int i = 0; i < 16; ++i) v[i] = v[i] * rstd * nw[i] * siluf(r[i]);
                u32x4 a, b; a.x = pk2(v[0], v[1]); a.y = pk2(v[2], v[3]); a.z = pk2(v[4], v[5]); a.w = pk2(v[6], v[7]); b.x = pk2(v[8], v[9]); b.y = pk2(v[10], v[11]); b.z = pk2(v[12], v[13]); b.w = pk2(v[14], v[15]);
                bf16* op = ORAW + t * 1024 + lane * 16; *(u32x4*)op = a; *(u32x4*)(op + 8) = b; }
        }
    }
}

DI void attn_unit(int b, int ph, int qb, const bf16* QK, const bf16* VT, bf16* OATT, const float* NORMS, ldsp lds, int tid) {
    asm volatile("" : "+v"(tid));
    constexpr int KBUF = 9216, VBUF = 18432, KOFF = 0, VOFF = 2 * KBUF, WSOFF = 2 * KBUF + 2 * VBUF;
    const int lane = tid & 63, w = tid >> 6, r32 = lane & 31, hi = lane >> 5;
    const int q0 = qb * 256, head = ph >> 1;
    const size_t rowb = (size_t)b * L_;
    const float cs = exp2f(-(float)(head + 1)) * 1.4426950408889634f;
    LAS float* wsf = (LAS float*)(lds + WSOFF) + w * 64;
    bf16x8 qf[4];
    { const bf16* qp = QK + (rowb + q0 + 32 * w + r32) * QK_LD + ph * 64 + 8 * hi;
#pragma unroll
      for (int ks = 0; ks < 4; ++ks) qf[ks] = *(const bf16x8*)(qp + 16 * ks); }
    asm volatile("s_waitcnt vmcnt(0)" : "+v"(qf[0]), "+v"(qf[1]), "+v"(qf[2]), "+v"(qf[3]) :: "memory");
    const int qpos = q0 + 32 * w + r32;
    const int rsw = ((r32 >> 3) & 1) * 8;
    f32x16 o[4];
#pragma unroll
    for (int d = 0; d < 4; ++d)
#pragma unroll
        for (int r = 0; r < 16; ++r) o[d][r] = 0.f;
    float l_run = 0.f;
    const float Bq = sqrtf(NORMS[b * 32 + ph] * NORMS[b * 32 + 16 + ph]);
    const float Wn = (150.f + 2.f * Bq) / cs;
    const float sk = ((float)(q0 - 63) - Wn) * (1.f / 64.f);
    int t_begin = (sk >= 0.f) ? (int)floorf(sk) + 1 : 0;
    t_begin = __builtin_amdgcn_readfirstlane(t_begin);
    const int t_end = (q0 + 256) / 64;
    float m_run = cs * (float)(64 * t_begin - q0);
    const int klane = r32 * 144 + 16 * hi, vlane = r32 * 144 + 16 * hi;
    const float cs_h = bf2f(pk2(cs, 0.f) & 0xffffu);
    const unsigned csw = (hi == 0) ? pk2(cs_h, cs - cs_h) : 0u;
    bf16x8 kext0, kext1;
    { u32x4 e0, e1; e0.x = (hi == 0) ? pk2((float)r32, (float)r32) : 0u; e0.y = (hi == 0) ? pk2(1.f, 1.f) : 0u; e0.z = 0u; e0.w = 0u;
      e1 = e0; e1.x = (hi == 0) ? pk2((float)(r32 + 32), (float)(r32 + 32)) : 0u; kext0 = __builtin_bit_cast(bf16x8, e0); kext1 = __builtin_bit_cast(bf16x8, e1); }
    const int kr = tid >> 3, kc = tid & 7;
    const bf16* ksrc = QK + (rowb + kr) * QK_LD + 1024 + ph * 64 + kc * 8;
    const bf16* vsrc0 = VT + (size_t)(head * 128 + kr) * VT_LD + rowb + kc * 8;
    const bf16* vsrc1 = VT + (size_t)(head * 128 + 64 + kr) * VT_LD + rowb + kc * 8;
    const int kdst = KOFF + kr * 144 + kc * 16, vdst0 = VOFF + kr * 144 + kc * 16, vdst1 = VOFF + (64 + kr) * 144 + kc * 16;
    u32x4 pk_, pv0, pv1;
    pk_ = *(const u32x4*)(ksrc + (size_t)t_begin * 64 * QK_LD); pv0 = *(const u32x4*)(vsrc0 + t_begin * 64); pv1 = *(const u32x4*)(vsrc1 + t_begin * 64);
    const int vp0 = (16 * (kc >> 1) + 4 * (kc & 1)) * 2, vp1 = vp0 + 16;
#define VSWZ(v) (v)
    __syncthreads();
    *(LAS u32x4*)(lds + kdst) = pk_;
    { *(LAS u32x2*)(lds + VOFF + kr * 144 + vp0) = (u32x2){pv0.x, pv0.y}; *(LAS u32x2*)(lds + VOFF + kr * 144 + vp1) = (u32x2){pv0.z, pv0.w};
      *(LAS u32x2*)(lds + VOFF + (64 + kr) * 144 + vp0) = (u32x2){pv1.x, pv1.y}; *(LAS u32x2*)(lds + VOFF + (64 + kr) * 144 + vp1) = (u32x2){pv1.z, pv1.w}; }
    __syncthreads();
#define ATTN_TILE(t_, buf_) do { \
        const int kbase = 64 * (t_); \
        if (kbase <= q0 + 32 * w + 31) { \
            const int kb = KOFF + (buf_) * KBUF + klane, vb = VOFF + (buf_) * VBUF + vlane; \
              \
            const float nm = cs * (float)(kbase - q0) - m_run; \
            const float nmh = bf2f(pk2(nm, 0.f) & 0xffffu); \
            u32x4 qe; qe.x = csw; qe.y = (hi == 0) ? pk2(nmh, nm - nmh) : 0u; qe.z = 0u; qe.w = 0u; \
            const bf16x8 qef = __builtin_bit_cast(bf16x8, qe); \
            bf16x8 kf0[4], kf1[4]; \
            _Pragma("unroll") \
            for (int ks = 0; ks < 4; ++ks) { kf0[ks] = lds16(lds, kb + 32 * ks); kf1[ks] = lds16(lds, kb + 32 * 144 + 32 * ks); } \
            __builtin_amdgcn_sched_barrier(0); \
            f32x16 s0, s1; \
            _Pragma("unroll") \
            for (int r = 0; r < 16; ++r) { s0[r] = 0.f; s1[r] = 0.f; } \
            s0 = mfma32(kext0, qef, s0); s1 = mfma32(kext1, qef, s1); \
            _Pragma("unroll") \
            for (int ks = 0; ks < 4; ++ks) { s0 = mfma32(kf0[ks], qf[ks], s0); s1 = mfma32(kf1[ks], qf[ks], s1); } \
            __builtin_amdgcn_sched_barrier(0); \
            asm volatile("s_nop 15\n\ts_nop 7" : "+v"(s0), "+v"(s1));     \
            if (kbase + 63 > q0 + 32 * w) { \
                _Pragma("unroll") \
                for (int r = 0; r < 16; ++r) { const int key = kbase + 4 * hi + (r & 3) + 8 * (r >> 2); if (key > qpos) s0[r] = -INFINITY; if (key + 32 > qpos) s1[r] = -INFINITY; } \
            } \
            float mx = s0[0], mx2 = s1[0]; \
            _Pragma("unroll") \
            for (int r = 1; r < 16; r += 2) { mx = max3f(mx, s0[r], s1[r]); if (r + 1 < 16) mx2 = max3f(mx2, s0[r + 1], s1[r + 1]); } \
            mx = max3f(mx, mx2, mx2); \
            mx = fmaxf(mx, __shfl_xor(mx, 32)); \
            if (__any(mx > 8.f)) { \
                const float dl = fmaxf(mx, 0.f); \
                const float alpha = __builtin_amdgcn_exp2f(-dl); \
                l_run *= alpha; m_run += dl; \
                _Pragma("unroll") \
                for (int r = 0; r < 16; ++r) { s0[r] -= dl; s1[r] -= dl; } \
                if (hi == 0) wsf[r32] = alpha; \
                LDS_FENCE(); \
                _Pragma("unroll") \
                for (int r = 0; r < 16; ++r) { const float a = wsf[crow(r, hi)]; \
                    _Pragma("unroll") \
                    for (int d = 0; d < 4; ++d) o[d][r] *= a; } \
            } \
            float rs = 0.f; \
            _Pragma("unroll") \
            for (int r = 0; r < 16; ++r) { s0[r] = __builtin_amdgcn_exp2f(s0[r]); s1[r] = __builtin_amdgcn_exp2f(s1[r]); rs += s0[r] + s1[r]; } \
            rs += __shfl_xor(rs, 32); \
            l_run += rs; \
            bf16x8 pa[2][2]; \
            _Pragma("unroll") \
            for (int s = 0; s < 2; ++s) { \
                u32x4 p0, p1; \
                p0.x = pk2(s0[8 * s + 0], s0[8 * s + 1]); p0.y = pk2(s0[8 * s + 2], s0[8 * s + 3]); p0.z = pk2(s0[8 * s + 4], s0[8 * s + 5]); p0.w = pk2(s0[8 * s + 6], s0[8 * s + 7]); \
                p1.x = pk2(s1[8 * s + 0], s1[8 * s + 1]); p1.y = pk2(s1[8 * s + 2], s1[8 * s + 3]); p1.z = pk2(s1[8 * s + 4], s1[8 * s + 5]); p1.w = pk2(s1[8 * s + 6], s1[8 * s + 7]); \
                pa[0][s] = __builtin_bit_cast(bf16x8, p0); pa[1][s] = __builtin_bit_cast(bf16x8, p1); \
            } \
            _Pragma("unroll") \
            for (int dh = 0; dh < 2; ++dh) { \
                bf16x8 vf[2][2][2]; \
                _Pragma("unroll") \
                for (int d2 = 0; d2 < 2; ++d2) \
                    _Pragma("unroll") \
                    for (int hf = 0; hf < 2; ++hf) \
                        _Pragma("unroll") \
                        for (int s = 0; s < 2; ++s) vf[d2][hf][s] = lds16(lds, vb + 4608 * (2 * dh + d2) + 64 * hf + 32 * s); \
                __builtin_amdgcn_sched_barrier(0); \
                _Pragma("unroll") \
                for (int hf = 0; hf < 2; ++hf) \
                    _Pragma("unroll") \
                    for (int s = 0; s < 2; ++s) \
                        _Pragma("unroll") \
                        for (int d2 = 0; d2 < 2; ++d2) o[2 * dh + d2] = mfma32(pa[hf][s], vf[d2][hf][s], o[2 * dh + d2]); \
                __builtin_amdgcn_sched_barrier(0); \
            } \
        } \
    } while (0)
#define ATTN_LOAD(t_, K_, V0_, V1_) do { K_ = *(const u32x4*)(ksrc + (size_t)(t_) * 64 * QK_LD); V0_ = *(const u32x4*)(vsrc0 + (t_) * 64); V1_ = *(const u32x4*)(vsrc1 + (t_) * 64); } while (0)
#define VT_PUT(off_, V_) do { *(LAS u32x2*)(lds + (off_) + vp0) = (u32x2){(V_).x, (V_).y}; *(LAS u32x2*)(lds + (off_) + vp1) = (u32x2){(V_).z, (V_).w}; } while (0)
#define ATTN_STORE(buf_, K_, V0_, V1_) do { *(LAS u32x4*)(lds + kdst + (buf_) * KBUF) = K_; VT_PUT(VOFF + (buf_) * VBUF + kr * 144, V0_); VT_PUT(VOFF + (buf_) * VBUF + (64 + kr) * 144, V1_); } while (0)
    u32x4 ak = pk_, av0 = pv0, av1 = pv1, bk = pk_, bv0 = pv0, bv1 = pv1;
    if (t_begin + 1 < t_end) ATTN_LOAD(t_begin + 1, ak, av0, av1);
    for (int t = t_begin; t < t_end; t += 2) {
        if (t + 2 < t_end) ATTN_LOAD(t + 2, bk, bv0, bv1);
        ATTN_TILE(t, 0);
        if (t + 1 < t_end) ATTN_STORE(1, ak, av0, av1);
        BAR_LDS();
        if (t + 1 < t_end) {
            if (t + 3 < t_end) ATTN_LOAD(t + 3, ak, av0, av1);
            ATTN_TILE(t + 1, 1);
            if (t + 2 < t_end) ATTN_STORE(0, bk, bv0, bv1);
            BAR_LDS();
        }
    }
#undef ATTN_TILE
#undef ATTN_LOAD
#undef ATTN_STORE
    LDS_FENCE();
    if (hi == 0) wsf[r32] = 1.f / l_run;
    LDS_FENCE();
    bf16* op = OATT + (rowb + q0 + 32 * w) * 2048 + ph * 128 + r32;
#pragma unroll
    for (int r = 0; r < 16; ++r) { const int qr = crow(r, hi); const float rl = wsf[qr];
#pragma unroll
        for (int d = 0; d < 4; ++d) op[(size_t)qr * 2048 + 32 * d] = (bf16)f2bf(o[d][r] * rl); }
#undef VSWZ
}

DI void qk_norms(const bf16* QK, float* NORMS, int gw, int NGW, int lane) {
    for (int b = 0; b < 2; ++b) {
        float mx = 0.f;
        for (int t = gw; t < L_; t += NGW) {
            const u32x4* p = (const u32x4*)(QK + ((size_t)b * L_ + t) * QK_LD + lane * 32);
            float s = 0.f;
#pragma unroll
            for (int i = 0; i < 4; ++i) { const u32x4 v = p[i];
                s += bflo(v.x) * bflo(v.x) + bfhi(v.x) * bfhi(v.x) + bflo(v.y) * bflo(v.y) + bfhi(v.y) * bfhi(v.y) + bflo(v.z) * bflo(v.z) + bfhi(v.z) * bfhi(v.z) + bflo(v.w) * bflo(v.w) + bfhi(v.w) * bfhi(v.w); }
            s += __shfl_xor(s, 1);
            mx = fmaxf(mx, s);
        }
        if (!(lane & 1)) atomicMax((unsigned*)NORMS + b * 32 + (lane >> 1), __float_as_uint(mx));
    }
}

DI void combine_rows(const bf16* OATT, bf16* OUT, const float* lq1, const float* lk1, const float* lq2, const float* lk2, const float* subln, float lam_init, int gw, int NGW, int lane) {
    const float e1 = __expf(wave_sum(lq1[lane] * lk1[lane])), e2 = __expf(wave_sum(lq2[lane] * lk2[lane]));
    const float lam = e1 - e2 + lam_init;
    const int head = lane >> 3, dv0 = (lane & 7) * 16;
    for (int t0 = 2 * gw; t0 < T_; t0 += 2 * NGW) {
        u32x4 A[2], B[2], C[2], Dd[2];
#pragma unroll
        for (int u = 0; u < 2; ++u) { const bf16* p1 = OATT + (size_t)(t0 + u) * 2048 + (2 * head) * 128 + dv0; const bf16* p2 = p1 + 128;
            A[u] = *(const u32x4*)p1; B[u] = *(const u32x4*)(p1 + 8); C[u] = *(const u32x4*)p2; Dd[u] = *(const u32x4*)(p2 + 8); }
#pragma unroll
        for (int u = 0; u < 2; ++u) {
            float v[16], q[16]; UNPACK16(A[u], B[u], v); UNPACK16(C[u], Dd[u], q);
            float s = 0.f;
#pragma unroll
            for (int i = 0; i < 16; ++i) { v[i] = v[i] - lam * q[i]; s += v[i] * v[i]; }
            s += __shfl_xor(s, 1); s += __shfl_xor(s, 2); s += __shfl_xor(s, 4);
            const float sc = rsqrtf(s * (1.f / 128.f) + EPS_) * (1.f - lam_init);
            const float* nw = subln + dv0;
            u32x4 oa, ob;
            oa.x = pk2(v[0] * sc * nw[0], v[1] * sc * nw[1]); oa.y = pk2(v[2] * sc * nw[2], v[3] * sc * nw[3]); oa.z = pk2(v[4] * sc * nw[4], v[5] * sc * nw[5]); oa.w = pk2(v[6] * sc * nw[6], v[7] * sc * nw[7]);
            ob.x = pk2(v[8] * sc * nw[8], v[9] * sc * nw[9]); ob.y = pk2(v[10] * sc * nw[10], v[11] * sc * nw[11]); ob.z = pk2(v[12] * sc * nw[12], v[13] * sc * nw[13]); ob.w = pk2(v[14] * sc * nw[14], v[15] * sc * nw[15]);
            bf16* qo = OUT + (size_t)(t0 + u) * 1024 + head * 128 + dv0;
            *(u32x4*)qo = oa; *(u32x4*)(qo + 8) = ob;
        }
    }
}

DI void softmax_rows256(bf16* S, int nrows, int gw, int NGW, int lane) {
    for (int r0 = gw * 4; r0 < nrows; r0 += NGW * 4) {
        u32x2 a[4];
#pragma unroll
        for (int i = 0; i < 4; ++i) a[i] = *((const u32x2*)(S + (size_t)(r0 + i) * 256) + lane);
#pragma unroll
        for (int i = 0; i < 4; ++i) {
            float v0 = bflo(a[i].x), v1 = bfhi(a[i].x), v2 = bflo(a[i].y), v3 = bfhi(a[i].y);
            const float mx = wave_max(fmaxf(fmaxf(v0, v1), fmaxf(v2, v3)));
            v0 = __expf(v0 - mx); v1 = __expf(v1 - mx); v2 = __expf(v2 - mx); v3 = __expf(v3 - mx);
            const float inv = 1.f / wave_sum((v0 + v1) + (v2 + v3));
            u32x2 o; o.x = pk2(v0 * inv, v1 * inv); o.y = pk2(v2 * inv, v3 * inv);
            *((u32x2*)(S + (size_t)(r0 + i) * 256) + lane) = o;
        }
    }
}

DI void softmax_tile256(bf16* SP, int pm, int pn, int wave, int lane) {
    bf16* base = SP + ((size_t)pm * 256 + wave * 32) * 1024 + pn * 256 + lane * 4;
    for (int r0 = 0; r0 < 32; r0 += 4) {
        u32x2 a[4];
#pragma unroll
        for (int i = 0; i < 4; ++i) a[i] = *(const u32x2*)(base + (size_t)(r0 + i) * 1024);
#pragma unroll
        for (int i = 0; i < 4; ++i) {
            float v0 = bflo(a[i].x), v1 = bfhi(a[i].x), v2 = bflo(a[i].y), v3 = bfhi(a[i].y);
            const float mx = wave_max(fmaxf(fmaxf(v0, v1), fmaxf(v2, v3)));
            v0 = __expf(v0 - mx); v1 = __expf(v1 - mx); v2 = __expf(v2 - mx); v3 = __expf(v3 - mx);
            const float inv = 1.f / wave_sum((v0 + v1) + (v2 + v3));
            u32x2 o; o.x = pk2(v0 * inv, v1 * inv); o.y = pk2(v2 * inv, v3 * inv);
            *(u32x2*)(base + (size_t)(r0 + i) * 1024) = o;
        }
    }
}

#define GAS __attribute__((address_space(1)))
#define XB_TMO      128
#define XB_XCNT(j)  (256  + 64 * (j))
#define XB_XSUB(j)  (1280 + 64 * (j))
#define XB_XGEN(j)  (2304 + 64 * (j))
#define XB_TOP      3328
#define XB_TOPGEN   3392
#define XCD_BAR_WORDS 3456
#define XB_SPIN_CAP (1u << 18)

__device__ __forceinline__ unsigned xb_ld(unsigned* p)              { return __hip_atomic_load(p, __ATOMIC_RELAXED, __HIP_MEMORY_SCOPE_AGENT); }
__device__ __forceinline__ unsigned xb_add(unsigned* p, unsigned v) { return __hip_atomic_fetch_add(p, v, __ATOMIC_RELAXED, __HIP_MEMORY_SCOPE_AGENT); }
__device__ __forceinline__ unsigned xb_xcc_id() { return (unsigned)__builtin_amdgcn_s_getreg((3 << 11) | 20) & 0xFu; }
#define XB_SPIN(cond, bar) do { unsigned _sp = 0; while (cond) { __builtin_amdgcn_s_sleep(1); \
    if ((++_sp & 255u) == 0u) { if (xb_ld(&(bar)[XB_TMO])) break; if (_sp > XB_SPIN_CAP) { atomicAdd(&(bar)[XB_TMO], 1u); break; } } } } while (0)

struct XcdBarrier {
    unsigned* bar; unsigned x;
    volatile LAS unsigned* st;
};

__device__ __forceinline__ XcdBarrier xcd_barrier_post(unsigned* bar, volatile LAS unsigned* st) {
    XcdBarrier b; b.bar = bar; b.x = xb_xcc_id(); b.st = st;
    if (threadIdx.x == 0) (void)xb_add(&bar[XB_XCNT(b.x)], 1u);
    return b;
}
__device__ __forceinline__ void xcd_barrier_complete(unsigned* bar, unsigned x, unsigned& nloc, unsigned& nx) {
    const unsigned G = gridDim.x * gridDim.y * gridDim.z;
    unsigned sum, cnt, mine, sp = 0u;
    for (;;) {
        sum = 0u; cnt = 0u; mine = 0u;
#pragma unroll
        for (unsigned j = 0; j < 16; ++j) { const unsigned c = xb_ld(&bar[XB_XCNT(j)]); sum += c; cnt += (c > 0u) ? 1u : 0u; mine = (j == x) ? c : mine; }
        if (sum == G) break;
        __builtin_amdgcn_s_sleep(1);
        if ((++sp & 255u) == 0u) { if (xb_ld(&bar[XB_TMO])) break; if (sp > XB_SPIN_CAP) { atomicAdd(&bar[XB_TMO], 1u); break; } }
    }
    nloc = mine > 0u ? mine : 1u; nx = cnt > 0u ? cnt : 1u;
}

__device__ __forceinline__ void xcd_barrier(const XcdBarrier& b) {
    asm volatile("s_waitcnt vmcnt(0)" ::: "memory");
    __syncthreads();
    if (threadIdx.x == 0) {
        unsigned* bar = b.bar;
        __builtin_amdgcn_s_waitcnt(0);
        unsigned nloc = b.st[0], nx = b.st[1];
        if (nloc == 0u) { xcd_barrier_complete(bar, b.x, nloc, nx); b.st[0] = nloc; b.st[1] = nx; }
        const unsigned old = xb_add(&bar[XB_XSUB(b.x)], 1u);
        const unsigned gen = old / nloc;
        if (old + 1u == (gen + 1u) * nloc) {
            __builtin_amdgcn_fence(__ATOMIC_RELEASE, "agent");
            asm volatile("s_waitcnt vmcnt(0)" ::: "memory");
            const unsigned og = xb_add(&bar[XB_TOP], 1u);
            const unsigned tg = og / nx;
            if (og + 1u == (tg + 1u) * nx) xb_add(&bar[XB_TOPGEN], 1u);
            else XB_SPIN(xb_ld(&bar[XB_TOPGEN]) == tg, bar);
            __builtin_amdgcn_fence(__ATOMIC_ACQUIRE, "agent");
            xb_add(&bar[XB_XGEN(b.x)], 1u);
            asm volatile("s_waitcnt vmcnt(0)" ::: "memory");
        } else {
            XB_SPIN(xb_ld(&bar[XB_XGEN(b.x)]) == gen, bar);
            __builtin_amdgcn_fence(__ATOMIC_ACQUIRE, "agent");
            asm volatile("s_waitcnt vmcnt(0)" ::: "memory");
        }
    }
    __syncthreads();
}

struct Args { const float* in[31]; float* out; unsigned char* ws; float lam_init[2]; int ph_lo, ph_hi; };
constexpr int NPL = 15, NPH = 4 * NPL + 1;

DI pg8::Gemm mk_gemm(const bf16* A, const bf16* Bt, int M, int N, int K, int lda, int ldb) {
    pg8::Gemm g; g.A = A; g.Bt = Bt; g.M = M; g.N = N; g.K = K; g.lda = lda; g.ldb = ldb; g.a_pn = 0; g.b_pn = (long)256 * ldb; g.b_b = 0; g.pm_per_b = 1 << 30; return g;
}
DI pg8::EpiU mk_store(bf16* O, int ldc, int act, int scale_cols, float scale) {
    pg8::EpiU e; e.mode = 0; e.O = O; e.ldc = ldc; e.act = act; e.scale_cols = scale_cols; e.scale = scale; e.small_out = nullptr; e.small_pn = -1; e.base = nullptr; e.outf = nullptr; return e;
}
DI pg8::EpiU mk_res(const float* base, float* outf) {
    pg8::EpiU e; e.mode = 1; e.O = nullptr; e.ldc = D_; e.act = 0; e.scale_cols = 0; e.scale = 1.f; e.small_out = nullptr; e.small_pn = -1; e.base = base; e.outf = outf; return e;
}

__global__ void __launch_bounds__(512, 2) mega_fwd(Args a) {
    extern __shared__ __attribute__((aligned(16))) unsigned char lds_raw[];
    ldsp lds = (ldsp)lds_raw;
    cg::grid_group grid = cg::this_grid();
    volatile LAS unsigned* bst = (volatile LAS unsigned*)(lds + LDS_BYTES - 16);
    if (threadIdx.x < 4) bst[threadIdx.x] = 0u;
    __syncthreads();
    const XcdBarrier xbar = xcd_barrier_post((unsigned*)(a.ws + 4096), bst);
    const int G = gridDim.x, blk = blockIdx.x, NGW = G * 8;
    for (int ph = a.ph_lo; ph < a.ph_hi; ++ph) {
#define PHASE_IDS int tid = threadIdx.x; asm volatile("" : "+v"(tid)); const int lane = tid & 63, wave = __builtin_amdgcn_readfirstlane(tid >> 6), gw = blk * 8 + wave; (void)lane; (void)gw; (void)wave;
        unsigned char* ws = a.ws;
        bf16* XN = (bf16*)(ws + WS_XN); bf16* BIG = (bf16*)(ws + WS_BIG); bf16* VT = (bf16*)(ws + WS_VT); bf16* ORAW = (bf16*)(ws + WS_ORAW);
        float* SMALL = (float*)(ws + WS_SMALL); bf16* MEMN = (bf16*)(ws + WS_MEMN); bf16* KX = (bf16*)(ws + WS_KX); bf16* VXT = (bf16*)(ws + WS_VXT);
        bf16* KT = (bf16*)(ws + WS_KT); float* DG = (float*)(ws + WS_DG); bf16* TAIL = (bf16*)(ws + WS_DG + 1 * MiB);
        bf16* WA = (bf16*)(ws + WS_WA); bf16* WV = (bf16*)(ws + WS_WV); bf16* WOUT = (bf16*)(ws + WS_WOUT); bf16* WQ = (bf16*)(ws + WS_WQ); bf16* WKV = (bf16*)(ws + WS_WKV);
        bf16* WXO = (bf16*)(ws + WS_WXO); bf16* W1 = (bf16*)(ws + WS_W1); bf16* W2 = (bf16*)(ws + WS_W2);
        bf16* QX = BIG; bf16* SP = BIG + (size_t)T_ * 1024; bf16* OX = BIG + (size_t)2 * T_ * 1024;
        bf16* OATT = (bf16*)(ws + WS_BIG + 132 * MiB);

        const int layer = ph / NPL, k = ph % NPL;
        const bool even = !(layer & 1); const int li = layer >> 1;
        bool did = true; int nj = 0;
        const float* xcur = (layer == 0 && k <= 5) ? a.in[0] : a.out;
        if (ph == NPH - 1) { PHASE_IDS
            rms_rows_f32_inplace(a.out, a.in[30], T_, gw, NGW, lane);
        } else if (k == 0) { PHASE_IDS
            LAS float* scr = (LAS float*)(lds + wave * 16384);
            const float* wq = a.in[24] + (size_t)layer * 1024 * 1024; const float* wkv = a.in[25] + (size_t)layer * 1024 * 2048; const float* wxo = a.in[26] + (size_t)layer * 1024 * 1024;
            const float* w1 = a.in[28] + (size_t)layer * 1024 * 4096; const float* w2 = a.in[29] + (size_t)layer * 4096 * 1024;
            const int I_Q = 16 * 32, I_KV = 16 * 64, I_XO = 16 * 32, I_1 = 16 * 128, I_2 = 64 * 32;
            const int I_A = even ? 16 * 144 : 16 * 64, I_V = 16 * 32, I_O = even ? 32 * 32 : 16 * 32;
            const int NIT = I_Q + I_KV + I_XO + I_1 + I_2 + I_A + I_V + I_O;
            for (int it = gw; it < NIT; it += NGW) {
                int r = it;
                if (r < I_Q) { conv_item(wq, 1024, 1024, WQ, 1024, 0, 0, scr, r, lane); continue; } r -= I_Q;
                if (r < I_KV) { conv_item(wkv, 2048, 1024, WKV, 2048, 0, 0, scr, r, lane); continue; } r -= I_KV;
                if (r < I_XO) { conv_item(wxo, 1024, 1024, WXO, 1024, 0, 0, scr, r, lane); continue; } r -= I_XO;
                if (r < I_1) { conv_item(w1, 4096, 1024, W1, 4096, 0, 0, scr, r, lane); continue; } r -= I_1;
                if (r < I_2) { conv_item(w2, 1024, 4096, W2, 1024, 0, 0, scr, r, lane); continue; } r -= I_2;
                if (even) {
                    const float* win = a.in[3] + (size_t)li * 1024 * 5408; const float* wout = a.in[13] + (size_t)li * 2048 * 1024;
                    if (r < I_A) { conv_item(win, 5408, 1024, WA, 4608, 1, 0, scr, r, lane); continue; } r -= I_A;
                    if (r < I_V) { conv_item(win, 5408, 1024, WV, 1024, 0, 3344, scr, r, lane); continue; } r -= I_V;
                    conv_item(wout, 1024, 2048, WOUT, 1024, 0, 0, scr, r, lane);
                } else {
                    const float* wqkv = a.in[15] + (size_t)li * 1024 * 3072; const float* wo = a.in[21] + (size_t)li * 1024 * 1024;
                    if (r < I_A) { conv_item(wqkv, 3072, 1024, WA, 2048, 0, 0, scr, r, lane); continue; } r -= I_A;
                    if (r < I_V) { conv_item(wqkv, 3072, 1024, WV, 1024, 0, 2048, scr, r, lane); continue; } r -= I_V;
                    conv_item(wo, 1024, 1024, WOUT, 1024, 0, 0, scr, r, lane);
                }
            }
            rms_rows_bf16(xcur, (even ? a.in[2] : a.in[14]) + (size_t)li * 1024, XN, T_, gw, NGW, lane);
            rms_rows_bf16(a.in[1], a.in[23] + (size_t)layer * 1024, MEMN, 512, gw, NGW, lane);
            if (blk == 0 && tid < 64) ((float*)ws)[tid] = 0.f;
        } else if (k == 1) { nj = 4;
        } else if (k == 2) { PHASE_IDS
            if (even) { for (int u = blk; u < T_ / 128; u += G) prep_unit(u, BIG, SMALL, KT, DG, TAIL, a.in[10] + (size_t)li * 16 * 512, a.in[11] + (size_t)li * 512, a.in[6] + li * 16, a.in[7] + li * 16, a.in[4] + (size_t)li * 4 * 1280, a.in[5] + (size_t)li * 1280, lds, tid); }
            else {
                qk_norms(BIG, (float*)ws, gw, NGW, lane);
                xcd_barrier(xbar);
                {
                    const int x = blk & 7, j = blk >> 3, bb = (x >> 1) & 1, br = x & 1, grp = x >> 2;
#pragma unroll 1
                    for (int u = 0; u < 8; ++u) { const int s = u >> 1; const int head = grp ? (s == 0 ? 6 : s == 1 ? 4 : s == 2 ? 3 : 2) : (s == 0 ? 7 : s == 1 ? 5 : s == 2 ? 1 : 0);
                        attn_unit(bb, 2 * head + br, (u & 1) ? j : 63 - j, BIG, VT, OATT, (const float*)ws, lds, tid); }
                }
            }
        } else if (k == 3) { PHASE_IDS
            if (even) {
                for (int j = blk; j < 64; j += G) {
                    if (j < 32) ssd_chain(j >> 4, j & 15, BIG, SMALL, TAIL, a.in[8] + li * 16, lds, tid);
                    else { const int i2 = j - 32; gla_chain(i2 >> 4, (i2 >> 2) & 3, i2 & 3, BIG, KT, VT, DG, ORAW, lds, tid); }
                }
            } else combine_rows(OATT, XN, a.in[16] + li * 64, a.in[17] + li * 64, a.in[18] + li * 64, a.in[19] + li * 64, a.in[20] + li * 128, a.lam_init[li], gw, NGW, lane);
        } else if (k == 4) { PHASE_IDS
            if (even) gate_rows(BIG, ORAW, a.in[9] + (size_t)li * 1024, a.in[12] + (size_t)li * 256, gw, NGW, lane);
            else nj = 1;
        } else if (k == 5) { if (even) nj = 2; else did = false;
        } else if (k == 6) { PHASE_IDS rms_rows_bf16(a.out, a.in[22] + (size_t)layer * 1024, XN, T_, gw, NGW, lane);
        } else if (k == 7) { nj = 3;
        } else if (k == 8 || k == 9 || k == 10) { did = false;
        } else if (k == 12) { PHASE_IDS rms_rows_bf16(a.out, a.in[27] + (size_t)layer * 1024, XN, T_, gw, NGW, lane);
        } else nj = 1;
        for (int j = 0; j < nj; ++j) { PHASE_IDS
            pg8::Gemm g = mk_gemm(XN, WA, T_, 1024, 1024, 1024, 1024); pg8::EpiU e = mk_store(BIG, 1024, 0, 0, 1.f);
            if (k == 1) {
                if (j == 0) { if (even) { g = mk_gemm(XN, WA, T_, 4608, 1024, 1024, 1024); e = mk_store(BIG, PROJ_LD, 0, 0, 1.f); e.small_out = SMALL; e.small_pn = 17; }
                              else { g = mk_gemm(XN, WA, T_, 2048, 1024, 1024, 1024); e = mk_store(BIG, QK_LD, 0, 1024, 0.125f * 1.4426950408889634f); } }
                else if (j == 1) { g = mk_gemm(WV, XN, 1024, T_, 1024, 1024, 1024); e = mk_store(VT, VT_LD, 0, 0, 1.f); }
                else if (j == 2) { g = mk_gemm(MEMN, WKV, 512, 1024, 1024, 1024, 1024); e = mk_store(KX, 1024, 0, 0, 1.f); }
                else { g = mk_gemm(WKV + (size_t)1024 * 1024, MEMN, 1024, 512, 1024, 1024, 1024); e = mk_store(VXT, 512, 0, 0, 1.f); }
            } else if (k == 4) { g = mk_gemm(XN, WOUT, T_, 1024, 1024, 1024, 1024); e = mk_res(xcur, a.out);
            } else if (k == 5) {
                if (j == 0) { g = mk_gemm(BIG + PC_Z, WOUT, T_, 1024, 1024, PROJ_LD, 2048); e = mk_res(xcur, a.out); }
                else { g = mk_gemm(ORAW, WOUT + 1024, T_, 1024, 1024, 1024, 2048); e = mk_res(a.out, a.out); }
            } else if (k == 7) {
                if (j == 0) { g = mk_gemm(XN, WQ, T_, 1024, 1024, 1024, 1024); e = mk_store(QX, 1024, 0, 1024, 0.0625f); }
                else if (j == 1) { g = mk_gemm(QX, KX, T_, 1024, 256, 1024, 1024); g.a_pn = 256; g.b_pn = 256; g.b_b = (long)256 * 1024; g.pm_per_b = 64; e = mk_store(SP, 1024, 0, 0, 1.f); }
                else { g = mk_gemm(SP, VXT, T_, 1024, 256, 1024, 512); g.a_pn = 256; g.b_pn = (long)256 * 512; g.b_b = 256; g.pm_per_b = 64; e = mk_store(OX, 1024, 0, 0, 1.f); }
            } else if (k == 11) { g = mk_gemm(OX, WXO, T_, 1024, 1024, 1024, 1024); e = mk_res(a.out, a.out);
            } else if (k == 13) { g = mk_gemm(XN, W1, T_, 4096, 1024, 1024, 1024); e = mk_store(BIG, 4096, 1, 0, 1.f);
            } else if (k == 14) { g = mk_gemm(BIG, W2, T_, 1024, 4096, 4096, 4096); e = mk_res(a.out, a.out); }
            pg8::StaticOrder S; S.init(g.M, g.N, G, (k == 1) ? (blk + 64 * j * (j >= 2)) % G : blk);
            pg8::gemm_phase<pg8::EpiU, pg8::StaticOrder, true, true>(lds, g, S, e, tid);
            if (k == 7 && j < 2) {
                asm volatile("s_waitcnt vmcnt(0)" ::: "memory"); __syncthreads(); __builtin_amdgcn_fence(__ATOMIC_ACQUIRE, "agent");
                if (j == 1) {
                    int t2 = threadIdx.x; asm volatile("" : "+v"(t2));
                    const int lane2 = t2 & 63, wave2 = __builtin_amdgcn_readfirstlane(t2 >> 6);
                    pg8::Unit u;
                    for (int i = 0; S.next(i, u); ++i) softmax_tile256(SP, u.pm, u.pn, wave2, lane2);
                    asm volatile("s_waitcnt vmcnt(0)" ::: "memory"); __syncthreads(); __builtin_amdgcn_fence(__ATOMIC_ACQUIRE, "agent");
                }
            }
        }
        if (did && ph + 1 < a.ph_hi) { if (ph == 0) grid.sync(); else xcd_barrier(xbar); }
    }
}

extern "C" void kernel_launch(void* const* d_in, const int* in_sizes, int n_in, void* d_out, int out_size, void* d_ws, size_t ws_size, hipStream_t stream) {
    static int grid = 0;
    if (grid == 0) {
        if (n_in != 31 || out_size != T_ * D_ || ws_size < WS_END) { fprintf(stderr, "kernel_launch: unexpected problem (n_in %d out %d ws %zu)\n", n_in, out_size, ws_size); grid = -1; return; }
        int dev = 0, cus = 0, per_cu = 0;
        hipGetDevice(&dev); hipDeviceGetAttribute(&cus, hipDeviceAttributeMultiprocessorCount, dev);
        if (hipFuncSetAttribute((const void*)mega_fwd, hipFuncAttributeMaxDynamicSharedMemorySize, LDS_BYTES) != hipSuccess) { fprintf(stderr, "kernel_launch: hipFuncSetAttribute failed\n"); grid = -1; return; }
        if (hipOccupancyMaxActiveBlocksPerMultiprocessor(&per_cu, (const void*)mega_fwd, 512, LDS_BYTES) != hipSuccess || per_cu < 1) { fprintf(stderr, "kernel_launch: occupancy query says %d\n", per_cu); per_cu = 1; }
        (void)hipGetLastError();
        grid = cus;
        if (grid != 256) { fprintf(stderr, "kernel_launch: built for a 256-CU device (got %d)\n", cus); grid = -1; return; }
    }
    if (grid < 0) return;
    Args a{};
    for (int i = 0; i < 31; ++i) a.in[i] = (const float*)d_in[i];
    a.out = (float*)d_out; a.ws = (unsigned char*)d_ws;
    a.lam_init[0] = (float)(0.8 - 0.6 * exp(-0.3 * 1.0)); a.lam_init[1] = (float)(0.8 - 0.6 * exp(-0.3 * 3.0));
    a.ph_lo = 0; a.ph_hi = NPH;
#ifdef PROBE_PREFIX
    {
        Args p = a; p.ph_hi = PROBE_PREFIX; void* pargs[] = {&p};
        (void)hipMemsetAsync(d_ws, 0, 65536, stream);
        (void)hipLaunchCooperativeKernel((const void*)mega_fwd, dim3(grid), dim3(512), pargs, LDS_BYTES, stream);
    }
#endif
    if (hipMemsetAsync(d_ws, 0, 65536, stream) != hipSuccess) { fprintf(stderr, "kernel_launch: memset failed\n"); return; }
    void* args[] = {&a};
    hipError_t e = hipLaunchCooperativeKernel((const void*)mega_fwd, dim3(grid), dim3(512), args, LDS_BYTES, stream);
    if (e != hipSuccess) fprintf(stderr, "cooperative launch failed: %s (grid %d)\n", hipGetErrorString(e), grid);
}
```

```cpp
#include <hip/hip_runtime.h>
#include <hip/hip_cooperative_groups.h>
#include <cstdio>
#include <cstdint>
#include <cmath>
namespace cg = cooperative_groups;

namespace pg8 {
#define PG8_LAS __attribute__((address_space(3)))
typedef unsigned short bf16_t;
typedef short bf16x8 __attribute__((ext_vector_type(8)));
typedef float f32x4 __attribute__((ext_vector_type(4)));
typedef unsigned u32x4 __attribute__((ext_vector_type(4)));
constexpr int BM = 256, BK = 64, HALF = 128, HTB = HALF * BK * 2, STAGE_BYTES = 8 * HTB, NXCD = 8, WGM = 8;

__host__ __device__ __forceinline__ int lds_byte(int r, int c) { const int st = (r >> 4) * 2 + (c >> 5), rr = r & 15, cc = c & 31, ob = rr * 64 + cc * 2; return st * 1024 + (ob ^ (((ob >> 9) & 1) << 5)); }
__host__ __device__ __forceinline__ void stage_rc(int b, int& R, int& C) { const int st = b / 1024, sb = b % 1024, swz = sb ^ (((sb >> 9) & 1) << 5); R = (st >> 1) * 16 + swz / 64; C = (st & 1) * 32 + (swz % 64) / 2; }
__host__ __device__ __forceinline__ int perm32(int rho) { const int n = rho >> 4, i = rho & 15; return 8 * (i >> 2) + 4 * n + (i & 3); }

struct Unit { int pm, pn; };
struct Gemm { const bf16_t* A; const bf16_t* Bt; int M, N, K, lda, ldb; long a_pn, b_pn, b_b; int pm_per_b; };

struct StaticOrder {
    int nM, nN, nwg, G, c;
    __host__ __device__ void init(int M, int N, int G_, int c_) { nM = M / BM; nN = N / BM; nwg = nM * nN; G = G_; c = c_; }
    __host__ __device__ bool next(int i, Unit& u) const {
        const long L = (long)i * G + c; if (L >= nwg) return false;
        int wgid = (int)L; { const int q = nwg / NXCD, r = nwg % NXCD, xcd = wgid % NXCD, off = wgid / NXCD; wgid = (xcd < r ? xcd * (q + 1) : r * (q + 1) + (xcd - r) * q) + off; }
        const int nig = WGM * nN, gid = wgid / nig, fm = gid * WGM, gsz = (nM - fm) < WGM ? (nM - fm) : WGM;
        u.pm = fm + ((wgid % nig) % gsz); u.pn = (wgid % nig) / gsz; return true;
    }
    __device__ __forceinline__ void ptrs(const Unit& u, const Gemm& g, const char*& a, const char*& b) const {
        a = (const char*)(g.A + (size_t)u.pm * BM * g.lda + (size_t)u.pn * g.a_pn);
        b = (const char*)(g.Bt + (size_t)u.pn * g.b_pn + (size_t)(u.pm / g.pm_per_b) * g.b_b);
    }
    __device__ __forceinline__ void a_ready(const Unit&) const {}
    __device__ __forceinline__ void done(const Unit&) const {}
};

__device__ __forceinline__ unsigned cvt_pk_bf16(float lo, float hi) { unsigned r; asm volatile("v_cvt_pk_bf16_f32 %0, %1, %2" : "=v"(r) : "v"(lo), "v"(hi)); return r; }

struct EpiU {
    static constexpr bool PERM = true, AFTER_DRAIN = false;
    int mode;
    bf16_t* O; int ldc; int act; int scale_cols; float scale;
    float* small_out; int small_pn;
    const float* base; const bf16_t* baseb; bf16_t* outb;
    __device__ __forceinline__ void operator()(const f32x4 (&acc)[2][2][4][2], const Unit& u, int wr, int wc, int fr, int fq) const {
        const int row0 = u.pm * BM + wr * 64 + fr; const int col0 = u.pn * BM + wc * 32 + 8 * fq;
        if (mode == 0) {
            if (small_out && u.pn == small_pn) {
                if (wc == 0) {
#pragma unroll
                    for (int ai = 0; ai < 2; ++ai)
#pragma unroll
                        for (int m = 0; m < 4; ++m) { float* p = small_out + (size_t)(row0 + ai * HALF + m * 16) * 32 + 8 * fq; *(f32x4*)p = acc[ai][0][m][0]; *(f32x4*)(p + 4) = acc[ai][0][m][1]; }
                }
                return;
            }
#pragma unroll
            for (int ai = 0; ai < 2; ++ai)
#pragma unroll
                for (int m = 0; m < 4; ++m) { bf16_t* rowp = O + (size_t)(row0 + ai * HALF + m * 16) * ldc + col0;
#pragma unroll
                    for (int bj = 0; bj < 2; ++bj) { f32x4 v0 = acc[ai][bj][m][0], v1 = acc[ai][bj][m][1];
                        if (act == 1) {
#pragma unroll
                            for (int e = 0; e < 4; ++e) { float t0 = fmaxf(v0[e], 0.f), t1 = fmaxf(v1[e], 0.f); v0[e] = t0 * t0; v1[e] = t1 * t1; } }
                        const float sc = (col0 + bj * HALF < scale_cols) ? scale : 1.f;
                        v0 = v0 * sc; v1 = v1 * sc; u32x4 w; w.x = cvt_pk_bf16(v0[0], v0[1]); w.y = cvt_pk_bf16(v0[2], v0[3]); w.z = cvt_pk_bf16(v1[0], v1[1]); w.w = cvt_pk_bf16(v1[2], v1[3]);
                        *(u32x4*)(rowp + bj * HALF) = w; } }
        } else {
#pragma unroll
            for (int ai = 0; ai < 2; ++ai)
#pragma unroll
                for (int m = 0; m < 4; ++m) { const size_t off = (size_t)(row0 + ai * HALF + m * 16) * ldc + col0;
#pragma unroll
                    for (int bj = 0; bj < 2; ++bj) { f32x4 b0, b1;
                        if (baseb) { const u32x4 wv = *(const u32x4*)(baseb + off + bj * HALF);
                            b0 = (f32x4){__builtin_bit_cast(float, wv.x << 16), __builtin_bit_cast(float, wv.x & 0xffff0000u), __builtin_bit_cast(float, wv.y << 16), __builtin_bit_cast(float, wv.y & 0xffff0000u)};
                            b1 = (f32x4){__builtin_bit_cast(float, wv.z << 16), __builtin_bit_cast(float, wv.z & 0xffff0000u), __builtin_bit_cast(float, wv.w << 16), __builtin_bit_cast(float, wv.w & 0xffff0000u)}; }
                        else { const float* bp = base + off + bj * HALF; b0 = *(const f32x4*)bp; b1 = *(const f32x4*)(bp + 4); }
                        const f32x4 x0 = b0 + acc[ai][bj][m][0], x1 = b1 + acc[ai][bj][m][1];
                        u32x4 w; w.x = cvt_pk_bf16(x0[0], x0[1]); w.y = cvt_pk_bf16(x0[2], x0[3]); w.z = cvt_pk_bf16(x1[0], x1[1]); w.w = cvt_pk_bf16(x1[2], x1[3]);
                        *(u32x4*)(outb + off + bj * HALF) = w; } }
        }
    }
};

template <class Epi, class Sched, bool ALIGN_EPI = false, bool SP2 = false>
__device__ __forceinline__ void gemm_phase(PG8_LAS unsigned char* lds, const Gemm g, const Sched& S, const Epi& E, const int tid) {
    const int wid = __builtin_amdgcn_readfirstlane(tid >> 6), lane = tid & 63, wr = wid >> 2, wc = wid & 3, fr = lane & 15, fq = lane >> 4;
    const int K = g.K, nt = K / BK;
    unsigned voffA[2], voffB[2];
#pragma unroll
    for (int i = 0; i < 2; ++i) { int R, C; stage_rc(tid * 16 + i * 8192, R, C); const int Rb = Epi::PERM ? ((R & ~31) + perm32(R & 31)) : R;
        voffA[i] = (unsigned)(R * g.lda + C) * 2u; voffB[i] = (unsigned)(Rb * g.ldb + C) * 2u; }
    const size_t kstep = (size_t)(BK * 2);
    const size_t hstepA = (size_t)HALF * g.lda * 2, hstepB = (size_t)HALF * g.ldb * 2;
    const unsigned ldsw = (unsigned)wid * 1024u;
    const int aoff = lds_byte(wr * 64 + fr, fq * 8), boff = lds_byte(wc * 32 + fr, fq * 8);
#define PG8_SA(b, h) (((b) * 2 + (h)) * HTB)
#define PG8_SB(b, h) ((4 + (b) * 2 + (h)) * HTB)
#define PG8_STAGE(bufoff, gbase, voff) do { _Pragma("unroll") for (int _i = 0; _i < 2; ++_i) \
        __builtin_amdgcn_global_load_lds((const unsigned*)((const char*)(gbase) + (voff)[_i]), (PG8_LAS unsigned*)(lds + (bufoff) + ldsw + _i * 8192), 16, 0, 0); } while (0)
#define PG8_LDA(dst, b, h) do { _Pragma("unroll") for (int m = 0; m < 4; ++m) _Pragma("unroll") for (int k = 0; k < 2; ++k) dst[m][k] = *(const PG8_LAS bf16x8*)(lds + PG8_SA(b, h) + aoff + m * 2048 + k * 1024); } while (0)
#define PG8_LDB(dst, b, h) do { _Pragma("unroll") for (int n = 0; n < 2; ++n) _Pragma("unroll") for (int k = 0; k < 2; ++k) dst[n][k] = *(const PG8_LAS bf16x8*)(lds + PG8_SB(b, h) + boff + n * 2048 + k * 1024); } while (0)
#define PG8_MMA(ai, bj, At, Bt) do { __builtin_amdgcn_s_setprio(1); _Pragma("unroll") for (int m = 0; m < 4; ++m) _Pragma("unroll") for (int n = 0; n < 2; ++n) _Pragma("unroll") for (int k = 0; k < 2; ++k) \
        acc[ai][bj][m][n] = __builtin_amdgcn_mfma_f32_16x16x32_bf16(Bt[n][k], At[m][k], acc[ai][bj][m][n], 0, 0, 0); __builtin_amdgcn_s_setprio(0); } while (0)
#define PG8_WAIT_V(n) asm volatile("s_waitcnt vmcnt(" #n ")" ::: "memory")
#define PG8_WAIT_L(n) asm volatile("s_waitcnt lgkmcnt(" #n ")" ::: "memory")
#define PG8_BAR __builtin_amdgcn_s_barrier()
#define PG8_SCHED __builtin_amdgcn_sched_barrier(0)
    Unit cur, nxt; int ui = 0;
    if (!S.next(0, cur)) return;
    f32x4 acc[2][2][4][2];
#pragma unroll
    for (int a = 0; a < 2; ++a)
#pragma unroll
        for (int b = 0; b < 2; ++b)
#pragma unroll
            for (int m = 0; m < 4; ++m)
#pragma unroll
                for (int n = 0; n < 2; ++n) acc[a][b][m][n] = (f32x4){0.f, 0.f, 0.f, 0.f};
    bf16x8 At[4][2], B0[2][2], B1[2][2];
    const char* cA; const char* cB; S.ptrs(cur, g, cA, cB);
    S.a_ready(cur);
    if constexpr (SP2) {
        PG8_STAGE(PG8_SB(0, 0), cB, voffB); PG8_STAGE(PG8_SB(0, 1), cB + hstepB, voffB); PG8_STAGE(PG8_SA(0, 0), cA, voffA); PG8_STAGE(PG8_SA(0, 1), cA + hstepA, voffA);
        if (wr == 1) PG8_BAR;
        PG8_WAIT_V(2); PG8_BAR;
        PG8_STAGE(PG8_SB(1, 0), cB + kstep, voffB); PG8_STAGE(PG8_SA(1, 0), cA + kstep, voffA); PG8_STAGE(PG8_SB(1, 1), cB + hstepB + kstep, voffB);
        PG8_WAIT_V(6); PG8_BAR;
    } else {
        PG8_STAGE(PG8_SB(0, 0), cB, voffB); PG8_STAGE(PG8_SA(0, 0), cA, voffA); PG8_STAGE(PG8_SB(0, 1), cB + hstepB, voffB); PG8_STAGE(PG8_SA(0, 1), cA + hstepA, voffA);
        if (wr == 1) PG8_BAR;
        PG8_WAIT_V(4); PG8_BAR;
        PG8_STAGE(PG8_SB(1, 0), cB + kstep, voffB); PG8_STAGE(PG8_SA(1, 0), cA + kstep, voffA); PG8_STAGE(PG8_SB(1, 1), cB + hstepB + kstep, voffB);
        PG8_WAIT_V(6); PG8_BAR;
    }
    for (;;) {
        const bool has_next = S.next(ui + 1, nxt);
        const char* nA = cA; const char* nB = cB; if (has_next) S.ptrs(nxt, g, nA, nB);
        for (int t = 0; t < nt; t += 2) {
            const bool last = (t == nt - 2);
            const char* a1 = cA + (size_t)(t + 1) * kstep;
            const char* a2 = last ? nA : cA + (size_t)(t + 2) * kstep; const char* b2 = last ? nB : cB + (size_t)(t + 2) * kstep;
            const char* a3 = a2 + kstep; const char* b3 = b2 + kstep;
            if (last && has_next) S.a_ready(nxt);
            if constexpr (SP2) {
            PG8_LDB(B0, 0, 0); PG8_LDB(B1, 0, 1); PG8_SCHED; PG8_LDA(At, 0, 0); PG8_STAGE(PG8_SA(1, 1), a1 + hstepA, voffA);
            PG8_WAIT_V(8); PG8_WAIT_L(0); PG8_BAR; PG8_MMA(0, 0, At, B0); PG8_MMA(0, 1, At, B1); PG8_BAR; PG8_SCHED;
            PG8_LDA(At, 0, 1); PG8_STAGE(PG8_SB(0, 0), b2, voffB); PG8_STAGE(PG8_SB(0, 1), b2 + hstepB, voffB); PG8_STAGE(PG8_SA(0, 0), a2, voffA);
            PG8_WAIT_V(8); PG8_WAIT_L(0); PG8_BAR; PG8_MMA(1, 0, At, B0); PG8_MMA(1, 1, At, B1); PG8_BAR; PG8_SCHED;
            PG8_LDB(B0, 1, 0); PG8_LDB(B1, 1, 1); PG8_SCHED; PG8_LDA(At, 1, 0); PG8_STAGE(PG8_SA(0, 1), a2 + hstepA, voffA);
            PG8_WAIT_V(8); PG8_WAIT_L(0); PG8_BAR; PG8_MMA(0, 0, At, B0); PG8_MMA(0, 1, At, B1); PG8_BAR; PG8_SCHED;
            PG8_LDA(At, 1, 1); PG8_STAGE(PG8_SB(1, 0), b3, voffB); PG8_STAGE(PG8_SB(1, 1), b3 + hstepB, voffB); PG8_STAGE(PG8_SA(1, 0), a3, voffA);
            PG8_WAIT_V(8); PG8_WAIT_L(0); PG8_BAR; PG8_MMA(1, 0, At, B0); PG8_MMA(1, 1, At, B1); PG8_BAR; PG8_SCHED;
            } else {
            PG8_LDB(B0, 0, 0); PG8_SCHED; PG8_LDA(At, 0, 0); PG8_STAGE(PG8_SA(1, 1), a1 + hstepA, voffA);
            PG8_WAIT_L(8); PG8_BAR; PG8_WAIT_L(0); PG8_MMA(0, 0, At, B0); PG8_BAR; PG8_SCHED;
            PG8_LDB(B1, 0, 1); PG8_STAGE(PG8_SB(0, 0), b2, voffB);
            PG8_BAR; PG8_WAIT_L(0); PG8_MMA(0, 1, At, B1); PG8_BAR;
            PG8_LDA(At, 0, 1); PG8_STAGE(PG8_SA(0, 0), a2, voffA);
            PG8_BAR; PG8_WAIT_L(0); PG8_MMA(1, 0, At, B0); PG8_BAR; PG8_SCHED;
            PG8_STAGE(PG8_SB(0, 1), b2 + hstepB, voffB);
            PG8_WAIT_V(6); PG8_BAR; PG8_MMA(1, 1, At, B1); PG8_BAR;
            PG8_LDB(B0, 1, 0); PG8_SCHED; PG8_LDA(At, 1, 0); PG8_STAGE(PG8_SA(0, 1), a2 + hstepA, voffA);
            PG8_WAIT_L(8); PG8_BAR; PG8_WAIT_L(0); PG8_MMA(0, 0, At, B0); PG8_BAR; PG8_SCHED;
            PG8_LDB(B1, 1, 1); PG8_STAGE(PG8_SB(1, 0), b3, voffB);
            PG8_BAR; PG8_WAIT_L(0); PG8_MMA(0, 1, At, B1); PG8_BAR;
            PG8_LDA(At, 1, 1); PG8_STAGE(PG8_SA(1, 0), a3, voffA);
            PG8_BAR; PG8_WAIT_L(0); PG8_MMA(1, 0, At, B0); PG8_BAR; PG8_SCHED;
            PG8_STAGE(PG8_SB(1, 1), b3 + hstepB, voffB);
            PG8_WAIT_V(6); PG8_BAR; PG8_MMA(1, 1, At, B1); PG8_BAR;
            }
        }
        if constexpr (ALIGN_EPI) { if (wr == 0) PG8_BAR; }
        if constexpr (!Epi::AFTER_DRAIN) { E(acc, cur, wr, wc, fr, fq); S.done(cur); }
        if (!has_next) break;
#pragma unroll
        for (int a = 0; a < 2; ++a)
#pragma unroll
            for (int b = 0; b < 2; ++b)
#pragma unroll
                for (int m = 0; m < 4; ++m)
#pragma unroll
                    for (int n = 0; n < 2; ++n) acc[a][b][m][n] = (f32x4){0.f, 0.f, 0.f, 0.f};
        cur = nxt; cA = nA; cB = nB; ++ui;
        if constexpr (ALIGN_EPI) { if (wr == 1) PG8_BAR; }
    }
    PG8_WAIT_V(0);
    if constexpr (!ALIGN_EPI) { if (wr == 0) PG8_BAR; }
    PG8_BAR;
    if constexpr (Epi::AFTER_DRAIN) { E.fused(acc, cur, wr, wc, fr, fq, lds, wid, lane); S.done(cur); }
#undef PG8_SA
#undef PG8_SB
#undef PG8_STAGE
#undef PG8_LDA
#undef PG8_LDB
#undef PG8_MMA
#undef PG8_WAIT_V
#undef PG8_WAIT_L
#undef PG8_BAR
#undef PG8_SCHED
}
}

#define LAS __attribute__((address_space(3)))
#define DI __device__ __forceinline__
typedef unsigned short bf16;
typedef short bf16x8 __attribute__((ext_vector_type(8)));
typedef short s16x4 __attribute__((ext_vector_type(4)));
typedef float f32x4 __attribute__((ext_vector_type(4)));
typedef float f32x16 __attribute__((ext_vector_type(16)));
typedef unsigned u32x4 __attribute__((ext_vector_type(4)));
typedef unsigned u32x2 __attribute__((ext_vector_type(2)));
typedef LAS unsigned char* ldsp;

constexpr int T_ = 32768, L_ = 16384, D_ = 1024;
constexpr float EPS_ = 1e-5f;
constexpr size_t MiB = (size_t)1 << 20;
constexpr size_t WS_W = 1 * MiB;
constexpr size_t WS_WA = WS_W, WS_WV = WS_W + 9 * MiB, WS_WOUT = WS_W + 11 * MiB, WS_WQ = WS_W + 15 * MiB, WS_WKV = WS_W + 17 * MiB,
                 WS_WXO = WS_W + 21 * MiB, WS_W1 = WS_W + 23 * MiB, WS_W2 = WS_W + 31 * MiB;
constexpr size_t WS_XN = 40 * MiB, WS_KT = WS_XN, WS_DG = WS_XN + 33 * MiB;
constexpr size_t WS_BIG = 104 * MiB, WS_VT = 376 * MiB, WS_ORAW = 441 * MiB, WS_SMALL = 505 * MiB, WS_MEMN = 509 * MiB, WS_KX = 510 * MiB, WS_VXT = 511 * MiB, WS_END = 512 * MiB;
constexpr int PROJ_LD = 4352;
constexpr int PC_Z = 0, PC_XBC = 1024, PC_Q = 2304, PC_K = 2816, PC_R = 3328;
constexpr int LDS_BYTES = 136 * 1024;
constexpr int VT_LD = T_ + 64, KT_LD = T_ + 64, QK_LD = 2048 + 64;

DI unsigned f2bf(float f) { unsigned u = __builtin_bit_cast(unsigned, f); return (u + 0x7fffu + ((u >> 16) & 1u)) >> 16; }
typedef float f32x2_t __attribute__((ext_vector_type(2))); typedef __bf16 bf16x2_t __attribute__((ext_vector_type(2)));
DI unsigned pk2(float lo, float hi) { f32x2_t v = {lo, hi}; bf16x2_t b = __builtin_convertvector(v, bf16x2_t); return __builtin_bit_cast(unsigned, b); }
DI float bf2f(unsigned h) { return __builtin_bit_cast(float, h << 16); }
DI float bflo(unsigned w) { return __builtin_bit_cast(float, w << 16); }
DI float bfhi(unsigned w) { return __builtin_bit_cast(float, w & 0xffff0000u); }
DI float wave_sum(float v) {
#pragma unroll
    for (int o = 1; o < 64; o <<= 1) v += __shfl_xor(v, o);
    return v;
}
DI float wave_max(float v) {
#pragma unroll
    for (int o = 1; o < 64; o <<= 1) v = fmaxf(v, __shfl_xor(v, o));
    return v;
}
DI float siluf(float x) { return x * __builtin_amdgcn_rcpf(1.f + __builtin_amdgcn_exp2f(-1.4426950408889634f * x)); }
DI float softplusf(float x) { return x > 20.f ? x : log1pf(__expf(x)); }
DI bf16x8 lds16(ldsp p, int off) { return *(LAS bf16x8*)(p + off); }
DI s16x4 lds8(ldsp p, int off) { return *(LAS s16x4*)(p + off); }
DI bf16x8 cat8(s16x4 a, s16x4 b) { return __builtin_shufflevector(a, b, 0, 1, 2, 3, 4, 5, 6, 7); }
DI f32x4 mfma16(bf16x8 a, bf16x8 b, f32x4 c) { return __builtin_amdgcn_mfma_f32_16x16x32_bf16(a, b, c, 0, 0, 0); }
DI f32x16 mfma32(bf16x8 a, bf16x8 b, f32x16 c) { return __builtin_amdgcn_mfma_f32_32x32x16_bf16(a, b, c, 0, 0, 0); }
DI int crow(int r, int hi) { return (r & 3) + 8 * (r >> 2) + 4 * hi; }
DI float max3f(float a, float b, float c) { float r; asm("v_max3_f32 %0, %1, %2, %3" : "=v"(r) : "v"(a), "v"(b), "v"(c)); return r; }
#define LDS_FENCE() asm volatile("s_waitcnt lgkmcnt(0)" ::: "memory")

DI void rms_rows_bf16(const float* x, const float* w, bf16* out, int nrows, int gw, int NGW, int lane) {
    for (int m = 2 * gw; m < nrows; m += 2 * NGW) {
        const f32x4* xr0 = (const f32x4*)(x + (size_t)m * D_) + lane; const f32x4* xr1 = xr0 + D_ / 4;
        f32x4 v0[4], v1[4]; float s0 = 0.f, s1 = 0.f;
#pragma unroll
        for (int j = 0; j < 4; ++j) { v0[j] = xr0[64 * j]; v1[j] = xr1[64 * j]; }
#pragma unroll
        for (int j = 0; j < 4; ++j) { s0 += (v0[j].x * v0[j].x + v0[j].y * v0[j].y) + (v0[j].z * v0[j].z + v0[j].w * v0[j].w); s1 += (v1[j].x * v1[j].x + v1[j].y * v1[j].y) + (v1[j].z * v1[j].z + v1[j].w * v1[j].w); }
#pragma unroll
        for (int o = 1; o < 64; o <<= 1) { s0 += __shfl_xor(s0, o); s1 += __shfl_xor(s1, o); }
        const float r0 = rsqrtf(s0 * (1.f / D_) + EPS_), r1 = rsqrtf(s1 * (1.f / D_) + EPS_);
        u32x2* o0 = (u32x2*)(out + (size_t)m * D_) + lane; u32x2* o1 = o0 + D_ / 4;
#pragma unroll
        for (int j = 0; j < 4; ++j) { const f32x4 wv = ((const f32x4*)w)[lane + 64 * j];
            u32x2 a, b; a.x = pk2(v0[j].x * r0 * wv.x, v0[j].y * r0 * wv.y); a.y = pk2(v0[j].z * r0 * wv.z, v0[j].w * r0 * wv.w);
            b.x = pk2(v1[j].x * r1 * wv.x, v1[j].y * r1 * wv.y); b.y = pk2(v1[j].z * r1 * wv.z, v1[j].w * r1 * wv.w);
            o0[64 * j] = a; o1[64 * j] = b; }
    }
}
template <bool TO_F32> DI void rms_rows_from_bf16(const bf16* x, const float* w, bf16* outb, float* outf, int nrows, int gw, int NGW, int lane) {
    f32x4 wv[4];
#pragma unroll
    for (int j = 0; j < 4; ++j) wv[j] = ((const f32x4*)(w + lane * 16))[j];
    for (int m = 2 * gw; m < nrows; m += 2 * NGW) {
        u32x4 ra[2], rb[2];
#pragma unroll
        for (int u = 0; u < 2; ++u) { const u32x4* p = (const u32x4*)(x + (size_t)(m + u) * D_ + lane * 16); ra[u] = p[0]; rb[u] = p[1]; }
#pragma unroll
        for (int u = 0; u < 2; ++u) {
            float v[16];
            v[0] = bflo(ra[u].x); v[1] = bfhi(ra[u].x); v[2] = bflo(ra[u].y); v[3] = bfhi(ra[u].y); v[4] = bflo(ra[u].z); v[5] = bfhi(ra[u].z); v[6] = bflo(ra[u].w); v[7] = bfhi(ra[u].w);
            v[8] = bflo(rb[u].x); v[9] = bfhi(rb[u].x); v[10] = bflo(rb[u].y); v[11] = bfhi(rb[u].y); v[12] = bflo(rb[u].z); v[13] = bfhi(rb[u].z); v[14] = bflo(rb[u].w); v[15] = bfhi(rb[u].w);
            float s = 0.f;
#pragma unroll
            for (int i = 0; i < 16; ++i) s += v[i] * v[i];
            const float r = rsqrtf(wave_sum(s) * (1.f / D_) + EPS_);
#pragma unroll
            for (int i = 0; i < 16; ++i) v[i] = v[i] * r * wv[i >> 2][i & 3];
            if (TO_F32) { f32x4* o = (f32x4*)(outf + (size_t)(m + u) * D_ + lane * 16);
#pragma unroll
                for (int j = 0; j < 4; ++j) o[j] = (f32x4){v[4 * j], v[4 * j + 1], v[4 * j + 2], v[4 * j + 3]}; }
            else { u32x4 a, b; a.x = pk2(v[0], v[1]); a.y = pk2(v[2], v[3]); a.z = pk2(v[4], v[5]); a.w = pk2(v[6], v[7]); b.x = pk2(v[8], v[9]); b.y = pk2(v[10], v[11]); b.z = pk2(v[12], v[13]); b.w = pk2(v[14], v[15]);
                u32x4* o = (u32x4*)(outb + (size_t)(m + u) * D_ + lane * 16); o[0] = a; o[1] = b; }
        }
    }
}
DI void rms_rows_f32_inplace(float* x, const float* w, int nrows, int gw, int NGW, int lane) {
    for (int m = gw; m < nrows; m += NGW) {
        f32x4* xr = (f32x4*)(x + (size_t)m * D_) + lane;
        f32x4 v[4]; float s = 0.f;
#pragma unroll
        for (int j = 0; j < 4; ++j) { v[j] = xr[64 * j]; s += (v[j].x * v[j].x + v[j].y * v[j].y) + (v[j].z * v[j].z + v[j].w * v[j].w); }
        const float rstd = rsqrtf(wave_sum(s) * (1.f / D_) + EPS_);
#pragma unroll
        for (int j = 0; j < 4; ++j) { const f32x4 wv = ((const f32x4*)w)[lane + 64 * j]; xr[64 * j] = v[j] * rstd * wv; }
    }
}

DI int map_plain(int d, int off) { return d + off; }
DI int map_win(int d) { if (d < 2304) return d; if (d < 3328) return d + 16; if (d < 4352) return d + 1056; if (d < 4368) return d - 4352 + 2304; if (d < 4384) return d; return -1; }
DI void conv_item(const float* W, int ldn, int K, bf16* WT, int nrows, int mode, int off, LAS float* scr, int item, int lane) {
    const int nblk = nrows / 32, kb = item / nblk, nb = item % nblk, k0 = 64 * kb, n0 = 32 * nb;
    const int d = n0 + (lane & 31); const int sc = mode ? map_win(d) : map_plain(d, off);
#pragma unroll 8
    for (int i = 0; i < 32; ++i) { const int kk = 2 * i + (lane >> 5); scr[kk * 33 + (lane & 31)] = sc >= 0 ? W[(size_t)(k0 + kk) * ldn + sc] : 0.f; }
    LDS_FENCE();
    const int c = lane & 7;
#pragma unroll
    for (int j = 0; j < 4; ++j) { const int n = (lane >> 3) + 8 * j; const LAS float* s = scr + (8 * c) * 33 + n;
        u32x4 o; o.x = pk2(s[0 * 33], s[1 * 33]); o.y = pk2(s[2 * 33], s[3 * 33]); o.z = pk2(s[4 * 33], s[5 * 33]); o.w = pk2(s[6 * 33], s[7 * 33]);
        *(u32x4*)(WT + (size_t)(n0 + n) * K + k0 + 8 * c) = o; }
    LDS_FENCE();
}

DI void prep_unit(int unit, bf16* PROJ, float* SMALL, bf16* KT, float* DG, bf16* TAIL, const float* gla_w2, const float* gla_b, const float* dt_bias, const float* a_log,
                  const float* conv_w, const float* conv_b, ldsp lds, int tid) {
    asm volatile("" : "+v"(tid));
    const int rowbase = unit * 128;
    LAS float* sm = (LAS float*)lds; LAS float* dtL = (LAS float*)(lds + 16384);
    for (int i = tid; i < 128 * 32 / 4; i += 512) ((LAS f32x4*)sm)[i] = ((const f32x4*)(SMALL + (size_t)rowbase * 32))[i];
    __syncthreads();
    if (tid < 16) {
        const int h = tid; const float a = -__expf(a_log[h]), bias = dt_bias[h]; float cum = 0.f;
        for (int tt = 0; tt < 128; ++tt) { const float dtv = softplusf(sm[tt * 32 + h] + bias); cum += dtv * a; dtL[tt * 16 + h] = dtv;
            SMALL[((size_t)rowbase + tt) * 32 + h] = dtv; SMALL[((size_t)rowbase + tt) * 32 + 16 + h] = cum; }
    }
    {   const int col = tid;
        float w2c[16];
#pragma unroll
        for (int r = 0; r < 16; ++r) w2c[r] = gla_w2[r * 512 + col];
        const float bcol = gla_b[col];
        for (int sub = 0; sub < 2; ++sub) {
            float cum = 0.f;
#pragma unroll 1
            for (int g8 = 0; g8 < 8; ++g8) {
                unsigned qk[8];
                { const bf16* pq = PROJ + ((size_t)rowbase + sub * 64 + g8 * 8) * PROJ_LD + col;
#pragma unroll
                  for (int e = 0; e < 8; ++e) qk[e] = (unsigned)pq[(size_t)e * PROJ_LD + PC_Q] | ((unsigned)pq[(size_t)e * PROJ_LD + PC_K] << 16); }
                float kt[8];
#pragma unroll
                for (int e = 0; e < 8; ++e) {
                    const int tt = sub * 64 + g8 * 8 + e; const size_t row = (size_t)rowbase + tt;
                    float x = bcol;
#pragma unroll
                    for (int r = 0; r < 16; ++r) x += sm[tt * 32 + 16 + r] * w2c[r];
                    const float lg = (fminf(x, 0.f) - __logf(1.f + __expf(-fabsf(x)))) * 0.0625f;
                    cum += lg;
                    const float qv = bflo(qk[e]), kv = bfhi(qk[e]);
                    PROJ[row * PROJ_LD + PC_Q + col] = (bf16)f2bf(qv * __expf(cum) * 0.08838834764831845f);
                    kt[e] = kv * __expf(-cum);
                    PROJ[row * PROJ_LD + PC_K + col] = (bf16)f2bf(kt[e]);
                }
                u32x4 o; o.x = pk2(kt[0], kt[1]); o.y = pk2(kt[2], kt[3]); o.z = pk2(kt[4], kt[5]); o.w = pk2(kt[6], kt[7]);
                *(u32x4*)(KT + (size_t)col * KT_LD + rowbase + sub * 64 + g8 * 8) = o;
            }
            DG[(size_t)((rowbase >> 6) + sub) * 512 + col] = __expf(cum);
        }
    }
    const int tin = rowbase & (L_ - 1);
    __syncthreads();
#pragma unroll 1
    for (int i = 4; i >= 0; --i) { const int it = tid + 512 * i, pair = it % 640, slab = it / 640, c0 = 2 * pair;
        unsigned rw[35];
        bf16* base = PROJ + ((size_t)rowbase + 32 * slab) * PROJ_LD + PC_XBC + c0;
#pragma unroll
        for (int j = 0; j < 35; ++j) rw[j] = (tin + 32 * slab - 3 + j >= 0) ? *(const unsigned*)(base + (ptrdiff_t)(j - 3) * PROJ_LD) : 0u;
        float cw0[4], cw1[4];
#pragma unroll
        for (int j = 0; j < 4; ++j) { cw0[j] = conv_w[j * 1280 + c0]; cw1[j] = conv_w[j * 1280 + c0 + 1]; }
        const float cb0 = conv_b[c0], cb1 = conv_b[c0 + 1];
        const bool isx = c0 < 1024; const int hh = (c0 >> 6) & 15;
        __syncthreads();
#pragma unroll
        for (int r = 0; r < 32; ++r) { float a0 = cb0, a1 = cb1;
#pragma unroll
            for (int j = 0; j < 4; ++j) { a0 += cw0[j] * bflo(rw[r + j]); a1 += cw1[j] * bfhi(rw[r + j]); }
            a0 = siluf(a0); a1 = siluf(a1);
            const int row = 32 * slab + r;
            if (isx) { const float d = dtL[row * 16 + hh]; a0 *= d; a1 *= d; }
            bf16* dst = (row >= 125) ? TAIL + ((size_t)unit * 3 + (row - 125)) * 1280 + c0 : base + (size_t)r * PROJ_LD;
            *(unsigned*)dst = pk2(a0, a1); }
    }
    __syncthreads();
}

#define BAR_LDS() asm volatile("s_waitcnt lgkmcnt(0)\n\ts_barrier" ::: "memory")
DI void ssd_chain(int b, int h, bf16* PROJ, const float* SMALL, const bf16* TAIL, const float* d_skip, ldsp lds, int tid) {
    constexpr int CS = 0, BS = 18432, BWT = 36864, XDT = 54272, MS = 71680, SS = 106496, CUML = 115712, DTL = 116224;
    asm volatile("" : "+v"(tid));
    const int lane = tid & 63, w = __builtin_amdgcn_readfirstlane(tid >> 6), quad = lane >> 4, l16 = lane & 15;
    const int g = h >> 3, cp = lane & 31, th = lane >> 5, tb = 16 * w + 8 * th;
    LAS float* cumL = (LAS float*)(lds + CUML); LAS float* dtL = (LAS float*)(lds + DTL);
    int ch[3]; ch[0] = h * 64 + 2 * cp; ch[1] = 1024 + g * 64 + 2 * cp; ch[2] = 1152 + g * 64 + 2 * cp;
    const float Dh = d_skip[h];
    const int pi = w >> 1, q = 16 * w + l16;
    f32x4 S[2]; S[0] = (f32x4){0.f, 0.f, 0.f, 0.f}; S[1] = S[0];
    unsigned raw[3][8]; float cmv[8], cum_last, cl_t = 0.f, dt_t = 0.f; u32x2 zz[4];
#define SSD_LOAD(c_) do { const size_t r0_ = (size_t)b * L_ + (size_t)(c_) * 128; \
        _Pragma("unroll") for (int i = 0; i < 8; ++i) cmv[i] = SMALL[(r0_ + tb + i) * 32 + 16 + h]; \
        cum_last = SMALL[(r0_ + 127) * 32 + 16 + h]; \
        if (tid < 128) { cl_t = SMALL[(r0_ + tid) * 32 + 16 + h]; dt_t = SMALL[(r0_ + tid) * 32 + h]; } \
        _Pragma("unroll") for (int arr = 0; arr < 3; ++arr) _Pragma("unroll") for (int i = 0; i < 8; ++i) { const int rr = tb + i; \
            const bf16* sp = (rr >= 125) ? TAIL + ((r0_ >> 7) * 3 + (rr - 125)) * 1280 + ch[arr] : PROJ + (r0_ + rr) * PROJ_LD + PC_XBC + ch[arr]; \
            raw[arr][i] = *(const unsigned*)sp; } \
        _Pragma("unroll") for (int pt = 0; pt < 4; ++pt) zz[pt] = *(const u32x2*)(PROJ + (r0_ + q) * PROJ_LD + PC_Z + h * 64 + 16 * pt + quad * 4); } while (0)
    SSD_LOAD(0);
    for (int c = 0; c < 128; ++c) {
        const size_t row0 = (size_t)b * L_ + (size_t)c * 128;
        if (tid < 128) { cumL[tid] = cl_t; dtL[tid] = dt_t; }
        {
            u32x4 v0, v1;
            v0.x = __builtin_amdgcn_perm(raw[0][1], raw[0][0], 0x05040100u); v0.y = __builtin_amdgcn_perm(raw[0][3], raw[0][2], 0x05040100u);
            v0.z = __builtin_amdgcn_perm(raw[0][5], raw[0][4], 0x05040100u); v0.w = __builtin_amdgcn_perm(raw[0][7], raw[0][6], 0x05040100u);
            v1.x = __builtin_amdgcn_perm(raw[0][1], raw[0][0], 0x07060302u); v1.y = __builtin_amdgcn_perm(raw[0][3], raw[0][2], 0x07060302u);
            v1.z = __builtin_amdgcn_perm(raw[0][5], raw[0][4], 0x07060302u); v1.w = __builtin_amdgcn_perm(raw[0][7], raw[0][6], 0x07060302u);
            *(LAS u32x4*)(lds + XDT + (2 * cp) * 272 + tb * 2) = v0; *(LAS u32x4*)(lds + XDT + (2 * cp + 1) * 272 + tb * 2) = v1;
        }
        {
            float o0[8], o1[8];
#pragma unroll
            for (int i = 0; i < 8; ++i) { *(LAS unsigned*)(lds + BS + (tb + i) * 144 + 4 * cp) = raw[1][i];
                const float wg = __expf(cum_last - cmv[i]); o0[i] = bflo(raw[1][i]) * wg; o1[i] = bfhi(raw[1][i]) * wg; }
            u32x4 v0, v1; v0.x = pk2(o0[0], o0[1]); v0.y = pk2(o0[2], o0[3]); v0.z = pk2(o0[4], o0[5]); v0.w = pk2(o0[6], o0[7]);
            v1.x = pk2(o1[0], o1[1]); v1.y = pk2(o1[2], o1[3]); v1.z = pk2(o1[4], o1[5]); v1.w = pk2(o1[6], o1[7]);
            *(LAS u32x4*)(lds + BWT + (2 * cp) * 272 + tb * 2) = v0; *(LAS u32x4*)(lds + BWT + (2 * cp + 1) * 272 + tb * 2) = v1;
        }
#pragma unroll
        for (int i = 0; i < 8; ++i) *(LAS unsigned*)(lds + CS + (tb + i) * 144 + 4 * cp) = raw[2][i];
        u32x2 zc[4];
#pragma unroll
        for (int pt = 0; pt < 4; ++pt) zc[pt] = zz[pt];
        if (c + 1 < 128) SSD_LOAD(c + 1);
        BAR_LDS();
        const float cq = cumL[q], dq = dtL[q];
        const int fo = quad * 16;
        {
            bf16x8 cb[2];
#pragma unroll
            for (int k = 0; k < 2; ++k) cb[k] = lds16(lds, CS + q * 144 + 64 * k + fo);
#pragma unroll
            for (int jh = 0; jh < 2; ++jh) {
                bf16x8 ba[4][2];
#pragma unroll
                for (int j4 = 0; j4 < 4; ++j4) if (4 * jh + j4 <= w) {
#pragma unroll
                    for (int k = 0; k < 2; ++k) ba[j4][k] = lds16(lds, BS + (16 * (4 * jh + j4) + l16) * 144 + 64 * k + fo); }
                __builtin_amdgcn_sched_barrier(0);
                f32x4 acc[4];
#pragma unroll
                for (int j4 = 0; j4 < 4; ++j4) { acc[j4] = (f32x4){0.f, 0.f, 0.f, 0.f};
                    if (4 * jh + j4 <= w) { acc[j4] = mfma16(ba[j4][0], cb[0], acc[j4]); acc[j4] = mfma16(ba[j4][1], cb[1], acc[j4]); } }
                __builtin_amdgcn_sched_barrier(0);
#pragma unroll
                for (int j4 = 0; j4 < 4; ++j4) {
                    const int s0 = 16 * (4 * jh + j4) + quad * 4;
                    const f32x4 cs = *(LAS f32x4*)(cumL + s0);
                    float v[4];
#pragma unroll
                    for (int jj = 0; jj < 4; ++jj) { const int s = s0 + jj; float t = (s <= q) ? acc[j4][jj] * __expf(cq - cs[jj]) : 0.f; if (s == q && dq > 0.f) t += Dh / dq; v[jj] = t; }
                    u32x2 o; o.x = pk2(v[0], v[1]); o.y = pk2(v[2], v[3]);
                    *(LAS u32x2*)(lds + MS + q * 272 + s0 * 2) = o;
                }
            }
        }
#pragma unroll
        for (int i = 0; i < 2; ++i) { const int ni = (w & 1) * 2 + i; u32x2 o; o.x = pk2(S[i][0], S[i][1]); o.y = pk2(S[i][2], S[i][3]);
            *(LAS u32x2*)(lds + SS + (16 * pi + l16) * 144 + (16 * ni + quad * 4) * 2) = o; }
        const float el = __expf(cumL[127]);
        BAR_LDS();
        const float eq = __expf(cq);
        {
            bf16x8 mb[4], cb[2];
#pragma unroll
            for (int ks = 0; ks < 4; ++ks) mb[ks] = lds16(lds, MS + q * 272 + 64 * ks + fo);
#pragma unroll
            for (int k = 0; k < 2; ++k) cb[k] = lds16(lds, CS + q * 144 + 64 * k + fo);
#pragma unroll
            for (int pt = 0; pt < 4; ++pt) {
                bf16x8 xa[4], sa[2];
#pragma unroll
                for (int ks = 0; ks < 4; ++ks) xa[ks] = lds16(lds, XDT + (16 * pt + l16) * 272 + 64 * ks + fo);
#pragma unroll
                for (int k = 0; k < 2; ++k) sa[k] = lds16(lds, SS + (16 * pt + l16) * 144 + 64 * k + fo);
                __builtin_amdgcn_sched_barrier(0);
                f32x4 y1 = (f32x4){0.f, 0.f, 0.f, 0.f}, y2 = y1;
#pragma unroll
                for (int ks = 0; ks < 4; ++ks) if (32 * ks < 16 * w + 16) y1 = mfma16(xa[ks], mb[ks], y1);
#pragma unroll
                for (int k = 0; k < 2; ++k) y2 = mfma16(sa[k], cb[k], y2);
                __builtin_amdgcn_sched_barrier(0);
                bf16* zp = PROJ + (row0 + q) * PROJ_LD + PC_Z + h * 64 + 16 * pt + quad * 4;
                const float z0 = bflo(zc[pt].x), z1 = bfhi(zc[pt].x), z2 = bflo(zc[pt].y), z3 = bfhi(zc[pt].y);
                u32x2 o; o.x = pk2((y1[0] + eq * y2[0]) * siluf(z0), (y1[1] + eq * y2[1]) * siluf(z1)); o.y = pk2((y1[2] + eq * y2[2]) * siluf(z2), (y1[3] + eq * y2[3]) * siluf(z3));
                *(u32x2*)zp = o;
            }
        }
        {
            bf16x8 xb[4], wa[2][4];
#pragma unroll
            for (int ks = 0; ks < 4; ++ks) xb[ks] = lds16(lds, XDT + (16 * pi + l16) * 272 + 64 * ks + fo);
#pragma unroll
            for (int i = 0; i < 2; ++i)
#pragma unroll
                for (int ks = 0; ks < 4; ++ks) wa[i][ks] = lds16(lds, BWT + (16 * ((w & 1) * 2 + i) + l16) * 272 + 64 * ks + fo);
            __builtin_amdgcn_sched_barrier(0);
            S[0] = S[0] * el; S[1] = S[1] * el;
#pragma unroll
            for (int ks = 0; ks < 4; ++ks) { S[0] = mfma16(wa[0][ks], xb[ks], S[0]); S[1] = mfma16(wa[1][ks], xb[ks], S[1]); }
        }
        BAR_LDS();
    }
#undef SSD_LOAD
}

DI void gla_chain(int b, int h, int vs, const bf16* PROJ, const bf16* KT, const bf16* VT, const float* DG, bf16* ORAW, ldsp lds, int tid) {
    constexpr int QS = 0, KS = 17408, KTS = 34816, VTS = 53248, PS = 62464, STS = 71680, DLO = 89088;
    asm volatile("" : "+v"(tid));
    const int lane = tid & 63, w = __builtin_amdgcn_readfirstlane(tid >> 6), quad = lane >> 4, l16 = lane & 15, qi = w >> 1;
    LAS float* dL = (LAS float*)(lds + DLO);
    f32x4 S[4];
#pragma unroll
    for (int i = 0; i < 4; ++i) S[i] = (f32x4){0.f, 0.f, 0.f, 0.f};
    u32x4 Aq[2], Ak[2], Akt[2], Av, Bq[2], Bk[2], Bkt[2], Bv; float Ad = 0.f, Bd = 0.f;
#define GLA_LOAD(c_, P) do { const size_t r0_ = (size_t)b * L_ + (size_t)(c_) * 64; \
        _Pragma("unroll") for (int i = 0; i < 2; ++i) { const int idx = tid + 512 * i, r = idx >> 4, cc = idx & 15; \
            P##q[i] = *(const u32x4*)(PROJ + (r0_ + r) * PROJ_LD + PC_Q + h * 128 + cc * 8); P##k[i] = *(const u32x4*)(PROJ + (r0_ + r) * PROJ_LD + PC_K + h * 128 + cc * 8); } \
        _Pragma("unroll") for (int i = 0; i < 2; ++i) { const int idx = tid + 512 * i, r = idx >> 3, cc = idx & 7; P##kt[i] = *(const u32x4*)(KT + (size_t)(h * 128 + r) * KT_LD + r0_ + cc * 8); } \
        { const int r = tid >> 3, cc = tid & 7; P##v = *(const u32x4*)(VT + (size_t)(h * 256 + vs * 64 + r) * VT_LD + r0_ + cc * 8); } \
        if (tid < 128) P##d = DG[(r0_ >> 6) * 512 + h * 128 + tid]; } while (0)
#define GLA_PUT(P) do { \
        _Pragma("unroll") for (int i = 0; i < 2; ++i) { const int idx = tid + 512 * i, r = idx >> 4, cc = idx & 15; \
            *(LAS u32x4*)(lds + QS + r * 272 + cc * 16) = P##q[i]; *(LAS u32x4*)(lds + KS + r * 272 + cc * 16) = P##k[i]; } \
        _Pragma("unroll") for (int i = 0; i < 2; ++i) { const int idx = tid + 512 * i, r = idx >> 3, cc = idx & 7; *(LAS u32x4*)(lds + KTS + r * 144 + cc * 16) = P##kt[i]; } \
        { const int r = tid >> 3, cc = tid & 7; *(LAS u32x4*)(lds + VTS + r * 144 + cc * 16) = P##v; } \
        if (tid < 128) dL[tid] = P##d; } while (0)
#define GLA_COMPUTE(c_) do { \
        const size_t row0 = (size_t)b * L_ + (size_t)(c_) * 64; \
        BAR_LDS(); \
        const int q = 16 * qi + l16; \
        const int fo = quad * 16; \
        { \
            bf16x8 fb[4], fa[2][4]; \
_Pragma("unroll") \
            for (int ks = 0; ks < 4; ++ks) fb[ks] = lds16(lds, QS + q * 272 + 64 * ks + fo); \
_Pragma("unroll") \
            for (int i = 0; i < 2; ++i) \
_Pragma("unroll") \
                for (int ks = 0; ks < 4; ++ks) fa[i][ks] = lds16(lds, KS + (16 * ((w & 1) * 2 + i) + l16) * 272 + 64 * ks + fo); \
            __builtin_amdgcn_sched_barrier(0); \
            f32x4 acc[2]; acc[0] = (f32x4){0.f, 0.f, 0.f, 0.f}; acc[1] = acc[0]; \
_Pragma("unroll") \
            for (int ks = 0; ks < 4; ++ks) { acc[0] = mfma16(fa[0][ks], fb[ks], acc[0]); acc[1] = mfma16(fa[1][ks], fb[ks], acc[1]); } \
            __builtin_amdgcn_sched_barrier(0); \
_Pragma("unroll") \
            for (int i = 0; i < 2; ++i) { const int s0 = 16 * ((w & 1) * 2 + i) + quad * 4; \
                u32x2 o; o.x = pk2(s0 <= q ? acc[i][0] : 0.f, s0 + 1 <= q ? acc[i][1] : 0.f); o.y = pk2(s0 + 2 <= q ? acc[i][2] : 0.f, s0 + 3 <= q ? acc[i][3] : 0.f); \
                *(LAS u32x2*)(lds + PS + q * 144 + s0 * 2) = o; } \
        } \
_Pragma("unroll") \
        for (int vt = 0; vt < 4; ++vt) { u32x2 o; o.x = pk2(S[vt][0], S[vt][1]); o.y = pk2(S[vt][2], S[vt][3]); \
            *(LAS u32x2*)(lds + STS + (16 * vt + l16) * 272 + (16 * w + quad * 4) * 2) = o; } \
        BAR_LDS(); \
        { \
            bf16x8 pb[2], qb4[4], va[2][2], sa[2][4], ka[2], vb[4][2]; \
_Pragma("unroll") \
            for (int ks = 0; ks < 2; ++ks) pb[ks] = lds16(lds, PS + q * 144 + 64 * ks + fo); \
_Pragma("unroll") \
            for (int ks = 0; ks < 4; ++ks) qb4[ks] = lds16(lds, QS + q * 272 + 64 * ks + fo); \
_Pragma("unroll") \
            for (int i = 0; i < 2; ++i) { const int vt = (w & 1) * 2 + i; \
_Pragma("unroll") \
                for (int ks = 0; ks < 2; ++ks) va[i][ks] = lds16(lds, VTS + (16 * vt + l16) * 144 + 64 * ks + fo); \
_Pragma("unroll") \
                for (int ks = 0; ks < 4; ++ks) sa[i][ks] = lds16(lds, STS + (16 * vt + l16) * 272 + 64 * ks + fo); } \
_Pragma("unroll") \
            for (int ks = 0; ks < 2; ++ks) ka[ks] = lds16(lds, KTS + (16 * w + l16) * 144 + 64 * ks + fo); \
_Pragma("unroll") \
            for (int vt = 0; vt < 4; ++vt) \
_Pragma("unroll") \
                for (int ks = 0; ks < 2; ++ks) vb[vt][ks] = lds16(lds, VTS + (16 * vt + l16) * 144 + 64 * ks + fo); \
            const f32x4 dv = *(LAS f32x4*)(dL + 16 * w + quad * 4); \
            __builtin_amdgcn_sched_barrier(0); \
            f32x4 o[2]; o[0] = (f32x4){0.f, 0.f, 0.f, 0.f}; o[1] = o[0]; \
_Pragma("unroll") \
            for (int ks = 0; ks < 2; ++ks) { o[0] = mfma16(va[0][ks], pb[ks], o[0]); o[1] = mfma16(va[1][ks], pb[ks], o[1]); } \
_Pragma("unroll") \
            for (int ks = 0; ks < 4; ++ks) { o[0] = mfma16(sa[0][ks], qb4[ks], o[0]); o[1] = mfma16(sa[1][ks], qb4[ks], o[1]); } \
_Pragma("unroll") \
            for (int ks = 0; ks < 2; ++ks) \
_Pragma("unroll") \
                for (int vt = 0; vt < 4; ++vt) S[vt] = mfma16(ka[ks], vb[vt][ks], S[vt]); \
            __builtin_amdgcn_sched_barrier(0); \
_Pragma("unroll") \
            for (int i = 0; i < 2; ++i) { const int vt = (w & 1) * 2 + i; u32x2 ov; ov.x = pk2(o[i][0], o[i][1]); ov.y = pk2(o[i][2], o[i][3]); \
                *(u32x2*)(ORAW + (row0 + q) * 1024 + h * 256 + vs * 64 + 16 * vt + quad * 4) = ov; } \
_Pragma("unroll") \
            for (int vt = 0; vt < 4; ++vt) S[vt] = S[vt] * dv; \
        } \
        BAR_LDS(); \
    } while (0)
    GLA_LOAD(0, A); GLA_LOAD(1, B);
    for (int c = 0; c < 256; c += 2) {
        GLA_PUT(A); if (c + 2 < 256) GLA_LOAD(c + 2, A); GLA_COMPUTE(c);
        GLA_PUT(B); if (c + 3 < 256) GLA_LOAD(c + 3, B); GLA_COMPUTE(c + 1);
    }
#undef GLA_PUT
#undef GLA_COMPUTE
#undef GLA_LOAD
}

#define UNPACK16(a, b, v) do { v[0] = bflo(a.x); v[1] = bfhi(a.x); v[2] = bflo(a.y); v[3] = bfhi(a.y); v[4] = bflo(a.z); v[5] = bfhi(a.z); v[6] = bflo(a.w); v[7] = bfhi(a.w); \
    v[8] = bflo(b.x); v[9] = bfhi(b.x); v[10] = bflo(b.y); v[11] = bfhi(b.y); v[12] = bflo(b.z); v[13] = bfhi(b.z); v[14] = bflo(b.w); v[15] = bfhi(b.w); } while (0)
DI void gate_rows(bf16* PROJ, bf16* ORAW, const float* ssd_norm, const float* gla_norm, int gw, int NGW, int lane) {
    for (int t0 = 2 * gw; t0 < T_; t0 += 2 * NGW) {
        u32x4 ya[2], yb[2], oa[2], ob[2], ra[2], rb[2];
#pragma unroll
        for (int u = 0; u < 2; ++u) { const size_t t = (size_t)t0 + u;
            const bf16* yp = PROJ + t * PROJ_LD + PC_Z + lane * 16; const bf16* op = ORAW + t * 1024 + lane * 16; const bf16* rp = PROJ + t * PROJ_LD + PC_R + lane * 16;
            ya[u] = *(const u32x4*)yp; yb[u] = *(const u32x4*)(yp + 8); oa[u] = *(const u32x4*)op; ob[u] = *(const u32x4*)(op + 8); ra[u] = *(const u32x4*)rp; rb[u] = *(const u32x4*)(rp + 8); }
#pragma unroll
        for (int u = 0; u < 2; ++u) { const size_t t = (size_t)t0 + u;
            {   float v[16]; UNPACK16(ya[u], yb[u], v);
                float s = 0.f;
#pragma unroll
                for (int i = 0; i < 16; ++i) s += v[i] * v[i];
#pragma unroll
                for (int o = 1; o < 32; o <<= 1) s += __shfl_xor(s, o);
                const float rstd = rsqrtf(s * (1.f / 512.f) + EPS_);
                const float* nw = ssd_norm + lane * 16;
#pragma unroll
                for (int i = 0; i < 16; ++i) v[i] = v[i] * rstd * nw[i];
                u32x4 a, b; a.x = pk2(v[0], v[1]); a.y = pk2(v[2], v[3]); a.z = pk2(v[4], v[5]); a.w = pk2(v[6], v[7]); b.x = pk2(v[8], v[9]); b.y = pk2(v[10], v[11]); b.z = pk2(v[12], v[13]); b.w = pk2(v[14], v[15]);
                bf16* yp = PROJ + t * PROJ_LD + PC_Z + lane * 16; *(u32x4*)yp = a; *(u32x4*)(yp + 8) = b; }
            {   float v[16], r[16]; UNPACK16(oa[u], ob[u], v); UNPACK16(ra[u], rb[u], r);
                float s = 0.f;
#pragma unroll
                for (int i = 0; i < 16; ++i) s += v[i] * v[i];
#pragma unroll
                for (int o = 1; o < 16; o <<= 1) s += __shfl_xor(s, o);
                const float rstd = rsqrtf(s * (1.f / 256.f) + EPS_);
                const float* nw = gla_norm + (lane & 15) * 16;
#pragma unroll
                for (int i = 0; i < 16; ++i) v[i] = v[i] * rstd * nw[i] * siluf(r[i]);
                u32x4 a, b; a.x = pk2(v[0], v[1]); a.y = pk2(v[2], v[3]); a.z = pk2(v[4], v[5]); a.w = pk2(v[6], v[7]); b.x = pk2(v[8], v[9]); b.y = pk2(v[10], v[11]); b.z = pk2(v[12], v[13]); b.w = pk2(v[14], v[15]);
                bf16* op = ORAW + t * 1024 + lane * 16; *(u32x4*)op = a; *(u32x4*)(op + 8) = b; }
        }
    }
}

DI void attn_unit(int b, int ph, int qb, const bf16* QK, const bf16* VT, bf16* OATT, const float* NORMS, ldsp lds, int tid) {
    asm volatile("" : "+v"(tid));
    constexpr int KBUF = 9216, VBUF = 18432, KOFF = 0, VOFF = 2 * KBUF, WSOFF = 2 * KBUF + 2 * VBUF;
    const int lane = tid & 63, w = tid >> 6, r32 = lane & 31, hi = lane >> 5;
    const int q0 = qb * 256, head = ph >> 1;
    const size_t rowb = (size_t)b * L_;
    const float cs = exp2f(-(float)(head + 1)) * 1.4426950408889634f;
    LAS float* wsf = (LAS float*)(lds + WSOFF) + w * 64;
    bf16x8 qf[4];
    { const bf16* qp = QK + (rowb + q0 + 32 * w + r32) * QK_LD + ph * 64 + 8 * hi;
#pragma unroll
      for (int ks = 0; ks < 4; ++ks) qf[ks] = *(const bf16x8*)(qp + 16 * ks); }
    asm volatile("s_waitcnt vmcnt(0)" : "+v"(qf[0]), "+v"(qf[1]), "+v"(qf[2]), "+v"(qf[3]) :: "memory");
    const int qpos = q0 + 32 * w + r32;
    const int rsw = ((r32 >> 3) & 1) * 8;
    f32x16 o[4];
#pragma unroll
    for (int d = 0; d < 4; ++d)
#pragma unroll
        for (int r = 0; r < 16; ++r) o[d][r] = 0.f;
    float l_run = 0.f;
    const float Bq = sqrtf(NORMS[b * 32 + ph] * NORMS[b * 32 + 16 + ph]);
    const float Wn = (150.f + 2.f * Bq) / cs;
    const float sk = ((float)(q0 - 63) - Wn) * (1.f / 64.f);
    int t_begin = (sk >= 0.f) ? (int)floorf(sk) + 1 : 0;
    t_begin = __builtin_amdgcn_readfirstlane(t_begin);
    const int t_end = (q0 + 256) / 64;
    float m_run = cs * (float)(64 * t_begin - q0);
    const int klane = r32 * 144 + 16 * hi, vlane = r32 * 144 + 16 * hi;
    const float cs_h = bf2f(pk2(cs, 0.f) & 0xffffu);
    const unsigned csw = (hi == 0) ? pk2(cs_h, cs - cs_h) : 0u;
    bf16x8 kext0, kext1;
    { u32x4 e0, e1; e0.x = (hi == 0) ? pk2((float)r32, (float)r32) : 0u; e0.y = (hi == 0) ? pk2(1.f, 1.f) : 0u; e0.z = 0u; e0.w = 0u;
      e1 = e0; e1.x = (hi == 0) ? pk2((float)(r32 + 32), (float)(r32 + 32)) : 0u; kext0 = __builtin_bit_cast(bf16x8, e0); kext1 = __builtin_bit_cast(bf16x8, e1); }
    const int kr = tid >> 3, kc = tid & 7;
    const bf16* ksrc = QK + (rowb + kr) * QK_LD + 1024 + ph * 64 + kc * 8;
    const bf16* vsrc0 = VT + (size_t)(head * 128 + kr) * VT_LD + rowb + kc * 8;
    const bf16* vsrc1 = VT + (size_t)(head * 128 + 64 + kr) * VT_LD + rowb + kc * 8;
    const int kdst = KOFF + kr * 144 + kc * 16, vdst0 = VOFF + kr * 144 + kc * 16, vdst1 = VOFF + (64 + kr) * 144 + kc * 16;
    u32x4 pk_, pv0, pv1;
    pk_ = *(const u32x4*)(ksrc + (size_t)t_begin * 64 * QK_LD); pv0 = *(const u32x4*)(vsrc0 + t_begin * 64); pv1 = *(const u32x4*)(vsrc1 + t_begin * 64);
    const int vp0 = (16 * (kc >> 1) + 4 * (kc & 1)) * 2, vp1 = vp0 + 16;
#define VSWZ(v) (v)
    __syncthreads();
    *(LAS u32x4*)(lds + kdst) = pk_;
    { *(LAS u32x2*)(lds + VOFF + kr * 144 + vp0) = (u32x2){pv0.x, pv0.y}; *(LAS u32x2*)(lds + VOFF + kr * 144 + vp1) = (u32x2){pv0.z, pv0.w};
      *(LAS u32x2*)(lds + VOFF + (64 + kr) * 144 + vp0) = (u32x2){pv1.x, pv1.y}; *(LAS u32x2*)(lds + VOFF + (64 + kr) * 144 + vp1) = (u32x2){pv1.z, pv1.w}; }
    __syncthreads();
#define ATTN_TILE(t_, buf_) do { \
        const int kbase = 64 * (t_); \
        if (kbase <= q0 + 32 * w + 31) { \
            const int kb = KOFF + (buf_) * KBUF + klane, vb = VOFF + (buf_) * VBUF + vlane; \
              \
            const float nm = cs * (float)(kbase - q0) - m_run; \
            const float nmh = bf2f(pk2(nm, 0.f) & 0xffffu); \
            u32x4 qe; qe.x = csw; qe.y = (hi == 0) ? pk2(nmh, nm - nmh) : 0u; qe.z = 0u; qe.w = 0u; \
            const bf16x8 qef = __builtin_bit_cast(bf16x8, qe); \
            bf16x8 kf0[4], kf1[4]; \
            _Pragma("unroll") \
            for (int ks = 0; ks < 4; ++ks) { kf0[ks] = lds16(lds, kb + 32 * ks); kf1[ks] = lds16(lds, kb + 32 * 144 + 32 * ks); } \
            __builtin_amdgcn_sched_barrier(0); \
            f32x16 s0, s1; \
            _Pragma("unroll") \
            for (int r = 0; r < 16; ++r) { s0[r] = 0.f; s1[r] = 0.f; } \
            s0 = mfma32(kext0, qef, s0); s1 = mfma32(kext1, qef, s1); \
            _Pragma("unroll") \
            for (int ks = 0; ks < 4; ++ks) { s0 = mfma32(kf0[ks], qf[ks], s0); s1 = mfma32(kf1[ks], qf[ks], s1); } \
            __builtin_amdgcn_sched_barrier(0); \
            asm volatile("s_nop 15\n\ts_nop 7" : "+v"(s0), "+v"(s1));     \
            if (kbase + 63 > q0 + 32 * w) { \
                _Pragma("unroll") \
                for (int r = 0; r < 16; ++r) { const int key = kbase + 4 * hi + (r & 3) + 8 * (r >> 2); if (key > qpos) s0[r] = -INFINITY; if (key + 32 > qpos) s1[r] = -INFINITY; } \
            } \
            float mx = s0[0], mx2 = s1[0]; \
            _Pragma("unroll") \
            for (int r = 1; r < 16; r += 2) { mx = max3f(mx, s0[r], s1[r]); if (r + 1 < 16) mx2 = max3f(mx2, s0[r + 1], s1[r + 1]); } \
            mx = max3f(mx, mx2, mx2); \
            mx = fmaxf(mx, __shfl_xor(mx, 32)); \
            if (__any(mx > 8.f)) { \
                const float dl = fmaxf(mx, 0.f); \
                const float alpha = __builtin_amdgcn_exp2f(-dl); \
                l_run *= alpha; m_run += dl; \
                _Pragma("unroll") \
                for (int r = 0; r < 16; ++r) { s0[r] -= dl; s1[r] -= dl; } \
                if (hi == 0) wsf[r32] = alpha; \
                LDS_FENCE(); \
                _Pragma("unroll") \
                for (int r = 0; r < 16; ++r) { const float a = wsf[crow(r, hi)]; \
                    _Pragma("unroll") \
                    for (int d = 0; d < 4; ++d) o[d][r] *= a; } \
            } \
            float rs = 0.f; \
            _Pragma("unroll") \
            for (int r = 0; r < 16; ++r) { s0[r] = __builtin_amdgcn_exp2f(s0[r]); s1[r] = __builtin_amdgcn_exp2f(s1[r]); rs += s0[r] + s1[r]; } \
            rs += __shfl_xor(rs, 32); \
            l_run += rs; \
            bf16x8 pa[2][2]; \
            _Pragma("unroll") \
            for (int s = 0; s < 2; ++s) { \
                u32x4 p0, p1; \
                p0.x = pk2(s0[8 * s + 0], s0[8 * s + 1]); p0.y = pk2(s0[8 * s + 2], s0[8 * s + 3]); p0.z = pk2(s0[8 * s + 4], s0[8 * s + 5]); p0.w = pk2(s0[8 * s + 6], s0[8 * s + 7]); \
                p1.x = pk2(s1[8 * s + 0], s1[8 * s + 1]); p1.y = pk2(s1[8 * s + 2], s1[8 * s + 3]); p1.z = pk2(s1[8 * s + 4], s1[8 * s + 5]); p1.w = pk2(s1[8 * s + 6], s1[8 * s + 7]); \
                pa[0][s] = __builtin_bit_cast(bf16x8, p0); pa[1][s] = __builtin_bit_cast(bf16x8, p1); \
            } \
            _Pragma("unroll") \
            for (int dh = 0; dh < 2; ++dh) { \
                bf16x8 vf[2][2][2]; \
                _Pragma("unroll") \
                for (int d2 = 0; d2 < 2; ++d2) \
                    _Pragma("unroll") \
                    for (int hf = 0; hf < 2; ++hf) \
                        _Pragma("unroll") \
                        for (int s = 0; s < 2; ++s) vf[d2][hf][s] = lds16(lds, vb + 4608 * (2 * dh + d2) + 64 * hf + 32 * s); \
                __builtin_amdgcn_sched_barrier(0); \
                _Pragma("unroll") \
                for (int hf = 0; hf < 2; ++hf) \
                    _Pragma("unroll") \
                    for (int s = 0; s < 2; ++s) \
                        _Pragma("unroll") \
                        for (int d2 = 0; d2 < 2; ++d2) o[2 * dh + d2] = mfma32(pa[hf][s], vf[d2][hf][s], o[2 * dh + d2]); \
                __builtin_amdgcn_sched_barrier(0); \
            } \
        } \
    } while (0)
#define ATTN_LOAD(t_, K_, V0_, V1_) do { K_ = *(const u32x4*)(ksrc + (size_t)(t_) * 64 * QK_LD); V0_ = *(const u32x4*)(vsrc0 + (t_) * 64); V1_ = *(const u32x4*)(vsrc1 + (t_) * 64); } while (0)
#define VT_PUT(off_, V_) do { *(LAS u32x2*)(lds + (off_) + vp0) = (u32x2){(V_).x, (V_).y}; *(LAS u32x2*)(lds + (off_) + vp1) = (u32x2){(V_).z, (V_).w}; } while (0)
#define ATTN_STORE(buf_, K_, V0_, V1_) do { *(LAS u32x4*)(lds + kdst + (buf_) * KBUF) = K_; VT_PUT(VOFF + (buf_) * VBUF + kr * 144, V0_); VT_PUT(VOFF + (buf_) * VBUF + (64 + kr) * 144, V1_); } while (0)
    u32x4 ak = pk_, av0 = pv0, av1 = pv1, bk = pk_, bv0 = pv0, bv1 = pv1;
    if (t_begin + 1 < t_end) ATTN_LOAD(t_begin + 1, ak, av0, av1);
    for (int t = t_begin; t < t_end; t += 2) {
        if (t + 2 < t_end) ATTN_LOAD(t + 2, bk, bv0, bv1);
        ATTN_TILE(t, 0);
        if (t + 1 < t_end) ATTN_STORE(1, ak, av0, av1);
        BAR_LDS();
        if (t + 1 < t_end) {
            if (t + 3 < t_end) ATTN_LOAD(t + 3, ak, av0, av1);
            ATTN_TILE(t + 1, 1);
            if (t + 2 < t_end) ATTN_STORE(0, bk, bv0, bv1);
            BAR_LDS();
        }
    }
#undef ATTN_TILE
#undef ATTN_LOAD
#undef ATTN_STORE
    LDS_FENCE();
    if (hi == 0) wsf[r32] = 1.f / l_run;
    LDS_FENCE();
    bf16* op = OATT + (rowb + q0 + 32 * w) * 2048 + ph * 128 + r32;
#pragma unroll
    for (int r = 0; r < 16; ++r) { const int qr = crow(r, hi); const float rl = wsf[qr];
#pragma unroll
        for (int d = 0; d < 4; ++d) op[(size_t)qr * 2048 + 32 * d] = (bf16)f2bf(o[d][r] * rl); }
#undef VSWZ
}

DI void qk_norms(const bf16* QK, float* NORMS, int gw, int NGW, int lane) {
    for (int b = 0; b < 2; ++b) {
        float mx = 0.f;
        for (int t = gw; t < L_; t += NGW) {
            const u32x4* p = (const u32x4*)(QK + ((size_t)b * L_ + t) * QK_LD + lane * 32);
            float s = 0.f;
#pragma unroll
            for (int i = 0; i < 4; ++i) { const u32x4 v = p[i];
                s += bflo(v.x) * bflo(v.x) + bfhi(v.x) * bfhi(v.x) + bflo(v.y) * bflo(v.y) + bfhi(v.y) * bfhi(v.y) + bflo(v.z) * bflo(v.z) + bfhi(v.z) * bfhi(v.z) + bflo(v.w) * bflo(v.w) + bfhi(v.w) * bfhi(v.w); }
            s += __shfl_xor(s, 1);
            mx = fmaxf(mx, s);
        }
        if (!(lane & 1)) atomicMax((unsigned*)NORMS + b * 32 + (lane >> 1), __float_as_uint(mx));
    }
}

DI void combine_rows(const bf16* OATT, bf16* OUT, const float* lq1, const float* lk1, const float* lq2, const float* lk2, const float* subln, float lam_init, int gw, int NGW, int lane) {
    const float e1 = __expf(wave_sum(lq1[lane] * lk1[lane])), e2 = __expf(wave_sum(lq2[lane] * lk2[lane]));
    const float lam = e1 - e2 + lam_init;
    const int head = lane >> 3, dv0 = (lane & 7) * 16;
    for (int t0 = 2 * gw; t0 < T_; t0 += 2 * NGW) {
        u32x4 A[2], B[2], C[2], Dd[2];
#pragma unroll
        for (int u = 0; u < 2; ++u) { const bf16* p1 = OATT + (size_t)(t0 + u) * 2048 + (2 * head) * 128 + dv0; const bf16* p2 = p1 + 128;
            A[u] = *(const u32x4*)p1; B[u] = *(const u32x4*)(p1 + 8); C[u] = *(const u32x4*)p2; Dd[u] = *(const u32x4*)(p2 + 8); }
#pragma unroll
        for (int u = 0; u < 2; ++u) {
            float v[16], q[16]; UNPACK16(A[u], B[u], v); UNPACK16(C[u], Dd[u], q);
            float s = 0.f;
#pragma unroll
            for (int i = 0; i < 16; ++i) { v[i] = v[i] - lam * q[i]; s += v[i] * v[i]; }
            s += __shfl_xor(s, 1); s += __shfl_xor(s, 2); s += __shfl_xor(s, 4);
            const float sc = rsqrtf(s * (1.f / 128.f) + EPS_) * (1.f - lam_init);
            const float* nw = subln + dv0;
            u32x4 oa, ob;
            oa.x = pk2(v[0] * sc * nw[0], v[1] * sc * nw[1]); oa.y = pk2(v[2] * sc * nw[2], v[3] * sc * nw[3]); oa.z = pk2(v[4] * sc * nw[4], v[5] * sc * nw[5]); oa.w = pk2(v[6] * sc * nw[6], v[7] * sc * nw[7]);
            ob.x = pk2(v[8] * sc * nw[8], v[9] * sc * nw[9]); ob.y = pk2(v[10] * sc * nw[10], v[11] * sc * nw[11]); ob.z = pk2(v[12] * sc * nw[12], v[13] * sc * nw[13]); ob.w = pk2(v[14] * sc * nw[14], v[15] * sc * nw[15]);
            bf16* qo = OUT + (size_t)(t0 + u) * 1024 + head * 128 + dv0;
            *(u32x4*)qo = oa; *(u32x4*)(qo + 8) = ob;
        }
    }
}

DI void softmax_rows256(bf16* S, int nrows, int gw, int NGW, int lane) {
    for (int r0 = gw * 4; r0 < nrows; r0 += NGW * 4) {
        u32x2 a[4];
#pragma unroll
        for (int i = 0; i < 4; ++i) a[i] = *((const u32x2*)(S + (size_t)(r0 + i) * 256) + lane);
#pragma unroll
        for (int i = 0; i < 4; ++i) {
            float v0 = bflo(a[i].x), v1 = bfhi(a[i].x), v2 = bflo(a[i].y), v3 = bfhi(a[i].y);
            const float mx = wave_max(fmaxf(fmaxf(v0, v1), fmaxf(v2, v3)));
            v0 = __expf(v0 - mx); v1 = __expf(v1 - mx); v2 = __expf(v2 - mx); v3 = __expf(v3 - mx);
            const float inv = 1.f / wave_sum((v0 + v1) + (v2 + v3));
            u32x2 o; o.x = pk2(v0 * inv, v1 * inv); o.y = pk2(v2 * inv, v3 * inv);
            *((u32x2*)(S + (size_t)(r0 + i) * 256) + lane) = o;
        }
    }
}

#define GAS __attribute__((address_space(1)))
#define XB_TMO      128
#define XB_XCNT(j)  (256  + 64 * (j))
#define XB_XSUB(j)  (1280 + 64 * (j))
#define XB_XGEN(j)  (2304 + 64 * (j))
#define XB_TOP      3328
#define XB_TOPGEN   3392
#define XCD_BAR_WORDS 3456
#define XB_SPIN_CAP (1u << 18)

__device__ __forceinline__ unsigned xb_ld(unsigned* p)              { return __hip_atomic_load(p, __ATOMIC_RELAXED, __HIP_MEMORY_SCOPE_AGENT); }
__device__ __forceinline__ unsigned xb_add(unsigned* p, unsigned v) { return __hip_atomic_fetch_add(p, v, __ATOMIC_RELAXED, __HIP_MEMORY_SCOPE_AGENT); }
__device__ __forceinline__ unsigned xb_xcc_id() { return (unsigned)__builtin_amdgcn_s_getreg((3 << 11) | 20) & 0xFu; }
#define XB_SPIN(cond, bar) do { unsigned _sp = 0; while (cond) { __builtin_amdgcn_s_sleep(1); \
    if ((++_sp & 255u) == 0u) { if (xb_ld(&(bar)[XB_TMO])) break; if (_sp > XB_SPIN_CAP) { atomicAdd(&(bar)[XB_TMO], 1u); break; } } } } while (0)

struct XcdBarrier {
    unsigned* bar; unsigned x;
    volatile LAS unsigned* st;
};

__device__ __forceinline__ XcdBarrier xcd_barrier_post(unsigned* bar, volatile LAS unsigned* st) {
    XcdBarrier b; b.bar = bar; b.x = xb_xcc_id(); b.st = st;
    if (threadIdx.x == 0) (void)xb_add(&bar[XB_XCNT(b.x)], 1u);
    return b;
}
__device__ __forceinline__ void xcd_barrier_complete(unsigned* bar, unsigned x, unsigned& nloc, unsigned& nx) {
    const unsigned G = gridDim.x * gridDim.y * gridDim.z;
    unsigned sum, cnt, mine, sp = 0u;
    for (;;) {
        sum = 0u; cnt = 0u; mine = 0u;
#pragma unroll
        for (unsigned j = 0; j < 16; ++j) { const unsigned c = xb_ld(&bar[XB_XCNT(j)]); sum += c; cnt += (c > 0u) ? 1u : 0u; mine = (j == x) ? c : mine; }
        if (sum == G) break;
        __builtin_amdgcn_s_sleep(1);
        if ((++sp & 255u) == 0u) { if (xb_ld(&bar[XB_TMO])) break; if (sp > XB_SPIN_CAP) { atomicAdd(&bar[XB_TMO], 1u); break; } }
    }
    nloc = mine > 0u ? mine : 1u; nx = cnt > 0u ? cnt : 1u;
}

__device__ __forceinline__ void xcd_barrier(const XcdBarrier& b) {
    asm volatile("s_waitcnt vmcnt(0)" ::: "memory");
    __syncthreads();
    if (threadIdx.x == 0) {
        unsigned* bar = b.bar;
        __builtin_amdgcn_s_waitcnt(0);
        unsigned nloc = b.st[0], nx = b.st[1];
        if (nloc == 0u) { xcd_barrier_complete(bar, b.x, nloc, nx); b.st[0] = nloc; b.st[1] = nx; }
        const unsigned old = xb_add(&bar[XB_XSUB(b.x)], 1u);
        const unsigned gen = old / nloc;
        if (old + 1u == (gen + 1u) * nloc) {
            __builtin_amdgcn_fence(__ATOMIC_RELEASE, "agent");
            asm volatile("s_waitcnt vmcnt(0)" ::: "memory");
            const unsigned og = xb_add(&bar[XB_TOP], 1u);
            const unsigned tg = og / nx;
            if (og + 1u == (tg + 1u) * nx) xb_add(&bar[XB_TOPGEN], 1u);
            else XB_SPIN(xb_ld(&bar[XB_TOPGEN]) == tg, bar);
            __builtin_amdgcn_fence(__ATOMIC_ACQUIRE, "agent");
            xb_add(&bar[XB_XGEN(b.x)], 1u);
            asm volatile("s_waitcnt vmcnt(0)" ::: "memory");
        } else {
            XB_SPIN(xb_ld(&bar[XB_XGEN(b.x)]) == gen, bar);
            __builtin_amdgcn_fence(__ATOMIC_ACQUIRE, "agent");
            asm volatile("s_waitcnt vmcnt(0)" ::: "memory");
        }
    }
    __syncthreads();
}

struct Args { const float* in[31]; float* out; unsigned char* ws; float lam_init[2]; int ph_lo, ph_hi; };
constexpr int NPL = 15, NPH = 4 * NPL + 1;

DI pg8::Gemm mk_gemm(const bf16* A, const bf16* Bt, int M, int N, int K, int lda, int ldb) {
    pg8::Gemm g; g.A = A; g.Bt = Bt; g.M = M; g.N = N; g.K = K; g.lda = lda; g.ldb = ldb; g.a_pn = 0; g.b_pn = (long)256 * ldb; g.b_b = 0; g.pm_per_b = 1 << 30; return g;
}
DI pg8::EpiU mk_store(bf16* O, int ldc, int act, int scale_cols, float scale) {
    pg8::EpiU e; e.mode = 0; e.O = O; e.ldc = ldc; e.act = act; e.scale_cols = scale_cols; e.scale = scale; e.small_out = nullptr; e.small_pn = -1; e.base = nullptr; e.baseb = nullptr; e.outb = nullptr; return e;
}
DI pg8::EpiU mk_res(const float* base, const bf16* baseb, bf16* outb) {
    pg8::EpiU e; e.mode = 1; e.O = nullptr; e.ldc = D_; e.act = 0; e.scale_cols = 0; e.scale = 1.f; e.small_out = nullptr; e.small_pn = -1; e.base = base; e.baseb = baseb; e.outb = outb; return e;
}

__global__ void __launch_bounds__(512, 2) mega_fwd(Args a) {
    extern __shared__ __attribute__((aligned(16))) unsigned char lds_raw[];
    ldsp lds = (ldsp)lds_raw;
    cg::grid_group grid = cg::this_grid();
    volatile LAS unsigned* bst = (volatile LAS unsigned*)(lds + LDS_BYTES - 16);
    if (threadIdx.x < 4) bst[threadIdx.x] = 0u;
    __syncthreads();
    const XcdBarrier xbar = xcd_barrier_post((unsigned*)(a.ws + 4096), bst);
    const int G = gridDim.x, blk = blockIdx.x, NGW = G * 8;
    for (int ph = a.ph_lo; ph < a.ph_hi; ++ph) {
        int tid = threadIdx.x; asm volatile("" : "+v"(tid));
        const int lane = tid & 63, wave = __builtin_amdgcn_readfirstlane(tid >> 6), gw = blk * 8 + wave;
        unsigned char* ws = a.ws;
        bf16* XN = (bf16*)(ws + WS_XN); bf16* BIG = (bf16*)(ws + WS_BIG); bf16* VT = (bf16*)(ws + WS_VT); bf16* ORAW = (bf16*)a.out; bf16* XR = (bf16*)(ws + WS_ORAW);
        float* SMALL = (float*)(ws + WS_SMALL); bf16* MEMN = (bf16*)(ws + WS_MEMN); bf16* KX = (bf16*)(ws + WS_KX); bf16* VXT = (bf16*)(ws + WS_VXT);
        bf16* KT = (bf16*)(ws + WS_KT); float* DG = (float*)(ws + WS_DG); bf16* TAIL = (bf16*)(ws + WS_DG + 1 * MiB);
        bf16* WA = (bf16*)(ws + WS_WA); bf16* WV = (bf16*)(ws + WS_WV); bf16* WOUT = (bf16*)(ws + WS_WOUT); bf16* WQ = (bf16*)(ws + WS_WQ); bf16* WKV = (bf16*)(ws + WS_WKV);
        bf16* WXO = (bf16*)(ws + WS_WXO); bf16* W1 = (bf16*)(ws + WS_W1); bf16* W2 = (bf16*)(ws + WS_W2);
        bf16* QX = BIG; bf16* SP = BIG + (size_t)T_ * 1024; bf16* OX = BIG + (size_t)2 * T_ * 1024;
        bf16* OATT = (bf16*)(ws + WS_BIG + 132 * MiB);

        const int layer = ph / NPL, k = ph % NPL;
        const bool even = !(layer & 1); const int li = layer >> 1;
        bool did = true; int nj = 0;
        const bool x_in = (layer == 0 && k <= 5);
        if (ph == NPH - 1) {
            rms_rows_from_bf16<true>(XR, a.in[30], nullptr, a.out, T_, gw, NGW, lane);
        } else if (k == 0) {
            LAS float* scr = (LAS float*)(lds + wave * 16384);
            const float* wq = a.in[24] + (size_t)layer * 1024 * 1024; const float* wkv = a.in[25] + (size_t)layer * 1024 * 2048; const float* wxo = a.in[26] + (size_t)layer * 1024 * 1024;
            const float* w1 = a.in[28] + (size_t)layer * 1024 * 4096; const float* w2 = a.in[29] + (size_t)layer * 4096 * 1024;
            const int I_Q = 16 * 32, I_KV = 16 * 64, I_XO = 16 * 32, I_1 = 16 * 128, I_2 = 64 * 32;
            const int I_A = even ? 16 * 144 : 16 * 64, I_V = 16 * 32, I_O = even ? 32 * 32 : 16 * 32;
            const int NIT = I_Q + I_KV + I_XO + I_1 + I_2 + I_A + I_V + I_O;
            for (int it = gw; it < NIT; it += NGW) {
                int r = it;
                if (r < I_Q) { conv_item(wq, 1024, 1024, WQ, 1024, 0, 0, scr, r, lane); continue; } r -= I_Q;
                if (r < I_KV) { conv_item(wkv, 2048, 1024, WKV, 2048, 0, 0, scr, r, lane); continue; } r -= I_KV;
                if (r < I_XO) { conv_item(wxo, 1024, 1024, WXO, 1024, 0, 0, scr, r, lane); continue; } r -= I_XO;
                if (r < I_1) { conv_item(w1, 4096, 1024, W1, 4096, 0, 0, scr, r, lane); continue; } r -= I_1;
                if (r < I_2) { conv_item(w2, 1024, 4096, W2, 1024, 0, 0, scr, r, lane); continue; } r -= I_2;
                if (even) {
                    const float* win = a.in[3] + (size_t)li * 1024 * 5408; const float* wout = a.in[13] + (size_t)li * 2048 * 1024;
                    if (r < I_A) { conv_item(win, 5408, 1024, WA, 4608, 1, 0, scr, r, lane); continue; } r -= I_A;
                    if (r < I_V) { conv_item(win, 5408, 1024, WV, 1024, 0, 3344, scr, r, lane); continue; } r -= I_V;
                    conv_item(wout, 1024, 2048, WOUT, 1024, 0, 0, scr, r, lane);
                } else {
                    const float* wqkv = a.in[15] + (size_t)li * 1024 * 3072; const float* wo = a.in[21] + (size_t)li * 1024 * 1024;
                    if (r < I_A) { conv_item(wqkv, 3072, 1024, WA, 2048, 0, 0, scr, r, lane); continue; } r -= I_A;
                    if (r < I_V) { conv_item(wqkv, 3072, 1024, WV, 1024, 0, 2048, scr, r, lane); continue; } r -= I_V;
                    conv_item(wo, 1024, 1024, WOUT, 1024, 0, 0, scr, r, lane);
                }
            }
            if (x_in) rms_rows_bf16(a.in[0], a.in[2], XN, T_, gw, NGW, lane);
            else rms_rows_from_bf16<false>(XR, (even ? a.in[2] : a.in[14]) + (size_t)li * 1024, XN, nullptr, T_, gw, NGW, lane);
            rms_rows_bf16(a.in[1], a.in[23] + (size_t)layer * 1024, MEMN, 512, gw, NGW, lane);
            if (blk == 0 && tid < 64) ((float*)ws)[tid] = 0.f;
        } else if (k == 1) { nj = 4;
        } else if (k == 2) {
            if (even) { for (int u = blk; u < T_ / 128; u += G) prep_unit(u, BIG, SMALL, KT, DG, TAIL, a.in[10] + (size_t)li * 16 * 512, a.in[11] + (size_t)li * 512, a.in[6] + li * 16, a.in[7] + li * 16, a.in[4] + (size_t)li * 4 * 1280, a.in[5] + (size_t)li * 1280, lds, tid); }
            else {
                qk_norms(BIG, (float*)ws, gw, NGW, lane);
                xcd_barrier(xbar);
                {
                    const int x = blk & 7, j = blk >> 3, bb = (x >> 1) & 1, br = x & 1, grp = x >> 2;
#pragma unroll 1
                    for (int u = 0; u < 8; ++u) { const int s = u >> 1; const int head = grp ? (s == 0 ? 6 : s == 1 ? 4 : s == 2 ? 3 : 2) : (s == 0 ? 7 : s == 1 ? 5 : s == 2 ? 1 : 0);
                        attn_unit(bb, 2 * head + br, (u & 1) ? j : 63 - j, BIG, VT, OATT, (const float*)ws, lds, tid); }
                }
            }
        } else if (k == 3) {
            if (even) {
                for (int j = blk; j < 64; j += G) {
                    if (j < 32) ssd_chain(j >> 4, j & 15, BIG, SMALL, TAIL, a.in[8] + li * 16, lds, tid);
                    else { const int i2 = j - 32; gla_chain(i2 >> 4, (i2 >> 2) & 3, i2 & 3, BIG, KT, VT, DG, ORAW, lds, tid); }
                }
            } else combine_rows(OATT, XN, a.in[16] + li * 64, a.in[17] + li * 64, a.in[18] + li * 64, a.in[19] + li * 64, a.in[20] + li * 128, a.lam_init[li], gw, NGW, lane);
        } else if (k == 4) {
            if (even) gate_rows(BIG, ORAW, a.in[9] + (size_t)li * 1024, a.in[12] + (size_t)li * 256, gw, NGW, lane);
            else nj = 1;
        } else if (k == 5) { if (even) nj = 2; else did = false;
        } else if (k == 6) { rms_rows_from_bf16<false>(XR, a.in[22] + (size_t)layer * 1024, XN, nullptr, T_, gw, NGW, lane);
        } else if (k == 9) { softmax_rows256(SP, T_ * 4, gw, NGW, lane);
        } else if (k == 12) { rms_rows_from_bf16<false>(XR, a.in[27] + (size_t)layer * 1024, XN, nullptr, T_, gw, NGW, lane);
        } else nj = 1;
        for (int j = 0; j < nj; ++j) {
            pg8::Gemm g = mk_gemm(XN, WA, T_, 1024, 1024, 1024, 1024); pg8::EpiU e = mk_store(BIG, 1024, 0, 0, 1.f);
            if (k == 1) {
                if (j == 0) { if (even) { g = mk_gemm(XN, WA, T_, 4608, 1024, 1024, 1024); e = mk_store(BIG, PROJ_LD, 0, 0, 1.f); e.small_out = SMALL; e.small_pn = 17; }
                              else { g = mk_gemm(XN, WA, T_, 2048, 1024, 1024, 1024); e = mk_store(BIG, QK_LD, 0, 1024, 0.125f * 1.4426950408889634f); } }
                else if (j == 1) { g = mk_gemm(WV, XN, 1024, T_, 1024, 1024, 1024); e = mk_store(VT, VT_LD, 0, 0, 1.f); }
                else if (j == 2) { g = mk_gemm(MEMN, WKV, 512, 1024, 1024, 1024, 1024); e = mk_store(KX, 1024, 0, 0, 1.f); }
                else { g = mk_gemm(WKV + (size_t)1024 * 1024, MEMN, 1024, 512, 1024, 1024, 1024); e = mk_store(VXT, 512, 0, 0, 1.f); }
            } else if (k == 4) { g = mk_gemm(XN, WOUT, T_, 1024, 1024, 1024, 1024); e = mk_res(nullptr, XR, XR);
            } else if (k == 5) {
                if (j == 0) { g = mk_gemm(BIG + PC_Z, WOUT, T_, 1024, 1024, PROJ_LD, 2048); e = x_in ? mk_res(a.in[0], nullptr, XR) : mk_res(nullptr, XR, XR); }
                else { g = mk_gemm(ORAW, WOUT + 1024, T_, 1024, 1024, 1024, 2048); e = mk_res(nullptr, XR, XR); }
            } else if (k == 7) { g = mk_gemm(XN, WQ, T_, 1024, 1024, 1024, 1024); e = mk_store(QX, 1024, 0, 1024, 0.0625f);
            } else if (k == 8) { g = mk_gemm(QX, KX, T_, 1024, 256, 1024, 1024); g.a_pn = 256; g.b_pn = 256; g.b_b = (long)256 * 1024; g.pm_per_b = 64; e = mk_store(SP, 1024, 0, 0, 1.f);
            } else if (k == 10) { g = mk_gemm(SP, VXT, T_, 1024, 256, 1024, 512); g.a_pn = 256; g.b_pn = (long)256 * 512; g.b_b = 256; g.pm_per_b = 64; e = mk_store(OX, 1024, 0, 0, 1.f);
            } else if (k == 11) { g = mk_gemm(OX, WXO, T_, 1024, 1024, 1024, 1024); e = mk_res(nullptr, XR, XR);
            } else if (k == 13) { g = mk_gemm(XN, W1, T_, 4096, 1024, 1024, 1024); e = mk_store(BIG, 4096, 1, 0, 1.f);
            } else if (k == 14) { g = mk_gemm(BIG, W2, T_, 1024, 4096, 4096, 4096); e = mk_res(nullptr, XR, XR); }
            pg8::StaticOrder S; S.init(g.M, g.N, G, (blk + 64 * j * (j >= 2)) % G);
            pg8::gemm_phase<pg8::EpiU, pg8::StaticOrder, true, true>(lds, g, S, e, tid);
        }
        if (did && ph + 1 < a.ph_hi) { if (ph == 0) grid.sync(); else xcd_barrier(xbar); }
    }
}

extern "C" void kernel_launch(void* const* d_in, const int* in_sizes, int n_in, void* d_out, int out_size, void* d_ws, size_t ws_size, hipStream_t stream) {
    static int grid = 0;
    if (grid == 0) {
        if (n_in != 31 || out_size != T_ * D_ || ws_size < WS_END) { fprintf(stderr, "kernel_launch: unexpected problem (n_in %d out %d ws %zu)\n", n_in, out_size, ws_size); grid = -1; return; }
        int dev = 0, cus = 0, per_cu = 0;
        hipGetDevice(&dev); hipDeviceGetAttribute(&cus, hipDeviceAttributeMultiprocessorCount, dev);
        if (hipFuncSetAttribute((const void*)mega_fwd, hipFuncAttributeMaxDynamicSharedMemorySize, LDS_BYTES) != hipSuccess) { fprintf(stderr, "kernel_launch: hipFuncSetAttribute failed\n"); grid = -1; return; }
        if (hipOccupancyMaxActiveBlocksPerMultiprocessor(&per_cu, (const void*)mega_fwd, 512, LDS_BYTES) != hipSuccess || per_cu < 1) { fprintf(stderr, "kernel_launch: occupancy query says %d\n", per_cu); per_cu = 1; }
        (void)hipGetLastError();
        grid = cus;
        if (grid != 256) { fprintf(stderr, "kernel_launch: built for a 256-CU device (got %d)\n", cus); grid = -1; return; }
    }
    if (grid < 0) return;
    Args a{};
    for (int i = 0; i < 31; ++i) a.in[i] = (const float*)d_in[i];
    a.out = (float*)d_out; a.ws = (unsigned char*)d_ws;
    a.lam_init[0] = (float)(0.8 - 0.6 * exp(-0.3 * 1.0)); a.lam_init[1] = (float)(0.8 - 0.6 * exp(-0.3 * 3.0));
    a.ph_lo = 0; a.ph_hi = NPH;
#ifdef PROBE_PREFIX
    {
        Args p = a; p.ph_hi = PROBE_PREFIX; void* pargs[] = {&p};
        (void)hipMemsetAsync(d_ws, 0, 65536, stream);
        (void)hipLaunchCooperativeKernel((const void*)mega_fwd, dim3(grid), dim3(512), pargs, LDS_BYTES, stream);
    }
#endif
    if (hipMemsetAsync(d_ws, 0, 65536, stream) != hipSuccess) { fprintf(stderr, "kernel_launch: memset failed\n"); return; }
    void* args[] = {&a};
    hipError_t e = hipLaunchCooperativeKernel((const void*)mega_fwd, dim3(grid), dim3(512), args, LDS_BYTES, stream);
    if (e != hipSuccess) fprintf(stderr, "cooperative launch failed: %s (grid %d)\n", hipGetErrorString(e), grid);
}
```

```cpp
#include <hip/hip_runtime.h>
#include <hip/hip_cooperative_groups.h>
#include <cstdio>
#include <cstdint>
#include <cmath>
namespace cg = cooperative_groups;

namespace pg8 {
#define PG8_LAS __attribute__((address_space(3)))
typedef unsigned short bf16_t;
typedef short bf16x8 __attribute__((ext_vector_type(8)));
typedef float f32x4 __attribute__((ext_vector_type(4)));
typedef unsigned u32x4 __attribute__((ext_vector_type(4)));
constexpr int BM = 256, BK = 64, HALF = 128, HTB = HALF * BK * 2, STAGE_BYTES = 8 * HTB, NXCD = 8, WGM = 8;

__host__ __device__ __forceinline__ int lds_byte(int r, int c) { const int st = (r >> 4) * 2 + (c >> 5), rr = r & 15, cc = c & 31, ob = rr * 64 + cc * 2; return st * 1024 + (ob ^ (((ob >> 9) & 1) << 5)); }
__host__ __device__ __forceinline__ void stage_rc(int b, int& R, int& C) { const int st = b / 1024, sb = b % 1024, swz = sb ^ (((sb >> 9) & 1) << 5); R = (st >> 1) * 16 + swz / 64; C = (st & 1) * 32 + (swz % 64) / 2; }
__host__ __device__ __forceinline__ int perm32(int rho) { const int n = rho >> 4, i = rho & 15; return 8 * (i >> 2) + 4 * n + (i & 3); }

struct Unit { int pm, pn; };
struct Gemm { const bf16_t* A; const bf16_t* Bt; int M, N, K, lda, ldb; long a_pn, b_pn, b_b; int pm_per_b; };

struct StaticOrder {
    int nM, nN, nwg, G, c;
    __host__ __device__ void init(int M, int N, int G_, int c_) { nM = M / BM; nN = N / BM; nwg = nM * nN; G = G_; c = c_; }
    __host__ __device__ bool next(int i, Unit& u) const {
        const long L = (long)i * G + c; if (L >= nwg) return false;
        int wgid = (int)L; { const int q = nwg / NXCD, r = nwg % NXCD, xcd = wgid % NXCD, off = wgid / NXCD; wgid = (xcd < r ? xcd * (q + 1) : r * (q + 1) + (xcd - r) * q) + off; }
        const int nig = WGM * nN, gid = wgid / nig, fm = gid * WGM, gsz = (nM - fm) < WGM ? (nM - fm) : WGM;
        u.pm = fm + ((wgid % nig) % gsz); u.pn = (wgid % nig) / gsz; return true;
    }
    __device__ __forceinline__ void ptrs(const Unit& u, const Gemm& g, const char*& a, const char*& b) const {
        a = (const char*)(g.A + (size_t)u.pm * BM * g.lda + (size_t)u.pn * g.a_pn);
        b = (const char*)(g.Bt + (size_t)u.pn * g.b_pn + (size_t)(u.pm / g.pm_per_b) * g.b_b);
    }
    __device__ __forceinline__ void a_ready(const Unit&) const {}
    __device__ __forceinline__ void done(const Unit&) const {}
};

__device__ __forceinline__ unsigned cvt_pk_bf16(float lo, float hi) { unsigned r; asm volatile("v_cvt_pk_bf16_f32 %0, %1, %2" : "=v"(r) : "v"(lo), "v"(hi)); return r; }

struct EpiU {
    static constexpr bool PERM = true, AFTER_DRAIN = false;
    int mode;
    bf16_t* O; int ldc; int act; int scale_cols; float scale;
    float* small_out; int small_pn;
    const float* base; const bf16_t* baseb; bf16_t* outb;
    __device__ __forceinline__ void operator()(const f32x4 (&acc)[2][2][4][2], const Unit& u, int wr, int wc, int fr, int fq) const {
        const int row0 = u.pm * BM + wr * 64 + fr; const int col0 = u.pn * BM + wc * 32 + 8 * fq;
        if (mode == 0) {
            if (small_out && u.pn == small_pn) {
                if (wc == 0) {
#pragma unroll
                    for (int ai = 0; ai < 2; ++ai)
#pragma unroll
                        for (int m = 0; m < 4; ++m) { float* p = small_out + (size_t)(row0 + ai * HALF + m * 16) * 32 + 8 * fq; *(f32x4*)p = acc[ai][0][m][0]; *(f32x4*)(p + 4) = acc[ai][0][m][1]; }
                }
                return;
            }
#pragma unroll
            for (int ai = 0; ai < 2; ++ai)
#pragma unroll
                for (int m = 0; m < 4; ++m) { bf16_t* rowp = O + (size_t)(row0 + ai * HALF + m * 16) * ldc + col0;
#pragma unroll
                    for (int bj = 0; bj < 2; ++bj) { f32x4 v0 = acc[ai][bj][m][0], v1 = acc[ai][bj][m][1];
                        if (act == 1) {
#pragma unroll
                            for (int e = 0; e < 4; ++e) { float t0 = fmaxf(v0[e], 0.f), t1 = fmaxf(v1[e], 0.f); v0[e] = t0 * t0; v1[e] = t1 * t1; } }
                        const float sc = (col0 + bj * HALF < scale_cols) ? scale : 1.f;
                        v0 = v0 * sc; v1 = v1 * sc; u32x4 w; w.x = cvt_pk_bf16(v0[0], v0[1]); w.y = cvt_pk_bf16(v0[2], v0[3]); w.z = cvt_pk_bf16(v1[0], v1[1]); w.w = cvt_pk_bf16(v1[2], v1[3]);
                        *(u32x4*)(rowp + bj * HALF) = w; } }
        } else {
#pragma unroll
            for (int ai = 0; ai < 2; ++ai)
#pragma unroll
                for (int m = 0; m < 4; ++m) { const size_t off = (size_t)(row0 + ai * HALF + m * 16) * ldc + col0;
#pragma unroll
                    for (int bj = 0; bj < 2; ++bj) { f32x4 b0, b1;
                        if (baseb) { const u32x4 wv = *(const u32x4*)(baseb + off + bj * HALF);
                            b0 = (f32x4){__builtin_bit_cast(float, wv.x << 16), __builtin_bit_cast(float, wv.x & 0xffff0000u), __builtin_bit_cast(float, wv.y << 16), __builtin_bit_cast(float, wv.y & 0xffff0000u)};
                            b1 = (f32x4){__builtin_bit_cast(float, wv.z << 16), __builtin_bit_cast(float, wv.z & 0xffff0000u), __builtin_bit_cast(float, wv.w << 16), __builtin_bit_cast(float, wv.w & 0xffff0000u)}; }
                        else { const float* bp = base + off + bj * HALF; b0 = *(const f32x4*)bp; b1 = *(const f32x4*)(bp + 4); }
                        const f32x4 x0 = b0 + acc[ai][bj][m][0], x1 = b1 + acc[ai][bj][m][1];
                        u32x4 w; w.x = cvt_pk_bf16(x0[0], x0[1]); w.y = cvt_pk_bf16(x0[2], x0[3]); w.z = cvt_pk_bf16(x1[0], x1[1]); w.w = cvt_pk_bf16(x1[2], x1[3]);
                        *(u32x4*)(outb + off + bj * HALF) = w; } }
        }
    }
};

template <class Epi, class Sched, bool ALIGN_EPI = false, bool SP2 = false>
__device__ __forceinline__ void gemm_phase(PG8_LAS unsigned char* lds, const Gemm g, const Sched& S, const Epi& E, const int tid) {
    const int wid = __builtin_amdgcn_readfirstlane(tid >> 6), lane = tid & 63, wr = wid >> 2, wc = wid & 3, fr = lane & 15, fq = lane >> 4;
    const int K = g.K, nt = K / BK;
    unsigned voffA[2], voffB[2];
#pragma unroll
    for (int i = 0; i < 2; ++i) { int R, C; stage_rc(tid * 16 + i * 8192, R, C); const int Rb = Epi::PERM ? ((R & ~31) + perm32(R & 31)) : R;
        voffA[i] = (unsigned)(R * g.lda + C) * 2u; voffB[i] = (unsigned)(Rb * g.ldb + C) * 2u; }
    const size_t kstep = (size_t)(BK * 2);
    const size_t hstepA = (size_t)HALF * g.lda * 2, hstepB = (size_t)HALF * g.ldb * 2;
    const unsigned ldsw = (unsigned)wid * 1024u;
    const int aoff = lds_byte(wr * 64 + fr, fq * 8), boff = lds_byte(wc * 32 + fr, fq * 8);
#define PG8_SA(b, h) (((b) * 2 + (h)) * HTB)
#define PG8_SB(b, h) ((4 + (b) * 2 + (h)) * HTB)
#define PG8_STAGE(bufoff, gbase, voff) do { _Pragma("unroll") for (int _i = 0; _i < 2; ++_i) \
        __builtin_amdgcn_global_load_lds((const unsigned*)((const char*)(gbase) + (voff)[_i]), (PG8_LAS unsigned*)(lds + (bufoff) + ldsw + _i * 8192), 16, 0, 0); } while (0)
#define PG8_LDA(dst, b, h) do { _Pragma("unroll") for (int m = 0; m < 4; ++m) _Pragma("unroll") for (int k = 0; k < 2; ++k) dst[m][k] = *(const PG8_LAS bf16x8*)(lds + PG8_SA(b, h) + aoff + m * 2048 + k * 1024); } while (0)
#define PG8_LDB(dst, b, h) do { _Pragma("unroll") for (int n = 0; n < 2; ++n) _Pragma("unroll") for (int k = 0; k < 2; ++k) dst[n][k] = *(const PG8_LAS bf16x8*)(lds + PG8_SB(b, h) + boff + n * 2048 + k * 1024); } while (0)
#define PG8_MMA(ai, bj, At, Bt) do { __builtin_amdgcn_s_setprio(1); _Pragma("unroll") for (int m = 0; m < 4; ++m) _Pragma("unroll") for (int n = 0; n < 2; ++n) _Pragma("unroll") for (int k = 0; k < 2; ++k) \
        acc[ai][bj][m][n] = __builtin_amdgcn_mfma_f32_16x16x32_bf16(Bt[n][k], At[m][k], acc[ai][bj][m][n], 0, 0, 0); __builtin_amdgcn_s_setprio(0); } while (0)
#define PG8_WAIT_V(n) asm volatile("s_waitcnt vmcnt(" #n ")" ::: "memory")
#define PG8_WAIT_L(n) asm volatile("s_waitcnt lgkmcnt(" #n ")" ::: "memory")
#define PG8_BAR __builtin_amdgcn_s_barrier()
#define PG8_SCHED __builtin_amdgcn_sched_barrier(0)
    Unit cur, nxt; int ui = 0;
    if (!S.next(0, cur)) return;
    f32x4 acc[2][2][4][2];
#pragma unroll
    for (int a = 0; a < 2; ++a)
#pragma unroll
        for (int b = 0; b < 2; ++b)
#pragma unroll
            for (int m = 0; m < 4; ++m)
#pragma unroll
                for (int n = 0; n < 2; ++n) acc[a][b][m][n] = (f32x4){0.f, 0.f, 0.f, 0.f};
    bf16x8 At[4][2], B0[2][2], B1[2][2];
    const char* cA; const char* cB; S.ptrs(cur, g, cA, cB);
    S.a_ready(cur);
    if constexpr (SP2) {
        PG8_STAGE(PG8_SB(0, 0), cB, voffB); PG8_STAGE(PG8_SB(0, 1), cB + hstepB, voffB); PG8_STAGE(PG8_SA(0, 0), cA, voffA); PG8_STAGE(PG8_SA(0, 1), cA + hstepA, voffA);
        if (wr == 1) PG8_BAR;
        PG8_WAIT_V(2); PG8_BAR;
        PG8_STAGE(PG8_SB(1, 0), cB + kstep, voffB); PG8_STAGE(PG8_SA(1, 0), cA + kstep, voffA); PG8_STAGE(PG8_SB(1, 1), cB + hstepB + kstep, voffB);
        PG8_WAIT_V(6); PG8_BAR;
    } else {
        PG8_STAGE(PG8_SB(0, 0), cB, voffB); PG8_STAGE(PG8_SA(0, 0), cA, voffA); PG8_STAGE(PG8_SB(0, 1), cB + hstepB, voffB); PG8_STAGE(PG8_SA(0, 1), cA + hstepA, voffA);
        if (wr == 1) PG8_BAR;
        PG8_WAIT_V(4); PG8_BAR;
        PG8_STAGE(PG8_SB(1, 0), cB + kstep, voffB); PG8_STAGE(PG8_SA(1, 0), cA + kstep, voffA); PG8_STAGE(PG8_SB(1, 1), cB + hstepB + kstep, voffB);
        PG8_WAIT_V(6); PG8_BAR;
    }
    for (;;) {
        const bool has_next = S.next(ui + 1, nxt);
        const char* nA = cA; const char* nB = cB; if (has_next) S.ptrs(nxt, g, nA, nB);
        for (int t = 0; t < nt; t += 2) {
            const bool last = (t == nt - 2);
            const char* a1 = cA + (size_t)(t + 1) * kstep;
            const char* a2 = last ? nA : cA + (size_t)(t + 2) * kstep; const char* b2 = last ? nB : cB + (size_t)(t + 2) * kstep;
            const char* a3 = a2 + kstep; const char* b3 = b2 + kstep;
            if (last && has_next) S.a_ready(nxt);
            if constexpr (SP2) {
            PG8_LDB(B0, 0, 0); PG8_LDB(B1, 0, 1); PG8_SCHED; PG8_LDA(At, 0, 0); PG8_STAGE(PG8_SA(1, 1), a1 + hstepA, voffA);
            PG8_WAIT_V(8); PG8_WAIT_L(0); PG8_BAR; PG8_MMA(0, 0, At, B0); PG8_MMA(0, 1, At, B1); PG8_BAR; PG8_SCHED;
            PG8_LDA(At, 0, 1); PG8_STAGE(PG8_SB(0, 0), b2, voffB); PG8_STAGE(PG8_SB(0, 1), b2 + hstepB, voffB); PG8_STAGE(PG8_SA(0, 0), a2, voffA);
            PG8_WAIT_V(8); PG8_WAIT_L(0); PG8_BAR; PG8_MMA(1, 0, At, B0); PG8_MMA(1, 1, At, B1); PG8_BAR; PG8_SCHED;
            PG8_LDB(B0, 1, 0); PG8_LDB(B1, 1, 1); PG8_SCHED; PG8_LDA(At, 1, 0); PG8_STAGE(PG8_SA(0, 1), a2 + hstepA, voffA);
            PG8_WAIT_V(8); PG8_WAIT_L(0); PG8_BAR; PG8_MMA(0, 0, At, B0); PG8_MMA(0, 1, At, B1); PG8_BAR; PG8_SCHED;
            PG8_LDA(At, 1, 1); PG8_STAGE(PG8_SB(1, 0), b3, voffB); PG8_STAGE(PG8_SB(1, 1), b3 + hstepB, voffB); PG8_STAGE(PG8_SA(1, 0), a3, voffA);
            PG8_WAIT_V(8); PG8_WAIT_L(0); PG8_BAR; PG8_MMA(1, 0, At, B0); PG8_MMA(1, 1, At, B1); PG8_BAR; PG8_SCHED;
            } else {
            PG8_LDB(B0, 0, 0); PG8_SCHED; PG8_LDA(At, 0, 0); PG8_STAGE(PG8_SA(1, 1), a1 + hstepA, voffA);
            PG8_WAIT_L(8); PG8_BAR; PG8_WAIT_L(0); PG8_MMA(0, 0, At, B0); PG8_BAR; PG8_SCHED;
            PG8_LDB(B1, 0, 1); PG8_STAGE(PG8_SB(0, 0), b2, voffB);
            PG8_BAR; PG8_WAIT_L(0); PG8_MMA(0, 1, At, B1); PG8_BAR;
            PG8_LDA(At, 0, 1); PG8_STAGE(PG8_SA(0, 0), a2, voffA);
            PG8_BAR; PG8_WAIT_L(0); PG8_MMA(1, 0, At, B0); PG8_BAR; PG8_SCHED;
            PG8_STAGE(PG8_SB(0, 1), b2 + hstepB, voffB);
            PG8_WAIT_V(6); PG8_BAR; PG8_MMA(1, 1, At, B1); PG8_BAR;
            PG8_LDB(B0, 1, 0); PG8_SCHED; PG8_LDA(At, 1, 0); PG8_STAGE(PG8_SA(0, 1), a2 + hstepA, voffA);
            PG8_WAIT_L(8); PG8_BAR; PG8_WAIT_L(0); PG8_MMA(0, 0, At, B0); PG8_BAR; PG8_SCHED;
            PG8_LDB(B1, 1, 1); PG8_STAGE(PG8_SB(1, 0), b3, voffB);
            PG8_BAR; PG8_WAIT_L(0); PG8_MMA(0, 1, At, B1); PG8_BAR;
            PG8_LDA(At, 1, 1); PG8_STAGE(PG8_SA(1, 0), a3, voffA);
            PG8_BAR; PG8_WAIT_L(0); PG8_MMA(1, 0, At, B0); PG8_BAR; PG8_SCHED;
            PG8_STAGE(PG8_SB(1, 1), b3 + hstepB, voffB);
            PG8_WAIT_V(6); PG8_BAR; PG8_MMA(1, 1, At, B1); PG8_BAR;
            }
        }
        if constexpr (ALIGN_EPI) { if (wr == 0) PG8_BAR; }
        if constexpr (!Epi::AFTER_DRAIN) { E(acc, cur, wr, wc, fr, fq); S.done(cur); }
        if (!has_next) break;
#pragma unroll
        for (int a = 0; a < 2; ++a)
#pragma unroll
            for (int b = 0; b < 2; ++b)
#pragma unroll
                for (int m = 0; m < 4; ++m)
#pragma unroll
                    for (int n = 0; n < 2; ++n) acc[a][b][m][n] = (f32x4){0.f, 0.f, 0.f, 0.f};
        cur = nxt; cA = nA; cB = nB; ++ui;
        if constexpr (ALIGN_EPI) { if (wr == 1) PG8_BAR; }
    }
    PG8_WAIT_V(0);
    if constexpr (!ALIGN_EPI) { if (wr == 0) PG8_BAR; }
    PG8_BAR;
    if constexpr (Epi::AFTER_DRAIN) { E.fused(acc, cur, wr, wc, fr, fq, lds, wid, lane); S.done(cur); }
#undef PG8_SA
#undef PG8_SB
#undef PG8_STAGE
#undef PG8_LDA
#undef PG8_LDB
#undef PG8_MMA
#undef PG8_WAIT_V
#undef PG8_WAIT_L
#undef PG8_BAR
#undef PG8_SCHED
}
}

#define LAS __attribute__((address_space(3)))
#define DI __device__ __forceinline__
typedef unsigned short bf16;
typedef short bf16x8 __attribute__((ext_vector_type(8)));
typedef short s16x4 __attribute__((ext_vector_type(4)));
typedef float f32x4 __attribute__((ext_vector_type(4)));
typedef float f32x16 __attribute__((ext_vector_type(16)));
typedef unsigned u32x4 __attribute__((ext_vector_type(4)));
typedef unsigned u32x2 __attribute__((ext_vector_type(2)));
typedef LAS unsigned char* ldsp;

constexpr int T_ = 32768, L_ = 16384, D_ = 1024;
constexpr float EPS_ = 1e-5f;
constexpr size_t MiB = (size_t)1 << 20;
constexpr size_t WS_W = 1 * MiB;
constexpr size_t WS_WA = WS_W, WS_WV = WS_W + 9 * MiB, WS_WOUT = WS_W + 11 * MiB, WS_WQ = WS_W + 15 * MiB, WS_WKV = WS_W + 17 * MiB,
                 WS_WXO = WS_W + 21 * MiB, WS_W1 = WS_W + 23 * MiB, WS_W2 = WS_W + 31 * MiB;
constexpr size_t WS_XN = 40 * MiB, WS_KT = WS_XN, WS_DG = WS_XN + 33 * MiB;
constexpr size_t WS_BIG = 104 * MiB, WS_VT = 376 * MiB, WS_ORAW = 441 * MiB, WS_SMALL = 505 * MiB, WS_MEMN = 509 * MiB, WS_KX = 510 * MiB, WS_VXT = 511 * MiB, WS_END = 512 * MiB;
constexpr int PROJ_LD = 4352;
constexpr int PC_Z = 0, PC_XBC = 1024, PC_Q = 2304, PC_K = 2816, PC_R = 3328;
constexpr int LDS_BYTES = 136 * 1024;
constexpr int VT_LD = T_ + 64, KT_LD = T_ + 64, QK_LD = 2048 + 64;

DI unsigned f2bf(float f) { unsigned u = __builtin_bit_cast(unsigned, f); return (u + 0x7fffu + ((u >> 16) & 1u)) >> 16; }
typedef float f32x2_t __attribute__((ext_vector_type(2))); typedef __bf16 bf16x2_t __attribute__((ext_vector_type(2)));
DI unsigned pk2(float lo, float hi) { f32x2_t v = {lo, hi}; bf16x2_t b = __builtin_convertvector(v, bf16x2_t); return __builtin_bit_cast(unsigned, b); }
DI float bf2f(unsigned h) { return __builtin_bit_cast(float, h << 16); }
DI float bflo(unsigned w) { return __builtin_bit_cast(float, w << 16); }
DI float bfhi(unsigned w) { return __builtin_bit_cast(float, w & 0xffff0000u); }
DI float wave_sum(float v) {
#pragma unroll
    for (int o = 1; o < 64; o <<= 1) v += __shfl_xor(v, o);
    return v;
}
DI float wave_max(float v) {
#pragma unroll
    for (int o = 1; o < 64; o <<= 1) v = fmaxf(v, __shfl_xor(v, o));
    return v;
}
DI float siluf(float x) { return x * __builtin_amdgcn_rcpf(1.f + __builtin_amdgcn_exp2f(-1.4426950408889634f * x)); }
DI float softplusf(float x) { return x > 20.f ? x : log1pf(__expf(x)); }
DI bf16x8 lds16(ldsp p, int off) { return *(LAS bf16x8*)(p + off); }
DI s16x4 lds8(ldsp p, int off) { return *(LAS s16x4*)(p + off); }
DI bf16x8 cat8(s16x4 a, s16x4 b) { return __builtin_shufflevector(a, b, 0, 1, 2, 3, 4, 5, 6, 7); }
DI f32x4 mfma16(bf16x8 a, bf16x8 b, f32x4 c) { return __builtin_amdgcn_mfma_f32_16x16x32_bf16(a, b, c, 0, 0, 0); }
DI f32x16 mfma32(bf16x8 a, bf16x8 b, f32x16 c) { return __builtin_amdgcn_mfma_f32_32x32x16_bf16(a, b, c, 0, 0, 0); }
DI int crow(int r, int hi) { return (r & 3) + 8 * (r >> 2) + 4 * hi; }
DI float max3f(float a, float b, float c) { float r; asm("v_max3_f32 %0, %1, %2, %3" : "=v"(r) : "v"(a), "v"(b), "v"(c)); return r; }
#define LDS_FENCE() asm volatile("s_waitcnt lgkmcnt(0)" ::: "memory")

DI void rms_rows_bf16(const float* x, const float* w, bf16* out, int nrows, int gw, int NGW, int lane) {
    for (int m = 2 * gw; m < nrows; m += 2 * NGW) {
        const f32x4* xr0 = (const f32x4*)(x + (size_t)m * D_) + lane; const f32x4* xr1 = xr0 + D_ / 4;
        f32x4 v0[4], v1[4]; float s0 = 0.f, s1 = 0.f;
#pragma unroll
        for (int j = 0; j < 4; ++j) { v0[j] = xr0[64 * j]; v1[j] = xr1[64 * j]; }
#pragma unroll
        for (int j = 0; j < 4; ++j) { s0 += (v0[j].x * v0[j].x + v0[j].y * v0[j].y) + (v0[j].z * v0[j].z + v0[j].w * v0[j].w); s1 += (v1[j].x * v1[j].x + v1[j].y * v1[j].y) + (v1[j].z * v1[j].z + v1[j].w * v1[j].w); }
#pragma unroll
        for (int o = 1; o < 64; o <<= 1) { s0 += __shfl_xor(s0, o); s1 += __shfl_xor(s1, o); }
        const float r0 = rsqrtf(s0 * (1.f / D_) + EPS_), r1 = rsqrtf(s1 * (1.f / D_) + EPS_);
        u32x2* o0 = (u32x2*)(out + (size_t)m * D_) + lane; u32x2* o1 = o0 + D_ / 4;
#pragma unroll
        for (int j = 0; j < 4; ++j) { const f32x4 wv = ((const f32x4*)w)[lane + 64 * j];
            u32x2 a, b; a.x = pk2(v0[j].x * r0 * wv.x, v0[j].y * r0 * wv.y); a.y = pk2(v0[j].z * r0 * wv.z, v0[j].w * r0 * wv.w);
            b.x = pk2(v1[j].x * r1 * wv.x, v1[j].y * r1 * wv.y); b.y = pk2(v1[j].z * r1 * wv.z, v1[j].w * r1 * wv.w);
            o0[64 * j] = a; o1[64 * j] = b; }
    }
}
template <bool TO_F32> DI void rms_rows_from_bf16(const bf16* x, const float* w, bf16* outb, float* outf, int nrows, int gw, int NGW, int lane) {
    f32x4 wv[4];
#pragma unroll
    for (int j = 0; j < 4; ++j) wv[j] = ((const f32x4*)(w + lane * 16))[j];
    for (int m = 2 * gw; m < nrows; m += 2 * NGW) {
        u32x4 ra[2], rb[2];
#pragma unroll
        for (int u = 0; u < 2; ++u) { const u32x4* p = (const u32x4*)(x + (size_t)(m + u) * D_ + lane * 16); ra[u] = p[0]; rb[u] = p[1]; }
#pragma unroll
        for (int u = 0; u < 2; ++u) {
            float v[16];
            v[0] = bflo(ra[u].x); v[1] = bfhi(ra[u].x); v[2] = bflo(ra[u].y); v[3] = bfhi(ra[u].y); v[4] = bflo(ra[u].z); v[5] = bfhi(ra[u].z); v[6] = bflo(ra[u].w); v[7] = bfhi(ra[u].w);
            v[8] = bflo(rb[u].x); v[9] = bfhi(rb[u].x); v[10] = bflo(rb[u].y); v[11] = bfhi(rb[u].y); v[12] = bflo(rb[u].z); v[13] = bfhi(rb[u].z); v[14] = bflo(rb[u].w); v[15] = bfhi(rb[u].w);
            float s = 0.f;
#pragma unroll
            for (int i = 0; i < 16; ++i) s += v[i] * v[i];
            const float r = rsqrtf(wave_sum(s) * (1.f / D_) + EPS_);
#pragma unroll
            for (int i = 0; i < 16; ++i) v[i] = v[i] * r * wv[i >> 2][i & 3];
            if (TO_F32) { f32x4* o = (f32x4*)(outf + (size_t)(m + u) * D_ + lane * 16);
#pragma unroll
                for (int j = 0; j < 4; ++j) o[j] = (f32x4){v[4 * j], v[4 * j + 1], v[4 * j + 2], v[4 * j + 3]}; }
            else { u32x4 a, b; a.x = pk2(v[0], v[1]); a.y = pk2(v[2], v[3]); a.z = pk2(v[4], v[5]); a.w = pk2(v[6], v[7]); b.x = pk2(v[8], v[9]); b.y = pk2(v[10], v[11]); b.z = pk2(v[12], v[13]); b.w = pk2(v[14], v[15]);
                u32x4* o = (u32x4*)(outb + (size_t)(m + u) * D_ + lane * 16); o[0] = a; o[1] = b; }
        }
    }
}
DI void rms_rows_f32_inplace(float* x, const float* w, int nrows, int gw, int NGW, int lane) {
    for (int m = gw; m < nrows; m += NGW) {
        f32x4* xr = (f32x4*)(x + (size_t)m * D_) + lane;
        f32x4 v[4]; float s = 0.f;
#pragma unroll
        for (int j = 0; j < 4; ++j) { v[j] = xr[64 * j]; s += (v[j].x * v[j].x + v[j].y * v[j].y) + (v[j].z * v[j].z + v[j].w * v[j].w); }
        const float rstd = rsqrtf(wave_sum(s) * (1.f / D_) + EPS_);
#pragma unroll
        for (int j = 0; j < 4; ++j) { const f32x4 wv = ((const f32x4*)w)[lane + 64 * j]; xr[64 * j] = v[j] * rstd * wv; }
    }
}

DI int map_plain(int d, int off) { return d + off; }
DI int map_win(int d) { if (d < 2304) return d; if (d < 3328) return d + 16; if (d < 4352) return d + 1056; if (d < 4368) return d - 4352 + 2304; if (d < 4384) return d; return -1; }
DI void conv_item(const float* W, int ldn, int K, bf16* WT, int nrows, int mode, int off, LAS float* scr, int item, int lane) {
    const int nblk = nrows / 32, kb = item / nblk, nb = item % nblk, k0 = 64 * kb, n0 = 32 * nb;
    const int d = n0 + (lane & 31); const int sc = mode ? map_win(d) : map_plain(d, off);
#pragma unroll 8
    for (int i = 0; i < 32; ++i) { const int kk = 2 * i + (lane >> 5); scr[kk * 33 + (lane & 31)] = sc >= 0 ? W[(size_t)(k0 + kk) * ldn + sc] : 0.f; }
    LDS_FENCE();
    const int c = lane & 7;
#pragma unroll
    for (int j = 0; j < 4; ++j) { const int n = (lane >> 3) + 8 * j; const LAS float* s = scr + (8 * c) * 33 + n;
        u32x4 o; o.x = pk2(s[0 * 33], s[1 * 33]); o.y = pk2(s[2 * 33], s[3 * 33]); o.z = pk2(s[4 * 33], s[5 * 33]); o.w = pk2(s[6 * 33], s[7 * 33]);
        *(u32x4*)(WT + (size_t)(n0 + n) * K + k0 + 8 * c) = o; }
    LDS_FENCE();
}

DI void prep_unit(int unit, bf16* PROJ, float* SMALL, bf16* KT, float* DG, bf16* TAIL, const float* gla_w2, const float* gla_b, const float* dt_bias, const float* a_log,
                  const float* conv_w, const float* conv_b, ldsp lds, int tid) {
    asm volatile("" : "+v"(tid));
    const int rowbase = unit * 128;
    LAS float* sm = (LAS float*)lds; LAS float* dtL = (LAS float*)(lds + 16384);
    for (int i = tid; i < 128 * 32 / 4; i += 512) ((LAS f32x4*)sm)[i] = ((const f32x4*)(SMALL + (size_t)rowbase * 32))[i];
    __syncthreads();
    if (tid < 16) {
        const int h = tid; const float a = -__expf(a_log[h]), bias = dt_bias[h]; float cum = 0.f;
        for (int tt = 0; tt < 128; ++tt) { const float dtv = softplusf(sm[tt * 32 + h] + bias); cum += dtv * a; dtL[tt * 16 + h] = dtv;
            SMALL[((size_t)rowbase + tt) * 32 + h] = dtv; SMALL[((size_t)rowbase + tt) * 32 + 16 + h] = cum; }
    }
    {   const int col = tid;
        float w2c[16];
#pragma unroll
        for (int r = 0; r < 16; ++r) w2c[r] = gla_w2[r * 512 + col];
        const float bcol = gla_b[col];
        for (int sub = 0; sub < 2; ++sub) {
            float cum = 0.f;
#pragma unroll 1
            for (int g8 = 0; g8 < 8; ++g8) {
                unsigned qk[8];
                { const bf16* pq = PROJ + ((size_t)rowbase + sub * 64 + g8 * 8) * PROJ_LD + col;
#pragma unroll
                  for (int e = 0; e < 8; ++e) qk[e] = (unsigned)pq[(size_t)e * PROJ_LD + PC_Q] | ((unsigned)pq[(size_t)e * PROJ_LD + PC_K] << 16); }
                float kt[8];
#pragma unroll
                for (int e = 0; e < 8; ++e) {
                    const int tt = sub * 64 + g8 * 8 + e; const size_t row = (size_t)rowbase + tt;
                    float x = bcol;
#pragma unroll
                    for (int r = 0; r < 16; ++r) x += sm[tt * 32 + 16 + r] * w2c[r];
                    const float lg = (fminf(x, 0.f) - __logf(1.f + __expf(-fabsf(x)))) * 0.0625f;
                    cum += lg;
                    const float qv = bflo(qk[e]), kv = bfhi(qk[e]);
                    PROJ[row * PROJ_LD + PC_Q + col] = (bf16)f2bf(qv * __expf(cum) * 0.08838834764831845f);
                    kt[e] = kv * __expf(-cum);
                    PROJ[row * PROJ_LD + PC_K + col] = (bf16)f2bf(kt[e]);
                }
                u32x4 o; o.x = pk2(kt[0], kt[1]); o.y = pk2(kt[2], kt[3]); o.z = pk2(kt[4], kt[5]); o.w = pk2(kt[6], kt[7]);
                *(u32x4*)(KT + (size_t)col * KT_LD + rowbase + sub * 64 + g8 * 8) = o;
            }
            DG[(size_t)((rowbase >> 6) + sub) * 512 + col] = __expf(cum);
        }
    }
    const int tin = rowbase & (L_ - 1);
    __syncthreads();
#pragma unroll 1
    for (int i = 4; i >= 0; --i) { const int it = tid + 512 * i, pair = it % 640, slab = it / 640, c0 = 2 * pair;
        unsigned rw[35];
        bf16* base = PROJ + ((size_t)rowbase + 32 * slab) * PROJ_LD + PC_XBC + c0;
#pragma unroll
        for (int j = 0; j < 35; ++j) rw[j] = (tin + 32 * slab - 3 + j >= 0) ? *(const unsigned*)(base + (ptrdiff_t)(j - 3) * PROJ_LD) : 0u;
        float cw0[4], cw1[4];
#pragma unroll
        for (int j = 0; j < 4; ++j) { cw0[j] = conv_w[j * 1280 + c0]; cw1[j] = conv_w[j * 1280 + c0 + 1]; }
        const float cb0 = conv_b[c0], cb1 = conv_b[c0 + 1];
        const bool isx = c0 < 1024; const int hh = (c0 >> 6) & 15;
        __syncthreads();
#pragma unroll
        for (int r = 0; r < 32; ++r) { float a0 = cb0, a1 = cb1;
#pragma unroll
            for (int j = 0; j < 4; ++j) { a0 += cw0[j] * bflo(rw[r + j]); a1 += cw1[j] * bfhi(rw[r + j]); }
            a0 = siluf(a0); a1 = siluf(a1);
            const int row = 32 * slab + r;
            if (isx) { const float d = dtL[row * 16 + hh]; a0 *= d; a1 *= d; }
            bf16* dst = (row >= 125) ? TAIL + ((size_t)unit * 3 + (row - 125)) * 1280 + c0 : base + (size_t)r * PROJ_LD;
            *(unsigned*)dst = pk2(a0, a1); }
    }
    __syncthreads();
}

#define BAR_LDS() asm volatile("s_waitcnt lgkmcnt(0)\n\ts_barrier" ::: "memory")
DI void ssd_chain(int b, int h, bf16* PROJ, const float* SMALL, const bf16* TAIL, const float* d_skip, ldsp lds, int tid) {
    constexpr int CS = 0, BS = 18432, BWT = 36864, XDT = 54272, MS = 71680, SS = 106496, CUML = 115712, DTL = 116224;
    asm volatile("" : "+v"(tid));
    const int lane = tid & 63, w = __builtin_amdgcn_readfirstlane(tid >> 6), quad = lane >> 4, l16 = lane & 15;
    const int g = h >> 3, cp = lane & 31, th = lane >> 5, tb = 16 * w + 8 * th;
    LAS float* cumL = (LAS float*)(lds + CUML); LAS float* dtL = (LAS float*)(lds + DTL);
    int ch[3]; ch[0] = h * 64 + 2 * cp; ch[1] = 1024 + g * 64 + 2 * cp; ch[2] = 1152 + g * 64 + 2 * cp;
    const float Dh = d_skip[h];
    const int pi = w >> 1, q = 16 * w + l16;
    f32x4 S[2]; S[0] = (f32x4){0.f, 0.f, 0.f, 0.f}; S[1] = S[0];
    unsigned raw[3][8]; float cmv[8], cum_last, cl_t = 0.f, dt_t = 0.f; u32x2 zz[4];
#define SSD_LOAD(c_) do { const size_t r0_ = (size_t)b * L_ + (size_t)(c_) * 128; \
        _Pragma("unroll") for (int i = 0; i < 8; ++i) cmv[i] = SMALL[(r0_ + tb + i) * 32 + 16 + h]; \
        cum_last = SMALL[(r0_ + 127) * 32 + 16 + h]; \
        if (tid < 128) { cl_t = SMALL[(r0_ + tid) * 32 + 16 + h]; dt_t = SMALL[(r0_ + tid) * 32 + h]; } \
        _Pragma("unroll") for (int arr = 0; arr < 3; ++arr) _Pragma("unroll") for (int i = 0; i < 8; ++i) { const int rr = tb + i; \
            const bf16* sp = (rr >= 125) ? TAIL + ((r0_ >> 7) * 3 + (rr - 125)) * 1280 + ch[arr] : PROJ + (r0_ + rr) * PROJ_LD + PC_XBC + ch[arr]; \
            raw[arr][i] = *(const unsigned*)sp; } \
        _Pragma("unroll") for (int pt = 0; pt < 4; ++pt) zz[pt] = *(const u32x2*)(PROJ + (r0_ + q) * PROJ_LD + PC_Z + h * 64 + 16 * pt + quad * 4); } while (0)
    SSD_LOAD(0);
    for (int c = 0; c < 128; ++c) {
        const size_t row0 = (size_t)b * L_ + (size_t)c * 128;
        if (tid < 128) { cumL[tid] = cl_t; dtL[tid] = dt_t; }
        {
            u32x4 v0, v1;
            v0.x = __builtin_amdgcn_perm(raw[0][1], raw[0][0], 0x05040100u); v0.y = __builtin_amdgcn_perm(raw[0][3], raw[0][2], 0x05040100u);
            v0.z = __builtin_amdgcn_perm(raw[0][5], raw[0][4], 0x05040100u); v0.w = __builtin_amdgcn_perm(raw[0][7], raw[0][6], 0x05040100u);
            v1.x = __builtin_amdgcn_perm(raw[0][1], raw[0][0], 0x07060302u); v1.y = __builtin_amdgcn_perm(raw[0][3], raw[0][2], 0x07060302u);
            v1.z = __builtin_amdgcn_perm(raw[0][5], raw[0][4], 0x07060302u); v1.w = __builtin_amdgcn_perm(raw[0][7], raw[0][6], 0x07060302u);
            *(LAS u32x4*)(lds + XDT + (2 * cp) * 272 + tb * 2) = v0; *(LAS u32x4*)(lds + XDT + (2 * cp + 1) * 272 + tb * 2) = v1;
        }
        {
            float o0[8], o1[8];
#pragma unroll
            for (int i = 0; i < 8; ++i) { *(LAS unsigned*)(lds + BS + (tb + i) * 144 + 4 * cp) = raw[1][i];
                const float wg = __expf(cum_last - cmv[i]); o0[i] = bflo(raw[1][i]) * wg; o1[i] = bfhi(raw[1][i]) * wg; }
            u32x4 v0, v1; v0.x = pk2(o0[0], o0[1]); v0.y = pk2(o0[2], o0[3]); v0.z = pk2(o0[4], o0[5]); v0.w = pk2(o0[6], o0[7]);
            v1.x = pk2(o1[0], o1[1]); v1.y = pk2(o1[2], o1[3]); v1.z = pk2(o1[4], o1[5]); v1.w = pk2(o1[6], o1[7]);
            *(LAS u32x4*)(lds + BWT + (2 * cp) * 272 + tb * 2) = v0; *(LAS u32x4*)(lds + BWT + (2 * cp + 1) * 272 + tb * 2) = v1;
        }
#pragma unroll
        for (int i = 0; i < 8; ++i) *(LAS unsigned*)(lds + CS + (tb + i) * 144 + 4 * cp) = raw[2][i];
        u32x2 zc[4];
#pragma unroll
        for (int pt = 0; pt < 4; ++pt) zc[pt] = zz[pt];
        if (c + 1 < 128) SSD_LOAD(c + 1);
        BAR_LDS();
        const float cq = cumL[q], dq = dtL[q];
        const int fo = quad * 16;
        {
            bf16x8 cb[2];
#pragma unroll
            for (int k = 0; k < 2; ++k) cb[k] = lds16(lds, CS + q * 144 + 64 * k + fo);
#pragma unroll
            for (int jh = 0; jh < 2; ++jh) {
                bf16x8 ba[4][2];
#pragma unroll
                for (int j4 = 0; j4 < 4; ++j4) if (4 * jh + j4 <= w) {
#pragma unroll
                    for (int k = 0; k < 2; ++k) ba[j4][k] = lds16(lds, BS + (16 * (4 * jh + j4) + l16) * 144 + 64 * k + fo); }
                __builtin_amdgcn_sched_barrier(0);
                f32x4 acc[4];
#pragma unroll
                for (int j4 = 0; j4 < 4; ++j4) { acc[j4] = (f32x4){0.f, 0.f, 0.f, 0.f};
                    if (4 * jh + j4 <= w) { acc[j4] = mfma16(ba[j4][0], cb[0], acc[j4]); acc[j4] = mfma16(ba[j4][1], cb[1], acc[j4]); } }
                __builtin_amdgcn_sched_barrier(0);
#pragma unroll
                for (int j4 = 0; j4 < 4; ++j4) {
                    const int s0 = 16 * (4 * jh + j4) + quad * 4;
                    const f32x4 cs = *(LAS f32x4*)(cumL + s0);
                    float v[4];
#pragma unroll
                    for (int jj = 0; jj < 4; ++jj) { const int s = s0 + jj; float t = (s <= q) ? acc[j4][jj] * __expf(cq - cs[jj]) : 0.f; if (s == q && dq > 0.f) t += Dh / dq; v[jj] = t; }
                    u32x2 o; o.x = pk2(v[0], v[1]); o.y = pk2(v[2], v[3]);
                    *(LAS u32x2*)(lds + MS + q * 272 + s0 * 2) = o;
                }
            }
        }
#pragma unroll
        for (int i = 0; i < 2; ++i) { const int ni = (w & 1) * 2 + i; u32x2 o; o.x = pk2(S[i][0], S[i][1]); o.y = pk2(S[i][2], S[i][3]);
            *(LAS u32x2*)(lds + SS + (16 * pi + l16) * 144 + (16 * ni + quad * 4) * 2) = o; }
        const float el = __expf(cumL[127]);
        BAR_LDS();
        const float eq = __expf(cq);
        {
            bf16x8 mb[4], cb[2];
#pragma unroll
            for (int ks = 0; ks < 4; ++ks) mb[ks] = lds16(lds, MS + q * 272 + 64 * ks + fo);
#pragma unroll
            for (int k = 0; k < 2; ++k) cb[k] = lds16(lds, CS + q * 144 + 64 * k + fo);
#pragma unroll
            for (int pt = 0; pt < 4; ++pt) {
                bf16x8 xa[4], sa[2];
#pragma unroll
                for (int ks = 0; ks < 4; ++ks) xa[ks] = lds16(lds, XDT + (16 * pt + l16) * 272 + 64 * ks + fo);
#pragma unroll
                for (int k = 0; k < 2; ++k) sa[k] = lds16(lds, SS + (16 * pt + l16) * 144 + 64 * k + fo);
                __builtin_amdgcn_sched_barrier(0);
                f32x4 y1 = (f32x4){0.f, 0.f, 0.f, 0.f}, y2 = y1;
#pragma unroll
                for (int ks = 0; ks < 4; ++ks) if (32 * ks < 16 * w + 16) y1 = mfma16(xa[ks], mb[ks], y1);
#pragma unroll
                for (int k = 0; k < 2; ++k) y2 = mfma16(sa[k], cb[k], y2);
                __builtin_amdgcn_sched_barrier(0);
                bf16* zp = PROJ + (row0 + q) * PROJ_LD + PC_Z + h * 64 + 16 * pt + quad * 4;
                const float z0 = bflo(zc[pt].x), z1 = bfhi(zc[pt].x), z2 = bflo(zc[pt].y), z3 = bfhi(zc[pt].y);
                u32x2 o; o.x = pk2((y1[0] + eq * y2[0]) * siluf(z0), (y1[1] + eq * y2[1]) * siluf(z1)); o.y = pk2((y1[2] + eq * y2[2]) * siluf(z2), (y1[3] + eq * y2[3]) * siluf(z3));
                *(u32x2*)zp = o;
            }
        }
        {
            bf16x8 xb[4], wa[2][4];
#pragma unroll
            for (int ks = 0; ks < 4; ++ks) xb[ks] = lds16(lds, XDT + (16 * pi + l16) * 272 + 64 * ks + fo);
#pragma unroll
            for (int i = 0; i < 2; ++i)
#pragma unroll
                for (int ks = 0; ks < 4; ++ks) wa[i][ks] = lds16(lds, BWT + (16 * ((w & 1) * 2 + i) + l16) * 272 + 64 * ks + fo);
            __builtin_amdgcn_sched_barrier(0);
            S[0] = S[0] * el; S[1] = S[1] * el;
#pragma unroll
            for (int ks = 0; ks < 4; ++ks) { S[0] = mfma16(wa[0][ks], xb[ks], S[0]); S[1] = mfma16(wa[1][ks], xb[ks], S[1]); }
        }
        BAR_LDS();
    }
#undef SSD_LOAD
}

DI void gla_chain(int b, int h, int vs, const bf16* PROJ, const bf16* KT, const bf16* VT, const float* DG, bf16* ORAW, ldsp lds, int tid) {
    constexpr int QS = 0, KS = 17408, KTS = 34816, VTS = 53248, PS = 62464, STS = 71680, DLO = 89088;
    asm volatile("" : "+v"(tid));
    const int lane = tid & 63, w = __builtin_amdgcn_readfirstlane(tid >> 6), quad = lane >> 4, l16 = lane & 15, qi = w >> 1;
    LAS float* dL = (LAS float*)(lds + DLO);
    f32x4 S[4];
#pragma unroll
    for (int i = 0; i < 4; ++i) S[i] = (f32x4){0.f, 0.f, 0.f, 0.f};
    u32x4 Aq[2], Ak[2], Akt[2], Av, Bq[2], Bk[2], Bkt[2], Bv; float Ad = 0.f, Bd = 0.f;
#define GLA_LOAD(c_, P) do { const size_t r0_ = (size_t)b * L_ + (size_t)(c_) * 64; \
        _Pragma("unroll") for (int i = 0; i < 2; ++i) { const int idx = tid + 512 * i, r = idx >> 4, cc = idx & 15; \
            P##q[i] = *(const u32x4*)(PROJ + (r0_ + r) * PROJ_LD + PC_Q + h * 128 + cc * 8); P##k[i] = *(const u32x4*)(PROJ + (r0_ + r) * PROJ_LD + PC_K + h * 128 + cc * 8); } \
        _Pragma("unroll") for (int i = 0; i < 2; ++i) { const int idx = tid + 512 * i, r = idx >> 3, cc = idx & 7; P##kt[i] = *(const u32x4*)(KT + (size_t)(h * 128 + r) * KT_LD + r0_ + cc * 8); } \
        { const int r = tid >> 3, cc = tid & 7; P##v = *(const u32x4*)(VT + (size_t)(h * 256 + vs * 64 + r) * VT_LD + r0_ + cc * 8); } \
        if (tid < 128) P##d = DG[(r0_ >> 6) * 512 + h * 128 + tid]; } while (0)
#define GLA_PUT(P) do { \
        _Pragma("unroll") for (int i = 0; i < 2; ++i) { const int idx = tid + 512 * i, r = idx >> 4, cc = idx & 15; \
            *(LAS u32x4*)(lds + QS + r * 272 + cc * 16) = P##q[i]; *(LAS u32x4*)(lds + KS + r * 272 + cc * 16) = P##k[i]; } \
        _Pragma("unroll") for (int i = 0; i < 2; ++i) { const int idx = tid + 512 * i, r = idx >> 3, cc = idx & 7; *(LAS u32x4*)(lds + KTS + r * 144 + cc * 16) = P##kt[i]; } \
        { const int r = tid >> 3, cc = tid & 7; *(LAS u32x4*)(lds + VTS + r * 144 + cc * 16) = P##v; } \
        if (tid < 128) dL[tid] = P##d; } while (0)
#define GLA_COMPUTE(c_) do { \
        const size_t row0 = (size_t)b * L_ + (size_t)(c_) * 64; \
        BAR_LDS(); \
        const int q = 16 * qi + l16; \
        const int fo = quad * 16; \
        { \
            bf16x8 fb[4], fa[2][4]; \
_Pragma("unroll") \
            for (int ks = 0; ks < 4; ++ks) fb[ks] = lds16(lds, QS + q * 272 + 64 * ks + fo); \
_Pragma("unroll") \
            for (int i = 0; i < 2; ++i) \
_Pragma("unroll") \
                for (int ks = 0; ks < 4; ++ks) fa[i][ks] = lds16(lds, KS + (16 * ((w & 1) * 2 + i) + l16) * 272 + 64 * ks + fo); \
            __builtin_amdgcn_sched_barrier(0); \
            f32x4 acc[2]; acc[0] = (f32x4){0.f, 0.f, 0.f, 0.f}; acc[1] = acc[0]; \
_Pragma("unroll") \
            for (int ks = 0; ks < 4; ++ks) { acc[0] = mfma16(fa[0][ks], fb[ks], acc[0]); acc[1] = mfma16(fa[1][ks], fb[ks], acc[1]); } \
            __builtin_amdgcn_sched_barrier(0); \
_Pragma("unroll") \
            for (int i = 0; i < 2; ++i) { const int s0 = 16 * ((w & 1) * 2 + i) + quad * 4; \
                u32x2 o; o.x = pk2(s0 <= q ? acc[i][0] : 0.f, s0 + 1 <= q ? acc[i][1] : 0.f); o.y = pk2(s0 + 2 <= q ? acc[i][2] : 0.f, s0 + 3 <= q ? acc[i][3] : 0.f); \
                *(LAS u32x2*)(lds + PS + q * 144 + s0 * 2) = o; } \
        } \
_Pragma("unroll") \
        for (int vt = 0; vt < 4; ++vt) { u32x2 o; o.x = pk2(S[vt][0], S[vt][1]); o.y = pk2(S[vt][2], S[vt][3]); \
            *(LAS u32x2*)(lds + STS + (16 * vt + l16) * 272 + (16 * w + quad * 4) * 2) = o; } \
        BAR_LDS(); \
        { \
            bf16x8 pb[2], qb4[4], va[2][2], sa[2][4], ka[2], vb[4][2]; \
_Pragma("unroll") \
            for (int ks = 0; ks < 2; ++ks) pb[ks] = lds16(lds, PS + q * 144 + 64 * ks + fo); \
_Pragma("unroll") \
            for (int ks = 0; ks < 4; ++ks) qb4[ks] = lds16(lds, QS + q * 272 + 64 * ks + fo); \
_Pragma("unroll") \
            for (int i = 0; i < 2; ++i) { const int vt = (w & 1) * 2 + i; \
_Pragma("unroll") \
                for (int ks = 0; ks < 2; ++ks) va[i][ks] = lds16(lds, VTS + (16 * vt + l16) * 144 + 64 * ks + fo); \
_Pragma("unroll") \
                for (int ks = 0; ks < 4; ++ks) sa[i][ks] = lds16(lds, STS + (16 * vt + l16) * 272 + 64 * ks + fo); } \
_Pragma("unroll") \
            for (int ks = 0; ks < 2; ++ks) ka[ks] = lds16(lds, KTS + (16 * w + l16) * 144 + 64 * ks + fo); \
_Pragma("unroll") \
            for (int vt = 0; vt < 4; ++vt) \
_Pragma("unroll") \
                for (int ks = 0; ks < 2; ++ks) vb[vt][ks] = lds16(lds, VTS + (16 * vt + l16) * 144 + 64 * ks + fo); \
            const f32x4 dv = *(LAS f32x4*)(dL + 16 * w + quad * 4); \
            __builtin_amdgcn_sched_barrier(0); \
            f32x4 o[2]; o[0] = (f32x4){0.f, 0.f, 0.f, 0.f}; o[1] = o[0]; \
_Pragma("unroll") \
            for (int ks = 0; ks < 2; ++ks) { o[0] = mfma16(va[0][ks], pb[ks], o[0]); o[1] = mfma16(va[1][ks], pb[ks], o[1]); } \
_Pragma("unroll") \
            for (int ks = 0; ks < 4; ++ks) { o[0] = mfma16(sa[0][ks], qb4[ks], o[0]); o[1] = mfma16(sa[1][ks], qb4[ks], o[1]); } \
_Pragma("unroll") \
            for (int ks = 0; ks < 2; ++ks) \
_Pragma("unroll") \
                for (int vt = 0; vt < 4; ++vt) S[vt] = mfma16(ka[ks], vb[vt][ks], S[vt]); \
            __builtin_amdgcn_sched_barrier(0); \
_Pragma("unroll") \
            for (int i = 0; i < 2; ++i) { const int vt = (w & 1) * 2 + i; u32x2 ov; ov.x = pk2(o[i][0], o[i][1]); ov.y = pk2(o[i][2], o[i][3]); \
                *(u32x2*)(ORAW + (row0 + q) * 2048 + 1024 + h * 256 + vs * 64 + 16 * vt + quad * 4) = ov; } \
_Pragma("unroll") \
            for (int vt = 0; vt < 4; ++vt) S[vt] = S[vt] * dv; \
        } \
        BAR_LDS(); \
    } while (0)
    GLA_LOAD(0, A); GLA_LOAD(1, B);
    for (int c = 0; c < 256; c += 2) {
        GLA_PUT(A); if (c + 2 < 256) GLA_LOAD(c + 2, A); GLA_COMPUTE(c);
        GLA_PUT(B); if (c + 3 < 256) GLA_LOAD(c + 3, B); GLA_COMPUTE(c + 1);
    }
#undef GLA_PUT
#undef GLA_COMPUTE
#undef GLA_LOAD
}

#define UNPACK16(a, b, v) do { v[0] = bflo(a.x); v[1] = bfhi(a.x); v[2] = bflo(a.y); v[3] = bfhi(a.y); v[4] = bflo(a.z); v[5] = bfhi(a.z); v[6] = bflo(a.w); v[7] = bfhi(a.w); \
    v[8] = bflo(b.x); v[9] = bfhi(b.x); v[10] = bflo(b.y); v[11] = bfhi(b.y); v[12] = bflo(b.z); v[13] = bfhi(b.z); v[14] = bflo(b.w); v[15] = bfhi(b.w); } while (0)
DI void gate_rows(bf16* PROJ, bf16* ORAW, const float* ssd_norm, const float* gla_norm, int gw, int NGW, int lane) {
    for (int t0 = 2 * gw; t0 < T_; t0 += 2 * NGW) {
        u32x4 ya[2], yb[2], oa[2], ob[2], ra[2], rb[2];
#pragma unroll
        for (int u = 0; u < 2; ++u) { const size_t t = (size_t)t0 + u;
            const bf16* yp = PROJ + t * PROJ_LD + PC_Z + lane * 16; const bf16* op = ORAW + t * 2048 + 1024 + lane * 16; const bf16* rp = PROJ + t * PROJ_LD + PC_R + lane * 16;
            ya[u] = *(const u32x4*)yp; yb[u] = *(const u32x4*)(yp + 8); oa[u] = *(const u32x4*)op; ob[u] = *(const u32x4*)(op + 8); ra[u] = *(const u32x4*)rp; rb[u] = *(const u32x4*)(rp + 8); }
#pragma unroll
        for (int u = 0; u < 2; ++u) { const size_t t = (size_t)t0 + u;
            {   float v[16]; UNPACK16(ya[u], yb[u], v);
                float s = 0.f;
#pragma unroll
                for (int i = 0; i < 16; ++i) s += v[i] * v[i];
#pragma unroll
                for (int o = 1; o < 32; o <<= 1) s += __shfl_xor(s, o);
                const float rstd = rsqrtf(s * (1.f / 512.f) + EPS_);
                const float* nw = ssd_norm + lane * 16;
#pragma unroll
                for (int i = 0; i < 16; ++i) v[i] = v[i] * rstd * nw[i];
                u32x4 a, b; a.x = pk2(v[0], v[1]); a.y = pk2(v[2], v[3]); a.z = pk2(v[4], v[5]); a.w = pk2(v[6], v[7]); b.x = pk2(v[8], v[9]); b.y = pk2(v[10], v[11]); b.z = pk2(v[12], v[13]); b.w = pk2(v[14], v[15]);
                bf16* yp = ORAW + t * 2048 + lane * 16; *(u32x4*)yp = a; *(u32x4*)(yp + 8) = b; }
            {   float v[16], r[16]; UNPACK16(oa[u], ob[u], v); UNPACK16(ra[u], rb[u], r);
                float s = 0.f;
#pragma unroll
                for (int i = 0; i < 16; ++i) s += v[i] * v[i];
#pragma unroll
                for (int o = 1; o < 16; o <<= 1) s += __shfl_xor(s, o);
                const float rstd = rsqrtf(s * (1.f / 256.f) + EPS_);
                const float* nw = gla_norm + (lane & 15) * 16;
#pragma unroll
                for (int i = 0; i < 16; ++i) v[i] = v[i] * rstd * nw[i] * siluf(r[i]);
                u32x4 a, b; a.x = pk2(v[0], v[1]); a.y = pk2(v[2], v[3]); a.z = pk2(v[4], v[5]); a.w = pk2(v[6], v[7]); b.x = pk2(v[8], v[9]); b.y = pk2(v[10], v[11]); b.z = pk2(v[12], v[13]); b.w = pk2(v[14], v[15]);
                bf16* op = ORAW + t * 2048 + 1024 + lane * 16; *(u32x4*)op = a; *(u32x4*)(op + 8) = b; }
        }
    }
}

DI void attn_unit(int b, int ph, int qb, const bf16* QK, const bf16* VT, bf16* OATT, const float* NORMS, ldsp lds, int tid) {
    asm volatile("" : "+v"(tid));
    constexpr int KBUF = 9216, VBUF = 18432, KOFF = 0, VOFF = 2 * KBUF, WSOFF = 2 * KBUF + 2 * VBUF;
    const int lane = tid & 63, w = tid >> 6, r32 = lane & 31, hi = lane >> 5;
    const int q0 = qb * 256, head = ph >> 1;
    const size_t rowb = (size_t)b * L_;
    const float cs = exp2f(-(float)(head + 1)) * 1.4426950408889634f;
    LAS float* wsf = (LAS float*)(lds + WSOFF) + w * 64;
    bf16x8 qf[4];
    { const bf16* qp = QK + (rowb + q0 + 32 * w + r32) * QK_LD + ph * 64 + 8 * hi;
#pragma unroll
      for (int ks = 0; ks < 4; ++ks) qf[ks] = *(const bf16x8*)(qp + 16 * ks); }
    asm volatile("s_waitcnt vmcnt(0)" : "+v"(qf[0]), "+v"(qf[1]), "+v"(qf[2]), "+v"(qf[3]) :: "memory");
    const int qpos = q0 + 32 * w + r32;
    const int rsw = ((r32 >> 3) & 1) * 8;
    f32x16 o[4];
#pragma unroll
    for (int d = 0; d < 4; ++d)
#pragma unroll
        for (int r = 0; r < 16; ++r) o[d][r] = 0.f;
    float l_run = 0.f;
    const float Bq = sqrtf(NORMS[b * 32 + ph] * NORMS[b * 32 + 16 + ph]);
    const float Wn = (150.f + 2.f * Bq) / cs;
    const float sk = ((float)(q0 - 63) - Wn) * (1.f / 64.f);
    int t_begin = (sk >= 0.f) ? (int)floorf(sk) + 1 : 0;
    t_begin = __builtin_amdgcn_readfirstlane(t_begin);
    const int t_end = (q0 + 256) / 64;
    float m_run = cs * (float)(64 * t_begin - q0);
    const int klane = r32 * 144 + 16 * hi, vlane = r32 * 144 + 16 * hi;
    const float cs_h = bf2f(pk2(cs, 0.f) & 0xffffu);
    const unsigned csw = (hi == 0) ? pk2(cs_h, cs - cs_h) : 0u;
    bf16x8 kext0, kext1;
    { u32x4 e0, e1; e0.x = (hi == 0) ? pk2((float)r32, (float)r32) : 0u; e0.y = (hi == 0) ? pk2(1.f, 1.f) : 0u; e0.z = 0u; e0.w = 0u;
      e1 = e0; e1.x = (hi == 0) ? pk2((float)(r32 + 32), (float)(r32 + 32)) : 0u; kext0 = __builtin_bit_cast(bf16x8, e0); kext1 = __builtin_bit_cast(bf16x8, e1); }
    const int kr = tid >> 3, kc = tid & 7;
    const bf16* ksrc = QK + (rowb + kr) * QK_LD + 1024 + ph * 64 + kc * 8;
    const bf16* vsrc0 = VT + (size_t)(head * 128 + kr) * VT_LD + rowb + kc * 8;
    const bf16* vsrc1 = VT + (size_t)(head * 128 + 64 + kr) * VT_LD + rowb + kc * 8;
    const int kdst = KOFF + kr * 144 + kc * 16, vdst0 = VOFF + kr * 144 + kc * 16, vdst1 = VOFF + (64 + kr) * 144 + kc * 16;
    u32x4 pk_, pv0, pv1;
    pk_ = *(const u32x4*)(ksrc + (size_t)t_begin * 64 * QK_LD); pv0 = *(const u32x4*)(vsrc0 + t_begin * 64); pv1 = *(const u32x4*)(vsrc1 + t_begin * 64);
    const int vp0 = (16 * (kc >> 1) + 4 * (kc & 1)) * 2, vp1 = vp0 + 16;
#define VSWZ(v) (v)
    __syncthreads();
    *(LAS u32x4*)(lds + kdst) = pk_;
    { *(LAS u32x2*)(lds + VOFF + kr * 144 + vp0) = (u32x2){pv0.x, pv0.y}; *(LAS u32x2*)(lds + VOFF + kr * 144 + vp1) = (u32x2){pv0.z, pv0.w};
      *(LAS u32x2*)(lds + VOFF + (64 + kr) * 144 + vp0) = (u32x2){pv1.x, pv1.y}; *(LAS u32x2*)(lds + VOFF + (64 + kr) * 144 + vp1) = (u32x2){pv1.z, pv1.w}; }
    __syncthreads();
#define ATTN_TILE(t_, buf_) do { \
        const int kbase = 64 * (t_); \
        if (kbase <= q0 + 32 * w + 31) { \
            const int kb = KOFF + (buf_) * KBUF + klane, vb = VOFF + (buf_) * VBUF + vlane; \
              \
            const float nm = cs * (float)(kbase - q0) - m_run; \
            const float nmh = bf2f(pk2(nm, 0.f) & 0xffffu); \
            u32x4 qe; qe.x = csw; qe.y = (hi == 0) ? pk2(nmh, nm - nmh) : 0u; qe.z = 0u; qe.w = 0u; \
            const bf16x8 qef = __builtin_bit_cast(bf16x8, qe); \
            bf16x8 kf0[4], kf1[4]; \
            _Pragma("unroll") \
            for (int ks = 0; ks < 4; ++ks) { kf0[ks] = lds16(lds, kb + 32 * ks); kf1[ks] = lds16(lds, kb + 32 * 144 + 32 * ks); } \
            __builtin_amdgcn_sched_barrier(0); \
            f32x16 s0, s1; \
            _Pragma("unroll") \
            for (int r = 0; r < 16; ++r) { s0[r] = 0.f; s1[r] = 0.f; } \
            s0 = mfma32(kext0, qef, s0); s1 = mfma32(kext1, qef, s1); \
            _Pragma("unroll") \
            for (int ks = 0; ks < 4; ++ks) { s0 = mfma32(kf0[ks], qf[ks], s0); s1 = mfma32(kf1[ks], qf[ks], s1); } \
            __builtin_amdgcn_sched_barrier(0); \
            asm volatile("s_nop 15\n\ts_nop 7" : "+v"(s0), "+v"(s1));     \
            if (kbase + 63 > q0 + 32 * w) { \
                _Pragma("unroll") \
                for (int r = 0; r < 16; ++r) { const int key = kbase + 4 * hi + (r & 3) + 8 * (r >> 2); if (key > qpos) s0[r] = -INFINITY; if (key + 32 > qpos) s1[r] = -INFINITY; } \
            } \
            float mx = s0[0], mx2 = s1[0]; \
            _Pragma("unroll") \
            for (int r = 1; r < 16; r += 2) { mx = max3f(mx, s0[r], s1[r]); if (r + 1 < 16) mx2 = max3f(mx2, s0[r + 1], s1[r + 1]); } \
            mx = max3f(mx, mx2, mx2); \
            mx = fmaxf(mx, __shfl_xor(mx, 32)); \
            if (__any(mx > 8.f)) { \
                const float dl = fmaxf(mx, 0.f); \
                const float alpha = __builtin_amdgcn_exp2f(-dl); \
                l_run *= alpha; m_run += dl; \
                _Pragma("unroll") \
                for (int r = 0; r < 16; ++r) { s0[r] -= dl; s1[r] -= dl; } \
                if (hi == 0) wsf[r32] = alpha; \
                LDS_FENCE(); \
                _Pragma("unroll") \
                for (int r = 0; r < 16; ++r) { const float a = wsf[crow(r, hi)]; \
                    _Pragma("unroll") \
                    for (int d = 0; d < 4; ++d) o[d][r] *= a; } \
            } \
            float rs = 0.f; \
            _Pragma("unroll") \
            for (int r = 0; r < 16; ++r) { s0[r] = __builtin_amdgcn_exp2f(s0[r]); s1[r] = __builtin_amdgcn_exp2f(s1[r]); rs += s0[r] + s1[r]; } \
            rs += __shfl_xor(rs, 32); \
            l_run += rs; \
            bf16x8 pa[2][2]; \
            _Pragma("unroll") \
            for (int s = 0; s < 2; ++s) { \
                u32x4 p0, p1; \
                p0.x = pk2(s0[8 * s + 0], s0[8 * s + 1]); p0.y = pk2(s0[8 * s + 2], s0[8 * s + 3]); p0.z = pk2(s0[8 * s + 4], s0[8 * s + 5]); p0.w = pk2(s0[8 * s + 6], s0[8 * s + 7]); \
                p1.x = pk2(s1[8 * s + 0], s1[8 * s + 1]); p1.y = pk2(s1[8 * s + 2], s1[8 * s + 3]); p1.z = pk2(s1[8 * s + 4], s1[8 * s + 5]); p1.w = pk2(s1[8 * s + 6], s1[8 * s + 7]); \
                pa[0][s] = __builtin_bit_cast(bf16x8, p0); pa[1][s] = __builtin_bit_cast(bf16x8, p1); \
            } \
            _Pragma("unroll") \
            for (int dh = 0; dh < 2; ++dh) { \
                bf16x8 vf[2][2][2]; \
                _Pragma("unroll") \
                for (int d2 = 0; d2 < 2; ++d2) \
                    _Pragma("unroll") \
                    for (int hf = 0; hf < 2; ++hf) \
                        _Pragma("unroll") \
                        for (int s = 0; s < 2; ++s) vf[d2][hf][s] = lds16(lds, vb + 4608 * (2 * dh + d2) + 64 * hf + 32 * s); \
                __builtin_amdgcn_sched_barrier(0); \
                _Pragma("unroll") \
                for (int hf = 0; hf < 2; ++hf) \
                    _Pragma("unroll") \
                    for (int s = 0; s < 2; ++s) \
                        _Pragma("unroll") \
                        for (int d2 = 0; d2 < 2; ++d2) o[2 * dh + d2] = mfma32(pa[hf][s], vf[d2][hf][s], o[2 * dh + d2]); \
                __builtin_amdgcn_sched_barrier(0); \
            } \
        } \
    } while (0)
#define ATTN_LOAD(t_, K_, V0_, V1_) do { K_ = *(const u32x4*)(ksrc + (size_t)(t_) * 64 * QK_LD); V0_ = *(const u32x4*)(vsrc0 + (t_) * 64); V1_ = *(const u32x4*)(vsrc1 + (t_) * 64); } while (0)
#define VT_PUT(off_, V_) do { *(LAS u32x2*)(lds + (off_) + vp0) = (u32x2){(V_).x, (V_).y}; *(LAS u32x2*)(lds + (off_) + vp1) = (u32x2){(V_).z, (V_).w}; } while (0)
#define ATTN_STORE(buf_, K_, V0_, V1_) do { *(LAS u32x4*)(lds + kdst + (buf_) * KBUF) = K_; VT_PUT(VOFF + (buf_) * VBUF + kr * 144, V0_); VT_PUT(VOFF + (buf_) * VBUF + (64 + kr) * 144, V1_); } while (0)
    u32x4 ak = pk_, av0 = pv0, av1 = pv1, bk = pk_, bv0 = pv0, bv1 = pv1;
    if (t_begin + 1 < t_end) ATTN_LOAD(t_begin + 1, ak, av0, av1);
    for (int t = t_begin; t < t_end; t += 2) {
        if (t + 2 < t_end) ATTN_LOAD(t + 2, bk, bv0, bv1);
        ATTN_TILE(t, 0);
        if (t + 1 < t_end) ATTN_STORE(1, ak, av0, av1);
        BAR_LDS();
        if (t + 1 < t_end) {
            if (t + 3 < t_end) ATTN_LOAD(t + 3, ak, av0, av1);
            ATTN_TILE(t + 1, 1);
            if (t + 2 < t_end) ATTN_STORE(0, bk, bv0, bv1);
            BAR_LDS();
        }
    }
#undef ATTN_TILE
#undef ATTN_LOAD
#undef ATTN_STORE
    LDS_FENCE();
    if (hi == 0) wsf[r32] = 1.f / l_run;
    LDS_FENCE();
    bf16* op = OATT + (rowb + q0 + 32 * w) * 2048 + ph * 128 + r32;
#pragma unroll
    for (int r = 0; r < 16; ++r) { const int qr = crow(r, hi); const float rl = wsf[qr];
#pragma unroll
        for (int d = 0; d < 4; ++d) op[(size_t)qr * 2048 + 32 * d] = (bf16)f2bf(o[d][r] * rl); }
#undef VSWZ
}

DI void qk_norms(const bf16* QK, float* NORMS, int gw, int NGW, int lane) {
    for (int b = 0; b < 2; ++b) {
        float mx = 0.f;
        for (int t = gw; t < L_; t += NGW) {
            const u32x4* p = (const u32x4*)(QK + ((size_t)b * L_ + t) * QK_LD + lane * 32);
            float s = 0.f;
#pragma unroll
            for (int i = 0; i < 4; ++i) { const u32x4 v = p[i];
                s += bflo(v.x) * bflo(v.x) + bfhi(v.x) * bfhi(v.x) + bflo(v.y) * bflo(v.y) + bfhi(v.y) * bfhi(v.y) + bflo(v.z) * bflo(v.z) + bfhi(v.z) * bfhi(v.z) + bflo(v.w) * bflo(v.w) + bfhi(v.w) * bfhi(v.w); }
            s += __shfl_xor(s, 1);
            mx = fmaxf(mx, s);
        }
        if (!(lane & 1)) atomicMax((unsigned*)NORMS + b * 32 + (lane >> 1), __float_as_uint(mx));
    }
}

DI void combine_rows(const bf16* OATT, bf16* OUT, const float* lq1, const float* lk1, const float* lq2, const float* lk2, const float* subln, float lam_init, int gw, int NGW, int lane) {
    const float e1 = __expf(wave_sum(lq1[lane] * lk1[lane])), e2 = __expf(wave_sum(lq2[lane] * lk2[lane]));
    const float lam = e1 - e2 + lam_init;
    const int head = lane >> 3, dv0 = (lane & 7) * 16;
    for (int t0 = 2 * gw; t0 < T_; t0 += 2 * NGW) {
        u32x4 A[2], B[2], C[2], Dd[2];
#pragma unroll
        for (int u = 0; u < 2; ++u) { const bf16* p1 = OATT + (size_t)(t0 + u) * 2048 + (2 * head) * 128 + dv0; const bf16* p2 = p1 + 128;
            A[u] = *(const u32x4*)p1; B[u] = *(const u32x4*)(p1 + 8); C[u] = *(const u32x4*)p2; Dd[u] = *(const u32x4*)(p2 + 8); }
#pragma unroll
        for (int u = 0; u < 2; ++u) {
            float v[16], q[16]; UNPACK16(A[u], B[u], v); UNPACK16(C[u], Dd[u], q);
            float s = 0.f;
#pragma unroll
            for (int i = 0; i < 16; ++i) { v[i] = v[i] - lam * q[i]; s += v[i] * v[i]; }
            s += __shfl_xor(s, 1); s += __shfl_xor(s, 2); s += __shfl_xor(s, 4);
            const float sc = rsqrtf(s * (1.f / 128.f) + EPS_) * (1.f - lam_init);
            const float* nw = subln + dv0;
            u32x4 oa, ob;
            oa.x = pk2(v[0] * sc * nw[0], v[1] * sc * nw[1]); oa.y = pk2(v[2] * sc * nw[2], v[3] * sc * nw[3]); oa.z = pk2(v[4] * sc * nw[4], v[5] * sc * nw[5]); oa.w = pk2(v[6] * sc * nw[6], v[7] * sc * nw[7]);
            ob.x = pk2(v[8] * sc * nw[8], v[9] * sc * nw[9]); ob.y = pk2(v[10] * sc * nw[10], v[11] * sc * nw[11]); ob.z = pk2(v[12] * sc * nw[12], v[13] * sc * nw[13]); ob.w = pk2(v[14] * sc * nw[14], v[15] * sc * nw[15]);
            bf16* qo = OUT + (size_t)(t0 + u) * 1024 + head * 128 + dv0;
            *(u32x4*)qo = oa; *(u32x4*)(qo + 8) = ob;
        }
    }
}

DI void softmax_rows256(bf16* S, int nrows, int gw, int NGW, int lane) {
    for (int r0 = gw * 4; r0 < nrows; r0 += NGW * 4) {
        u32x2 a[4];
#pragma unroll
        for (int i = 0; i < 4; ++i) a[i] = *((const u32x2*)(S + (size_t)(r0 + i) * 256) + lane);
#pragma unroll
        for (int i = 0; i < 4; ++i) {
            float v0 = bflo(a[i].x), v1 = bfhi(a[i].x), v2 = bflo(a[i].y), v3 = bfhi(a[i].y);
            const float mx = wave_max(fmaxf(fmaxf(v0, v1), fmaxf(v2, v3)));
            v0 = __expf(v0 - mx); v1 = __expf(v1 - mx); v2 = __expf(v2 - mx); v3 = __expf(v3 - mx);
            const float inv = 1.f / wave_sum((v0 + v1) + (v2 + v3));
            u32x2 o; o.x = pk2(v0 * inv, v1 * inv); o.y = pk2(v2 * inv, v3 * inv);
            *((u32x2*)(S + (size_t)(r0 + i) * 256) + lane) = o;
        }
    }
}

#define GAS __attribute__((address_space(1)))
#define XB_TMO      128
#define XB_XCNT(j)  (256  + 64 * (j))
#define XB_XSUB(j)  (1280 + 64 * (j))
#define XB_XGEN(j)  (2304 + 64 * (j))
#define XB_TOP      3328
#define XB_TOPGEN   3392
#define XCD_BAR_WORDS 3456
#define XB_SPIN_CAP (1u << 18)

__device__ __forceinline__ unsigned xb_ld(unsigned* p)              { return __hip_atomic_load(p, __ATOMIC_RELAXED, __HIP_MEMORY_SCOPE_AGENT); }
__device__ __forceinline__ unsigned xb_add(unsigned* p, unsigned v) { return __hip_atomic_fetch_add(p, v, __ATOMIC_RELAXED, __HIP_MEMORY_SCOPE_AGENT); }
__device__ __forceinline__ unsigned xb_xcc_id() { return (unsigned)__builtin_amdgcn_s_getreg((3 << 11) | 20) & 0xFu; }
#define XB_SPIN(cond, bar) do { unsigned _sp = 0; while (cond) { __builtin_amdgcn_s_sleep(1); \
    if ((++_sp & 255u) == 0u) { if (xb_ld(&(bar)[XB_TMO])) break; if (_sp > XB_SPIN_CAP) { atomicAdd(&(bar)[XB_TMO], 1u); break; } } } } while (0)

struct XcdBarrier {
    unsigned* bar; unsigned x;
    volatile LAS unsigned* st;
};

__device__ __forceinline__ XcdBarrier xcd_barrier_post(unsigned* bar, volatile LAS unsigned* st) {
    XcdBarrier b; b.bar = bar; b.x = xb_xcc_id(); b.st = st;
    if (threadIdx.x == 0) (void)xb_add(&bar[XB_XCNT(b.x)], 1u);
    return b;
}
__device__ __forceinline__ void xcd_barrier_complete(unsigned* bar, unsigned x, unsigned& nloc, unsigned& nx) {
    const unsigned G = gridDim.x * gridDim.y * gridDim.z;
    unsigned sum, cnt, mine, sp = 0u;
    for (;;) {
        sum = 0u; cnt = 0u; mine = 0u;
#pragma unroll
        for (unsigned j = 0; j < 16; ++j) { const unsigned c = xb_ld(&bar[XB_XCNT(j)]); sum += c; cnt += (c > 0u) ? 1u : 0u; mine = (j == x) ? c : mine; }
        if (sum == G) break;
        __builtin_amdgcn_s_sleep(1);
        if ((++sp & 255u) == 0u) { if (xb_ld(&bar[XB_TMO])) break; if (sp > XB_SPIN_CAP) { atomicAdd(&bar[XB_TMO], 1u); break; } }
    }
    nloc = mine > 0u ? mine : 1u; nx = cnt > 0u ? cnt : 1u;
}

__device__ __forceinline__ void xcd_barrier(const XcdBarrier& b) {
    asm volatile("s_waitcnt vmcnt(0)" ::: "memory");
    __syncthreads();
    if (threadIdx.x == 0) {
        unsigned* bar = b.bar;
        __builtin_amdgcn_s_waitcnt(0);
        unsigned nloc = b.st[0], nx = b.st[1];
        if (nloc == 0u) { xcd_barrier_complete(bar, b.x, nloc, nx); b.st[0] = nloc; b.st[1] = nx; }
        const unsigned old = xb_add(&bar[XB_XSUB(b.x)], 1u);
        const unsigned gen = old / nloc;
        if (old + 1u == (gen + 1u) * nloc) {
            __builtin_amdgcn_fence(__ATOMIC_RELEASE, "agent");
            asm volatile("s_waitcnt vmcnt(0)" ::: "memory");
            const unsigned og = xb_add(&bar[XB_TOP], 1u);
            const unsigned tg = og / nx;
            if (og + 1u == (tg + 1u) * nx) xb_add(&bar[XB_TOPGEN], 1u);
            else XB_SPIN(xb_ld(&bar[XB_TOPGEN]) == tg, bar);
            __builtin_amdgcn_fence(__ATOMIC_ACQUIRE, "agent");
            xb_add(&bar[XB_XGEN(b.x)], 1u);
            asm volatile("s_waitcnt vmcnt(0)" ::: "memory");
        } else {
            XB_SPIN(xb_ld(&bar[XB_XGEN(b.x)]) == gen, bar);
            __builtin_amdgcn_fence(__ATOMIC_ACQUIRE, "agent");
            asm volatile("s_waitcnt vmcnt(0)" ::: "memory");
        }
    }
    __syncthreads();
}

struct Args { const float* in[31]; float* out; unsigned char* ws; float lam_init[2]; int ph_lo, ph_hi; };
constexpr int NPL = 15, NPH = 4 * NPL + 1;

DI pg8::Gemm mk_gemm(const bf16* A, const bf16* Bt, int M, int N, int K, int lda, int ldb) {
    pg8::Gemm g; g.A = A; g.Bt = Bt; g.M = M; g.N = N; g.K = K; g.lda = lda; g.ldb = ldb; g.a_pn = 0; g.b_pn = (long)256 * ldb; g.b_b = 0; g.pm_per_b = 1 << 30; return g;
}
DI pg8::EpiU mk_store(bf16* O, int ldc, int act, int scale_cols, float scale) {
    pg8::EpiU e; e.mode = 0; e.O = O; e.ldc = ldc; e.act = act; e.scale_cols = scale_cols; e.scale = scale; e.small_out = nullptr; e.small_pn = -1; e.base = nullptr; e.baseb = nullptr; e.outb = nullptr; return e;
}
DI pg8::EpiU mk_res(const float* base, const bf16* baseb, bf16* outb) {
    pg8::EpiU e; e.mode = 1; e.O = nullptr; e.ldc = D_; e.act = 0; e.scale_cols = 0; e.scale = 1.f; e.small_out = nullptr; e.small_pn = -1; e.base = base; e.baseb = baseb; e.outb = outb; return e;
}

__global__ void __launch_bounds__(512, 2) mega_fwd(Args a) {
    extern __shared__ __attribute__((aligned(16))) unsigned char lds_raw[];
    ldsp lds = (ldsp)lds_raw;
    cg::grid_group grid = cg::this_grid();
    volatile LAS unsigned* bst = (volatile LAS unsigned*)(lds + LDS_BYTES - 16);
    if (threadIdx.x < 4) bst[threadIdx.x] = 0u;
    __syncthreads();
    const XcdBarrier xbar = xcd_barrier_post((unsigned*)(a.ws + 4096), bst);
    const int G = gridDim.x, blk = blockIdx.x, NGW = G * 8;
    for (int ph = a.ph_lo; ph < a.ph_hi; ++ph) {
        int tid = threadIdx.x; asm volatile("" : "+v"(tid));
        const int lane = tid & 63, wave = __builtin_amdgcn_readfirstlane(tid >> 6), gw = blk * 8 + wave;
        unsigned char* ws = a.ws;
        bf16* XN = (bf16*)(ws + WS_XN); bf16* BIG = (bf16*)(ws + WS_BIG); bf16* VT = (bf16*)(ws + WS_VT); bf16* ORAW = (bf16*)a.out;   bf16* XR = (bf16*)(ws + WS_ORAW);
        float* SMALL = (float*)(ws + WS_SMALL); bf16* MEMN = (bf16*)(ws + WS_MEMN); bf16* KX = (bf16*)(ws + WS_KX); bf16* VXT = (bf16*)(ws + WS_VXT);
        bf16* KT = (bf16*)(ws + WS_KT); float* DG = (float*)(ws + WS_DG); bf16* TAIL = (bf16*)(ws + WS_DG + 1 * MiB);
        bf16* WA = (bf16*)(ws + WS_WA); bf16* WV = (bf16*)(ws + WS_WV); bf16* WOUT = (bf16*)(ws + WS_WOUT); bf16* WQ = (bf16*)(ws + WS_WQ); bf16* WKV = (bf16*)(ws + WS_WKV);
        bf16* WXO = (bf16*)(ws + WS_WXO); bf16* W1 = (bf16*)(ws + WS_W1); bf16* W2 = (bf16*)(ws + WS_W2);
        bf16* QX = BIG; bf16* SP = BIG + (size_t)T_ * 1024; bf16* OX = BIG + (size_t)2 * T_ * 1024;
        bf16* OATT = (bf16*)(ws + WS_BIG + 132 * MiB);

        const int layer = ph / NPL, k = ph % NPL;
        const bool even = !(layer & 1); const int li = layer >> 1;
        bool did = true; int nj = 0;
        const bool x_in = (layer == 0 && k <= 5);
        if (ph == NPH - 1) {
            rms_rows_from_bf16<true>(XR, a.in[30], nullptr, a.out, T_, gw, NGW, lane);
        } else if (k == 0) {
            LAS float* scr = (LAS float*)(lds + wave * 16384);
            const float* wq = a.in[24] + (size_t)layer * 1024 * 1024; const float* wkv = a.in[25] + (size_t)layer * 1024 * 2048; const float* wxo = a.in[26] + (size_t)layer * 1024 * 1024;
            const float* w1 = a.in[28] + (size_t)layer * 1024 * 4096; const float* w2 = a.in[29] + (size_t)layer * 4096 * 1024;
            const int I_Q = 16 * 32, I_KV = 16 * 64, I_XO = 16 * 32, I_1 = 16 * 128, I_2 = 64 * 32;
            const int I_A = even ? 16 * 144 : 16 * 64, I_V = 16 * 32, I_O = even ? 32 * 32 : 16 * 32;
            const int NIT = I_Q + I_KV + I_XO + I_1 + I_2 + I_A + I_V + I_O;
            for (int it = gw; it < NIT; it += NGW) {
                int r = it;
                if (r < I_Q) { conv_item(wq, 1024, 1024, WQ, 1024, 0, 0, scr, r, lane); continue; } r -= I_Q;
                if (r < I_KV) { conv_item(wkv, 2048, 1024, WKV, 2048, 0, 0, scr, r, lane); continue; } r -= I_KV;
                if (r < I_XO) { conv_item(wxo, 1024, 1024, WXO, 1024, 0, 0, scr, r, lane); continue; } r -= I_XO;
                if (r < I_1) { conv_item(w1, 4096, 1024, W1, 4096, 0, 0, scr, r, lane); continue; } r -= I_1;
                if (r < I_2) { conv_item(w2, 1024, 4096, W2, 1024, 0, 0, scr, r, lane); continue; } r -= I_2;
                if (even) {
                    const float* win = a.in[3] + (size_t)li * 1024 * 5408; const float* wout = a.in[13] + (size_t)li * 2048 * 1024;
                    if (r < I_A) { conv_item(win, 5408, 1024, WA, 4608, 1, 0, scr, r, lane); continue; } r -= I_A;
                    if (r < I_V) { conv_item(win, 5408, 1024, WV, 1024, 0, 3344, scr, r, lane); continue; } r -= I_V;
                    conv_item(wout, 1024, 2048, WOUT, 1024, 0, 0, scr, r, lane);
                } else {
                    const float* wqkv = a.in[15] + (size_t)li * 1024 * 3072; const float* wo = a.in[21] + (size_t)li * 1024 * 1024;
                    if (r < I_A) { conv_item(wqkv, 3072, 1024, WA, 2048, 0, 0, scr, r, lane); continue; } r -= I_A;
                    if (r < I_V) { conv_item(wqkv, 3072, 1024, WV, 1024, 0, 2048, scr, r, lane); continue; } r -= I_V;
                    conv_item(wo, 1024, 1024, WOUT, 1024, 0, 0, scr, r, lane);
                }
            }
            if (x_in) rms_rows_bf16(a.in[0], a.in[2], XN, T_, gw, NGW, lane);
            else rms_rows_from_bf16<false>(XR, (even ? a.in[2] : a.in[14]) + (size_t)li * 1024, XN, nullptr, T_, gw, NGW, lane);
            rms_rows_bf16(a.in[1], a.in[23] + (size_t)layer * 1024, MEMN, 512, gw, NGW, lane);
            if (blk == 0 && tid < 64) ((float*)ws)[tid] = 0.f;
        } else if (k == 1) { nj = 4;
        } else if (k == 2) {
            if (even) { for (int u = blk; u < T_ / 128; u += G) prep_unit(u, BIG, SMALL, KT, DG, TAIL, a.in[10] + (size_t)li * 16 * 512, a.in[11] + (size_t)li * 512, a.in[6] + li * 16, a.in[7] + li * 16, a.in[4] + (size_t)li * 4 * 1280, a.in[5] + (size_t)li * 1280, lds, tid); }
            else {
                qk_norms(BIG, (float*)ws, gw, NGW, lane);
                xcd_barrier(xbar);
                {
                    const int x = blk & 7, j = blk >> 3, bb = (x >> 1) & 1, br = x & 1, grp = x >> 2;
#pragma unroll 1
                    for (int u = 0; u < 8; ++u) { const int s = u >> 1; const int head = grp ? (s == 0 ? 6 : s == 1 ? 4 : s == 2 ? 3 : 2) : (s == 0 ? 7 : s == 1 ? 5 : s == 2 ? 1 : 0);
                        attn_unit(bb, 2 * head + br, (u & 1) ? j : 63 - j, BIG, VT, OATT, (const float*)ws, lds, tid); }
                }
            }
        } else if (k == 3) {
            if (even) {
                for (int j = blk; j < 64; j += G) {
                    if (j < 32) ssd_chain(j >> 4, j & 15, BIG, SMALL, TAIL, a.in[8] + li * 16, lds, tid);
                    else { const int i2 = j - 32; gla_chain(i2 >> 4, (i2 >> 2) & 3, i2 & 3, BIG, KT, VT, DG, ORAW, lds, tid); }
                }
            } else combine_rows(OATT, XN, a.in[16] + li * 64, a.in[17] + li * 64, a.in[18] + li * 64, a.in[19] + li * 64, a.in[20] + li * 128, a.lam_init[li], gw, NGW, lane);
        } else if (k == 4) {
            if (even) gate_rows(BIG, ORAW, a.in[9] + (size_t)li * 1024, a.in[12] + (size_t)li * 256, gw, NGW, lane);
            else nj = 1;
        } else if (k == 5) { if (even) nj = 1; else did = false;
        } else if (k == 6) { rms_rows_from_bf16<false>(XR, a.in[22] + (size_t)layer * 1024, XN, nullptr, T_, gw, NGW, lane);
        } else if (k == 9) { softmax_rows256(SP, T_ * 4, gw, NGW, lane);
        } else if (k == 12) { rms_rows_from_bf16<false>(XR, a.in[27] + (size_t)layer * 1024, XN, nullptr, T_, gw, NGW, lane);
        } else nj = 1;
        for (int j = 0; j < nj; ++j) {
            pg8::Gemm g = mk_gemm(XN, WA, T_, 1024, 1024, 1024, 1024); pg8::EpiU e = mk_store(BIG, 1024, 0, 0, 1.f);
            if (k == 1) {
                if (j == 0) { if (even) { g = mk_gemm(XN, WA, T_, 4608, 1024, 1024, 1024); e = mk_store(BIG, PROJ_LD, 0, 0, 1.f); e.small_out = SMALL; e.small_pn = 17; }
                              else { g = mk_gemm(XN, WA, T_, 2048, 1024, 1024, 1024); e = mk_store(BIG, QK_LD, 0, 1024, 0.125f * 1.4426950408889634f); } }
                else if (j == 1) { g = mk_gemm(WV, XN, 1024, T_, 1024, 1024, 1024); e = mk_store(VT, VT_LD, 0, 0, 1.f); }
                else if (j == 2) { g = mk_gemm(MEMN, WKV, 512, 1024, 1024, 1024, 1024); e = mk_store(KX, 1024, 0, 0, 1.f); }
                else { g = mk_gemm(WKV + (size_t)1024 * 1024, MEMN, 1024, 512, 1024, 1024, 1024); e = mk_store(VXT, 512, 0, 0, 1.f); }
            } else if (k == 4) { g = mk_gemm(XN, WOUT, T_, 1024, 1024, 1024, 1024); e = mk_res(nullptr, XR, XR);
            } else if (k == 5) {
                g = mk_gemm(ORAW, WOUT, T_, 1024, 2048, 2048, 2048); e = x_in ? mk_res(a.in[0], nullptr, XR) : mk_res(nullptr, XR, XR);
            } else if (k == 7) { g = mk_gemm(XN, WQ, T_, 1024, 1024, 1024, 1024); e = mk_store(QX, 1024, 0, 1024, 0.0625f);
            } else if (k == 8) { g = mk_gemm(QX, KX, T_, 1024, 256, 1024, 1024); g.a_pn = 256; g.b_pn = 256; g.b_b = (long)256 * 1024; g.pm_per_b = 64; e = mk_store(SP, 1024, 0, 0, 1.f);
            } else if (k == 10) { g = mk_gemm(SP, VXT, T_, 1024, 256, 1024, 512); g.a_pn = 256; g.b_pn = (long)256 * 512; g.b_b = 256; g.pm_per_b = 64; e = mk_store(OX, 1024, 0, 0, 1.f);
            } else if (k == 11) { g = mk_gemm(OX, WXO, T_, 1024, 1024, 1024, 1024); e = mk_res(nullptr, XR, XR);
            } else if (k == 13) { g = mk_gemm(XN, W1, T_, 4096, 1024, 1024, 1024); e = mk_store(BIG, 4096, 1, 0, 1.f);
            } else if (k == 14) { g = mk_gemm(BIG, W2, T_, 1024, 4096, 4096, 4096); e = mk_res(nullptr, XR, XR); }
            pg8::StaticOrder S; S.init(g.M, g.N, G, (blk + 64 * j * (j >= 2)) % G);
            pg8::gemm_phase<pg8::EpiU, pg8::StaticOrder, true, true>(lds, g, S, e, tid);
        }
        if (did && ph + 1 < a.ph_hi) { if (ph == 0) grid.sync(); else xcd_barrier(xbar); }
    }
}

extern "C" void kernel_launch(void* const* d_in, const int* in_sizes, int n_in, void* d_out, int out_size, void* d_ws, size_t ws_size, hipStream_t stream) {
    static int grid = 0;
    if (grid == 0) {
        if (n_in != 31 || out_size != T_ * D_ || ws_size < WS_END) { fprintf(stderr, "kernel_launch: unexpected problem (n_in %d out %d ws %zu)\n", n_in, out_size, ws_size); grid = -1; return; }
        int dev = 0, cus = 0, per_cu = 0;
        hipGetDevice(&dev); hipDeviceGetAttribute(&cus, hipDeviceAttributeMultiprocessorCount, dev);
        if (hipFuncSetAttribute((const void*)mega_fwd, hipFuncAttributeMaxDynamicSharedMemorySize, LDS_BYTES) != hipSuccess) { fprintf(stderr, "kernel_launch: hipFuncSetAttribute failed\n"); grid = -1; return; }
        if (hipOccupancyMaxActiveBlocksPerMultiprocessor(&per_cu, (const void*)mega_fwd, 512, LDS_BYTES) != hipSuccess || per_cu < 1) { fprintf(stderr, "kernel_launch: occupancy query says %d\n", per_cu); per_cu = 1; }
        (void)hipGetLastError();
        grid = cus;
        if (grid != 256) { fprintf(stderr, "kernel_launch: built for a 256-CU device (got %d)\n", cus); grid = -1; return; }
    }
    if (grid < 0) return;
    Args a{};
    for (int i = 0; i < 31; ++i) a.in[i] = (const float*)d_in[i];
    a.out = (float*)d_out; a.ws = (unsigned char*)d_ws;
    a.lam_init[0] = (float)(0.8 - 0.6 * exp(-0.3 * 1.0)); a.lam_init[1] = (float)(0.8 - 0.6 * exp(-0.3 * 3.0));
    a.ph_lo = 0; a.ph_hi = NPH;
#ifdef PROBE_PREFIX
    {
        Args p = a; p.ph_hi = PROBE_PREFIX; void* pargs[] = {&p};
        (void)hipMemsetAsync(d_ws, 0, 65536, stream);
        (void)hipLaunchCooperativeKernel((const void*)mega_fwd, dim3(grid), dim3(512), pargs, LDS_BYTES, stream);
    }
#endif
    if (hipMemsetAsync(d_ws, 0, 65536, stream) != hipSuccess) { fprintf(stderr, "kernel_launch: memset failed\n"); return; }
    void* args[] = {&a};
    hipError_t e = hipLaunchCooperativeKernel((const void*)mega_fwd, dim3(grid), dim3(512), args, LDS_BYTES, stream);
    if (e != hipSuccess) fprintf(stderr, "cooperative launch failed: %s (grid %d)\n", hipGetErrorString(e), grid);
}
```

```cpp
#include <hip/hip_runtime.h>
#include <hip/hip_cooperative_groups.h>
#include <cstdio>
#include <cstdint>
#include <cmath>
namespace cg = cooperative_groups;

namespace pg8 {
#define PG8_LAS __attribute__((address_space(3)))
typedef unsigned short bf16_t;
typedef short bf16x8 __attribute__((ext_vector_type(8)));
typedef float f32x4 __attribute__((ext_vector_type(4)));
typedef unsigned u32x4 __attribute__((ext_vector_type(4)));
constexpr int BM = 256, BK = 64, HALF = 128, HTB = HALF * BK * 2, STAGE_BYTES = 8 * HTB, NXCD = 8, WGM = 8;

__host__ __device__ __forceinline__ int lds_byte(int r, int c) { const int st = (r >> 4) * 2 + (c >> 5), rr = r & 15, cc = c & 31, ob = rr * 64 + cc * 2; return st * 1024 + (ob ^ (((ob >> 9) & 1) << 5)); }
__host__ __device__ __forceinline__ void stage_rc(int b, int& R, int& C) { const int st = b / 1024, sb = b % 1024, swz = sb ^ (((sb >> 9) & 1) << 5); R = (st >> 1) * 16 + swz / 64; C = (st & 1) * 32 + (swz % 64) / 2; }
__host__ __device__ __forceinline__ int perm32(int rho) { const int n = rho >> 4, i = rho & 15; return 8 * (i >> 2) + 4 * n + (i & 3); }

struct Unit { int pm, pn; };
struct Gemm { const bf16_t* A; const bf16_t* Bt; int M, N, K, lda, ldb; long a_pn, b_pn, b_b; int pm_per_b; };

struct StaticOrder {
    int nM, nN, nwg, G, c;
    __host__ __device__ void init(int M, int N, int G_, int c_) { nM = M / BM; nN = N / BM; nwg = nM * nN; G = G_; c = c_; }
    __host__ __device__ bool next(int i, Unit& u) const {
        const long L = (long)i * G + c; if (L >= nwg) return false;
        int wgid = (int)L; { const int q = nwg / NXCD, r = nwg % NXCD, xcd = wgid % NXCD, off = wgid / NXCD; wgid = (xcd < r ? xcd * (q + 1) : r * (q + 1) + (xcd - r) * q) + off; }
        const int nig = WGM * nN, gid = wgid / nig, fm = gid * WGM, gsz = (nM - fm) < WGM ? (nM - fm) : WGM;
        u.pm = fm + ((wgid % nig) % gsz); u.pn = (wgid % nig) / gsz; return true;
    }
    __device__ __forceinline__ void ptrs(const Unit& u, const Gemm& g, const char*& a, const char*& b) const {
        a = (const char*)(g.A + (size_t)u.pm * BM * g.lda + (size_t)u.pn * g.a_pn);
        b = (const char*)(g.Bt + (size_t)u.pn * g.b_pn + (size_t)(u.pm / g.pm_per_b) * g.b_b);
    }
    __device__ __forceinline__ void a_ready(const Unit&) const {}
    __device__ __forceinline__ void done(const Unit&) const {}
};

__device__ __forceinline__ unsigned cvt_pk_bf16(float lo, float hi) { unsigned r; asm volatile("v_cvt_pk_bf16_f32 %0, %1, %2" : "=v"(r) : "v"(lo), "v"(hi)); return r; }

__device__ __forceinline__ float rstd16(const float* p) {
    const f32x4 a = *(const f32x4*)p, b = *(const f32x4*)(p + 4), c = *(const f32x4*)(p + 8), d = *(const f32x4*)(p + 12);
    const float s = (((a[0] + a[1]) + (a[2] + a[3])) + ((b[0] + b[1]) + (b[2] + b[3]))) + (((c[0] + c[1]) + (c[2] + c[3])) + ((d[0] + d[1]) + (d[2] + d[3])));
    return rsqrtf(s * (1.f / 1024.f) + 1e-5f);
}
struct EpiU {
    static constexpr bool PERM = true, AFTER_DRAIN = false;
    int mode;
    bf16_t* O; int ldc; int act; int scale_cols; float scale;
    float* small_out; int small_pn;
    float* ssq; const float* nssq; int nmode;
    const float* base; const bf16_t* baseb; bf16_t* outb;
    __device__ __forceinline__ void operator()(const f32x4 (&acc)[2][2][4][2], const Unit& u, int wr, int wc, int fr, int fq) const {
        const int row0 = u.pm * BM + wr * 64 + fr; const int col0 = u.pn * BM + wc * 32 + 8 * fq;
        if (mode == 0) {
            if (small_out && u.pn == small_pn) {
                if (wc == 0) {
#pragma unroll
                    for (int ai = 0; ai < 2; ++ai)
#pragma unroll
                        for (int m = 0; m < 4; ++m) { const int rr = row0 + ai * HALF + m * 16; const float rsc = (nmode == 1) ? rstd16(nssq + (size_t)rr * 16) : 1.f;
                            float* p = small_out + (size_t)rr * 32 + 8 * fq; *(f32x4*)p = acc[ai][0][m][0] * rsc; *(f32x4*)(p + 4) = acc[ai][0][m][1] * rsc; }
                }
                return;
            }
            f32x4 csc[2][2];
#pragma unroll
            for (int bj = 0; bj < 2; ++bj)
#pragma unroll
                for (int e = 0; e < 4; ++e) { csc[bj][0][e] = (nmode == 2) ? rstd16(nssq + (size_t)(col0 + bj * HALF + e) * 16) : 1.f; csc[bj][1][e] = (nmode == 2) ? rstd16(nssq + (size_t)(col0 + bj * HALF + 4 + e) * 16) : 1.f; }
#pragma unroll
            for (int ai = 0; ai < 2; ++ai)
#pragma unroll
                for (int m = 0; m < 4; ++m) { bf16_t* rowp = O + (size_t)(row0 + ai * HALF + m * 16) * ldc + col0;
                    const float rsc = (nmode == 1) ? rstd16(nssq + (size_t)(row0 + ai * HALF + m * 16) * 16) : 1.f;
#pragma unroll
                    for (int bj = 0; bj < 2; ++bj) { f32x4 v0 = acc[ai][bj][m][0] * rsc * csc[bj][0], v1 = acc[ai][bj][m][1] * rsc * csc[bj][1];
                        if (act == 1) {
#pragma unroll
                            for (int e = 0; e < 4; ++e) { float t0 = fmaxf(v0[e], 0.f), t1 = fmaxf(v1[e], 0.f); v0[e] = t0 * t0; v1[e] = t1 * t1; } }
                        const float sc = (col0 + bj * HALF < scale_cols) ? scale : 1.f;
                        v0 = v0 * sc; v1 = v1 * sc; u32x4 w; w.x = cvt_pk_bf16(v0[0], v0[1]); w.y = cvt_pk_bf16(v0[2], v0[3]); w.z = cvt_pk_bf16(v1[0], v1[1]); w.w = cvt_pk_bf16(v1[2], v1[3]);
                        *(u32x4*)(rowp + bj * HALF) = w; } }
        } else {
#pragma unroll
            for (int ai = 0; ai < 2; ++ai)
#pragma unroll
                for (int m = 0; m < 4; ++m) { const size_t off = (size_t)(row0 + ai * HALF + m * 16) * ldc + col0; float ss = 0.f;
#pragma unroll
                    for (int bj = 0; bj < 2; ++bj) { f32x4 b0, b1;
                        if (baseb) { const u32x4 wv = *(const u32x4*)(baseb + off + bj * HALF);
                            b0 = (f32x4){__builtin_bit_cast(float, wv.x << 16), __builtin_bit_cast(float, wv.x & 0xffff0000u), __builtin_bit_cast(float, wv.y << 16), __builtin_bit_cast(float, wv.y & 0xffff0000u)};
                            b1 = (f32x4){__builtin_bit_cast(float, wv.z << 16), __builtin_bit_cast(float, wv.z & 0xffff0000u), __builtin_bit_cast(float, wv.w << 16), __builtin_bit_cast(float, wv.w & 0xffff0000u)}; }
                        else { const float* bp = base + off + bj * HALF; b0 = *(const f32x4*)bp; b1 = *(const f32x4*)(bp + 4); }
                        const f32x4 x0 = b0 + acc[ai][bj][m][0], x1 = b1 + acc[ai][bj][m][1];
                        u32x4 w; w.x = cvt_pk_bf16(x0[0], x0[1]); w.y = cvt_pk_bf16(x0[2], x0[3]); w.z = cvt_pk_bf16(x1[0], x1[1]); w.w = cvt_pk_bf16(x1[2], x1[3]);
                        *(u32x4*)(outb + off + bj * HALF) = w;
                        ss += (x0[0] * x0[0] + x0[1] * x0[1]) + (x0[2] * x0[2] + x0[3] * x0[3]) + (x1[0] * x1[0] + x1[1] * x1[1]) + (x1[2] * x1[2] + x1[3] * x1[3]); }
                    ss += __shfl_xor(ss, 16); ss += __shfl_xor(ss, 32);
                    if (fq == 0) ssq[(size_t)(row0 + ai * HALF + m * 16) * 16 + u.pn * 4 + wc] = ss;
                }
        }
    }
};

template <class Epi, class Sched, bool ALIGN_EPI = false, bool SP2 = false>
__device__ __forceinline__ void gemm_phase(PG8_LAS unsigned char* lds, const Gemm g, const Sched& S, const Epi& E, const int tid) {
    const int wid = __builtin_amdgcn_readfirstlane(tid >> 6), lane = tid & 63, wr = wid >> 2, wc = wid & 3, fr = lane & 15, fq = lane >> 4;
    const int K = g.K, nt = K / BK;
    unsigned voffA[2], voffB[2];
#pragma unroll
    for (int i = 0; i < 2; ++i) { int R, C; stage_rc(tid * 16 + i * 8192, R, C); const int Rb = Epi::PERM ? ((R & ~31) + perm32(R & 31)) : R;
        voffA[i] = (unsigned)(R * g.lda + C) * 2u; voffB[i] = (unsigned)(Rb * g.ldb + C) * 2u; }
    const size_t kstep = (size_t)(BK * 2);
    const size_t hstepA = (size_t)HALF * g.lda * 2, hstepB = (size_t)HALF * g.ldb * 2;
    const unsigned ldsw = (unsigned)wid * 1024u;
    const int aoff = lds_byte(wr * 64 + fr, fq * 8), boff = lds_byte(wc * 32 + fr, fq * 8);
#define PG8_SA(b, h) (((b) * 2 + (h)) * HTB)
#define PG8_SB(b, h) ((4 + (b) * 2 + (h)) * HTB)
#define PG8_STAGE(bufoff, gbase, voff) do { _Pragma("unroll") for (int _i = 0; _i < 2; ++_i) \
        __builtin_amdgcn_global_load_lds((const unsigned*)((const char*)(gbase) + (voff)[_i]), (PG8_LAS unsigned*)(lds + (bufoff) + ldsw + _i * 8192), 16, 0, 0); } while (0)
#define PG8_LDA(dst, b, h) do { _Pragma("unroll") for (int m = 0; m < 4; ++m) _Pragma("unroll") for (int k = 0; k < 2; ++k) dst[m][k] = *(const PG8_LAS bf16x8*)(lds + PG8_SA(b, h) + aoff + m * 2048 + k * 1024); } while (0)
#define PG8_LDB(dst, b, h) do { _Pragma("unroll") for (int n = 0; n < 2; ++n) _Pragma("unroll") for (int k = 0; k < 2; ++k) dst[n][k] = *(const PG8_LAS bf16x8*)(lds + PG8_SB(b, h) + boff + n * 2048 + k * 1024); } while (0)
#define PG8_MMA(ai, bj, At, Bt) do { __builtin_amdgcn_s_setprio(1); _Pragma("unroll") for (int m = 0; m < 4; ++m) _Pragma("unroll") for (int n = 0; n < 2; ++n) _Pragma("unroll") for (int k = 0; k < 2; ++k) \
        acc[ai][bj][m][n] = __builtin_amdgcn_mfma_f32_16x16x32_bf16(Bt[n][k], At[m][k], acc[ai][bj][m][n], 0, 0, 0); __builtin_amdgcn_s_setprio(0); } while (0)
#define PG8_WAIT_V(n) asm volatile("s_waitcnt vmcnt(" #n ")" ::: "memory")
#define PG8_WAIT_L(n) asm volatile("s_waitcnt lgkmcnt(" #n ")" ::: "memory")
#define PG8_BAR __builtin_amdgcn_s_barrier()
#define PG8_SCHED __builtin_amdgcn_sched_barrier(0)
    Unit cur, nxt; int ui = 0;
    if (!S.next(0, cur)) return;
    f32x4 acc[2][2][4][2];
#pragma unroll
    for (int a = 0; a < 2; ++a)
#pragma unroll
        for (int b = 0; b < 2; ++b)
#pragma unroll
            for (int m = 0; m < 4; ++m)
#pragma unroll
                for (int n = 0; n < 2; ++n) acc[a][b][m][n] = (f32x4){0.f, 0.f, 0.f, 0.f};
    bf16x8 At[4][2], B0[2][2], B1[2][2];
    const char* cA; const char* cB; S.ptrs(cur, g, cA, cB);
    S.a_ready(cur);
    if constexpr (SP2) {
        PG8_STAGE(PG8_SB(0, 0), cB, voffB); PG8_STAGE(PG8_SB(0, 1), cB + hstepB, voffB); PG8_STAGE(PG8_SA(0, 0), cA, voffA); PG8_STAGE(PG8_SA(0, 1), cA + hstepA, voffA);
        if (wr == 1) PG8_BAR;
        PG8_WAIT_V(2); PG8_BAR;
        PG8_STAGE(PG8_SB(1, 0), cB + kstep, voffB); PG8_STAGE(PG8_SA(1, 0), cA + kstep, voffA); PG8_STAGE(PG8_SB(1, 1), cB + hstepB + kstep, voffB);
        PG8_WAIT_V(6); PG8_BAR;
    } else {
        PG8_STAGE(PG8_SB(0, 0), cB, voffB); PG8_STAGE(PG8_SA(0, 0), cA, voffA); PG8_STAGE(PG8_SB(0, 1), cB + hstepB, voffB); PG8_STAGE(PG8_SA(0, 1), cA + hstepA, voffA);
        if (wr == 1) PG8_BAR;
        PG8_WAIT_V(4); PG8_BAR;
        PG8_STAGE(PG8_SB(1, 0), cB + kstep, voffB); PG8_STAGE(PG8_SA(1, 0), cA + kstep, voffA); PG8_STAGE(PG8_SB(1, 1), cB + hstepB + kstep, voffB);
        PG8_WAIT_V(6); PG8_BAR;
    }
    for (;;) {
        const bool has_next = S.next(ui + 1, nxt);
        const char* nA = cA; const char* nB = cB; if (has_next) S.ptrs(nxt, g, nA, nB);
        for (int t = 0; t < nt; t += 2) {
            const bool last = (t == nt - 2);
            const char* a1 = cA + (size_t)(t + 1) * kstep;
            const char* a2 = last ? nA : cA + (size_t)(t + 2) * kstep; const char* b2 = last ? nB : cB + (size_t)(t + 2) * kstep;
            const char* a3 = a2 + kstep; const char* b3 = b2 + kstep;
            if (last && has_next) S.a_ready(nxt);
            if constexpr (SP2) {
            PG8_LDB(B0, 0, 0); PG8_LDB(B1, 0, 1); PG8_SCHED; PG8_LDA(At, 0, 0); PG8_STAGE(PG8_SA(1, 1), a1 + hstepA, voffA);
            PG8_WAIT_V(8); PG8_WAIT_L(0); PG8_BAR; PG8_MMA(0, 0, At, B0); PG8_MMA(0, 1, At, B1); PG8_BAR; PG8_SCHED;
            PG8_LDA(At, 0, 1); PG8_STAGE(PG8_SB(0, 0), b2, voffB); PG8_STAGE(PG8_SB(0, 1), b2 + hstepB, voffB); PG8_STAGE(PG8_SA(0, 0), a2, voffA);
            PG8_WAIT_V(8); PG8_WAIT_L(0); PG8_BAR; PG8_MMA(1, 0, At, B0); PG8_MMA(1, 1, At, B1); PG8_BAR; PG8_SCHED;
            PG8_LDB(B0, 1, 0); PG8_LDB(B1, 1, 1); PG8_SCHED; PG8_LDA(At, 1, 0); PG8_STAGE(PG8_SA(0, 1), a2 + hstepA, voffA);
            PG8_WAIT_V(8); PG8_WAIT_L(0); PG8_BAR; PG8_MMA(0, 0, At, B0); PG8_MMA(0, 1, At, B1); PG8_BAR; PG8_SCHED;
            PG8_LDA(At, 1, 1); PG8_STAGE(PG8_SB(1, 0), b3, voffB); PG8_STAGE(PG8_SB(1, 1), b3 + hstepB, voffB); PG8_STAGE(PG8_SA(1, 0), a3, voffA);
            PG8_WAIT_V(8); PG8_WAIT_L(0); PG8_BAR; PG8_MMA(1, 0, At, B0); PG8_MMA(1, 1, At, B1); PG8_BAR; PG8_SCHED;
            } else {
            PG8_LDB(B0, 0, 0); PG8_SCHED; PG8_LDA(At, 0, 0); PG8_STAGE(PG8_SA(1, 1), a1 + hstepA, voffA);
            PG8_WAIT_L(8); PG8_BAR; PG8_WAIT_L(0); PG8_MMA(0, 0, At, B0); PG8_BAR; PG8_SCHED;
            PG8_LDB(B1, 0, 1); PG8_STAGE(PG8_SB(0, 0), b2, voffB);
            PG8_BAR; PG8_WAIT_L(0); PG8_MMA(0, 1, At, B1); PG8_BAR;
            PG8_LDA(At, 0, 1); PG8_STAGE(PG8_SA(0, 0), a2, voffA);
            PG8_BAR; PG8_WAIT_L(0); PG8_MMA(1, 0, At, B0); PG8_BAR; PG8_SCHED;
            PG8_STAGE(PG8_SB(0, 1), b2 + hstepB, voffB);
            PG8_WAIT_V(6); PG8_BAR; PG8_MMA(1, 1, At, B1); PG8_BAR;
            PG8_LDB(B0, 1, 0); PG8_SCHED; PG8_LDA(At, 1, 0); PG8_STAGE(PG8_SA(0, 1), a2 + hstepA, voffA);
            PG8_WAIT_L(8); PG8_BAR; PG8_WAIT_L(0); PG8_MMA(0, 0, At, B0); PG8_BAR; PG8_SCHED;
            PG8_LDB(B1, 1, 1); PG8_STAGE(PG8_SB(1, 0), b3, voffB);
            PG8_BAR; PG8_WAIT_L(0); PG8_MMA(0, 1, At, B1); PG8_BAR;
            PG8_LDA(At, 1, 1); PG8_STAGE(PG8_SA(1, 0), a3, voffA);
            PG8_BAR; PG8_WAIT_L(0); PG8_MMA(1, 0, At, B0); PG8_BAR; PG8_SCHED;
            PG8_STAGE(PG8_SB(1, 1), b3 + hstepB, voffB);
            PG8_WAIT_V(6); PG8_BAR; PG8_MMA(1, 1, At, B1); PG8_BAR;
            }
        }
        if constexpr (ALIGN_EPI) { if (wr == 0) PG8_BAR; }
        if constexpr (!Epi::AFTER_DRAIN) { E(acc, cur, wr, wc, fr, fq); S.done(cur); }
        if (!has_next) break;
#pragma unroll
        for (int a = 0; a < 2; ++a)
#pragma unroll
            for (int b = 0; b < 2; ++b)
#pragma unroll
                for (int m = 0; m < 4; ++m)
#pragma unroll
                    for (int n = 0; n < 2; ++n) acc[a][b][m][n] = (f32x4){0.f, 0.f, 0.f, 0.f};
        cur = nxt; cA = nA; cB = nB; ++ui;
        if constexpr (ALIGN_EPI) { if (wr == 1) PG8_BAR; }
    }
    PG8_WAIT_V(0);
    if constexpr (!ALIGN_EPI) { if (wr == 0) PG8_BAR; }
    PG8_BAR;
    if constexpr (Epi::AFTER_DRAIN) { E.fused(acc, cur, wr, wc, fr, fq, lds, wid, lane); S.done(cur); }
#undef PG8_SA
#undef PG8_SB
#undef PG8_STAGE
#undef PG8_LDA
#undef PG8_LDB
#undef PG8_MMA
#undef PG8_WAIT_V
#undef PG8_WAIT_L
#undef PG8_BAR
#undef PG8_SCHED
}
}

#define LAS __attribute__((address_space(3)))
#define DI __device__ __forceinline__
typedef unsigned short bf16;
typedef short bf16x8 __attribute__((ext_vector_type(8)));
typedef short s16x4 __attribute__((ext_vector_type(4)));
typedef float f32x4 __attribute__((ext_vector_type(4)));
typedef float f32x16 __attribute__((ext_vector_type(16)));
typedef unsigned u32x4 __attribute__((ext_vector_type(4)));
typedef unsigned u32x2 __attribute__((ext_vector_type(2)));
typedef LAS unsigned char* ldsp;

constexpr int T_ = 32768, L_ = 16384, D_ = 1024;
constexpr float EPS_ = 1e-5f;
constexpr size_t MiB = (size_t)1 << 20;
constexpr size_t WS_W = 1 * MiB;
constexpr size_t WS_WA = WS_W, WS_WV = WS_W + 9 * MiB, WS_WOUT = WS_W + 11 * MiB, WS_WQ = WS_W + 15 * MiB, WS_WKV = WS_W + 17 * MiB,
                 WS_WXO = WS_W + 21 * MiB, WS_W1 = WS_W + 23 * MiB, WS_W2 = WS_W + 31 * MiB;
constexpr size_t WS_XN = 40 * MiB, WS_KT = WS_XN, WS_DG = WS_XN + 33 * MiB;
constexpr size_t WS_BIG = 104 * MiB, WS_VT = 376 * MiB, WS_ORAW = 441 * MiB, WS_SMALL = 505 * MiB, WS_MEMN = 509 * MiB, WS_KX = 510 * MiB, WS_VXT = 511 * MiB, WS_END = 512 * MiB;
constexpr int PROJ_LD = 4352;
constexpr int PC_Z = 0, PC_XBC = 1024, PC_Q = 2304, PC_K = 2816, PC_R = 3328;
constexpr int LDS_BYTES = 136 * 1024;
constexpr int VT_LD = T_ + 64, KT_LD = T_ + 64, QK_LD = 2048 + 64;

DI unsigned f2bf(float f) { unsigned u = __builtin_bit_cast(unsigned, f); return (u + 0x7fffu + ((u >> 16) & 1u)) >> 16; }
typedef float f32x2_t __attribute__((ext_vector_type(2))); typedef __bf16 bf16x2_t __attribute__((ext_vector_type(2)));
DI unsigned pk2(float lo, float hi) { f32x2_t v = {lo, hi}; bf16x2_t b = __builtin_convertvector(v, bf16x2_t); return __builtin_bit_cast(unsigned, b); }
DI float bf2f(unsigned h) { return __builtin_bit_cast(float, h << 16); }
DI float bflo(unsigned w) { return __builtin_bit_cast(float, w << 16); }
DI float bfhi(unsigned w) { return __builtin_bit_cast(float, w & 0xffff0000u); }
DI float wave_sum(float v) {
#pragma unroll
    for (int o = 1; o < 64; o <<= 1) v += __shfl_xor(v, o);
    return v;
}
DI float wave_max(float v) {
#pragma unroll
    for (int o = 1; o < 64; o <<= 1) v = fmaxf(v, __shfl_xor(v, o));
    return v;
}
DI float siluf(float x) { return x * __builtin_amdgcn_rcpf(1.f + __builtin_amdgcn_exp2f(-1.4426950408889634f * x)); }
DI float softplusf(float x) {
    const float e = __expf(-fabsf(x));
    const float l = (e < 0.01f) ? e * (1.f - e * (0.5f - e * (1.f / 3.f))) : __logf(1.f + e);
    return fmaxf(x, 0.f) + l;
}
DI bf16x8 lds16(ldsp p, int off) { return *(LAS bf16x8*)(p + off); }
DI s16x4 lds8(ldsp p, int off) { return *(LAS s16x4*)(p + off); }
DI bf16x8 cat8(s16x4 a, s16x4 b) { return __builtin_shufflevector(a, b, 0, 1, 2, 3, 4, 5, 6, 7); }
DI f32x4 mfma16(bf16x8 a, bf16x8 b, f32x4 c) { return __builtin_amdgcn_mfma_f32_16x16x32_bf16(a, b, c, 0, 0, 0); }
DI f32x16 mfma32(bf16x8 a, bf16x8 b, f32x16 c) { return __builtin_amdgcn_mfma_f32_32x32x16_bf16(a, b, c, 0, 0, 0); }
DI int crow(int r, int hi) { return (r & 3) + 8 * (r >> 2) + 4 * hi; }
DI float max3f(float a, float b, float c) { float r; asm("v_max3_f32 %0, %1, %2, %3" : "=v"(r) : "v"(a), "v"(b), "v"(c)); return r; }
#define LDS_FENCE() asm volatile("s_waitcnt lgkmcnt(0)" ::: "memory")

DI void rms_rows_bf16(const float* x, const float* w, bf16* out, int nrows, int gw, int NGW, int lane) {
    for (int m = 2 * gw; m < nrows; m += 2 * NGW) {
        const f32x4* xr0 = (const f32x4*)(x + (size_t)m * D_) + lane; const f32x4* xr1 = xr0 + D_ / 4;
        f32x4 v0[4], v1[4]; float s0 = 0.f, s1 = 0.f;
#pragma unroll
        for (int j = 0; j < 4; ++j) { v0[j] = xr0[64 * j]; v1[j] = xr1[64 * j]; }
#pragma unroll
        for (int j = 0; j < 4; ++j) { s0 += (v0[j].x * v0[j].x + v0[j].y * v0[j].y) + (v0[j].z * v0[j].z + v0[j].w * v0[j].w); s1 += (v1[j].x * v1[j].x + v1[j].y * v1[j].y) + (v1[j].z * v1[j].z + v1[j].w * v1[j].w); }
#pragma unroll
        for (int o = 1; o < 64; o <<= 1) { s0 += __shfl_xor(s0, o); s1 += __shfl_xor(s1, o); }
        const float r0 = rsqrtf(s0 * (1.f / D_) + EPS_), r1 = rsqrtf(s1 * (1.f / D_) + EPS_);
        u32x2* o0 = (u32x2*)(out + (size_t)m * D_) + lane; u32x2* o1 = o0 + D_ / 4;
#pragma unroll
        for (int j = 0; j < 4; ++j) { const f32x4 wv = ((const f32x4*)w)[lane + 64 * j];
            u32x2 a, b; a.x = pk2(v0[j].x * r0 * wv.x, v0[j].y * r0 * wv.y); a.y = pk2(v0[j].z * r0 * wv.z, v0[j].w * r0 * wv.w);
            b.x = pk2(v1[j].x * r1 * wv.x, v1[j].y * r1 * wv.y); b.y = pk2(v1[j].z * r1 * wv.z, v1[j].w * r1 * wv.w);
            o0[64 * j] = a; o1[64 * j] = b; }
    }
}
template <bool TO_F32> DI void rms_rows_from_bf16(const bf16* x, const float* w, bf16* outb, float* outf, int nrows, int gw, int NGW, int lane) {
    f32x4 wv[4];
#pragma unroll
    for (int j = 0; j < 4; ++j) wv[j] = ((const f32x4*)(w + lane * 16))[j];
    for (int m = 2 * gw; m < nrows; m += 2 * NGW) {
        u32x4 ra[2], rb[2];
#pragma unroll
        for (int u = 0; u < 2; ++u) { const u32x4* p = (const u32x4*)(x + (size_t)(m + u) * D_ + lane * 16); ra[u] = p[0]; rb[u] = p[1]; }
#pragma unroll
        for (int u = 0; u < 2; ++u) {
            float v[16];
            v[0] = bflo(ra[u].x); v[1] = bfhi(ra[u].x); v[2] = bflo(ra[u].y); v[3] = bfhi(ra[u].y); v[4] = bflo(ra[u].z); v[5] = bfhi(ra[u].z); v[6] = bflo(ra[u].w); v[7] = bfhi(ra[u].w);
            v[8] = bflo(rb[u].x); v[9] = bfhi(rb[u].x); v[10] = bflo(rb[u].y); v[11] = bfhi(rb[u].y); v[12] = bflo(rb[u].z); v[13] = bfhi(rb[u].z); v[14] = bflo(rb[u].w); v[15] = bfhi(rb[u].w);
            float s = 0.f;
#pragma unroll
            for (int i = 0; i < 16; ++i) s += v[i] * v[i];
            const float r = rsqrtf(wave_sum(s) * (1.f / D_) + EPS_);
#pragma unroll
            for (int i = 0; i < 16; ++i) v[i] = v[i] * r * wv[i >> 2][i & 3];
            if (TO_F32) { f32x4* o = (f32x4*)(outf + (size_t)(m + u) * D_ + lane * 16);
#pragma unroll
                for (int j = 0; j < 4; ++j) o[j] = (f32x4){v[4 * j], v[4 * j + 1], v[4 * j + 2], v[4 * j + 3]}; }
            else { u32x4 a, b; a.x = pk2(v[0], v[1]); a.y = pk2(v[2], v[3]); a.z = pk2(v[4], v[5]); a.w = pk2(v[6], v[7]); b.x = pk2(v[8], v[9]); b.y = pk2(v[10], v[11]); b.z = pk2(v[12], v[13]); b.w = pk2(v[14], v[15]);
                u32x4* o = (u32x4*)(outb + (size_t)(m + u) * D_ + lane * 16); o[0] = a; o[1] = b; }
        }
    }
}
DI void xb_rows(const float* x, bf16* out, float* ssq, int nrows, int gw, int NGW, int lane) {
    for (int m = gw; m < nrows; m += NGW) {
        const f32x4* xr = (const f32x4*)(x + (size_t)m * D_) + lane;
        f32x4 v[4]; float s = 0.f;
#pragma unroll
        for (int j = 0; j < 4; ++j) { v[j] = xr[64 * j]; s += (v[j].x * v[j].x + v[j].y * v[j].y) + (v[j].z * v[j].z + v[j].w * v[j].w); }
        s = wave_sum(s);
        u32x2* o8 = (u32x2*)(out + (size_t)m * D_) + lane;
#pragma unroll
        for (int j = 0; j < 4; ++j) { u32x2 o; o.x = pk2(v[j].x, v[j].y); o.y = pk2(v[j].z, v[j].w); o8[64 * j] = o; }
        if (lane < 16) ssq[(size_t)m * 16 + lane] = (lane == 0) ? s : 0.f;
    }
}
DI void rms_rows_f32_inplace(float* x, const float* w, int nrows, int gw, int NGW, int lane) {
    for (int m = gw; m < nrows; m += NGW) {
        f32x4* xr = (f32x4*)(x + (size_t)m * D_) + lane;
        f32x4 v[4]; float s = 0.f;
#pragma unroll
        for (int j = 0; j < 4; ++j) { v[j] = xr[64 * j]; s += (v[j].x * v[j].x + v[j].y * v[j].y) + (v[j].z * v[j].z + v[j].w * v[j].w); }
        const float rstd = rsqrtf(wave_sum(s) * (1.f / D_) + EPS_);
#pragma unroll
        for (int j = 0; j < 4; ++j) { const f32x4 wv = ((const f32x4*)w)[lane + 64 * j]; xr[64 * j] = v[j] * rstd * wv; }
    }
}

DI int map_plain(int d, int off) { return d + off; }
DI int map_win(int d) { if (d < 2304) return d; if (d < 3328) return d + 16; if (d < 4352) return d + 1056; if (d < 4368) return d - 4352 + 2304; if (d < 4384) return d; return -1; }
DI void conv_item(const float* W, int ldn, int K, bf16* WT, int nrows, int mode, int off, LAS float* scr, int item, int lane, const float* kscale = nullptr) {
    const int nblk = nrows / 32, kb = item / nblk, nb = item % nblk, k0 = 64 * kb, n0 = 32 * nb;
    const int d = n0 + (lane & 31); const int sc = mode ? map_win(d) : map_plain(d, off);
#pragma unroll 8
    for (int i = 0; i < 32; ++i) { const int kk = 2 * i + (lane >> 5); scr[kk * 33 + (lane & 31)] = sc >= 0 ? W[(size_t)(k0 + kk) * ldn + sc] : 0.f; }
    LDS_FENCE();
    const int c = lane & 7;
    f32x4 ka = (f32x4){1.f, 1.f, 1.f, 1.f}, kb2 = ka;
    if (kscale) { ka = *(const f32x4*)(kscale + k0 + 8 * c); kb2 = *(const f32x4*)(kscale + k0 + 8 * c + 4); }
#pragma unroll
    for (int j = 0; j < 4; ++j) { const int n = (lane >> 3) + 8 * j; const LAS float* s = scr + (8 * c) * 33 + n;
        u32x4 o; o.x = pk2(s[0 * 33] * ka[0], s[1 * 33] * ka[1]); o.y = pk2(s[2 * 33] * ka[2], s[3 * 33] * ka[3]); o.z = pk2(s[4 * 33] * kb2[0], s[5 * 33] * kb2[1]); o.w = pk2(s[6 * 33] * kb2[2], s[7 * 33] * kb2[3]);
        *(u32x4*)(WT + (size_t)(n0 + n) * K + k0 + 8 * c) = o; }
    LDS_FENCE();
}

DI void prep_unit(int unit, bf16* PROJ, float* SMALL, bf16* KT, float* DG, bf16* TAIL, const float* gla_w2, const float* gla_b, const float* dt_bias, const float* a_log,
                  const float* conv_w, const float* conv_b, ldsp lds, int tid) {
    asm volatile("" : "+v"(tid));
    const int rowbase = unit * 128;
    LAS float* sm = (LAS float*)lds; LAS float* dtL = (LAS float*)(lds + 16384);
    for (int i = tid; i < 128 * 32 / 4; i += 512) ((LAS f32x4*)sm)[i] = ((const f32x4*)(SMALL + (size_t)rowbase * 32))[i];
    __syncthreads();
    if (tid < 16) {
        const int h = tid; const float a = -__expf(a_log[h]), bias = dt_bias[h]; float cum = 0.f;
        for (int tt = 0; tt < 128; ++tt) { const float dtv = softplusf(sm[tt * 32 + h] + bias); cum += dtv * a; dtL[tt * 16 + h] = dtv;
            SMALL[((size_t)rowbase + tt) * 32 + h] = dtv; SMALL[((size_t)rowbase + tt) * 32 + 16 + h] = cum; }
    }
    {   const int col = tid;
        float w2c[16];
#pragma unroll
        for (int r = 0; r < 16; ++r) w2c[r] = gla_w2[r * 512 + col];
        const float bcol = gla_b[col];
        for (int sub = 0; sub < 2; ++sub) {
            float cum = 0.f;
#pragma unroll 1
            for (int g8 = 0; g8 < 8; ++g8) {
                unsigned qk[8];
                { const bf16* pq = PROJ + ((size_t)rowbase + sub * 64 + g8 * 8) * PROJ_LD + col;
#pragma unroll
                  for (int e = 0; e < 8; ++e) qk[e] = (unsigned)pq[(size_t)e * PROJ_LD + PC_Q] | ((unsigned)pq[(size_t)e * PROJ_LD + PC_K] << 16); }
                float kt[8];
#pragma unroll
                for (int e = 0; e < 8; ++e) {
                    const int tt = sub * 64 + g8 * 8 + e; const size_t row = (size_t)rowbase + tt;
                    float x = bcol;
#pragma unroll
                    for (int r = 0; r < 16; ++r) x += sm[tt * 32 + 16 + r] * w2c[r];
                    const float lg = (fminf(x, 0.f) - __logf(1.f + __expf(-fabsf(x)))) * 0.0625f;
                    cum += lg;
                    const float qv = bflo(qk[e]), kv = bfhi(qk[e]);
                    PROJ[row * PROJ_LD + PC_Q + col] = (bf16)f2bf(qv * __expf(cum) * 0.08838834764831845f);
                    kt[e] = kv * __expf(-cum);
                    PROJ[row * PROJ_LD + PC_K + col] = (bf16)f2bf(kt[e]);
                }
                u32x4 o; o.x = pk2(kt[0], kt[1]); o.y = pk2(kt[2], kt[3]); o.z = pk2(kt[4], kt[5]); o.w = pk2(kt[6], kt[7]);
                *(u32x4*)(KT + (size_t)col * KT_LD + rowbase + sub * 64 + g8 * 8) = o;
            }
            DG[(size_t)((rowbase >> 6) + sub) * 512 + col] = __expf(cum);
        }
    }
    const int tin = rowbase & (L_ - 1);
    __syncthreads();
#pragma unroll 1
    for (int i = 4; i >= 0; --i) { const int it = tid + 512 * i, pair = it % 640, slab = it / 640, c0 = 2 * pair;
        unsigned rw[35];
        bf16* base = PROJ + ((size_t)rowbase + 32 * slab) * PROJ_LD + PC_XBC + c0;
#pragma unroll
        for (int j = 0; j < 35; ++j) rw[j] = (tin + 32 * slab - 3 + j >= 0) ? *(const unsigned*)(base + (ptrdiff_t)(j - 3) * PROJ_LD) : 0u;
        float cw0[4], cw1[4];
#pragma unroll
        for (int j = 0; j < 4; ++j) { cw0[j] = conv_w[j * 1280 + c0]; cw1[j] = conv_w[j * 1280 + c0 + 1]; }
        const float cb0 = conv_b[c0], cb1 = conv_b[c0 + 1];
        const bool isx = c0 < 1024; const int hh = (c0 >> 6) & 15;
        __syncthreads();
#pragma unroll
        for (int r = 0; r < 32; ++r) { float a0 = cb0, a1 = cb1;
#pragma unroll
            for (int j = 0; j < 4; ++j) { a0 += cw0[j] * bflo(rw[r + j]); a1 += cw1[j] * bfhi(rw[r + j]); }
            a0 = siluf(a0); a1 = siluf(a1);
            const int row = 32 * slab + r;
            if (isx) { const float d = dtL[row * 16 + hh]; a0 *= d; a1 *= d; }
            bf16* dst = (row >= 125) ? TAIL + ((size_t)unit * 3 + (row - 125)) * 1280 + c0 : base + (size_t)r * PROJ_LD;
            *(unsigned*)dst = pk2(a0, a1); }
    }
    __syncthreads();
}

#define BAR_LDS() asm volatile("s_waitcnt lgkmcnt(0)\n\ts_barrier" ::: "memory")
DI void ssd_chain(int b, int h, bf16* PROJ, const float* SMALL, const bf16* TAIL, const float* d_skip, ldsp lds, int tid) {
    constexpr int CS = 0, BS = 18432, BWT = 36864, XDT = 54272, MS = 71680, SS = 106496, CUML = 115712, DTL = 116224;
    asm volatile("" : "+v"(tid));
    const int lane = tid & 63, w = __builtin_amdgcn_readfirstlane(tid >> 6), quad = lane >> 4, l16 = lane & 15;
    const int g = h >> 3, cp = lane & 31, th = lane >> 5, tb = 16 * w + 8 * th;
    LAS float* cumL = (LAS float*)(lds + CUML); LAS float* dtL = (LAS float*)(lds + DTL);
    int ch[3]; ch[0] = h * 64 + 2 * cp; ch[1] = 1024 + g * 64 + 2 * cp; ch[2] = 1152 + g * 64 + 2 * cp;
    const float Dh = d_skip[h];
    const int pi = w >> 1, q = 16 * w + l16;
    f32x4 S[2]; S[0] = (f32x4){0.f, 0.f, 0.f, 0.f}; S[1] = S[0];
    unsigned raw[3][8]; float cmv[8], cum_last, cl_t = 0.f, dt_t = 0.f; u32x2 zz[4];
#define SSD_LOAD(c_) do { const size_t r0_ = (size_t)b * L_ + (size_t)(c_) * 128; \
        _Pragma("unroll") for (int i = 0; i < 8; ++i) cmv[i] = SMALL[(r0_ + tb + i) * 32 + 16 + h]; \
        cum_last = SMALL[(r0_ + 127) * 32 + 16 + h]; \
        if (tid < 128) { cl_t = SMALL[(r0_ + tid) * 32 + 16 + h]; dt_t = SMALL[(r0_ + tid) * 32 + h]; } \
        _Pragma("unroll") for (int arr = 0; arr < 3; ++arr) _Pragma("unroll") for (int i = 0; i < 8; ++i) { const int rr = tb + i; \
            const bf16* sp = (rr >= 125) ? TAIL + ((r0_ >> 7) * 3 + (rr - 125)) * 1280 + ch[arr] : PROJ + (r0_ + rr) * PROJ_LD + PC_XBC + ch[arr]; \
            raw[arr][i] = *(const unsigned*)sp; } \
        _Pragma("unroll") for (int pt = 0; pt < 4; ++pt) zz[pt] = *(const u32x2*)(PROJ + (r0_ + q) * PROJ_LD + PC_Z + h * 64 + 16 * pt + quad * 4); } while (0)
    SSD_LOAD(0);
    for (int c = 0; c < 128; ++c) {
        const size_t row0 = (size_t)b * L_ + (size_t)c * 128;
        if (tid < 128) { cumL[tid] = cl_t; dtL[tid] = dt_t; }
        {
            u32x4 v0, v1;
            v0.x = __builtin_amdgcn_perm(raw[0][1], raw[0][0], 0x05040100u); v0.y = __builtin_amdgcn_perm(raw[0][3], raw[0][2], 0x05040100u);
            v0.z = __builtin_amdgcn_perm(raw[0][5], raw[0][4], 0x05040100u); v0.w = __builtin_amdgcn_perm(raw[0][7], raw[0][6], 0x05040100u);
            v1.x = __builtin_amdgcn_perm(raw[0][1], raw[0][0], 0x07060302u); v1.y = __builtin_amdgcn_perm(raw[0][3], raw[0][2], 0x07060302u);
            v1.z = __builtin_amdgcn_perm(raw[0][5], raw[0][4], 0x07060302u); v1.w = __builtin_amdgcn_perm(raw[0][7], raw[0][6], 0x07060302u);
            *(LAS u32x4*)(lds + XDT + (2 * cp) * 272 + tb * 2) = v0; *(LAS u32x4*)(lds + XDT + (2 * cp + 1) * 272 + tb * 2) = v1;
        }
        {
            float o0[8], o1[8];
#pragma unroll
            for (int i = 0; i < 8; ++i) { *(LAS unsigned*)(lds + BS + (tb + i) * 144 + 4 * cp) = raw[1][i];
                const float wg = __expf(cum_last - cmv[i]); o0[i] = bflo(raw[1][i]) * wg; o1[i] = bfhi(raw[1][i]) * wg; }
            u32x4 v0, v1; v0.x = pk2(o0[0], o0[1]); v0.y = pk2(o0[2], o0[3]); v0.z = pk2(o0[4], o0[5]); v0.w = pk2(o0[6], o0[7]);
            v1.x = pk2(o1[0], o1[1]); v1.y = pk2(o1[2], o1[3]); v1.z = pk2(o1[4], o1[5]); v1.w = pk2(o1[6], o1[7]);
            *(LAS u32x4*)(lds + BWT + (2 * cp) * 272 + tb * 2) = v0; *(LAS u32x4*)(lds + BWT + (2 * cp + 1) * 272 + tb * 2) = v1;
        }
#pragma unroll
        for (int i = 0; i < 8; ++i) *(LAS unsigned*)(lds + CS + (tb + i) * 144 + 4 * cp) = raw[2][i];
        u32x2 zc[4];
#pragma unroll
        for (int pt = 0; pt < 4; ++pt) zc[pt] = zz[pt];
        if (c + 1 < 128) SSD_LOAD(c + 1);
        BAR_LDS();
        const float cq = cumL[q], dq = dtL[q];
        const int fo = quad * 16;
        {
            bf16x8 cb[2];
#pragma unroll
            for (int k = 0; k < 2; ++k) cb[k] = lds16(lds, CS + q * 144 + 64 * k + fo);
#pragma unroll
            for (int jh = 0; jh < 2; ++jh) {
                bf16x8 ba[4][2];
#pragma unroll
                for (int j4 = 0; j4 < 4; ++j4) if (4 * jh + j4 <= w) {
#pragma unroll
                    for (int k = 0; k < 2; ++k) ba[j4][k] = lds16(lds, BS + (16 * (4 * jh + j4) + l16) * 144 + 64 * k + fo); }
                __builtin_amdgcn_sched_barrier(0);
                f32x4 acc[4];
#pragma unroll
                for (int j4 = 0; j4 < 4; ++j4) { acc[j4] = (f32x4){0.f, 0.f, 0.f, 0.f};
                    if (4 * jh + j4 <= w) { acc[j4] = mfma16(ba[j4][0], cb[0], acc[j4]); acc[j4] = mfma16(ba[j4][1], cb[1], acc[j4]); } }
                __builtin_amdgcn_sched_barrier(0);
#pragma unroll
                for (int j4 = 0; j4 < 4; ++j4) {
                    const int s0 = 16 * (4 * jh + j4) + quad * 4;
                    const f32x4 cs = *(LAS f32x4*)(cumL + s0);
                    float v[4];
#pragma unroll
                    for (int jj = 0; jj < 4; ++jj) { const int s = s0 + jj; float t = (s <= q) ? acc[j4][jj] * __expf(cq - cs[jj]) : 0.f; if (s == q && dq > 0.f) t += Dh / dq; v[jj] = t; }
                    u32x2 o; o.x = pk2(v[0], v[1]); o.y = pk2(v[2], v[3]);
                    *(LAS u32x2*)(lds + MS + q * 272 + s0 * 2) = o;
                }
            }
        }
#pragma unroll
        for (int i = 0; i < 2; ++i) { const int ni = (w & 1) * 2 + i; u32x2 o; o.x = pk2(S[i][0], S[i][1]); o.y = pk2(S[i][2], S[i][3]);
            *(LAS u32x2*)(lds + SS + (16 * pi + l16) * 144 + (16 * ni + quad * 4) * 2) = o; }
        const float el = __expf(cumL[127]);
        BAR_LDS();
        const float eq = __expf(cq);
        {
            bf16x8 mb[4], cb[2];
#pragma unroll
            for (int ks = 0; ks < 4; ++ks) mb[ks] = lds16(lds, MS + q * 272 + 64 * ks + fo);
#pragma unroll
            for (int k = 0; k < 2; ++k) cb[k] = lds16(lds, CS + q * 144 + 64 * k + fo);
#pragma unroll
            for (int pt = 0; pt < 4; ++pt) {
                bf16x8 xa[4], sa[2];
#pragma unroll
                for (int ks = 0; ks < 4; ++ks) xa[ks] = lds16(lds, XDT + (16 * pt + l16) * 272 + 64 * ks + fo);
#pragma unroll
                for (int k = 0; k < 2; ++k) sa[k] = lds16(lds, SS + (16 * pt + l16) * 144 + 64 * k + fo);
                __builtin_amdgcn_sched_barrier(0);
                f32x4 y1 = (f32x4){0.f, 0.f, 0.f, 0.f}, y2 = y1;
#pragma unroll
                for (int ks = 0; ks < 4; ++ks) if (32 * ks < 16 * w + 16) y1 = mfma16(xa[ks], mb[ks], y1);
#pragma unroll
                for (int k = 0; k < 2; ++k) y2 = mfma16(sa[k], cb[k], y2);
                __builtin_amdgcn_sched_barrier(0);
                bf16* zp = PROJ + (row0 + q) * PROJ_LD + PC_Z + h * 64 + 16 * pt + quad * 4;
                const float z0 = bflo(zc[pt].x), z1 = bfhi(zc[pt].x), z2 = bflo(zc[pt].y), z3 = bfhi(zc[pt].y);
                u32x2 o; o.x = pk2((y1[0] + eq * y2[0]) * siluf(z0), (y1[1] + eq * y2[1]) * siluf(z1)); o.y = pk2((y1[2] + eq * y2[2]) * siluf(z2), (y1[3] + eq * y2[3]) * siluf(z3));
                *(u32x2*)zp = o;
            }
        }
        {
            bf16x8 xb[4], wa[2][4];
#pragma unroll
            for (int ks = 0; ks < 4; ++ks) xb[ks] = lds16(lds, XDT + (16 * pi + l16) * 272 + 64 * ks + fo);
#pragma unroll
            for (int i = 0; i < 2; ++i)
#pragma unroll
                for (int ks = 0; ks < 4; ++ks) wa[i][ks] = lds16(lds, BWT + (16 * ((w & 1) * 2 + i) + l16) * 272 + 64 * ks + fo);
            __builtin_amdgcn_sched_barrier(0);
            S[0] = S[0] * el; S[1] = S[1] * el;
#pragma unroll
            for (int ks = 0; ks < 4; ++ks) { S[0] = mfma16(wa[0][ks], xb[ks], S[0]); S[1] = mfma16(wa[1][ks], xb[ks], S[1]); }
        }
        BAR_LDS();
    }
#undef SSD_LOAD
}

DI void gla_chain(int b, int h, int vs, const bf16* PROJ, const bf16* KT, const bf16* VT, const float* DG, bf16* ORAW, ldsp lds, int tid) {
    constexpr int QS = 0, KS = 17408, KTS = 34816, VTS = 53248, PS = 62464, STS = 71680, DLO = 89088;
    asm volatile("" : "+v"(tid));
    const int lane = tid & 63, w = __builtin_amdgcn_readfirstlane(tid >> 6), quad = lane >> 4, l16 = lane & 15, qi = w >> 1;
    LAS float* dL = (LAS float*)(lds + DLO);
    f32x4 S[4];
#pragma unroll
    for (int i = 0; i < 4; ++i) S[i] = (f32x4){0.f, 0.f, 0.f, 0.f};
    u32x4 Aq[2], Ak[2], Akt[2], Av, Bq[2], Bk[2], Bkt[2], Bv; float Ad = 0.f, Bd = 0.f;
#define GLA_LOAD(c_, P) do { const size_t r0_ = (size_t)b * L_ + (size_t)(c_) * 64; \
        _Pragma("unroll") for (int i = 0; i < 2; ++i) { const int idx = tid + 512 * i, r = idx >> 4, cc = idx & 15; \
            P##q[i] = *(const u32x4*)(PROJ + (r0_ + r) * PROJ_LD + PC_Q + h * 128 + cc * 8); P##k[i] = *(const u32x4*)(PROJ + (r0_ + r) * PROJ_LD + PC_K + h * 128 + cc * 8); } \
        _Pragma("unroll") for (int i = 0; i < 2; ++i) { const int idx = tid + 512 * i, r = idx >> 3, cc = idx & 7; P##kt[i] = *(const u32x4*)(KT + (size_t)(h * 128 + r) * KT_LD + r0_ + cc * 8); } \
        { const int r = tid >> 3, cc = tid & 7; P##v = *(const u32x4*)(VT + (size_t)(h * 256 + vs * 64 + r) * VT_LD + r0_ + cc * 8); } \
        if (tid < 128) P##d = DG[(r0_ >> 6) * 512 + h * 128 + tid]; } while (0)
#define GLA_PUT(P) do { \
        _Pragma("unroll") for (int i = 0; i < 2; ++i) { const int idx = tid + 512 * i, r = idx >> 4, cc = idx & 15; \
            *(LAS u32x4*)(lds + QS + r * 272 + cc * 16) = P##q[i]; *(LAS u32x4*)(lds + KS + r * 272 + cc * 16) = P##k[i]; } \
        _Pragma("unroll") for (int i = 0; i < 2; ++i) { const int idx = tid + 512 * i, r = idx >> 3, cc = idx & 7; *(LAS u32x4*)(lds + KTS + r * 144 + cc * 16) = P##kt[i]; } \
        { const int r = tid >> 3, cc = tid & 7; *(LAS u32x4*)(lds + VTS + r * 144 + cc * 16) = P##v; } \
        if (tid < 128) dL[tid] = P##d; } while (0)
#define GLA_COMPUTE(c_) do { \
        const size_t row0 = (size_t)b * L_ + (size_t)(c_) * 64; \
        BAR_LDS(); \
        const int q = 16 * qi + l16; \
        const int fo = quad * 16; \
        { \
            bf16x8 fb[4], fa[2][4]; \
_Pragma("unroll") \
            for (int ks = 0; ks < 4; ++ks) fb[ks] = lds16(lds, QS + q * 272 + 64 * ks + fo); \
_Pragma("unroll") \
            for (int i = 0; i < 2; ++i) \
_Pragma("unroll") \
                for (int ks = 0; ks < 4; ++ks) fa[i][ks] = lds16(lds, KS + (16 * ((w & 1) * 2 + i) + l16) * 272 + 64 * ks + fo); \
            __builtin_amdgcn_sched_barrier(0); \
            f32x4 acc[2]; acc[0] = (f32x4){0.f, 0.f, 0.f, 0.f}; acc[1] = acc[0]; \
_Pragma("unroll") \
            for (int ks = 0; ks < 4; ++ks) { acc[0] = mfma16(fa[0][ks], fb[ks], acc[0]); acc[1] = mfma16(fa[1][ks], fb[ks], acc[1]); } \
            __builtin_amdgcn_sched_barrier(0); \
_Pragma("unroll") \
            for (int i = 0; i < 2; ++i) { const int s0 = 16 * ((w & 1) * 2 + i) + quad * 4; \
                u32x2 o; o.x = pk2(s0 <= q ? acc[i][0] : 0.f, s0 + 1 <= q ? acc[i][1] : 0.f); o.y = pk2(s0 + 2 <= q ? acc[i][2] : 0.f, s0 + 3 <= q ? acc[i][3] : 0.f); \
                *(LAS u32x2*)(lds + PS + q * 144 + s0 * 2) = o; } \
        } \
_Pragma("unroll") \
        for (int vt = 0; vt < 4; ++vt) { u32x2 o; o.x = pk2(S[vt][0], S[vt][1]); o.y = pk2(S[vt][2], S[vt][3]); \
            *(LAS u32x2*)(lds + STS + (16 * vt + l16) * 272 + (16 * w + quad * 4) * 2) = o; } \
        BAR_LDS(); \
        { \
            bf16x8 pb[2], qb4[4], va[2][2], sa[2][4], ka[2], vb[4][2]; \
_Pragma("unroll") \
            for (int ks = 0; ks < 2; ++ks) pb[ks] = lds16(lds, PS + q * 144 + 64 * ks + fo); \
_Pragma("unroll") \
            for (int ks = 0; ks < 4; ++ks) qb4[ks] = lds16(lds, QS + q * 272 + 64 * ks + fo); \
_Pragma("unroll") \
            for (int i = 0; i < 2; ++i) { const int vt = (w & 1) * 2 + i; \
_Pragma("unroll") \
                for (int ks = 0; ks < 2; ++ks) va[i][ks] = lds16(lds, VTS + (16 * vt + l16) * 144 + 64 * ks + fo); \
_Pragma("unroll") \
                for (int ks = 0; ks < 4; ++ks) sa[i][ks] = lds16(lds, STS + (16 * vt + l16) * 272 + 64 * ks + fo); } \
_Pragma("unroll") \
            for (int ks = 0; ks < 2; ++ks) ka[ks] = lds16(lds, KTS + (16 * w + l16) * 144 + 64 * ks + fo); \
_Pragma("unroll") \
            for (int vt = 0; vt < 4; ++vt) \
_Pragma("unroll") \
                for (int ks = 0; ks < 2; ++ks) vb[vt][ks] = lds16(lds, VTS + (16 * vt + l16) * 144 + 64 * ks + fo); \
            const f32x4 dv = *(LAS f32x4*)(dL + 16 * w + quad * 4); \
            __builtin_amdgcn_sched_barrier(0); \
            f32x4 o[2]; o[0] = (f32x4){0.f, 0.f, 0.f, 0.f}; o[1] = o[0]; \
_Pragma("unroll") \
            for (int ks = 0; ks < 2; ++ks) { o[0] = mfma16(va[0][ks], pb[ks], o[0]); o[1] = mfma16(va[1][ks], pb[ks], o[1]); } \
_Pragma("unroll") \
            for (int ks = 0; ks < 4; ++ks) { o[0] = mfma16(sa[0][ks], qb4[ks], o[0]); o[1] = mfma16(sa[1][ks], qb4[ks], o[1]); } \
_Pragma("unroll") \
            for (int ks = 0; ks < 2; ++ks) \
_Pragma("unroll") \
                for (int vt = 0; vt < 4; ++vt) S[vt] = mfma16(ka[ks], vb[vt][ks], S[vt]); \
            __builtin_amdgcn_sched_barrier(0); \
_Pragma("unroll") \
            for (int i = 0; i < 2; ++i) { const int vt = (w & 1) * 2 + i; u32x2 ov; ov.x = pk2(o[i][0], o[i][1]); ov.y = pk2(o[i][2], o[i][3]); \
                *(u32x2*)(ORAW + (row0 + q) * 2048 + 1024 + h * 256 + vs * 64 + 16 * vt + quad * 4) = ov; } \
_Pragma("unroll") \
            for (int vt = 0; vt < 4; ++vt) S[vt] = S[vt] * dv; \
        } \
        BAR_LDS(); \
    } while (0)
    GLA_LOAD(0, A); GLA_LOAD(1, B);
    for (int c = 0; c < 256; c += 2) {
        GLA_PUT(A); if (c + 2 < 256) GLA_LOAD(c + 2, A); GLA_COMPUTE(c);
        GLA_PUT(B); if (c + 3 < 256) GLA_LOAD(c + 3, B); GLA_COMPUTE(c + 1);
    }
#undef GLA_PUT
#undef GLA_COMPUTE
#undef GLA_LOAD
}

#define UNPACK16(a, b, v) do { v[0] = bflo(a.x); v[1] = bfhi(a.x); v[2] = bflo(a.y); v[3] = bfhi(a.y); v[4] = bflo(a.z); v[5] = bfhi(a.z); v[6] = bflo(a.w); v[7] = bfhi(a.w); \
    v[8] = bflo(b.x); v[9] = bfhi(b.x); v[10] = bflo(b.y); v[11] = bfhi(b.y); v[12] = bflo(b.z); v[13] = bfhi(b.z); v[14] = bflo(b.w); v[15] = bfhi(b.w); } while (0)
DI void gate_rows(bf16* PROJ, bf16* ORAW, const float* ssd_norm, const float* gla_norm, int gw, int NGW, int lane) {
    for (int t0 = 2 * gw; t0 < T_; t0 += 2 * NGW) {
        u32x4 ya[2], yb[2], oa[2], ob[2], ra[2], rb[2];
#pragma unroll
        for (int u = 0; u < 2; ++u) { const size_t t = (size_t)t0 + u;
            const bf16* yp = PROJ + t * PROJ_LD + PC_Z + lane * 16; const bf16* op = ORAW + t * 2048 + 1024 + lane * 16; const bf16* rp = PROJ + t * PROJ_LD + PC_R + lane * 16;
            ya[u] = *(const u32x4*)yp; yb[u] = *(const u32x4*)(yp + 8); oa[u] = *(const u32x4*)op; ob[u] = *(const u32x4*)(op + 8); ra[u] = *(const u32x4*)rp; rb[u] = *(const u32x4*)(rp + 8); }
#pragma unroll
        for (int u = 0; u < 2; ++u) { const size_t t = (size_t)t0 + u;
            {   float v[16]; UNPACK16(ya[u], yb[u], v);
                float s = 0.f;
#pragma unroll
                for (int i = 0; i < 16; ++i) s += v[i] * v[i];
#pragma unroll
                for (int o = 1; o < 32; o <<= 1) s += __shfl_xor(s, o);
                const float rstd = rsqrtf(s * (1.f / 512.f) + EPS_);
                const float* nw = ssd_norm + lane * 16;
#pragma unroll
                for (int i = 0; i < 16; ++i) v[i] = v[i] * rstd * nw[i];
                u32x4 a, b; a.x = pk2(v[0], v[1]); a.y = pk2(v[2], v[3]); a.z = pk2(v[4], v[5]); a.w = pk2(v[6], v[7]); b.x = pk2(v[8], v[9]); b.y = pk2(v[10], v[11]); b.z = pk2(v[12], v[13]); b.w = pk2(v[14], v[15]);
                bf16* yp = ORAW + t * 2048 + lane * 16; *(u32x4*)yp = a; *(u32x4*)(yp + 8) = b; }
            {   float v[16], r[16]; UNPACK16(oa[u], ob[u], v); UNPACK16(ra[u], rb[u], r);
                float s = 0.f;
#pragma unroll
                for (int i = 0; i < 16; ++i) s += v[i] * v[i];
#pragma unroll
                for (int o = 1; o < 16; o <<= 1) s += __shfl_xor(s, o);
                const float rstd = rsqrtf(s * (1.f / 256.f) + EPS_);
                const float* nw = gla_norm + (lane & 15) * 16;
#pragma unroll
                for (int i = 0; i < 16; ++i) v[i] = v[i] * rstd * nw[i] * siluf(r[i]);
                u32x4 a, b; a.x = pk2(v[0], v[1]); a.y = pk2(v[2], v[3]); a.z = pk2(v[4], v[5]); a.w = pk2(v[6], v[7]); b.x = pk2(v[8], v[9]); b.y = pk2(v[10], v[11]); b.z = pk2(v[12], v[13]); b.w = pk2(v[14], v[15]);
                bf16* op = ORAW + t * 2048 + 1024 + lane * 16; *(u32x4*)op = a; *(u32x4*)(op + 8) = b; }
        }
    }
}

DI void attn_unit(int b, int ph, int qb, const bf16* QK, const bf16* VT, bf16* OATT, const float* NORMS, ldsp lds, int tid) {
    asm volatile("" : "+v"(tid));
    constexpr int KBUF = 9216, VBUF = 18432, KOFF = 0, VOFF = 2 * KBUF, WSOFF = 2 * KBUF + 2 * VBUF;
    const int lane = tid & 63, w = tid >> 6, r32 = lane & 31, hi = lane >> 5;
    const int q0 = qb * 256, head = ph >> 1;
    const size_t rowb = (size_t)b * L_;
    const float cs = exp2f(-(float)(head + 1)) * 1.4426950408889634f;
    LAS float* wsf = (LAS float*)(lds + WSOFF) + w * 64;
    bf16x8 qf[4];
    { const bf16* qp = QK + (rowb + q0 + 32 * w + r32) * QK_LD + ph * 64 + 8 * hi;
#pragma unroll
      for (int ks = 0; ks < 4; ++ks) qf[ks] = *(const bf16x8*)(qp + 16 * ks); }
    asm volatile("s_waitcnt vmcnt(0)" : "+v"(qf[0]), "+v"(qf[1]), "+v"(qf[2]), "+v"(qf[3]) :: "memory");
    const int qpos = q0 + 32 * w + r32;
    const int rsw = ((r32 >> 3) & 1) * 8;
    f32x16 o[4];
#pragma unroll
    for (int d = 0; d < 4; ++d)
#pragma unroll
        for (int r = 0; r < 16; ++r) o[d][r] = 0.f;
    float l_run = 0.f;
    const float Bq = sqrtf(NORMS[b * 32 + ph] * NORMS[b * 32 + 16 + ph]);
    const float Wn = (150.f + 2.f * Bq) / cs;
    const float sk = ((float)(q0 - 63) - Wn) * (1.f / 64.f);
    int t_begin = (sk >= 0.f) ? (int)floorf(sk) + 1 : 0;
    t_begin = __builtin_amdgcn_readfirstlane(t_begin);
    const int t_end = (q0 + 256) / 64;
    float m_run = cs * (float)(64 * t_begin - q0);
    const int klane = r32 * 144 + 16 * hi, vlane = r32 * 144 + 16 * hi;
    const float cs_h = bf2f(pk2(cs, 0.f) & 0xffffu);
    const unsigned csw = (hi == 0) ? pk2(cs_h, cs - cs_h) : 0u;
    bf16x8 kext0, kext1;
    { u32x4 e0, e1; e0.x = (hi == 0) ? pk2((float)r32, (float)r32) : 0u; e0.y = (hi == 0) ? pk2(1.f, 1.f) : 0u; e0.z = 0u; e0.w = 0u;
      e1 = e0; e1.x = (hi == 0) ? pk2((float)(r32 + 32), (float)(r32 + 32)) : 0u; kext0 = __builtin_bit_cast(bf16x8, e0); kext1 = __builtin_bit_cast(bf16x8, e1); }
    const int kr = tid >> 3, kc = tid & 7;
    const bf16* ksrc = QK + (rowb + kr) * QK_LD + 1024 + ph * 64 + kc * 8;
    const bf16* vsrc0 = VT + (size_t)(head * 128 + kr) * VT_LD + rowb + kc * 8;
    const bf16* vsrc1 = VT + (size_t)(head * 128 + 64 + kr) * VT_LD + rowb + kc * 8;
    const int kdst = KOFF + kr * 144 + kc * 16, vdst0 = VOFF + kr * 144 + kc * 16, vdst1 = VOFF + (64 + kr) * 144 + kc * 16;
    u32x4 pk_, pv0, pv1;
    pk_ = *(const u32x4*)(ksrc + (size_t)t_begin * 64 * QK_LD); pv0 = *(const u32x4*)(vsrc0 + t_begin * 64); pv1 = *(const u32x4*)(vsrc1 + t_begin * 64);
    const int vp0 = (16 * (kc >> 1) + 4 * (kc & 1)) * 2, vp1 = vp0 + 16;
#define VSWZ(v) (v)
    __syncthreads();
    *(LAS u32x4*)(lds + kdst) = pk_;
    { *(LAS u32x2*)(lds + VOFF + kr * 144 + vp0) = (u32x2){pv0.x, pv0.y}; *(LAS u32x2*)(lds + VOFF + kr * 144 + vp1) = (u32x2){pv0.z, pv0.w};
      *(LAS u32x2*)(lds + VOFF + (64 + kr) * 144 + vp0) = (u32x2){pv1.x, pv1.y}; *(LAS u32x2*)(lds + VOFF + (64 + kr) * 144 + vp1) = (u32x2){pv1.z, pv1.w}; }
    __syncthreads();
#define ATTN_TILE(t_, buf_) do { \
        const int kbase = 64 * (t_); \
        if (kbase <= q0 + 32 * w + 31) { \
            const int kb = KOFF + (buf_) * KBUF + klane, vb = VOFF + (buf_) * VBUF + vlane; \
              \
            const float nm = cs * (float)(kbase - q0) - m_run; \
            const float nmh = bf2f(pk2(nm, 0.f) & 0xffffu); \
            u32x4 qe; qe.x = csw; qe.y = (hi == 0) ? pk2(nmh, nm - nmh) : 0u; qe.z = 0u; qe.w = 0u; \
            const bf16x8 qef = __builtin_bit_cast(bf16x8, qe); \
            bf16x8 kf0[4], kf1[4]; \
            _Pragma("unroll") \
            for (int ks = 0; ks < 4; ++ks) { kf0[ks] = lds16(lds, kb + 32 * ks); kf1[ks] = lds16(lds, kb + 32 * 144 + 32 * ks); } \
            __builtin_amdgcn_sched_barrier(0); \
            f32x16 s0, s1; \
            _Pragma("unroll") \
            for (int r = 0; r < 16; ++r) { s0[r] = 0.f; s1[r] = 0.f; } \
            s0 = mfma32(kext0, qef, s0); s1 = mfma32(kext1, qef, s1); \
            _Pragma("unroll") \
            for (int ks = 0; ks < 4; ++ks) { s0 = mfma32(kf0[ks], qf[ks], s0); s1 = mfma32(kf1[ks], qf[ks], s1); } \
            __builtin_amdgcn_sched_barrier(0); \
            asm volatile("s_nop 15\n\ts_nop 7" : "+v"(s0), "+v"(s1));     \
            if (kbase + 63 > q0 + 32 * w) { \
                _Pragma("unroll") \
                for (int r = 0; r < 16; ++r) { const int key = kbase + 4 * hi + (r & 3) + 8 * (r >> 2); if (key > qpos) s0[r] = -INFINITY; if (key + 32 > qpos) s1[r] = -INFINITY; } \
            } \
            float mx = s0[0], mx2 = s1[0]; \
            _Pragma("unroll") \
            for (int r = 1; r < 16; r += 2) { mx = max3f(mx, s0[r], s1[r]); if (r + 1 < 16) mx2 = max3f(mx2, s0[r + 1], s1[r + 1]); } \
            mx = max3f(mx, mx2, mx2); \
            mx = fmaxf(mx, __shfl_xor(mx, 32)); \
            if (__any(mx > 8.f)) { \
                const float dl = fmaxf(mx, 0.f); \
                const float alpha = __builtin_amdgcn_exp2f(-dl); \
                l_run *= alpha; m_run += dl; \
                _Pragma("unroll") \
                for (int r = 0; r < 16; ++r) { s0[r] -= dl; s1[r] -= dl; } \
                if (hi == 0) wsf[r32] = alpha; \
                LDS_FENCE(); \
                _Pragma("unroll") \
                for (int r = 0; r < 16; ++r) { const float a = wsf[crow(r, hi)]; \
                    _Pragma("unroll") \
                    for (int d = 0; d < 4; ++d) o[d][r] *= a; } \
            } \
            float rs = 0.f; \
            _Pragma("unroll") \
            for (int r = 0; r < 16; ++r) { s0[r] = __builtin_amdgcn_exp2f(s0[r]); s1[r] = __builtin_amdgcn_exp2f(s1[r]); rs += s0[r] + s1[r]; } \
            rs += __shfl_xor(rs, 32); \
            l_run += rs; \
            bf16x8 pa[2][2]; \
            _Pragma("unroll") \
            for (int s = 0; s < 2; ++s) { \
                u32x4 p0, p1; \
                p0.x = pk2(s0[8 * s + 0], s0[8 * s + 1]); p0.y = pk2(s0[8 * s + 2], s0[8 * s + 3]); p0.z = pk2(s0[8 * s + 4], s0[8 * s + 5]); p0.w = pk2(s0[8 * s + 6], s0[8 * s + 7]); \
                p1.x = pk2(s1[8 * s + 0], s1[8 * s + 1]); p1.y = pk2(s1[8 * s + 2], s1[8 * s + 3]); p1.z = pk2(s1[8 * s + 4], s1[8 * s + 5]); p1.w = pk2(s1[8 * s + 6], s1[8 * s + 7]); \
                pa[0][s] = __builtin_bit_cast(bf16x8, p0); pa[1][s] = __builtin_bit_cast(bf16x8, p1); \
            } \
            _Pragma("unroll") \
            for (int dh = 0; dh < 2; ++dh) { \
                bf16x8 vf[2][2][2]; \
                _Pragma("unroll") \
                for (int d2 = 0; d2 < 2; ++d2) \
                    _Pragma("unroll") \
                    for (int hf = 0; hf < 2; ++hf) \
                        _Pragma("unroll") \
                        for (int s = 0; s < 2; ++s) vf[d2][hf][s] = lds16(lds, vb + 4608 * (2 * dh + d2) + 64 * hf + 32 * s); \
                __builtin_amdgcn_sched_barrier(0); \
                _Pragma("unroll") \
                for (int hf = 0; hf < 2; ++hf) \
                    _Pragma("unroll") \
                    for (int s = 0; s < 2; ++s) \
                        _Pragma("unroll") \
                        for (int d2 = 0; d2 < 2; ++d2) o[2 * dh + d2] = mfma32(pa[hf][s], vf[d2][hf][s], o[2 * dh + d2]); \
                __builtin_amdgcn_sched_barrier(0); \
            } \
        } \
    } while (0)
#define ATTN_LOAD(t_, K_, V0_, V1_) do { K_ = *(const u32x4*)(ksrc + (size_t)(t_) * 64 * QK_LD); V0_ = *(const u32x4*)(vsrc0 + (t_) * 64); V1_ = *(const u32x4*)(vsrc1 + (t_) * 64); } while (0)
#define VT_PUT(off_, V_) do { *(LAS u32x2*)(lds + (off_) + vp0) = (u32x2){(V_).x, (V_).y}; *(LAS u32x2*)(lds + (off_) + vp1) = (u32x2){(V_).z, (V_).w}; } while (0)
#define ATTN_STORE(buf_, K_, V0_, V1_) do { *(LAS u32x4*)(lds + kdst + (buf_) * KBUF) = K_; VT_PUT(VOFF + (buf_) * VBUF + kr * 144, V0_); VT_PUT(VOFF + (buf_) * VBUF + (64 + kr) * 144, V1_); } while (0)
    u32x4 ak = pk_, av0 = pv0, av1 = pv1, bk = pk_, bv0 = pv0, bv1 = pv1;
    if (t_begin + 1 < t_end) ATTN_LOAD(t_begin + 1, ak, av0, av1);
    for (int t = t_begin; t < t_end; t += 2) {
        if (t + 2 < t_end) ATTN_LOAD(t + 2, bk, bv0, bv1);
        ATTN_TILE(t, 0);
        if (t + 1 < t_end) ATTN_STORE(1, ak, av0, av1);
        BAR_LDS();
        if (t + 1 < t_end) {
            if (t + 3 < t_end) ATTN_LOAD(t + 3, ak, av0, av1);
            ATTN_TILE(t + 1, 1);
            if (t + 2 < t_end) ATTN_STORE(0, bk, bv0, bv1);
            BAR_LDS();
        }
    }
#undef ATTN_TILE
#undef ATTN_LOAD
#undef ATTN_STORE
    LDS_FENCE();
    if (hi == 0) wsf[r32] = 1.f / l_run;
    LDS_FENCE();
    bf16* op = OATT + (rowb + q0 + 32 * w) * 2048 + ph * 128 + r32;
#pragma unroll
    for (int r = 0; r < 16; ++r) { const int qr = crow(r, hi); const float rl = wsf[qr];
#pragma unroll
        for (int d = 0; d < 4; ++d) op[(size_t)qr * 2048 + 32 * d] = (bf16)f2bf(o[d][r] * rl); }
#undef VSWZ
}

DI void qk_norms(const bf16* QK, float* NORMS, int gw, int NGW, int lane) {
    for (int b = 0; b < 2; ++b) {
        float mx = 0.f;
        for (int t = gw; t < L_; t += NGW) {
            const u32x4* p = (const u32x4*)(QK + ((size_t)b * L_ + t) * QK_LD + lane * 32);
            float s = 0.f;
#pragma unroll
            for (int i = 0; i < 4; ++i) { const u32x4 v = p[i];
                s += bflo(v.x) * bflo(v.x) + bfhi(v.x) * bfhi(v.x) + bflo(v.y) * bflo(v.y) + bfhi(v.y) * bfhi(v.y) + bflo(v.z) * bflo(v.z) + bfhi(v.z) * bfhi(v.z) + bflo(v.w) * bflo(v.w) + bfhi(v.w) * bfhi(v.w); }
            s += __shfl_xor(s, 1);
            mx = fmaxf(mx, s);
        }
        if (!(lane & 1)) atomicMax((unsigned*)NORMS + b * 32 + (lane >> 1), __float_as_uint(mx));
    }
}

DI void combine_rows(const bf16* OATT, bf16* OUT, const float* lq1, const float* lk1, const float* lq2, const float* lk2, const float* subln, float lam_init, int gw, int NGW, int lane) {
    const float e1 = __expf(wave_sum(lq1[lane] * lk1[lane])), e2 = __expf(wave_sum(lq2[lane] * lk2[lane]));
    const float lam = e1 - e2 + lam_init;
    const int head = lane >> 3, dv0 = (lane & 7) * 16;
    for (int t0 = 2 * gw; t0 < T_; t0 += 2 * NGW) {
        u32x4 A[2], B[2], C[2], Dd[2];
#pragma unroll
        for (int u = 0; u < 2; ++u) { const bf16* p1 = OATT + (size_t)(t0 + u) * 2048 + (2 * head) * 128 + dv0; const bf16* p2 = p1 + 128;
            A[u] = *(const u32x4*)p1; B[u] = *(const u32x4*)(p1 + 8); C[u] = *(const u32x4*)p2; Dd[u] = *(const u32x4*)(p2 + 8); }
#pragma unroll
        for (int u = 0; u < 2; ++u) {
            float v[16], q[16]; UNPACK16(A[u], B[u], v); UNPACK16(C[u], Dd[u], q);
            float s = 0.f;
#pragma unroll
            for (int i = 0; i < 16; ++i) { v[i] = v[i] - lam * q[i]; s += v[i] * v[i]; }
            s += __shfl_xor(s, 1); s += __shfl_xor(s, 2); s += __shfl_xor(s, 4);
            const float sc = rsqrtf(s * (1.f / 128.f) + EPS_) * (1.f - lam_init);
            const float* nw = subln + dv0;
            u32x4 oa, ob;
            oa.x = pk2(v[0] * sc * nw[0], v[1] * sc * nw[1]); oa.y = pk2(v[2] * sc * nw[2], v[3] * sc * nw[3]); oa.z = pk2(v[4] * sc * nw[4], v[5] * sc * nw[5]); oa.w = pk2(v[6] * sc * nw[6], v[7] * sc * nw[7]);
            ob.x = pk2(v[8] * sc * nw[8], v[9] * sc * nw[9]); ob.y = pk2(v[10] * sc * nw[10], v[11] * sc * nw[11]); ob.z = pk2(v[12] * sc * nw[12], v[13] * sc * nw[13]); ob.w = pk2(v[14] * sc * nw[14], v[15] * sc * nw[15]);
            bf16* qo = OUT + (size_t)(t0 + u) * 1024 + head * 128 + dv0;
            *(u32x4*)qo = oa; *(u32x4*)(qo + 8) = ob;
        }
    }
}

DI void softmax_rows256(bf16* S, int nrows, int gw, int NGW, int lane) {
    for (int r0 = gw * 4; r0 < nrows; r0 += NGW * 4) {
        u32x2 a[4];
#pragma unroll
        for (int i = 0; i < 4; ++i) a[i] = *((const u32x2*)(S + (size_t)(r0 + i) * 256) + lane);
#pragma unroll
        for (int i = 0; i < 4; ++i) {
            float v0 = bflo(a[i].x), v1 = bfhi(a[i].x), v2 = bflo(a[i].y), v3 = bfhi(a[i].y);
            const float mx = wave_max(fmaxf(fmaxf(v0, v1), fmaxf(v2, v3)));
            v0 = __expf(v0 - mx); v1 = __expf(v1 - mx); v2 = __expf(v2 - mx); v3 = __expf(v3 - mx);
            const float inv = 1.f / wave_sum((v0 + v1) + (v2 + v3));
            u32x2 o; o.x = pk2(v0 * inv, v1 * inv); o.y = pk2(v2 * inv, v3 * inv);
            *((u32x2*)(S + (size_t)(r0 + i) * 256) + lane) = o;
        }
    }
}

#define GAS __attribute__((address_space(1)))
#define XB_TMO      128
#define XB_XCNT(j)  (256  + 64 * (j))
#define XB_XSUB(j)  (1280 + 64 * (j))
#define XB_XGEN(j)  (2304 + 64 * (j))
#define XB_TOP      3328
#define XB_TOPGEN   3392
#define XCD_BAR_WORDS 3456
#define XB_SPIN_CAP (1u << 18)

__device__ __forceinline__ unsigned xb_ld(unsigned* p)              { return __hip_atomic_load(p, __ATOMIC_RELAXED, __HIP_MEMORY_SCOPE_AGENT); }
__device__ __forceinline__ unsigned xb_add(unsigned* p, unsigned v) { return __hip_atomic_fetch_add(p, v, __ATOMIC_RELAXED, __HIP_MEMORY_SCOPE_AGENT); }
__device__ __forceinline__ unsigned xb_xcc_id() { return (unsigned)__builtin_amdgcn_s_getreg((3 << 11) | 20) & 0xFu; }
#define XB_SPIN(cond, bar) do { unsigned _sp = 0; while (cond) { __builtin_amdgcn_s_sleep(1); \
    if ((++_sp & 255u) == 0u) { if (xb_ld(&(bar)[XB_TMO])) break; if (_sp > XB_SPIN_CAP) { atomicAdd(&(bar)[XB_TMO], 1u); break; } } } } while (0)

struct XcdBarrier {
    unsigned* bar; unsigned x;
    volatile LAS unsigned* st;
};

__device__ __forceinline__ XcdBarrier xcd_barrier_post(unsigned* bar, volatile LAS unsigned* st) {
    XcdBarrier b; b.bar = bar; b.x = xb_xcc_id(); b.st = st;
    if (threadIdx.x == 0) (void)xb_add(&bar[XB_XCNT(b.x)], 1u);
    return b;
}
__device__ __forceinline__ void xcd_barrier_complete(unsigned* bar, unsigned x, unsigned& nloc, unsigned& nx) {
    const unsigned G = gridDim.x * gridDim.y * gridDim.z;
    unsigned sum, cnt, mine, sp = 0u;
    for (;;) {
        sum = 0u; cnt = 0u; mine = 0u;
#pragma unroll
        for (unsigned j = 0; j < 16; ++j) { const unsigned c = xb_ld(&bar[XB_XCNT(j)]); sum += c; cnt += (c > 0u) ? 1u : 0u; mine = (j == x) ? c : mine; }
        if (sum == G) break;
        __builtin_amdgcn_s_sleep(1);
        if ((++sp & 255u) == 0u) { if (xb_ld(&bar[XB_TMO])) break; if (sp > XB_SPIN_CAP) { atomicAdd(&bar[XB_TMO], 1u); break; } }
    }
    nloc = mine > 0u ? mine : 1u; nx = cnt > 0u ? cnt : 1u;
}

__device__ __forceinline__ void xcd_barrier(const XcdBarrier& b) {
    asm volatile("s_waitcnt vmcnt(0)" ::: "memory");
    __syncthreads();
    if (threadIdx.x == 0) {
        unsigned* bar = b.bar;
        __builtin_amdgcn_s_waitcnt(0);
        unsigned nloc = b.st[0], nx = b.st[1];
        if (nloc == 0u) { xcd_barrier_complete(bar, b.x, nloc, nx); b.st[0] = nloc; b.st[1] = nx; }
        const unsigned old = xb_add(&bar[XB_XSUB(b.x)], 1u);
        const unsigned gen = old / nloc;
        if (old + 1u == (gen + 1u) * nloc) {
            __builtin_amdgcn_fence(__ATOMIC_RELEASE, "agent");
            asm volatile("s_waitcnt vmcnt(0)" ::: "memory");
            const unsigned og = xb_add(&bar[XB_TOP], 1u);
            const unsigned tg = og / nx;
            if (og + 1u == (tg + 1u) * nx) xb_add(&bar[XB_TOPGEN], 1u);
            else XB_SPIN(xb_ld(&bar[XB_TOPGEN]) == tg, bar);
            __builtin_amdgcn_fence(__ATOMIC_ACQUIRE, "agent");
            xb_add(&bar[XB_XGEN(b.x)], 1u);
            asm volatile("s_waitcnt vmcnt(0)" ::: "memory");
        } else {
            XB_SPIN(xb_ld(&bar[XB_XGEN(b.x)]) == gen, bar);
            __builtin_amdgcn_fence(__ATOMIC_ACQUIRE, "agent");
            asm volatile("s_waitcnt vmcnt(0)" ::: "memory");
        }
    }
    __syncthreads();
}

struct Args { const float* in[31]; float* out; unsigned char* ws; float lam_init[2]; int ph_lo, ph_hi; };
constexpr int NPL = 15, NPH = 4 * NPL + 1;

DI pg8::Gemm mk_gemm(const bf16* A, const bf16* Bt, int M, int N, int K, int lda, int ldb) {
    pg8::Gemm g; g.A = A; g.Bt = Bt; g.M = M; g.N = N; g.K = K; g.lda = lda; g.ldb = ldb; g.a_pn = 0; g.b_pn = (long)256 * ldb; g.b_b = 0; g.pm_per_b = 1 << 30; return g;
}
DI pg8::EpiU mk_store(bf16* O, int ldc, int act, int scale_cols, float scale) {
    pg8::EpiU e; e.mode = 0; e.O = O; e.ldc = ldc; e.act = act; e.scale_cols = scale_cols; e.scale = scale; e.small_out = nullptr; e.small_pn = -1; e.base = nullptr; e.baseb = nullptr; e.outb = nullptr; e.ssq = nullptr; e.nssq = nullptr; e.nmode = 0; return e;
}
DI pg8::EpiU mk_res(const float* base, const bf16* baseb, bf16* outb, float* ssq) {
    pg8::EpiU e; e.mode = 1; e.ssq = ssq; e.nssq = nullptr; e.nmode = 0; e.O = nullptr; e.ldc = D_; e.act = 0; e.scale_cols = 0; e.scale = 1.f; e.small_out = nullptr; e.small_pn = -1; e.base = base; e.baseb = baseb; e.outb = outb; return e;
}

__global__ void __launch_bounds__(512, 2) mega_fwd(Args a) {
    extern __shared__ __attribute__((aligned(16))) unsigned char lds_raw[];
    ldsp lds = (ldsp)lds_raw;
    cg::grid_group grid = cg::this_grid();
    volatile LAS unsigned* bst = (volatile LAS unsigned*)(lds + LDS_BYTES - 16);
    if (threadIdx.x < 4) bst[threadIdx.x] = 0u;
    __syncthreads();
    const XcdBarrier xbar = xcd_barrier_post((unsigned*)(a.ws + 4096), bst);
    const int G = gridDim.x, blk = blockIdx.x, NGW = G * 8;
    for (int ph = a.ph_lo; ph < a.ph_hi; ++ph) {
#define PHASE_IDS int tid = threadIdx.x; asm volatile("" : "+v"(tid)); const int lane = tid & 63, wave = __builtin_amdgcn_readfirstlane(tid >> 6), gw = blk * 8 + wave; (void)lane; (void)gw; (void)wave;
        unsigned char* ws = a.ws;
        bf16* XN = (bf16*)(ws + WS_XN); bf16* BIG = (bf16*)(ws + WS_BIG); bf16* VT = (bf16*)(ws + WS_VT); bf16* ORAW = (bf16*)a.out;   bf16* XR = (bf16*)(ws + WS_ORAW);
        float* SSQ_M = (float*)a.out; float* SSQ_X = (float*)(ws + WS_SMALL); float* SSQ_F = (float*)(ws + WS_SMALL + 2 * MiB);
        float* SMALL = (float*)(ws + WS_SMALL); bf16* MEMN = (bf16*)(ws + WS_MEMN); bf16* KX = (bf16*)(ws + WS_KX); bf16* VXT = (bf16*)(ws + WS_VXT);
        bf16* KT = (bf16*)(ws + WS_KT); float* DG = (float*)(ws + WS_DG); bf16* TAIL = (bf16*)(ws + WS_DG + 1 * MiB);
        bf16* WA = (bf16*)(ws + WS_WA); bf16* WV = (bf16*)(ws + WS_WV); bf16* WOUT = (bf16*)(ws + WS_WOUT); bf16* WQ = (bf16*)(ws + WS_WQ); bf16* WKV = (bf16*)(ws + WS_WKV);
        bf16* WXO = (bf16*)(ws + WS_WXO); bf16* W1 = (bf16*)(ws + WS_W1); bf16* W2 = (bf16*)(ws + WS_W2);
        bf16* QX = BIG; bf16* SP = BIG + (size_t)T_ * 1024; bf16* OX = BIG + (size_t)2 * T_ * 1024;
        bf16* OATT = (bf16*)(ws + WS_BIG + 132 * MiB);

        const int layer = ph / NPL, k = ph % NPL;
        const bool even = !(layer & 1); const int li = layer >> 1;
        bool did = true; int nj = 0;
        const bool x_in = (layer == 0 && k <= 5);
        if (ph == NPH - 1) { PHASE_IDS
            rms_rows_from_bf16<true>(XR, a.in[30], nullptr, a.out, T_, gw, NGW, lane);
        } else if (k == 0) { PHASE_IDS
            LAS float* scr = (LAS float*)(lds + wave * 16384);
            const float* wq = a.in[24] + (size_t)layer * 1024 * 1024; const float* wkv = a.in[25] + (size_t)layer * 1024 * 2048; const float* wxo = a.in[26] + (size_t)layer * 1024 * 1024;
            const float* w1 = a.in[28] + (size_t)layer * 1024 * 4096; const float* w2 = a.in[29] + (size_t)layer * 4096 * 1024;
            const int I_Q = 16 * 32, I_KV = 16 * 64, I_XO = 16 * 32, I_1 = 16 * 128, I_2 = 64 * 32;
            const int I_A = even ? 16 * 144 : 16 * 64, I_V = 16 * 32, I_O = even ? 32 * 32 : 16 * 32;
            const int NIT = I_Q + I_KV + I_XO + I_1 + I_2 + I_A + I_V + I_O;
            for (int it = gw; it < NIT; it += NGW) {
                int r = it;
                if (r < I_Q) { conv_item(wq, 1024, 1024, WQ, 1024, 0, 0, scr, r, lane, a.in[22] + (size_t)layer * 1024); continue; } r -= I_Q;
                if (r < I_KV) { conv_item(wkv, 2048, 1024, WKV, 2048, 0, 0, scr, r, lane); continue; } r -= I_KV;
                if (r < I_XO) { conv_item(wxo, 1024, 1024, WXO, 1024, 0, 0, scr, r, lane); continue; } r -= I_XO;
                if (r < I_1) { conv_item(w1, 4096, 1024, W1, 4096, 0, 0, scr, r, lane, a.in[27] + (size_t)layer * 1024); continue; } r -= I_1;
                if (r < I_2) { conv_item(w2, 1024, 4096, W2, 1024, 0, 0, scr, r, lane); continue; } r -= I_2;
                if (even) {
                    const float* win = a.in[3] + (size_t)li * 1024 * 5408; const float* wout = a.in[13] + (size_t)li * 2048 * 1024;
                    if (r < I_A) { conv_item(win, 5408, 1024, WA, 4608, 1, 0, scr, r, lane, a.in[2] + (size_t)li * 1024); continue; } r -= I_A;
                    if (r < I_V) { conv_item(win, 5408, 1024, WV, 1024, 0, 3344, scr, r, lane, a.in[2] + (size_t)li * 1024); continue; } r -= I_V;
                    conv_item(wout, 1024, 2048, WOUT, 1024, 0, 0, scr, r, lane);
                } else {
                    const float* wqkv = a.in[15] + (size_t)li * 1024 * 3072; const float* wo = a.in[21] + (size_t)li * 1024 * 1024;
                    if (r < I_A) { conv_item(wqkv, 3072, 1024, WA, 2048, 0, 0, scr, r, lane, a.in[14] + (size_t)li * 1024); continue; } r -= I_A;
                    if (r < I_V) { conv_item(wqkv, 3072, 1024, WV, 1024, 0, 2048, scr, r, lane, a.in[14] + (size_t)li * 1024); continue; } r -= I_V;
                    conv_item(wo, 1024, 1024, WOUT, 1024, 0, 0, scr, r, lane);
                }
            }
            if (layer == 0) xb_rows(a.in[0], XR, SSQ_M, T_, gw, NGW, lane);
            rms_rows_bf16(a.in[1], a.in[23] + (size_t)layer * 1024, MEMN, 512, gw, NGW, lane);
            if (blk == 0 && tid < 64) ((float*)ws)[tid] = 0.f;
        } else if (k == 1) { nj = 4;
        } else if (k == 2) { PHASE_IDS
            if (even) { for (int u = blk; u < T_ / 128; u += G) prep_unit(u, BIG, SMALL, KT, DG, TAIL, a.in[10] + (size_t)li * 16 * 512, a.in[11] + (size_t)li * 512, a.in[6] + li * 16, a.in[7] + li * 16, a.in[4] + (size_t)li * 4 * 1280, a.in[5] + (size_t)li * 1280, lds, tid); }
            else {
                qk_norms(BIG, (float*)ws, gw, NGW, lane);
                xcd_barrier(xbar);
                {
                    const int x = blk & 7, j = blk >> 3, bb = (x >> 1) & 1, br = x & 1, grp = x >> 2;
#pragma unroll 1
                    for (int u = 0; u < 8; ++u) { const int s = u >> 1; const int head = grp ? (s == 0 ? 6 : s == 1 ? 4 : s == 2 ? 3 : 2) : (s == 0 ? 7 : s == 1 ? 5 : s == 2 ? 1 : 0);
                        attn_unit(bb, 2 * head + br, (u & 1) ? j : 63 - j, BIG, VT, OATT, (const float*)ws, lds, tid); }
                }
            }
        } else if (k == 3) { PHASE_IDS
            if (even) {
                for (int j = blk; j < 64; j += G) {
                    if (j < 32) ssd_chain(j >> 4, j & 15, BIG, SMALL, TAIL, a.in[8] + li * 16, lds, tid);
                    else { const int i2 = j - 32; gla_chain(i2 >> 4, (i2 >> 2) & 3, i2 & 3, BIG, KT, VT, DG, ORAW, lds, tid); }
                }
            } else combine_rows(OATT, XN, a.in[16] + li * 64, a.in[17] + li * 64, a.in[18] + li * 64, a.in[19] + li * 64, a.in[20] + li * 128, a.lam_init[li], gw, NGW, lane);
        } else if (k == 4) { PHASE_IDS
            if (even) gate_rows(BIG, ORAW, a.in[9] + (size_t)li * 1024, a.in[12] + (size_t)li * 256, gw, NGW, lane);
            else nj = 1;
        } else if (k == 5) { if (even) nj = 1; else did = false;
        } else if (k == 6) { did = false;
        } else if (k == 9) { PHASE_IDS softmax_rows256(SP, T_ * 4, gw, NGW, lane);
        } else if (k == 12) { did = false;
        } else nj = 1;
        for (int j = 0; j < nj; ++j) { PHASE_IDS
            pg8::Gemm g = mk_gemm(XN, WA, T_, 1024, 1024, 1024, 1024); pg8::EpiU e = mk_store(BIG, 1024, 0, 0, 1.f);
            if (k == 1) {
                if (j == 0) { if (even) { g = mk_gemm(XR, WA, T_, 4608, 1024, 1024, 1024); e = mk_store(BIG, PROJ_LD, 0, 0, 1.f); e.small_out = SMALL; e.small_pn = 17; }
                              else { g = mk_gemm(XR, WA, T_, 2048, 1024, 1024, 1024); e = mk_store(BIG, QK_LD, 0, 1024, 0.125f * 1.4426950408889634f); }
                              e.nssq = SSQ_M; e.nmode = 1; }
                else if (j == 1) { g = mk_gemm(WV, XR, 1024, T_, 1024, 1024, 1024); e = mk_store(VT, VT_LD, 0, 0, 1.f); e.nssq = SSQ_M; e.nmode = 2; }
                else if (j == 2) { g = mk_gemm(MEMN, WKV, 512, 1024, 1024, 1024, 1024); e = mk_store(KX, 1024, 0, 0, 1.f); }
                else { g = mk_gemm(WKV + (size_t)1024 * 1024, MEMN, 1024, 512, 1024, 1024, 1024); e = mk_store(VXT, 512, 0, 0, 1.f); }
            } else if (k == 4) { g = mk_gemm(XN, WOUT, T_, 1024, 1024, 1024, 1024); e = mk_res(nullptr, XR, XR, SSQ_X);
            } else if (k == 5) {
                g = mk_gemm(ORAW, WOUT, T_, 1024, 2048, 2048, 2048); e = mk_res(nullptr, XR, XR, SSQ_X);
            } else if (k == 7) { g = mk_gemm(XR, WQ, T_, 1024, 1024, 1024, 1024); e = mk_store(QX, 1024, 0, 1024, 0.0625f); e.nssq = SSQ_X; e.nmode = 1;
            } else if (k == 8) { g = mk_gemm(QX, KX, T_, 1024, 256, 1024, 1024); g.a_pn = 256; g.b_pn = 256; g.b_b = (long)256 * 1024; g.pm_per_b = 64; e = mk_store(SP, 1024, 0, 0, 1.f);
            } else if (k == 10) { g = mk_gemm(SP, VXT, T_, 1024, 256, 1024, 512); g.a_pn = 256; g.b_pn = (long)256 * 512; g.b_b = 256; g.pm_per_b = 64; e = mk_store(OX, 1024, 0, 0, 1.f);
            } else if (k == 11) { g = mk_gemm(OX, WXO, T_, 1024, 1024, 1024, 1024); e = mk_res(nullptr, XR, XR, SSQ_F);
            } else if (k == 13) { g = mk_gemm(XR, W1, T_, 4096, 1024, 1024, 1024); e = mk_store(BIG, 4096, 1, 0, 1.f); e.nssq = SSQ_F; e.nmode = 1;
            } else if (k == 14) { g = mk_gemm(BIG, W2, T_, 1024, 4096, 4096, 4096); e = mk_res(nullptr, XR, XR, SSQ_M); }
            pg8::StaticOrder S; S.init(g.M, g.N, G, (blk + 64 * j * (j >= 2)) % G);
            pg8::gemm_phase<pg8::EpiU, pg8::StaticOrder, true, true>(lds, g, S, e, tid);
        }
        if (did && ph + 1 < a.ph_hi) { if (ph == 0) grid.sync(); else xcd_barrier(xbar); }
    }
}

extern "C" void kernel_launch(void* const* d_in, const int* in_sizes, int n_in, void* d_out, int out_size, void* d_ws, size_t ws_size, hipStream_t stream) {
    static int grid = 0;
    if (grid == 0) {
        if (n_in != 31 || out_size != T_ * D_ || ws_size < WS_END) { fprintf(stderr, "kernel_launch: unexpected problem (n_in %d out %d ws %zu)\n", n_in, out_size, ws_size); grid = -1; return; }
        int dev = 0, cus = 0, per_cu = 0;
        hipGetDevice(&dev); hipDeviceGetAttribute(&cus, hipDeviceAttributeMultiprocessorCount, dev);
        if (hipFuncSetAttribute((const void*)mega_fwd, hipFuncAttributeMaxDynamicSharedMemorySize, LDS_BYTES) != hipSuccess) { fprintf(stderr, "kernel_launch: hipFuncSetAttribute failed\n"); grid = -1; return; }
        if (hipOccupancyMaxActiveBlocksPerMultiprocessor(&per_cu, (const void*)mega_fwd, 512, LDS_BYTES) != hipSuccess || per_cu < 1) { fprintf(stderr, "kernel_launch: occupancy query says %d\n", per_cu); per_cu = 1; }
        (void)hipGetLastError();
        grid = cus;
        if (grid != 256) { fprintf(stderr, "kernel_launch: built for a 256-CU device (got %d)\n", cus); grid = -1; return; }
    }
    if (grid < 0) return;
    Args a{};
    for (int i = 0; i < 31; ++i) a.in[i] = (const float*)d_in[i];
    a.out = (float*)d_out; a.ws = (unsigned char*)d_ws;
    a.lam_init[0] = (float)(0.8 - 0.6 * exp(-0.3 * 1.0)); a.lam_init[1] = (float)(0.8 - 0.6 * exp(-0.3 * 3.0));
    a.ph_lo = 0; a.ph_hi = NPH;
#ifdef PROBE_PREFIX
    {
        Args p = a; p.ph_hi = PROBE_PREFIX; void* pargs[] = {&p};
        (void)hipMemsetAsync(d_ws, 0, 65536, stream);
        (void)hipLaunchCooperativeKernel((const void*)mega_fwd, dim3(grid), dim3(512), pargs, LDS_BYTES, stream);
    }
#endif
    if (hipMemsetAsync(d_ws, 0, 65536, stream) != hipSuccess) { fprintf(stderr, "kernel_launch: memset failed\n"); return; }
    void* args[] = {&a};
    hipError_t e = hipLaunchCooperativeKernel((const void*)mega_fwd, dim3(grid), dim3(512), args, LDS_BYTES, stream);
    if (e != hipSuccess) fprintf(stderr, "cooperative launch failed: %s (grid %d)\n", hipGetErrorString(e), grid);
}
```

```cpp
#include <hip/hip_runtime.h>
#include <hip/hip_cooperative_groups.h>
#include <cstdio>
#include <cstdint>
#include <cmath>
namespace cg = cooperative_groups;

namespace pg8 {
#define PG8_LAS __attribute__((address_space(3)))
typedef unsigned short bf16_t;
typedef short bf16x8 __attribute__((ext_vector_type(8)));
typedef float f32x4 __attribute__((ext_vector_type(4)));
typedef unsigned u32x4 __attribute__((ext_vector_type(4)));
constexpr int BM = 256, BK = 64, HALF = 128, HTB = HALF * BK * 2, STAGE_BYTES = 8 * HTB, NXCD = 8, WGM = 8;

__host__ __device__ __forceinline__ int lds_byte(int r, int c) { const int st = (r >> 4) * 2 + (c >> 5), rr = r & 15, cc = c & 31, ob = rr * 64 + cc * 2; return st * 1024 + (ob ^ (((ob >> 9) & 1) << 5)); }
__host__ __device__ __forceinline__ void stage_rc(int b, int& R, int& C) { const int st = b / 1024, sb = b % 1024, swz = sb ^ (((sb >> 9) & 1) << 5); R = (st >> 1) * 16 + swz / 64; C = (st & 1) * 32 + (swz % 64) / 2; }
__host__ __device__ __forceinline__ int perm32(int rho) { const int n = rho >> 4, i = rho & 15; return 8 * (i >> 2) + 4 * n + (i & 3); }

struct Unit { int pm, pn; };
struct Gemm { const bf16_t* A; const bf16_t* Bt; int M, N, K, lda, ldb; long a_pn, b_pn, b_b; int pm_per_b; };

struct StaticOrder {
    int nM, nN, nwg, G, c;
    __host__ __device__ void init(int M, int N, int G_, int c_) { nM = M / BM; nN = N / BM; nwg = nM * nN; G = G_; c = c_; }
    __host__ __device__ bool next(int i, Unit& u) const {
        const long L = (long)i * G + c; if (L >= nwg) return false;
        int wgid = (int)L; { const int q = nwg / NXCD, r = nwg % NXCD, xcd = wgid % NXCD, off = wgid / NXCD; wgid = (xcd < r ? xcd * (q + 1) : r * (q + 1) + (xcd - r) * q) + off; }
        const int nig = WGM * nN, gid = wgid / nig, fm = gid * WGM, gsz = (nM - fm) < WGM ? (nM - fm) : WGM;
        u.pm = fm + ((wgid % nig) % gsz); u.pn = (wgid % nig) / gsz; return true;
    }
    __device__ __forceinline__ void ptrs(const Unit& u, const Gemm& g, const char*& a, const char*& b) const {
        a = (const char*)(g.A + (size_t)u.pm * BM * g.lda + (size_t)u.pn * g.a_pn);
        b = (const char*)(g.Bt + (size_t)u.pn * g.b_pn + (size_t)(u.pm / g.pm_per_b) * g.b_b);
    }
    __device__ __forceinline__ void a_ready(const Unit&) const {}
    __device__ __forceinline__ void done(const Unit&) const {}
};

__device__ __forceinline__ unsigned cvt_pk_bf16(float lo, float hi) { unsigned r; asm volatile("v_cvt_pk_bf16_f32 %0, %1, %2" : "=v"(r) : "v"(lo), "v"(hi)); return r; }

__device__ __forceinline__ float rstd16(const float* p) {
    const f32x4 a = *(const f32x4*)p, b = *(const f32x4*)(p + 4), c = *(const f32x4*)(p + 8), d = *(const f32x4*)(p + 12);
    const float s = (((a[0] + a[1]) + (a[2] + a[3])) + ((b[0] + b[1]) + (b[2] + b[3]))) + (((c[0] + c[1]) + (c[2] + c[3])) + ((d[0] + d[1]) + (d[2] + d[3])));
    return rsqrtf(s * (1.f / 1024.f) + 1e-5f);
}
struct EpiU {
    static constexpr bool PERM = true, AFTER_DRAIN = false;
    int mode;
    bf16_t* O; int ldc; int act; int scale_cols; float scale;
    float* small_out; int small_pn;
    PG8_LAS float* smx;
    float* ssq; const float* nssq; int nmode;
    const float* base; const bf16_t* baseb; bf16_t* outb;
    __device__ __forceinline__ void operator()(const f32x4 (&acc)[2][2][4][2], const Unit& u, int wr, int wc, int fr, int fq) const {
        const int row0 = u.pm * BM + wr * 64 + fr; const int col0 = u.pn * BM + wc * 32 + 8 * fq;
        if (mode == 0) {
            if (smx) {
#pragma unroll
                for (int ai = 0; ai < 2; ++ai)
#pragma unroll
                    for (int m = 0; m < 4; ++m) { float mx = -INFINITY;
#pragma unroll
                        for (int bj = 0; bj < 2; ++bj)
#pragma unroll
                            for (int n = 0; n < 2; ++n)
#pragma unroll
                                for (int e = 0; e < 4; ++e) mx = fmaxf(mx, acc[ai][bj][m][n][e]);
                        mx = fmaxf(mx, __shfl_xor(mx, 16)); mx = fmaxf(mx, __shfl_xor(mx, 32));
                        if (fq == 0) smx[(ai * HALF + wr * 64 + m * 16 + fr) * 4 + wc] = mx; }
                asm volatile("s_waitcnt lgkmcnt(0)\n\ts_barrier" ::: "memory");
#pragma unroll
                for (int ai = 0; ai < 2; ++ai)
#pragma unroll
                    for (int m = 0; m < 4; ++m) { const int rl = ai * HALF + wr * 64 + m * 16 + fr;
                        const f32x4 q4 = *(PG8_LAS f32x4*)(smx + rl * 4); const float mx = fmaxf(fmaxf(q4[0], q4[1]), fmaxf(q4[2], q4[3]));
                        float sm = 0.f;
#pragma unroll
                        for (int bj = 0; bj < 2; ++bj)
#pragma unroll
                            for (int n = 0; n < 2; ++n)
#pragma unroll
                                for (int e = 0; e < 4; ++e) sm += __expf(acc[ai][bj][m][n][e] - mx);
                        sm += __shfl_xor(sm, 16); sm += __shfl_xor(sm, 32);
                        if (fq == 0) smx[1024 + rl * 4 + wc] = sm; }
                asm volatile("s_waitcnt lgkmcnt(0)\n\ts_barrier" ::: "memory");
#pragma unroll
                for (int ai = 0; ai < 2; ++ai)
#pragma unroll
                    for (int m = 0; m < 4; ++m) { const int rl = ai * HALF + wr * 64 + m * 16 + fr;
                        const f32x4 q4 = *(PG8_LAS f32x4*)(smx + rl * 4); const float mx = fmaxf(fmaxf(q4[0], q4[1]), fmaxf(q4[2], q4[3]));
                        const f32x4 l4 = *(PG8_LAS f32x4*)(smx + 1024 + rl * 4); const float inv = 1.f / ((l4[0] + l4[1]) + (l4[2] + l4[3]));
                        bf16_t* rowp = O + (size_t)(row0 + ai * HALF + m * 16) * ldc + col0;
#pragma unroll
                        for (int bj = 0; bj < 2; ++bj) { f32x4 v0, v1;
#pragma unroll
                            for (int e = 0; e < 4; ++e) { v0[e] = __expf(acc[ai][bj][m][0][e] - mx) * inv; v1[e] = __expf(acc[ai][bj][m][1][e] - mx) * inv; }
                            u32x4 w; w.x = cvt_pk_bf16(v0[0], v0[1]); w.y = cvt_pk_bf16(v0[2], v0[3]); w.z = cvt_pk_bf16(v1[0], v1[1]); w.w = cvt_pk_bf16(v1[2], v1[3]);
                            *(u32x4*)(rowp + bj * HALF) = w; } }
                return;
            }
            if (small_out && u.pn == small_pn) {
                if (wc == 0) {
#pragma unroll
                    for (int ai = 0; ai < 2; ++ai)
#pragma unroll
                        for (int m = 0; m < 4; ++m) { const int rr = row0 + ai * HALF + m * 16; const float rsc = (nmode == 1) ? rstd16(nssq + (size_t)rr * 16) : 1.f;
                            float* p = small_out + (size_t)rr * 32 + 8 * fq; *(f32x4*)p = acc[ai][0][m][0] * rsc; *(f32x4*)(p + 4) = acc[ai][0][m][1] * rsc; }
                }
                return;
            }
            f32x4 csc[2][2];
#pragma unroll
            for (int bj = 0; bj < 2; ++bj)
#pragma unroll
                for (int e = 0; e < 4; ++e) { csc[bj][0][e] = (nmode == 2) ? rstd16(nssq + (size_t)(col0 + bj * HALF + e) * 16) : 1.f; csc[bj][1][e] = (nmode == 2) ? rstd16(nssq + (size_t)(col0 + bj * HALF + 4 + e) * 16) : 1.f; }
#pragma unroll
            for (int ai = 0; ai < 2; ++ai)
#pragma unroll
                for (int m = 0; m < 4; ++m) { bf16_t* rowp = O + (size_t)(row0 + ai * HALF + m * 16) * ldc + col0;
                    const float rsc = (nmode == 1) ? rstd16(nssq + (size_t)(row0 + ai * HALF + m * 16) * 16) : 1.f;
#pragma unroll
                    for (int bj = 0; bj < 2; ++bj) { f32x4 v0 = acc[ai][bj][m][0] * rsc * csc[bj][0], v1 = acc[ai][bj][m][1] * rsc * csc[bj][1];
                        if (act == 1) {
#pragma unroll
                            for (int e = 0; e < 4; ++e) { float t0 = fmaxf(v0[e], 0.f), t1 = fmaxf(v1[e], 0.f); v0[e] = t0 * t0; v1[e] = t1 * t1; } }
                        const float sc = (col0 + bj * HALF < scale_cols) ? scale : 1.f;
                        v0 = v0 * sc; v1 = v1 * sc; u32x4 w; w.x = cvt_pk_bf16(v0[0], v0[1]); w.y = cvt_pk_bf16(v0[2], v0[3]); w.z = cvt_pk_bf16(v1[0], v1[1]); w.w = cvt_pk_bf16(v1[2], v1[3]);
                        *(u32x4*)(rowp + bj * HALF) = w; } }
        } else {
#pragma unroll
            for (int ai = 0; ai < 2; ++ai)
#pragma unroll
                for (int m = 0; m < 4; ++m) { const size_t off = (size_t)(row0 + ai * HALF + m * 16) * ldc + col0; float ss = 0.f;
#pragma unroll
                    for (int bj = 0; bj < 2; ++bj) { f32x4 b0, b1;
                        if (baseb) { const u32x4 wv = *(const u32x4*)(baseb + off + bj * HALF);
                            b0 = (f32x4){__builtin_bit_cast(float, wv.x << 16), __builtin_bit_cast(float, wv.x & 0xffff0000u), __builtin_bit_cast(float, wv.y << 16), __builtin_bit_cast(float, wv.y & 0xffff0000u)};
                            b1 = (f32x4){__builtin_bit_cast(float, wv.z << 16), __builtin_bit_cast(float, wv.z & 0xffff0000u), __builtin_bit_cast(float, wv.w << 16), __builtin_bit_cast(float, wv.w & 0xffff0000u)}; }
                        else { const float* bp = base + off + bj * HALF; b0 = *(const f32x4*)bp; b1 = *(const f32x4*)(bp + 4); }
                        const f32x4 x0 = b0 + acc[ai][bj][m][0], x1 = b1 + acc[ai][bj][m][1];
                        u32x4 w; w.x = cvt_pk_bf16(x0[0], x0[1]); w.y = cvt_pk_bf16(x0[2], x0[3]); w.z = cvt_pk_bf16(x1[0], x1[1]); w.w = cvt_pk_bf16(x1[2], x1[3]);
                        *(u32x4*)(outb + off + bj * HALF) = w;
                        ss += (x0[0] * x0[0] + x0[1] * x0[1]) + (x0[2] * x0[2] + x0[3] * x0[3]) + (x1[0] * x1[0] + x1[1] * x1[1]) + (x1[2] * x1[2] + x1[3] * x1[3]); }
                    ss += __shfl_xor(ss, 16); ss += __shfl_xor(ss, 32);
                    if (fq == 0) ssq[(size_t)(row0 + ai * HALF + m * 16) * 16 + u.pn * 4 + wc] = ss;
                }
        }
    }
};

template <class Epi, class Sched, bool ALIGN_EPI = false, bool SP2 = false>
__device__ __forceinline__ void gemm_phase(PG8_LAS unsigned char* lds, const Gemm g, const Sched& S, const Epi& E, const int tid) {
    const int wid = __builtin_amdgcn_readfirstlane(tid >> 6), lane = tid & 63, wr = wid >> 2, wc = wid & 3, fr = lane & 15, fq = lane >> 4;
    const int K = g.K, nt = K / BK;
    unsigned voffA[2], voffB[2];
#pragma unroll
    for (int i = 0; i < 2; ++i) { int R, C; stage_rc(tid * 16 + i * 8192, R, C); const int Rb = Epi::PERM ? ((R & ~31) + perm32(R & 31)) : R;
        voffA[i] = (unsigned)(R * g.lda + C) * 2u; voffB[i] = (unsigned)(Rb * g.ldb + C) * 2u; }
    const size_t kstep = (size_t)(BK * 2);
    const size_t hstepA = (size_t)HALF * g.lda * 2, hstepB = (size_t)HALF * g.ldb * 2;
    const unsigned ldsw = (unsigned)wid * 1024u;
    const int aoff = lds_byte(wr * 64 + fr, fq * 8), boff = lds_byte(wc * 32 + fr, fq * 8);
#define PG8_SA(b, h) (((b) * 2 + (h)) * HTB)
#define PG8_SB(b, h) ((4 + (b) * 2 + (h)) * HTB)
#define PG8_STAGE(bufoff, gbase, voff) do { _Pragma("unroll") for (int _i = 0; _i < 2; ++_i) \
        __builtin_amdgcn_global_load_lds((const unsigned*)((const char*)(gbase) + (voff)[_i]), (PG8_LAS unsigned*)(lds + (bufoff) + ldsw + _i * 8192), 16, 0, 0); } while (0)
#define PG8_LDA(dst, b, h) do { _Pragma("unroll") for (int m = 0; m < 4; ++m) _Pragma("unroll") for (int k = 0; k < 2; ++k) dst[m][k] = *(const PG8_LAS bf16x8*)(lds + PG8_SA(b, h) + aoff + m * 2048 + k * 1024); } while (0)
#define PG8_LDB(dst, b, h) do { _Pragma("unroll") for (int n = 0; n < 2; ++n) _Pragma("unroll") for (int k = 0; k < 2; ++k) dst[n][k] = *(const PG8_LAS bf16x8*)(lds + PG8_SB(b, h) + boff + n * 2048 + k * 1024); } while (0)
#define PG8_MMA(ai, bj, At, Bt) do { __builtin_amdgcn_s_setprio(1); _Pragma("unroll") for (int m = 0; m < 4; ++m) _Pragma("unroll") for (int n = 0; n < 2; ++n) _Pragma("unroll") for (int k = 0; k < 2; ++k) \
        acc[ai][bj][m][n] = __builtin_amdgcn_mfma_f32_16x16x32_bf16(Bt[n][k], At[m][k], acc[ai][bj][m][n], 0, 0, 0); __builtin_amdgcn_s_setprio(0); } while (0)
#define PG8_WAIT_V(n) asm volatile("s_waitcnt vmcnt(" #n ")" ::: "memory")
#define PG8_WAIT_L(n) asm volatile("s_waitcnt lgkmcnt(" #n ")" ::: "memory")
#define PG8_BAR __builtin_amdgcn_s_barrier()
#define PG8_SCHED __builtin_amdgcn_sched_barrier(0)
    Unit cur, nxt; int ui = 0;
    if (!S.next(0, cur)) return;
    f32x4 acc[2][2][4][2];
#pragma unroll
    for (int a = 0; a < 2; ++a)
#pragma unroll
        for (int b = 0; b < 2; ++b)
#pragma unroll
            for (int m = 0; m < 4; ++m)
#pragma unroll
                for (int n = 0; n < 2; ++n) acc[a][b][m][n] = (f32x4){0.f, 0.f, 0.f, 0.f};
    bf16x8 At[4][2], B0[2][2], B1[2][2];
    const char* cA; const char* cB; S.ptrs(cur, g, cA, cB);
    S.a_ready(cur);
    if constexpr (SP2) {
        PG8_STAGE(PG8_SB(0, 0), cB, voffB); PG8_STAGE(PG8_SB(0, 1), cB + hstepB, voffB); PG8_STAGE(PG8_SA(0, 0), cA, voffA); PG8_STAGE(PG8_SA(0, 1), cA + hstepA, voffA);
        if (wr == 1) PG8_BAR;
        PG8_WAIT_V(2); PG8_BAR;
        PG8_STAGE(PG8_SB(1, 0), cB + kstep, voffB); PG8_STAGE(PG8_SA(1, 0), cA + kstep, voffA); PG8_STAGE(PG8_SB(1, 1), cB + hstepB + kstep, voffB);
        PG8_WAIT_V(6); PG8_BAR;
    } else {
        PG8_STAGE(PG8_SB(0, 0), cB, voffB); PG8_STAGE(PG8_SA(0, 0), cA, voffA); PG8_STAGE(PG8_SB(0, 1), cB + hstepB, voffB); PG8_STAGE(PG8_SA(0, 1), cA + hstepA, voffA);
        if (wr == 1) PG8_BAR;
        PG8_WAIT_V(4); PG8_BAR;
        PG8_STAGE(PG8_SB(1, 0), cB + kstep, voffB); PG8_STAGE(PG8_SA(1, 0), cA + kstep, voffA); PG8_STAGE(PG8_SB(1, 1), cB + hstepB + kstep, voffB);
        PG8_WAIT_V(6); PG8_BAR;
    }
    for (;;) {
        const bool has_next = S.next(ui + 1, nxt);
        const char* nA = cA; const char* nB = cB; if (has_next) S.ptrs(nxt, g, nA, nB);
        for (int t = 0; t < nt; t += 2) {
            const bool last = (t == nt - 2);
            const char* a1 = cA + (size_t)(t + 1) * kstep;
            const char* a2 = last ? nA : cA + (size_t)(t + 2) * kstep; const char* b2 = last ? nB : cB + (size_t)(t + 2) * kstep;
            const char* a3 = a2 + kstep; const char* b3 = b2 + kstep;
            if (last && has_next) S.a_ready(nxt);
            if constexpr (SP2) {
            PG8_LDB(B0, 0, 0); PG8_LDB(B1, 0, 1); PG8_SCHED; PG8_LDA(At, 0, 0); PG8_STAGE(PG8_SA(1, 1), a1 + hstepA, voffA);
            PG8_WAIT_V(8); PG8_WAIT_L(0); PG8_BAR; PG8_MMA(0, 0, At, B0); PG8_MMA(0, 1, At, B1); PG8_BAR; PG8_SCHED;
            PG8_LDA(At, 0, 1); PG8_STAGE(PG8_SB(0, 0), b2, voffB); PG8_STAGE(PG8_SB(0, 1), b2 + hstepB, voffB); PG8_STAGE(PG8_SA(0, 0), a2, voffA);
            PG8_WAIT_V(8); PG8_WAIT_L(0); PG8_BAR; PG8_MMA(1, 0, At, B0); PG8_MMA(1, 1, At, B1); PG8_BAR; PG8_SCHED;
            PG8_LDB(B0, 1, 0); PG8_LDB(B1, 1, 1); PG8_SCHED; PG8_LDA(At, 1, 0); PG8_STAGE(PG8_SA(0, 1), a2 + hstepA, voffA);
            PG8_WAIT_V(8); PG8_WAIT_L(0); PG8_BAR; PG8_MMA(0, 0, At, B0); PG8_MMA(0, 1, At, B1); PG8_BAR; PG8_SCHED;
            PG8_LDA(At, 1, 1); PG8_STAGE(PG8_SB(1, 0), b3, voffB); PG8_STAGE(PG8_SB(1, 1), b3 + hstepB, voffB); PG8_STAGE(PG8_SA(1, 0), a3, voffA);
            PG8_WAIT_V(8); PG8_WAIT_L(0); PG8_BAR; PG8_MMA(1, 0, At, B0); PG8_MMA(1, 1, At, B1); PG8_BAR; PG8_SCHED;
            } else {
            PG8_LDB(B0, 0, 0); PG8_SCHED; PG8_LDA(At, 0, 0); PG8_STAGE(PG8_SA(1, 1), a1 + hstepA, voffA);
            PG8_WAIT_L(8); PG8_BAR; PG8_WAIT_L(0); PG8_MMA(0, 0, At, B0); PG8_BAR; PG8_SCHED;
            PG8_LDB(B1, 0, 1); PG8_STAGE(PG8_SB(0, 0), b2, voffB);
            PG8_BAR; PG8_WAIT_L(0); PG8_MMA(0, 1, At, B1); PG8_BAR;
            PG8_LDA(At, 0, 1); PG8_STAGE(PG8_SA(0, 0), a2, voffA);
            PG8_BAR; PG8_WAIT_L(0); PG8_MMA(1, 0, At, B0); PG8_BAR; PG8_SCHED;
            PG8_STAGE(PG8_SB(0, 1), b2 + hstepB, voffB);
            PG8_WAIT_V(6); PG8_BAR; PG8_MMA(1, 1, At, B1); PG8_BAR;
            PG8_LDB(B0, 1, 0); PG8_SCHED; PG8_LDA(At, 1, 0); PG8_STAGE(PG8_SA(0, 1), a2 + hstepA, voffA);
            PG8_WAIT_L(8); PG8_BAR; PG8_WAIT_L(0); PG8_MMA(0, 0, At, B0); PG8_BAR; PG8_SCHED;
            PG8_LDB(B1, 1, 1); PG8_STAGE(PG8_SB(1, 0), b3, voffB);
            PG8_BAR; PG8_WAIT_L(0); PG8_MMA(0, 1, At, B1); PG8_BAR;
            PG8_LDA(At, 1, 1); PG8_STAGE(PG8_SA(1, 0), a3, voffA);
            PG8_BAR; PG8_WAIT_L(0); PG8_MMA(1, 0, At, B0); PG8_BAR; PG8_SCHED;
            PG8_STAGE(PG8_SB(1, 1), b3 + hstepB, voffB);
            PG8_WAIT_V(6); PG8_BAR; PG8_MMA(1, 1, At, B1); PG8_BAR;
            }
        }
        if constexpr (ALIGN_EPI) { if (wr == 0) PG8_BAR; }
        if constexpr (!Epi::AFTER_DRAIN) { E(acc, cur, wr, wc, fr, fq); S.done(cur); }
        if (!has_next) break;
#pragma unroll
        for (int a = 0; a < 2; ++a)
#pragma unroll
            for (int b = 0; b < 2; ++b)
#pragma unroll
                for (int m = 0; m < 4; ++m)
#pragma unroll
                    for (int n = 0; n < 2; ++n) acc[a][b][m][n] = (f32x4){0.f, 0.f, 0.f, 0.f};
        cur = nxt; cA = nA; cB = nB; ++ui;
        if constexpr (ALIGN_EPI) { if (wr == 1) PG8_BAR; }
    }
    PG8_WAIT_V(0);
    if constexpr (!ALIGN_EPI) { if (wr == 0) PG8_BAR; }
    PG8_BAR;
    if constexpr (Epi::AFTER_DRAIN) { E.fused(acc, cur, wr, wc, fr, fq, lds, wid, lane); S.done(cur); }
#undef PG8_SA
#undef PG8_SB
#undef PG8_STAGE
#undef PG8_LDA
#undef PG8_LDB
#undef PG8_MMA
#undef PG8_WAIT_V
#undef PG8_WAIT_L
#undef PG8_BAR
#undef PG8_SCHED
}
}

#define LAS __attribute__((address_space(3)))
#define DI __device__ __forceinline__
typedef unsigned short bf16;
typedef short bf16x8 __attribute__((ext_vector_type(8)));
typedef short s16x4 __attribute__((ext_vector_type(4)));
typedef float f32x4 __attribute__((ext_vector_type(4)));
typedef float f32x16 __attribute__((ext_vector_type(16)));
typedef unsigned u32x4 __attribute__((ext_vector_type(4)));
typedef unsigned u32x2 __attribute__((ext_vector_type(2)));
typedef LAS unsigned char* ldsp;

constexpr int T_ = 32768, L_ = 16384, D_ = 1024;
constexpr float EPS_ = 1e-5f;
constexpr size_t MiB = (size_t)1 << 20;
constexpr size_t WS_W = 1 * MiB;
constexpr size_t WS_WA = WS_W, WS_WV = WS_W + 9 * MiB, WS_WOUT = WS_W + 11 * MiB, WS_WQ = WS_W + 15 * MiB, WS_WKV = WS_W + 17 * MiB,
                 WS_WXO = WS_W + 21 * MiB, WS_W1 = WS_W + 23 * MiB, WS_W2 = WS_W + 31 * MiB;
constexpr size_t WS_XN = 40 * MiB, WS_KT = WS_XN, WS_DG = WS_XN + 33 * MiB;
constexpr size_t WS_BIG = 104 * MiB, WS_VT = 376 * MiB, WS_ORAW = 441 * MiB, WS_SMALL = 505 * MiB, WS_MEMN = 509 * MiB, WS_KX = 510 * MiB, WS_VXT = 511 * MiB, WS_END = 512 * MiB;
constexpr int PROJ_LD = 4352;
constexpr int PC_Z = 0, PC_XBC = 1024, PC_Q = 2304, PC_K = 2816, PC_R = 3328;
constexpr int LDS_BYTES = 140 * 1024;
constexpr int VT_LD = T_ + 64, KT_LD = T_ + 64, QK_LD = 2048 + 64;

DI unsigned f2bf(float f) { unsigned u = __builtin_bit_cast(unsigned, f); return (u + 0x7fffu + ((u >> 16) & 1u)) >> 16; }
typedef float f32x2_t __attribute__((ext_vector_type(2))); typedef __bf16 bf16x2_t __attribute__((ext_vector_type(2)));
DI unsigned pk2(float lo, float hi) { f32x2_t v = {lo, hi}; bf16x2_t b = __builtin_convertvector(v, bf16x2_t); return __builtin_bit_cast(unsigned, b); }
DI float bf2f(unsigned h) { return __builtin_bit_cast(float, h << 16); }
DI float bflo(unsigned w) { return __builtin_bit_cast(float, w << 16); }
DI float bfhi(unsigned w) { return __builtin_bit_cast(float, w & 0xffff0000u); }
DI float wave_sum(float v) {
#pragma unroll
    for (int o = 1; o < 64; o <<= 1) v += __shfl_xor(v, o);
    return v;
}
DI float wave_max(float v) {
#pragma unroll
    for (int o = 1; o < 64; o <<= 1) v = fmaxf(v, __shfl_xor(v, o));
    return v;
}
DI float siluf(float x) { return x * __builtin_amdgcn_rcpf(1.f + __builtin_amdgcn_exp2f(-1.4426950408889634f * x)); }
DI float softplusf(float x) {
    const float e = __expf(-fabsf(x));
    const float l = (e < 0.01f) ? e * (1.f - e * (0.5f - e * (1.f / 3.f))) : __logf(1.f + e);
    return fmaxf(x, 0.f) + l;
}
DI bf16x8 lds16(ldsp p, int off) { return *(LAS bf16x8*)(p + off); }
DI s16x4 lds8(ldsp p, int off) { return *(LAS s16x4*)(p + off); }
DI bf16x8 cat8(s16x4 a, s16x4 b) { return __builtin_shufflevector(a, b, 0, 1, 2, 3, 4, 5, 6, 7); }
DI f32x4 mfma16(bf16x8 a, bf16x8 b, f32x4 c) { return __builtin_amdgcn_mfma_f32_16x16x32_bf16(a, b, c, 0, 0, 0); }
DI f32x16 mfma32(bf16x8 a, bf16x8 b, f32x16 c) { return __builtin_amdgcn_mfma_f32_32x32x16_bf16(a, b, c, 0, 0, 0); }
DI int crow(int r, int hi) { return (r & 3) + 8 * (r >> 2) + 4 * hi; }
DI float max3f(float a, float b, float c) { float r; asm("v_max3_f32 %0, %1, %2, %3" : "=v"(r) : "v"(a), "v"(b), "v"(c)); return r; }
#define LDS_FENCE() asm volatile("s_waitcnt lgkmcnt(0)" ::: "memory")

DI void rms_rows_bf16(const float* x, const float* w, bf16* out, int nrows, int gw, int NGW, int lane) {
    for (int m = 2 * gw; m < nrows; m += 2 * NGW) {
        const f32x4* xr0 = (const f32x4*)(x + (size_t)m * D_) + lane; const f32x4* xr1 = xr0 + D_ / 4;
        f32x4 v0[4], v1[4]; float s0 = 0.f, s1 = 0.f;
#pragma unroll
        for (int j = 0; j < 4; ++j) { v0[j] = xr0[64 * j]; v1[j] = xr1[64 * j]; }
#pragma unroll
        for (int j = 0; j < 4; ++j) { s0 += (v0[j].x * v0[j].x + v0[j].y * v0[j].y) + (v0[j].z * v0[j].z + v0[j].w * v0[j].w); s1 += (v1[j].x * v1[j].x + v1[j].y * v1[j].y) + (v1[j].z * v1[j].z + v1[j].w * v1[j].w); }
#pragma unroll
        for (int o = 1; o < 64; o <<= 1) { s0 += __shfl_xor(s0, o); s1 += __shfl_xor(s1, o); }
        const float r0 = rsqrtf(s0 * (1.f / D_) + EPS_), r1 = rsqrtf(s1 * (1.f / D_) + EPS_);
        u32x2* o0 = (u32x2*)(out + (size_t)m * D_) + lane; u32x2* o1 = o0 + D_ / 4;
#pragma unroll
        for (int j = 0; j < 4; ++j) { const f32x4 wv = ((const f32x4*)w)[lane + 64 * j];
            u32x2 a, b; a.x = pk2(v0[j].x * r0 * wv.x, v0[j].y * r0 * wv.y); a.y = pk2(v0[j].z * r0 * wv.z, v0[j].w * r0 * wv.w);
            b.x = pk2(v1[j].x * r1 * wv.x, v1[j].y * r1 * wv.y); b.y = pk2(v1[j].z * r1 * wv.z, v1[j].w * r1 * wv.w);
            o0[64 * j] = a; o1[64 * j] = b; }
    }
}
template <bool TO_F32> DI void rms_rows_from_bf16(const bf16* x, const float* w, bf16* outb, float* outf, int nrows, int gw, int NGW, int lane) {
    f32x4 wv[4];
#pragma unroll
    for (int j = 0; j < 4; ++j) wv[j] = ((const f32x4*)(w + lane * 16))[j];
    for (int m = 2 * gw; m < nrows; m += 2 * NGW) {
        u32x4 ra[2], rb[2];
#pragma unroll
        for (int u = 0; u < 2; ++u) { const u32x4* p = (const u32x4*)(x + (size_t)(m + u) * D_ + lane * 16); ra[u] = p[0]; rb[u] = p[1]; }
#pragma unroll
        for (int u = 0; u < 2; ++u) {
            float v[16];
            v[0] = bflo(ra[u].x); v[1] = bfhi(ra[u].x); v[2] = bflo(ra[u].y); v[3] = bfhi(ra[u].y); v[4] = bflo(ra[u].z); v[5] = bfhi(ra[u].z); v[6] = bflo(ra[u].w); v[7] = bfhi(ra[u].w);
            v[8] = bflo(rb[u].x); v[9] = bfhi(rb[u].x); v[10] = bflo(rb[u].y); v[11] = bfhi(rb[u].y); v[12] = bflo(rb[u].z); v[13] = bfhi(rb[u].z); v[14] = bflo(rb[u].w); v[15] = bfhi(rb[u].w);
            float s = 0.f;
#pragma unroll
            for (int i = 0; i < 16; ++i) s += v[i] * v[i];
            const float r = rsqrtf(wave_sum(s) * (1.f / D_) + EPS_);
#pragma unroll
            for (int i = 0; i < 16; ++i) v[i] = v[i] * r * wv[i >> 2][i & 3];
            if (TO_F32) { f32x4* o = (f32x4*)(outf + (size_t)(m + u) * D_ + lane * 16);
#pragma unroll
                for (int j = 0; j < 4; ++j) o[j] = (f32x4){v[4 * j], v[4 * j + 1], v[4 * j + 2], v[4 * j + 3]}; }
            else { u32x4 a, b; a.x = pk2(v[0], v[1]); a.y = pk2(v[2], v[3]); a.z = pk2(v[4], v[5]); a.w = pk2(v[6], v[7]); b.x = pk2(v[8], v[9]); b.y = pk2(v[10], v[11]); b.z = pk2(v[12], v[13]); b.w = pk2(v[14], v[15]);
                u32x4* o = (u32x4*)(outb + (size_t)(m + u) * D_ + lane * 16); o[0] = a; o[1] = b; }
        }
    }
}
DI void xb_rows(const float* x, bf16* out, float* ssq, int nrows, int gw, int NGW, int lane) {
    for (int m = gw; m < nrows; m += NGW) {
        const f32x4* xr = (const f32x4*)(x + (size_t)m * D_) + lane;
        f32x4 v[4]; float s = 0.f;
#pragma unroll
        for (int j = 0; j < 4; ++j) { v[j] = xr[64 * j]; s += (v[j].x * v[j].x + v[j].y * v[j].y) + (v[j].z * v[j].z + v[j].w * v[j].w); }
        s = wave_sum(s);
        u32x2* o8 = (u32x2*)(out + (size_t)m * D_) + lane;
#pragma unroll
        for (int j = 0; j < 4; ++j) { u32x2 o; o.x = pk2(v[j].x, v[j].y); o.y = pk2(v[j].z, v[j].w); o8[64 * j] = o; }
        if (lane < 16) ssq[(size_t)m * 16 + lane] = (lane == 0) ? s : 0.f;
    }
}
DI void rms_rows_f32_inplace(float* x, const float* w, int nrows, int gw, int NGW, int lane) {
    for (int m = gw; m < nrows; m += NGW) {
        f32x4* xr = (f32x4*)(x + (size_t)m * D_) + lane;
        f32x4 v[4]; float s = 0.f;
#pragma unroll
        for (int j = 0; j < 4; ++j) { v[j] = xr[64 * j]; s += (v[j].x * v[j].x + v[j].y * v[j].y) + (v[j].z * v[j].z + v[j].w * v[j].w); }
        const float rstd = rsqrtf(wave_sum(s) * (1.f / D_) + EPS_);
#pragma unroll
        for (int j = 0; j < 4; ++j) { const f32x4 wv = ((const f32x4*)w)[lane + 64 * j]; xr[64 * j] = v[j] * rstd * wv; }
    }
}

DI int map_plain(int d, int off) { return d + off; }
DI int map_win(int d) { if (d < 2304) return d; if (d < 3328) return d + 16; if (d < 4352) return d + 1056; if (d < 4368) return d - 4352 + 2304; if (d < 4384) return d; return -1; }
DI void conv_item(const float* W, int ldn, int K, bf16* WT, int nrows, int mode, int off, LAS float* scr, int item, int lane, const float* kscale = nullptr) {
    const int nblk = nrows / 32, kb = item / nblk, nb = item % nblk, k0 = 64 * kb, n0 = 32 * nb;
    const int d = n0 + (lane & 31); const int sc = mode ? map_win(d) : map_plain(d, off);
#pragma unroll 8
    for (int i = 0; i < 32; ++i) { const int kk = 2 * i + (lane >> 5); scr[kk * 33 + (lane & 31)] = sc >= 0 ? W[(size_t)(k0 + kk) * ldn + sc] : 0.f; }
    LDS_FENCE();
    const int c = lane & 7;
    f32x4 ka = (f32x4){1.f, 1.f, 1.f, 1.f}, kb2 = ka;
    if (kscale) { ka = *(const f32x4*)(kscale + k0 + 8 * c); kb2 = *(const f32x4*)(kscale + k0 + 8 * c + 4); }
#pragma unroll
    for (int j = 0; j < 4; ++j) { const int n = (lane >> 3) + 8 * j; const LAS float* s = scr + (8 * c) * 33 + n;
        u32x4 o; o.x = pk2(s[0 * 33] * ka[0], s[1 * 33] * ka[1]); o.y = pk2(s[2 * 33] * ka[2], s[3 * 33] * ka[3]); o.z = pk2(s[4 * 33] * kb2[0], s[5 * 33] * kb2[1]); o.w = pk2(s[6 * 33] * kb2[2], s[7 * 33] * kb2[3]);
        *(u32x4*)(WT + (size_t)(n0 + n) * K + k0 + 8 * c) = o; }
    LDS_FENCE();
}

DI void prep_unit(int unit, bf16* PROJ, float* SMALL, bf16* KT, float* DG, bf16* TAIL, const float* gla_w2, const float* gla_b, const float* dt_bias, const float* a_log,
                  const float* conv_w, const float* conv_b, ldsp lds, int tid) {
    asm volatile("" : "+v"(tid));
    const int rowbase = unit * 128;
    LAS float* sm = (LAS float*)lds; LAS float* dtL = (LAS float*)(lds + 16384);
    for (int i = tid; i < 128 * 32 / 4; i += 512) ((LAS f32x4*)sm)[i] = ((const f32x4*)(SMALL + (size_t)rowbase * 32))[i];
    __syncthreads();
    if (tid < 16) {
        const int h = tid; const float a = -__expf(a_log[h]), bias = dt_bias[h]; float cum = 0.f;
        for (int tt = 0; tt < 128; ++tt) { const float dtv = softplusf(sm[tt * 32 + h] + bias); cum += dtv * a; dtL[tt * 16 + h] = dtv;
            SMALL[((size_t)rowbase + tt) * 32 + h] = dtv; SMALL[((size_t)rowbase + tt) * 32 + 16 + h] = cum; }
    }
    {   const int col = tid;
        float w2c[16];
#pragma unroll
        for (int r = 0; r < 16; ++r) w2c[r] = gla_w2[r * 512 + col];
        const float bcol = gla_b[col];
        for (int sub = 0; sub < 2; ++sub) {
            float cum = 0.f;
#pragma unroll 1
            for (int g8 = 0; g8 < 8; ++g8) {
                unsigned qk[8];
                { const bf16* pq = PROJ + ((size_t)rowbase + sub * 64 + g8 * 8) * PROJ_LD + col;
#pragma unroll
                  for (int e = 0; e < 8; ++e) qk[e] = (unsigned)pq[(size_t)e * PROJ_LD + PC_Q] | ((unsigned)pq[(size_t)e * PROJ_LD + PC_K] << 16); }
                float kt[8];
#pragma unroll
                for (int e = 0; e < 8; ++e) {
                    const int tt = sub * 64 + g8 * 8 + e; const size_t row = (size_t)rowbase + tt;
                    float x = bcol;
#pragma unroll
                    for (int r = 0; r < 16; ++r) x += sm[tt * 32 + 16 + r] * w2c[r];
                    const float lg = (fminf(x, 0.f) - __logf(1.f + __expf(-fabsf(x)))) * 0.0625f;
                    cum += lg;
                    const float qv = bflo(qk[e]), kv = bfhi(qk[e]);
                    PROJ[row * PROJ_LD + PC_Q + col] = (bf16)f2bf(qv * __expf(cum) * 0.08838834764831845f);
                    kt[e] = kv * __expf(-cum);
                    PROJ[row * PROJ_LD + PC_K + col] = (bf16)f2bf(kt[e]);
                }
                u32x4 o; o.x = pk2(kt[0], kt[1]); o.y = pk2(kt[2], kt[3]); o.z = pk2(kt[4], kt[5]); o.w = pk2(kt[6], kt[7]);
                *(u32x4*)(KT + (size_t)col * KT_LD + rowbase + sub * 64 + g8 * 8) = o;
            }
            DG[(size_t)((rowbase >> 6) + sub) * 512 + col] = __expf(cum);
        }
    }
    const int tin = rowbase & (L_ - 1);
    __syncthreads();
#pragma unroll 1
    for (int i = 4; i >= 0; --i) { const int it = tid + 512 * i, pair = it % 640, slab = it / 640, c0 = 2 * pair;
        unsigned rw[35];
        bf16* base = PROJ + ((size_t)rowbase + 32 * slab) * PROJ_LD + PC_XBC + c0;
#pragma unroll
        for (int j = 0; j < 35; ++j) rw[j] = (tin + 32 * slab - 3 + j >= 0) ? *(const unsigned*)(base + (ptrdiff_t)(j - 3) * PROJ_LD) : 0u;
        float cw0[4], cw1[4];
#pragma unroll
        for (int j = 0; j < 4; ++j) { cw0[j] = conv_w[j * 1280 + c0]; cw1[j] = conv_w[j * 1280 + c0 + 1]; }
        const float cb0 = conv_b[c0], cb1 = conv_b[c0 + 1];
        const bool isx = c0 < 1024; const int hh = (c0 >> 6) & 15;
        __syncthreads();
#pragma unroll
        for (int r = 0; r < 32; ++r) { float a0 = cb0, a1 = cb1;
#pragma unroll
            for (int j = 0; j < 4; ++j) { a0 += cw0[j] * bflo(rw[r + j]); a1 += cw1[j] * bfhi(rw[r + j]); }
            a0 = siluf(a0); a1 = siluf(a1);
            const int row = 32 * slab + r;
            if (isx) { const float d = dtL[row * 16 + hh]; a0 *= d; a1 *= d; }
            bf16* dst = (row >= 125) ? TAIL + ((size_t)unit * 3 + (row - 125)) * 1280 + c0 : base + (size_t)r * PROJ_LD;
            *(unsigned*)dst = pk2(a0, a1); }
    }
    __syncthreads();
}

#define BAR_LDS() asm volatile("s_waitcnt lgkmcnt(0)\n\ts_barrier" ::: "memory")
DI void ssd_chain(int b, int h, bf16* PROJ, const float* SMALL, const bf16* TAIL, const float* d_skip, ldsp lds, int tid) {
    constexpr int CS = 0, BS = 18432, BWT = 36864, XDT = 54272, MS = 71680, SS = 106496, CUML = 115712, DTL = 116224;
    asm volatile("" : "+v"(tid));
    const int lane = tid & 63, w = __builtin_amdgcn_readfirstlane(tid >> 6), quad = lane >> 4, l16 = lane & 15;
    const int g = h >> 3, cp = lane & 31, th = lane >> 5, tb = 16 * w + 8 * th;
    LAS float* cumL = (LAS float*)(lds + CUML); LAS float* dtL = (LAS float*)(lds + DTL);
    int ch[3]; ch[0] = h * 64 + 2 * cp; ch[1] = 1024 + g * 64 + 2 * cp; ch[2] = 1152 + g * 64 + 2 * cp;
    const float Dh = d_skip[h];
    const int pi = w >> 1, q = 16 * w + l16;
    f32x4 S[2]; S[0] = (f32x4){0.f, 0.f, 0.f, 0.f}; S[1] = S[0];
    unsigned raw[3][8]; float cmv[8], cum_last, cl_t = 0.f, dt_t = 0.f; u32x2 zz[4];
#define SSD_LOAD(c_) do { const size_t r0_ = (size_t)b * L_ + (size_t)(c_) * 128; \
        _Pragma("unroll") for (int i = 0; i < 8; ++i) cmv[i] = SMALL[(r0_ + tb + i) * 32 + 16 + h]; \
        cum_last = SMALL[(r0_ + 127) * 32 + 16 + h]; \
        if (tid < 128) { cl_t = SMALL[(r0_ + tid) * 32 + 16 + h]; dt_t = SMALL[(r0_ + tid) * 32 + h]; } \
        _Pragma("unroll") for (int arr = 0; arr < 3; ++arr) _Pragma("unroll") for (int i = 0; i < 8; ++i) { const int rr = tb + i; \
            const bf16* sp = (rr >= 125) ? TAIL + ((r0_ >> 7) * 3 + (rr - 125)) * 1280 + ch[arr] : PROJ + (r0_ + rr) * PROJ_LD + PC_XBC + ch[arr]; \
            raw[arr][i] = *(const unsigned*)sp; } \
        _Pragma("unroll") for (int pt = 0; pt < 4; ++pt) zz[pt] = *(const u32x2*)(PROJ + (r0_ + q) * PROJ_LD + PC_Z + h * 64 + 16 * pt + quad * 4); } while (0)
    SSD_LOAD(0);
    for (int c = 0; c < 128; ++c) {
        const size_t row0 = (size_t)b * L_ + (size_t)c * 128;
        if (tid < 128) { cumL[tid] = cl_t; dtL[tid] = dt_t; }
        {
            u32x4 v0, v1;
            v0.x = __builtin_amdgcn_perm(raw[0][1], raw[0][0], 0x05040100u); v0.y = __builtin_amdgcn_perm(raw[0][3], raw[0][2], 0x05040100u);
            v0.z = __builtin_amdgcn_perm(raw[0][5], raw[0][4], 0x05040100u); v0.w = __builtin_amdgcn_perm(raw[0][7], raw[0][6], 0x05040100u);
            v1.x = __builtin_amdgcn_perm(raw[0][1], raw[0][0], 0x07060302u); v1.y = __builtin_amdgcn_perm(raw[0][3], raw[0][2], 0x07060302u);
            v1.z = __builtin_amdgcn_perm(raw[0][5], raw[0][4], 0x07060302u); v1.w = __builtin_amdgcn_perm(raw[0][7], raw[0][6], 0x07060302u);
            *(LAS u32x4*)(lds + XDT + (2 * cp) * 272 + tb * 2) = v0; *(LAS u32x4*)(lds + XDT + (2 * cp + 1) * 272 + tb * 2) = v1;
        }
        {
            float o0[8], o1[8];
#pragma unroll
            for (int i = 0; i < 8; ++i) { *(LAS unsigned*)(lds + BS + (tb + i) * 144 + 4 * cp) = raw[1][i];
                const float wg = __expf(cum_last - cmv[i]); o0[i] = bflo(raw[1][i]) * wg; o1[i] = bfhi(raw[1][i]) * wg; }
            u32x4 v0, v1; v0.x = pk2(o0[0], o0[1]); v0.y = pk2(o0[2], o0[3]); v0.z = pk2(o0[4], o0[5]); v0.w = pk2(o0[6], o0[7]);
            v1.x = pk2(o1[0], o1[1]); v1.y = pk2(o1[2], o1[3]); v1.z = pk2(o1[4], o1[5]); v1.w = pk2(o1[6], o1[7]);
            *(LAS u32x4*)(lds + BWT + (2 * cp) * 272 + tb * 2) = v0; *(LAS u32x4*)(lds + BWT + (2 * cp + 1) * 272 + tb * 2) = v1;
        }
#pragma unroll
        for (int i = 0; i < 8; ++i) *(LAS unsigned*)(lds + CS + (tb + i) * 144 + 4 * cp) = raw[2][i];
        u32x2 zc[4];
#pragma unroll
        for (int pt = 0; pt < 4; ++pt) zc[pt] = zz[pt];
        if (c + 1 < 128) SSD_LOAD(c + 1);
        BAR_LDS();
        const float cq = cumL[q], dq = dtL[q];
        const int fo = quad * 16;
        {
            bf16x8 cb[2];
#pragma unroll
            for (int k = 0; k < 2; ++k) cb[k] = lds16(lds, CS + q * 144 + 64 * k + fo);
#pragma unroll
            for (int jh = 0; jh < 2; ++jh) {
                bf16x8 ba[4][2];
#pragma unroll
                for (int j4 = 0; j4 < 4; ++j4) if (4 * jh + j4 <= w) {
#pragma unroll
                    for (int k = 0; k < 2; ++k) ba[j4][k] = lds16(lds, BS + (16 * (4 * jh + j4) + l16) * 144 + 64 * k + fo); }
                __builtin_amdgcn_sched_barrier(0);
                f32x4 acc[4];
#pragma unroll
                for (int j4 = 0; j4 < 4; ++j4) { acc[j4] = (f32x4){0.f, 0.f, 0.f, 0.f};
                    if (4 * jh + j4 <= w) { acc[j4] = mfma16(ba[j4][0], cb[0], acc[j4]); acc[j4] = mfma16(ba[j4][1], cb[1], acc[j4]); } }
                __builtin_amdgcn_sched_barrier(0);
#pragma unroll
                for (int j4 = 0; j4 < 4; ++j4) {
                    const int s0 = 16 * (4 * jh + j4) + quad * 4;
                    const f32x4 cs = *(LAS f32x4*)(cumL + s0);
                    float v[4];
#pragma unroll
                    for (int jj = 0; jj < 4; ++jj) { const int s = s0 + jj; float t = (s <= q) ? acc[j4][jj] * __expf(cq - cs[jj]) : 0.f; if (s == q && dq > 0.f) t += Dh / dq; v[jj] = t; }
                    u32x2 o; o.x = pk2(v[0], v[1]); o.y = pk2(v[2], v[3]);
                    *(LAS u32x2*)(lds + MS + q * 272 + s0 * 2) = o;
                }
            }
        }
#pragma unroll
        for (int i = 0; i < 2; ++i) { const int ni = (w & 1) * 2 + i; u32x2 o; o.x = pk2(S[i][0], S[i][1]); o.y = pk2(S[i][2], S[i][3]);
            *(LAS u32x2*)(lds + SS + (16 * pi + l16) * 144 + (16 * ni + quad * 4) * 2) = o; }
        const float el = __expf(cumL[127]);
        BAR_LDS();
        const float eq = __expf(cq);
        {
            bf16x8 mb[4], cb[2];
#pragma unroll
            for (int ks = 0; ks < 4; ++ks) mb[ks] = lds16(lds, MS + q * 272 + 64 * ks + fo);
#pragma unroll
            for (int k = 0; k < 2; ++k) cb[k] = lds16(lds, CS + q * 144 + 64 * k + fo);
#pragma unroll
            for (int pt = 0; pt < 4; ++pt) {
                bf16x8 xa[4], sa[2];
#pragma unroll
                for (int ks = 0; ks < 4; ++ks) xa[ks] = lds16(lds, XDT + (16 * pt + l16) * 272 + 64 * ks + fo);
#pragma unroll
                for (int k = 0; k < 2; ++k) sa[k] = lds16(lds, SS + (16 * pt + l16) * 144 + 64 * k + fo);
                __builtin_amdgcn_sched_barrier(0);
                f32x4 y1 = (f32x4){0.f, 0.f, 0.f, 0.f}, y2 = y1;
#pragma unroll
                for (int ks = 0; ks < 4; ++ks) if (32 * ks < 16 * w + 16) y1 = mfma16(xa[ks], mb[ks], y1);
#pragma unroll
                for (int k = 0; k < 2; ++k) y2 = mfma16(sa[k], cb[k], y2);
                __builtin_amdgcn_sched_barrier(0);
                bf16* zp = PROJ + (row0 + q) * PROJ_LD + PC_Z + h * 64 + 16 * pt + quad * 4;
                const float z0 = bflo(zc[pt].x), z1 = bfhi(zc[pt].x), z2 = bflo(zc[pt].y), z3 = bfhi(zc[pt].y);
                u32x2 o; o.x = pk2((y1[0] + eq * y2[0]) * siluf(z0), (y1[1] + eq * y2[1]) * siluf(z1)); o.y = pk2((y1[2] + eq * y2[2]) * siluf(z2), (y1[3] + eq * y2[3]) * siluf(z3));
                *(u32x2*)zp = o;
            }
        }
        {
            bf16x8 xb[4], wa[2][4];
#pragma unroll
            for (int ks = 0; ks < 4; ++ks) xb[ks] = lds16(lds, XDT + (16 * pi + l16) * 272 + 64 * ks + fo);
#pragma unroll
            for (int i = 0; i < 2; ++i)
#pragma unroll
                for (int ks = 0; ks < 4; ++ks) wa[i][ks] = lds16(lds, BWT + (16 * ((w & 1) * 2 + i) + l16) * 272 + 64 * ks + fo);
            __builtin_amdgcn_sched_barrier(0);
            S[0] = S[0] * el; S[1] = S[1] * el;
#pragma unroll
            for (int ks = 0; ks < 4; ++ks) { S[0] = mfma16(wa[0][ks], xb[ks], S[0]); S[1] = mfma16(wa[1][ks], xb[ks], S[1]); }
        }
        BAR_LDS();
    }
#undef SSD_LOAD
}

DI void gla_chain(int b, int h, int vs, const bf16* PROJ, const bf16* KT, const bf16* VT, const float* DG, bf16* ORAW, ldsp lds, int tid) {
    constexpr int QS = 0, KS = 17408, KTS = 34816, VTS = 53248, PS = 62464, STS = 71680, DLO = 89088;
    asm volatile("" : "+v"(tid));
    const int lane = tid & 63, w = __builtin_amdgcn_readfirstlane(tid >> 6), quad = lane >> 4, l16 = lane & 15, qi = w >> 1;
    LAS float* dL = (LAS float*)(lds + DLO);
    f32x4 S[4];
#pragma unroll
    for (int i = 0; i < 4; ++i) S[i] = (f32x4){0.f, 0.f, 0.f, 0.f};
    u32x4 Aq[2], Ak[2], Akt[2], Av, Bq[2], Bk[2], Bkt[2], Bv; float Ad = 0.f, Bd = 0.f;
#define GLA_LOAD(c_, P) do { const size_t r0_ = (size_t)b * L_ + (size_t)(c_) * 64; \
        _Pragma("unroll") for (int i = 0; i < 2; ++i) { const int idx = tid + 512 * i, r = idx >> 4, cc = idx & 15; \
            P##q[i] = *(const u32x4*)(PROJ + (r0_ + r) * PROJ_LD + PC_Q + h * 128 + cc * 8); P##k[i] = *(const u32x4*)(PROJ + (r0_ + r) * PROJ_LD + PC_K + h * 128 + cc * 8); } \
        _Pragma("unroll") for (int i = 0; i < 2; ++i) { const int idx = tid + 512 * i, r = idx >> 3, cc = idx & 7; P##kt[i] = *(const u32x4*)(KT + (size_t)(h * 128 + r) * KT_LD + r0_ + cc * 8); } \
        { const int r = tid >> 3, cc = tid & 7; P##v = *(const u32x4*)(VT + (size_t)(h * 256 + vs * 64 + r) * VT_LD + r0_ + cc * 8); } \
        if (tid < 128) P##d = DG[(r0_ >> 6) * 512 + h * 128 + tid]; } while (0)
#define GLA_PUT(P) do { \
        _Pragma("unroll") for (int i = 0; i < 2; ++i) { const int idx = tid + 512 * i, r = idx >> 4, cc = idx & 15; \
            *(LAS u32x4*)(lds + QS + r * 272 + cc * 16) = P##q[i]; *(LAS u32x4*)(lds + KS + r * 272 + cc * 16) = P##k[i]; } \
        _Pragma("unroll") for (int i = 0; i < 2; ++i) { const int idx = tid + 512 * i, r = idx >> 3, cc = idx & 7; *(LAS u32x4*)(lds + KTS + r * 144 + cc * 16) = P##kt[i]; } \
        { const int r = tid >> 3, cc = tid & 7; *(LAS u32x4*)(lds + VTS + r * 144 + cc * 16) = P##v; } \
        if (tid < 128) dL[tid] = P##d; } while (0)
#define GLA_COMPUTE(c_) do { \
        const size_t row0 = (size_t)b * L_ + (size_t)(c_) * 64; \
        BAR_LDS(); \
        const int q = 16 * qi + l16; \
        const int fo = quad * 16; \
        { \
            bf16x8 fb[4], fa[2][4]; \
_Pragma("unroll") \
            for (int ks = 0; ks < 4; ++ks) fb[ks] = lds16(lds, QS + q * 272 + 64 * ks + fo); \
_Pragma("unroll") \
            for (int i = 0; i < 2; ++i) \
_Pragma("unroll") \
                for (int ks = 0; ks < 4; ++ks) fa[i][ks] = lds16(lds, KS + (16 * ((w & 1) * 2 + i) + l16) * 272 + 64 * ks + fo); \
            __builtin_amdgcn_sched_barrier(0); \
            f32x4 acc[2]; acc[0] = (f32x4){0.f, 0.f, 0.f, 0.f}; acc[1] = acc[0]; \
_Pragma("unroll") \
            for (int ks = 0; ks < 4; ++ks) { acc[0] = mfma16(fa[0][ks], fb[ks], acc[0]); acc[1] = mfma16(fa[1][ks], fb[ks], acc[1]); } \
            __builtin_amdgcn_sched_barrier(0); \
_Pragma("unroll") \
            for (int i = 0; i < 2; ++i) { const int s0 = 16 * ((w & 1) * 2 + i) + quad * 4; \
                u32x2 o; o.x = pk2(s0 <= q ? acc[i][0] : 0.f, s0 + 1 <= q ? acc[i][1] : 0.f); o.y = pk2(s0 + 2 <= q ? acc[i][2] : 0.f, s0 + 3 <= q ? acc[i][3] : 0.f); \
                *(LAS u32x2*)(lds + PS + q * 144 + s0 * 2) = o; } \
        } \
_Pragma("unroll") \
        for (int vt = 0; vt < 4; ++vt) { u32x2 o; o.x = pk2(S[vt][0], S[vt][1]); o.y = pk2(S[vt][2], S[vt][3]); \
            *(LAS u32x2*)(lds + STS + (16 * vt + l16) * 272 + (16 * w + quad * 4) * 2) = o; } \
        BAR_LDS(); \
        { \
            bf16x8 pb[2], qb4[4], va[2][2], sa[2][4], ka[2], vb[4][2]; \
_Pragma("unroll") \
            for (int ks = 0; ks < 2; ++ks) pb[ks] = lds16(lds, PS + q * 144 + 64 * ks + fo); \
_Pragma("unroll") \
            for (int ks = 0; ks < 4; ++ks) qb4[ks] = lds16(lds, QS + q * 272 + 64 * ks + fo); \
_Pragma("unroll") \
            for (int i = 0; i < 2; ++i) { const int vt = (w & 1) * 2 + i; \
_Pragma("unroll") \
                for (int ks = 0; ks < 2; ++ks) va[i][ks] = lds16(lds, VTS + (16 * vt + l16) * 144 + 64 * ks + fo); \
_Pragma("unroll") \
                for (int ks = 0; ks < 4; ++ks) sa[i][ks] = lds16(lds, STS + (16 * vt + l16) * 272 + 64 * ks + fo); } \
_Pragma("unroll") \
            for (int ks = 0; ks < 2; ++ks) ka[ks] = lds16(lds, KTS + (16 * w + l16) * 144 + 64 * ks + fo); \
_Pragma("unroll") \
            for (int vt = 0; vt < 4; ++vt) \
_Pragma("unroll") \
                for (int ks = 0; ks < 2; ++ks) vb[vt][ks] = lds16(lds, VTS + (16 * vt + l16) * 144 + 64 * ks + fo); \
            const f32x4 dv = *(LAS f32x4*)(dL + 16 * w + quad * 4); \
            __builtin_amdgcn_sched_barrier(0); \
            f32x4 o[2]; o[0] = (f32x4){0.f, 0.f, 0.f, 0.f}; o[1] = o[0]; \
_Pragma("unroll") \
            for (int ks = 0; ks < 2; ++ks) { o[0] = mfma16(va[0][ks], pb[ks], o[0]); o[1] = mfma16(va[1][ks], pb[ks], o[1]); } \
_Pragma("unroll") \
            for (int ks = 0; ks < 4; ++ks) { o[0] = mfma16(sa[0][ks], qb4[ks], o[0]); o[1] = mfma16(sa[1][ks], qb4[ks], o[1]); } \
_Pragma("unroll") \
            for (int ks = 0; ks < 2; ++ks) \
_Pragma("unroll") \
                for (int vt = 0; vt < 4; ++vt) S[vt] = mfma16(ka[ks], vb[vt][ks], S[vt]); \
            __builtin_amdgcn_sched_barrier(0); \
_Pragma("unroll") \
            for (int i = 0; i < 2; ++i) { const int vt = (w & 1) * 2 + i; u32x2 ov; ov.x = pk2(o[i][0], o[i][1]); ov.y = pk2(o[i][2], o[i][3]); \
                *(u32x2*)(ORAW + (row0 + q) * 2048 + 1024 + h * 256 + vs * 64 + 16 * vt + quad * 4) = ov; } \
_Pragma("unroll") \
            for (int vt = 0; vt < 4; ++vt) S[vt] = S[vt] * dv; \
        } \
        BAR_LDS(); \
    } while (0)
    GLA_LOAD(0, A); GLA_LOAD(1, B);
    for (int c = 0; c < 256; c += 2) {
        GLA_PUT(A); if (c + 2 < 256) GLA_LOAD(c + 2, A); GLA_COMPUTE(c);
        GLA_PUT(B); if (c + 3 < 256) GLA_LOAD(c + 3, B); GLA_COMPUTE(c + 1);
    }
#undef GLA_PUT
#undef GLA_COMPUTE
#undef GLA_LOAD
}

#define UNPACK16(a, b, v) do { v[0] = bflo(a.x); v[1] = bfhi(a.x); v[2] = bflo(a.y); v[3] = bfhi(a.y); v[4] = bflo(a.z); v[5] = bfhi(a.z); v[6] = bflo(a.w); v[7] = bfhi(a.w); \
    v[8] = bflo(b.x); v[9] = bfhi(b.x); v[10] = bflo(b.y); v[11] = bfhi(b.y); v[12] = bflo(b.z); v[13] = bfhi(b.z); v[14] = bflo(b.w); v[15] = bfhi(b.w); } while (0)
DI void gate_rows(bf16* PROJ, bf16* ORAW, const float* ssd_norm, const float* gla_norm, int gw, int NGW, int lane) {
    for (int t0 = 2 * gw; t0 < T_; t0 += 2 * NGW) {
        u32x4 ya[2], yb[2], oa[2], ob[2], ra[2], rb[2];
#pragma unroll
        for (int u = 0; u < 2; ++u) { const size_t t = (size_t)t0 + u;
            const bf16* yp = PROJ + t * PROJ_LD + PC_Z + lane * 16; const bf16* op = ORAW + t * 2048 + 1024 + lane * 16; const bf16* rp = PROJ + t * PROJ_LD + PC_R + lane * 16;
            ya[u] = *(const u32x4*)yp; yb[u] = *(const u32x4*)(yp + 8); oa[u] = *(const u32x4*)op; ob[u] = *(const u32x4*)(op + 8); ra[u] = *(const u32x4*)rp; rb[u] = *(const u32x4*)(rp + 8); }
#pragma unroll
        for (int u = 0; u < 2; ++u) { const size_t t = (size_t)t0 + u;
            {   float v[16]; UNPACK16(ya[u], yb[u], v);
                float s = 0.f;
#pragma unroll
                for (int i = 0; i < 16; ++i) s += v[i] * v[i];
#pragma unroll
                for (int o = 1; o < 32; o <<= 1) s += __shfl_xor(s, o);
                const float rstd = rsqrtf(s * (1.f / 512.f) + EPS_);
                const float* nw = ssd_norm + lane * 16;
#pragma unroll
                for (int i = 0; i < 16; ++i) v[i] = v[i] * rstd * nw[i];
                u32x4 a, b; a.x = pk2(v[0], v[1]); a.y = pk2(v[2], v[3]); a.z = pk2(v[4], v[5]); a.w = pk2(v[6], v[7]); b.x = pk2(v[8], v[9]); b.y = pk2(v[10], v[11]); b.z = pk2(v[12], v[13]); b.w = pk2(v[14], v[15]);
                bf16* yp = ORAW + t * 2048 + lane * 16; *(u32x4*)yp = a; *(u32x4*)(yp + 8) = b; }
            {   float v[16], r[16]; UNPACK16(oa[u], ob[u], v); UNPACK16(ra[u], rb[u], r);
                float s = 0.f;
#pragma unroll
                for (int i = 0; i < 16; ++i) s += v[i] * v[i];
#pragma unroll
                for (int o = 1; o < 16; o <<= 1) s += __shfl_xor(s, o);
                const float rstd = rsqrtf(s * (1.f / 256.f) + EPS_);
                const float* nw = gla_norm + (lane & 15) * 16;
#pragma unroll
                for (int i = 0; i < 16; ++i) v[i] = v[i] * rstd * nw[i] * siluf(r[i]);
                u32x4 a, b; a.x = pk2(v[0], v[1]); a.y = pk2(v[2], v[3]); a.z = pk2(v[4], v[5]); a.w = pk2(v[6], v[7]); b.x = pk2(v[8], v[9]); b.y = pk2(v[10], v[11]); b.z = pk2(v[12], v[13]); b.w = pk2(v[14], v[15]);
                bf16* op = ORAW + t * 2048 + 1024 + lane * 16; *(u32x4*)op = a; *(u32x4*)(op + 8) = b; }
        }
    }
}

DI void attn_unit(int b, int ph, int qb, const bf16* QK, const bf16* VT, bf16* OATT, const float* NORMS, ldsp lds, int tid) {
    asm volatile("" : "+v"(tid));
    constexpr int KBUF = 9216, VBUF = 18432, KOFF = 0, VOFF = 2 * KBUF, WSOFF = 2 * KBUF + 2 * VBUF;
    const int lane = tid & 63, w = tid >> 6, r32 = lane & 31, hi = lane >> 5;
    const int q0 = qb * 256, head = ph >> 1;
    const size_t rowb = (size_t)b * L_;
    const float cs = exp2f(-(float)(head + 1)) * 1.4426950408889634f;
    LAS float* wsf = (LAS float*)(lds + WSOFF) + w * 64;
    bf16x8 qf[4];
    { const bf16* qp = QK + (rowb + q0 + 32 * w + r32) * QK_LD + ph * 64 + 8 * hi;
#pragma unroll
      for (int ks = 0; ks < 4; ++ks) qf[ks] = *(const bf16x8*)(qp + 16 * ks); }
    asm volatile("s_waitcnt vmcnt(0)" : "+v"(qf[0]), "+v"(qf[1]), "+v"(qf[2]), "+v"(qf[3]) :: "memory");
    const int qpos = q0 + 32 * w + r32;
    const int rsw = ((r32 >> 3) & 1) * 8;
    f32x16 o[4];
#pragma unroll
    for (int d = 0; d < 4; ++d)
#pragma unroll
        for (int r = 0; r < 16; ++r) o[d][r] = 0.f;
    float l_run = 0.f;
    const float Bq = sqrtf(NORMS[b * 32 + ph] * NORMS[b * 32 + 16 + ph]);
    const float Wn = (150.f + 2.f * Bq) / cs;
    const float sk = ((float)(q0 - 63) - Wn) * (1.f / 64.f);
    int t_begin = (sk >= 0.f) ? (int)floorf(sk) + 1 : 0;
    t_begin = __builtin_amdgcn_readfirstlane(t_begin);
    const int t_end = (q0 + 256) / 64;
    float m_run = cs * (float)(64 * t_begin - q0);
    const int klane = r32 * 144 + 16 * hi, vlane = r32 * 144 + 16 * hi;
    const float cs_h = bf2f(pk2(cs, 0.f) & 0xffffu);
    const unsigned csw = (hi == 0) ? pk2(cs_h, cs - cs_h) : 0u;
    bf16x8 kext0, kext1;
    { u32x4 e0, e1; e0.x = (hi == 0) ? pk2((float)r32, (float)r32) : 0u; e0.y = (hi == 0) ? pk2(1.f, 1.f) : 0u; e0.z = 0u; e0.w = 0u;
      e1 = e0; e1.x = (hi == 0) ? pk2((float)(r32 + 32), (float)(r32 + 32)) : 0u; kext0 = __builtin_bit_cast(bf16x8, e0); kext1 = __builtin_bit_cast(bf16x8, e1); }
    const int kr = tid >> 3, kc = tid & 7;
    const bf16* ksrc = QK + (rowb + kr) * QK_LD + 1024 + ph * 64 + kc * 8;
    const bf16* vsrc0 = VT + (size_t)(head * 128 + kr) * VT_LD + rowb + kc * 8;
    const bf16* vsrc1 = VT + (size_t)(head * 128 + 64 + kr) * VT_LD + rowb + kc * 8;
    const int kdst = KOFF + kr * 144 + kc * 16, vdst0 = VOFF + kr * 144 + kc * 16, vdst1 = VOFF + (64 + kr) * 144 + kc * 16;
    u32x4 pk_, pv0, pv1;
    pk_ = *(const u32x4*)(ksrc + (size_t)t_begin * 64 * QK_LD); pv0 = *(const u32x4*)(vsrc0 + t_begin * 64); pv1 = *(const u32x4*)(vsrc1 + t_begin * 64);
    const int vp0 = (16 * (kc >> 1) + 4 * (kc & 1)) * 2, vp1 = vp0 + 16;
#define VSWZ(v) (v)
    __syncthreads();
    *(LAS u32x4*)(lds + kdst) = pk_;
    { *(LAS u32x2*)(lds + VOFF + kr * 144 + vp0) = (u32x2){pv0.x, pv0.y}; *(LAS u32x2*)(lds + VOFF + kr * 144 + vp1) = (u32x2){pv0.z, pv0.w};
      *(LAS u32x2*)(lds + VOFF + (64 + kr) * 144 + vp0) = (u32x2){pv1.x, pv1.y}; *(LAS u32x2*)(lds + VOFF + (64 + kr) * 144 + vp1) = (u32x2){pv1.z, pv1.w}; }
    __syncthreads();
#define ATTN_TILE(t_, buf_) do { \
        const int kbase = 64 * (t_); \
        if (kbase <= q0 + 32 * w + 31) { \
            const int kb = KOFF + (buf_) * KBUF + klane, vb = VOFF + (buf_) * VBUF + vlane; \
              \
            const float nm = cs * (float)(kbase - q0) - m_run; \
            const float nmh = bf2f(pk2(nm, 0.f) & 0xffffu); \
            u32x4 qe; qe.x = csw; qe.y = (hi == 0) ? pk2(nmh, nm - nmh) : 0u; qe.z = 0u; qe.w = 0u; \
            const bf16x8 qef = __builtin_bit_cast(bf16x8, qe); \
            bf16x8 kf0[4], kf1[4]; \
            _Pragma("unroll") \
            for (int ks = 0; ks < 4; ++ks) { kf0[ks] = lds16(lds, kb + 32 * ks); kf1[ks] = lds16(lds, kb + 32 * 144 + 32 * ks); } \
            __builtin_amdgcn_sched_barrier(0); \
            f32x16 s0, s1; \
            _Pragma("unroll") \
            for (int r = 0; r < 16; ++r) { s0[r] = 0.f; s1[r] = 0.f; } \
            s0 = mfma32(kext0, qef, s0); s1 = mfma32(kext1, qef, s1); \
            _Pragma("unroll") \
            for (int ks = 0; ks < 4; ++ks) { s0 = mfma32(kf0[ks], qf[ks], s0); s1 = mfma32(kf1[ks], qf[ks], s1); } \
            __builtin_amdgcn_sched_barrier(0); \
            asm volatile("s_nop 15\n\ts_nop 7" : "+v"(s0), "+v"(s1));     \
            if (kbase + 63 > q0 + 32 * w) { \
                _Pragma("unroll") \
                for (int r = 0; r < 16; ++r) { const int key = kbase + 4 * hi + (r & 3) + 8 * (r >> 2); if (key > qpos) s0[r] = -INFINITY; if (key + 32 > qpos) s1[r] = -INFINITY; } \
            } \
            float mx = s0[0], mx2 = s1[0]; \
            _Pragma("unroll") \
            for (int r = 1; r < 16; r += 2) { mx = max3f(mx, s0[r], s1[r]); if (r + 1 < 16) mx2 = max3f(mx2, s0[r + 1], s1[r + 1]); } \
            mx = max3f(mx, mx2, mx2); \
            mx = fmaxf(mx, __shfl_xor(mx, 32)); \
            if (__any(mx > 8.f)) { \
                const float dl = fmaxf(mx, 0.f); \
                const float alpha = __builtin_amdgcn_exp2f(-dl); \
                l_run *= alpha; m_run += dl; \
                _Pragma("unroll") \
                for (int r = 0; r < 16; ++r) { s0[r] -= dl; s1[r] -= dl; } \
                if (hi == 0) wsf[r32] = alpha; \
                LDS_FENCE(); \
                _Pragma("unroll") \
                for (int r = 0; r < 16; ++r) { const float a = wsf[crow(r, hi)]; \
                    _Pragma("unroll") \
                    for (int d = 0; d < 4; ++d) o[d][r] *= a; } \
            } \
            float rs = 0.f; \
            _Pragma("unroll") \
            for (int r = 0; r < 16; ++r) { s0[r] = __builtin_amdgcn_exp2f(s0[r]); s1[r] = __builtin_amdgcn_exp2f(s1[r]); rs += s0[r] + s1[r]; } \
            rs += __shfl_xor(rs, 32); \
            l_run += rs; \
            bf16x8 pa[2][2]; \
            _Pragma("unroll") \
            for (int s = 0; s < 2; ++s) { \
                u32x4 p0, p1; \
                p0.x = pk2(s0[8 * s + 0], s0[8 * s + 1]); p0.y = pk2(s0[8 * s + 2], s0[8 * s + 3]); p0.z = pk2(s0[8 * s + 4], s0[8 * s + 5]); p0.w = pk2(s0[8 * s + 6], s0[8 * s + 7]); \
                p1.x = pk2(s1[8 * s + 0], s1[8 * s + 1]); p1.y = pk2(s1[8 * s + 2], s1[8 * s + 3]); p1.z = pk2(s1[8 * s + 4], s1[8 * s + 5]); p1.w = pk2(s1[8 * s + 6], s1[8 * s + 7]); \
                pa[0][s] = __builtin_bit_cast(bf16x8, p0); pa[1][s] = __builtin_bit_cast(bf16x8, p1); \
            } \
            _Pragma("unroll") \
            for (int dh = 0; dh < 2; ++dh) { \
                bf16x8 vf[2][2][2]; \
                _Pragma("unroll") \
                for (int d2 = 0; d2 < 2; ++d2) \
                    _Pragma("unroll") \
                    for (int hf = 0; hf < 2; ++hf) \
                        _Pragma("unroll") \
                        for (int s = 0; s < 2; ++s) vf[d2][hf][s] = lds16(lds, vb + 4608 * (2 * dh + d2) + 64 * hf + 32 * s); \
                __builtin_amdgcn_sched_barrier(0); \
                _Pragma("unroll") \
                for (int hf = 0; hf < 2; ++hf) \
                    _Pragma("unroll") \
                    for (int s = 0; s < 2; ++s) \
                        _Pragma("unroll") \
                        for (int d2 = 0; d2 < 2; ++d2) o[2 * dh + d2] = mfma32(pa[hf][s], vf[d2][hf][s], o[2 * dh + d2]); \
                __builtin_amdgcn_sched_barrier(0); \
            } \
        } \
    } while (0)
#define ATTN_LOAD(t_, K_, V0_, V1_) do { K_ = *(const u32x4*)(ksrc + (size_t)(t_) * 64 * QK_LD); V0_ = *(const u32x4*)(vsrc0 + (t_) * 64); V1_ = *(const u32x4*)(vsrc1 + (t_) * 64); } while (0)
#define VT_PUT(off_, V_) do { *(LAS u32x2*)(lds + (off_) + vp0) = (u32x2){(V_).x, (V_).y}; *(LAS u32x2*)(lds + (off_) + vp1) = (u32x2){(V_).z, (V_).w}; } while (0)
#define ATTN_STORE(buf_, K_, V0_, V1_) do { *(LAS u32x4*)(lds + kdst + (buf_) * KBUF) = K_; VT_PUT(VOFF + (buf_) * VBUF + kr * 144, V0_); VT_PUT(VOFF + (buf_) * VBUF + (64 + kr) * 144, V1_); } while (0)
    u32x4 ak = pk_, av0 = pv0, av1 = pv1, bk = pk_, bv0 = pv0, bv1 = pv1;
    if (t_begin + 1 < t_end) ATTN_LOAD(t_begin + 1, ak, av0, av1);
    for (int t = t_begin; t < t_end; t += 2) {
        if (t + 2 < t_end) ATTN_LOAD(t + 2, bk, bv0, bv1);
        ATTN_TILE(t, 0);
        if (t + 1 < t_end) ATTN_STORE(1, ak, av0, av1);
        BAR_LDS();
        if (t + 1 < t_end) {
            if (t + 3 < t_end) ATTN_LOAD(t + 3, ak, av0, av1);
            ATTN_TILE(t + 1, 1);
            if (t + 2 < t_end) ATTN_STORE(0, bk, bv0, bv1);
            BAR_LDS();
        }
    }
#undef ATTN_TILE
#undef ATTN_LOAD
#undef ATTN_STORE
    LDS_FENCE();
    if (hi == 0) wsf[r32] = 1.f / l_run;
    LDS_FENCE();
    bf16* op = OATT + (rowb + q0 + 32 * w) * 2048 + ph * 128 + r32;
#pragma unroll
    for (int r = 0; r < 16; ++r) { const int qr = crow(r, hi); const float rl = wsf[qr];
#pragma unroll
        for (int d = 0; d < 4; ++d) op[(size_t)qr * 2048 + 32 * d] = (bf16)f2bf(o[d][r] * rl); }
#undef VSWZ
}

DI void qk_norms(const bf16* QK, float* NORMS, int gw, int NGW, int lane) {
    for (int b = 0; b < 2; ++b) {
        float mx = 0.f;
        for (int t = gw; t < L_; t += NGW) {
            const u32x4* p = (const u32x4*)(QK + ((size_t)b * L_ + t) * QK_LD + lane * 32);
            float s = 0.f;
#pragma unroll
            for (int i = 0; i < 4; ++i) { const u32x4 v = p[i];
                s += bflo(v.x) * bflo(v.x) + bfhi(v.x) * bfhi(v.x) + bflo(v.y) * bflo(v.y) + bfhi(v.y) * bfhi(v.y) + bflo(v.z) * bflo(v.z) + bfhi(v.z) * bfhi(v.z) + bflo(v.w) * bflo(v.w) + bfhi(v.w) * bfhi(v.w); }
            s += __shfl_xor(s, 1);
            mx = fmaxf(mx, s);
        }
        if (!(lane & 1)) atomicMax((unsigned*)NORMS + b * 32 + (lane >> 1), __float_as_uint(mx));
    }
}

DI void combine_rows(const bf16* OATT, bf16* OUT, const float* lq1, const float* lk1, const float* lq2, const float* lk2, const float* subln, float lam_init, int gw, int NGW, int lane) {
    const float e1 = __expf(wave_sum(lq1[lane] * lk1[lane])), e2 = __expf(wave_sum(lq2[lane] * lk2[lane]));
    const float lam = e1 - e2 + lam_init;
    const int head = lane >> 3, dv0 = (lane & 7) * 16;
    for (int t0 = 2 * gw; t0 < T_; t0 += 2 * NGW) {
        u32x4 A[2], B[2], C[2], Dd[2];
#pragma unroll
        for (int u = 0; u < 2; ++u) { const bf16* p1 = OATT + (size_t)(t0 + u) * 2048 + (2 * head) * 128 + dv0; const bf16* p2 = p1 + 128;
            A[u] = *(const u32x4*)p1; B[u] = *(const u32x4*)(p1 + 8); C[u] = *(const u32x4*)p2; Dd[u] = *(const u32x4*)(p2 + 8); }
#pragma unroll
        for (int u = 0; u < 2; ++u) {
            float v[16], q[16]; UNPACK16(A[u], B[u], v); UNPACK16(C[u], Dd[u], q);
            float s = 0.f;
#pragma unroll
            for (int i = 0; i < 16; ++i) { v[i] = v[i] - lam * q[i]; s += v[i] * v[i]; }
            s += __shfl_xor(s, 1); s += __shfl_xor(s, 2); s += __shfl_xor(s, 4);
            const float sc = rsqrtf(s * (1.f / 128.f) + EPS_) * (1.f - lam_init);
            const float* nw = subln + dv0;
            u32x4 oa, ob;
            oa.x = pk2(v[0] * sc * nw[0], v[1] * sc * nw[1]); oa.y = pk2(v[2] * sc * nw[2], v[3] * sc * nw[3]); oa.z = pk2(v[4] * sc * nw[4], v[5] * sc * nw[5]); oa.w = pk2(v[6] * sc * nw[6], v[7] * sc * nw[7]);
            ob.x = pk2(v[8] * sc * nw[8], v[9] * sc * nw[9]); ob.y = pk2(v[10] * sc * nw[10], v[11] * sc * nw[11]); ob.z = pk2(v[12] * sc * nw[12], v[13] * sc * nw[13]); ob.w = pk2(v[14] * sc * nw[14], v[15] * sc * nw[15]);
            bf16* qo = OUT + (size_t)(t0 + u) * 1024 + head * 128 + dv0;
            *(u32x4*)qo = oa; *(u32x4*)(qo + 8) = ob;
        }
    }
}

DI void softmax_rows256(bf16* S, int nrows, int gw, int NGW, int lane) {
    for (int r0 = gw * 4; r0 < nrows; r0 += NGW * 4) {
        u32x2 a[4];
#pragma unroll
        for (int i = 0; i < 4; ++i) a[i] = *((const u32x2*)(S + (size_t)(r0 + i) * 256) + lane);
#pragma unroll
        for (int i = 0; i < 4; ++i) {
            float v0 = bflo(a[i].x), v1 = bfhi(a[i].x), v2 = bflo(a[i].y), v3 = bfhi(a[i].y);
            const float mx = wave_max(fmaxf(fmaxf(v0, v1), fmaxf(v2, v3)));
            v0 = __expf(v0 - mx); v1 = __expf(v1 - mx); v2 = __expf(v2 - mx); v3 = __expf(v3 - mx);
            const float inv = 1.f / wave_sum((v0 + v1) + (v2 + v3));
            u32x2 o; o.x = pk2(v0 * inv, v1 * inv); o.y = pk2(v2 * inv, v3 * inv);
            *((u32x2*)(S + (size_t)(r0 + i) * 256) + lane) = o;
        }
    }
}

#define GAS __attribute__((address_space(1)))
#define XB_TMO      128
#define XB_XCNT(j)  (256  + 64 * (j))
#define XB_XSUB(j)  (1280 + 64 * (j))
#define XB_XGEN(j)  (2304 + 64 * (j))
#define XB_TOP      3328
#define XB_TOPGEN   3392
#define XCD_BAR_WORDS 3456
#define XB_SPIN_CAP (1u << 18)

__device__ __forceinline__ unsigned xb_ld(unsigned* p)              { return __hip_atomic_load(p, __ATOMIC_RELAXED, __HIP_MEMORY_SCOPE_AGENT); }
__device__ __forceinline__ unsigned xb_add(unsigned* p, unsigned v) { return __hip_atomic_fetch_add(p, v, __ATOMIC_RELAXED, __HIP_MEMORY_SCOPE_AGENT); }
__device__ __forceinline__ unsigned xb_xcc_id() { return (unsigned)__builtin_amdgcn_s_getreg((3 << 11) | 20) & 0xFu; }
#define XB_SPIN(cond, bar) do { unsigned _sp = 0; while (cond) { __builtin_amdgcn_s_sleep(1); \
    if ((++_sp & 255u) == 0u) { if (xb_ld(&(bar)[XB_TMO])) break; if (_sp > XB_SPIN_CAP) { atomicAdd(&(bar)[XB_TMO], 1u); break; } } } } while (0)

struct XcdBarrier {
    unsigned* bar; unsigned x;
    volatile LAS unsigned* st;
};

__device__ __forceinline__ XcdBarrier xcd_barrier_post(unsigned* bar, volatile LAS unsigned* st) {
    XcdBarrier b; b.bar = bar; b.x = xb_xcc_id(); b.st = st;
    if (threadIdx.x == 0) (void)xb_add(&bar[XB_XCNT(b.x)], 1u);
    return b;
}
__device__ __forceinline__ void xcd_barrier_complete(unsigned* bar, unsigned x, unsigned& nloc, unsigned& nx) {
    const unsigned G = gridDim.x * gridDim.y * gridDim.z;
    unsigned sum, cnt, mine, sp = 0u;
    for (;;) {
        sum = 0u; cnt = 0u; mine = 0u;
#pragma unroll
        for (unsigned j = 0; j < 16; ++j) { const unsigned c = xb_ld(&bar[XB_XCNT(j)]); sum += c; cnt += (c > 0u) ? 1u : 0u; mine = (j == x) ? c : mine; }
        if (sum == G) break;
        __builtin_amdgcn_s_sleep(1);
        if ((++sp & 255u) == 0u) { if (xb_ld(&bar[XB_TMO])) break; if (sp > XB_SPIN_CAP) { atomicAdd(&bar[XB_TMO], 1u); break; } }
    }
    nloc = mine > 0u ? mine : 1u; nx = cnt > 0u ? cnt : 1u;
}

__device__ __forceinline__ void xcd_barrier(const XcdBarrier& b) {
    asm volatile("s_waitcnt vmcnt(0)" ::: "memory");
    __syncthreads();
    if (threadIdx.x == 0) {
        unsigned* bar = b.bar;
        __builtin_amdgcn_s_waitcnt(0);
        unsigned nloc = b.st[0], nx = b.st[1];
        if (nloc == 0u) { xcd_barrier_complete(bar, b.x, nloc, nx); b.st[0] = nloc; b.st[1] = nx; }
        const unsigned old = xb_add(&bar[XB_XSUB(b.x)], 1u);
        const unsigned gen = old / nloc;
        if (old + 1u == (gen + 1u) * nloc) {
            __builtin_amdgcn_fence(__ATOMIC_RELEASE, "agent");
            asm volatile("s_waitcnt vmcnt(0)" ::: "memory");
            const unsigned og = xb_add(&bar[XB_TOP], 1u);
            const unsigned tg = og / nx;
            if (og + 1u == (tg + 1u) * nx) xb_add(&bar[XB_TOPGEN], 1u);
            else XB_SPIN(xb_ld(&bar[XB_TOPGEN]) == tg, bar);
            __builtin_amdgcn_fence(__ATOMIC_ACQUIRE, "agent");
            xb_add(&bar[XB_XGEN(b.x)], 1u);
            asm volatile("s_waitcnt vmcnt(0)" ::: "memory");
        } else {
            XB_SPIN(xb_ld(&bar[XB_XGEN(b.x)]) == gen, bar);
            __builtin_amdgcn_fence(__ATOMIC_ACQUIRE, "agent");
            asm volatile("s_waitcnt vmcnt(0)" ::: "memory");
        }
    }
    __syncthreads();
}

struct Args { const float* in[31]; float* out; unsigned char* ws; float lam_init[2]; int ph_lo, ph_hi; };
constexpr int NPL = 15, NPH = 4 * NPL + 1;

DI pg8::Gemm mk_gemm(const bf16* A, const bf16* Bt, int M, int N, int K, int lda, int ldb) {
    pg8::Gemm g; g.A = A; g.Bt = Bt; g.M = M; g.N = N; g.K = K; g.lda = lda; g.ldb = ldb; g.a_pn = 0; g.b_pn = (long)256 * ldb; g.b_b = 0; g.pm_per_b = 1 << 30; return g;
}
DI pg8::EpiU mk_store(bf16* O, int ldc, int act, int scale_cols, float scale) {
    pg8::EpiU e; e.mode = 0; e.O = O; e.ldc = ldc; e.act = act; e.scale_cols = scale_cols; e.scale = scale; e.small_out = nullptr; e.small_pn = -1; e.base = nullptr; e.baseb = nullptr; e.outb = nullptr; e.ssq = nullptr; e.nssq = nullptr; e.nmode = 0; e.smx = nullptr; return e;
}
DI pg8::EpiU mk_res(const float* base, const bf16* baseb, bf16* outb, float* ssq) {
    pg8::EpiU e; e.mode = 1; e.ssq = ssq; e.nssq = nullptr; e.nmode = 0; e.smx = nullptr; e.O = nullptr; e.ldc = D_; e.act = 0; e.scale_cols = 0; e.scale = 1.f; e.small_out = nullptr; e.small_pn = -1; e.base = base; e.baseb = baseb; e.outb = outb; return e;
}

__global__ void __launch_bounds__(512, 2) mega_fwd(Args a) {
    extern __shared__ __attribute__((aligned(16))) unsigned char lds_raw[];
    ldsp lds = (ldsp)lds_raw;
    cg::grid_group grid = cg::this_grid();
    volatile LAS unsigned* bst = (volatile LAS unsigned*)(lds + LDS_BYTES - 16);
    if (threadIdx.x < 4) bst[threadIdx.x] = 0u;
    __syncthreads();
    const XcdBarrier xbar = xcd_barrier_post((unsigned*)(a.ws + 4096), bst);
    const int G = gridDim.x, blk = blockIdx.x, NGW = G * 8;
    for (int ph = a.ph_lo; ph < a.ph_hi; ++ph) {
#define PHASE_IDS int tid = threadIdx.x; asm volatile("" : "+v"(tid)); const int lane = tid & 63, wave = __builtin_amdgcn_readfirstlane(tid >> 6), gw = blk * 8 + wave; (void)lane; (void)gw; (void)wave;
        unsigned char* ws = a.ws;
        bf16* XN = (bf16*)(ws + WS_XN); bf16* BIG = (bf16*)(ws + WS_BIG); bf16* VT = (bf16*)(ws + WS_VT); bf16* ORAW = (bf16*)a.out;   bf16* XR = (bf16*)(ws + WS_ORAW);
        float* SSQ_M = (float*)a.out; float* SSQ_X = (float*)(ws + WS_SMALL); float* SSQ_F = (float*)(ws + WS_SMALL + 2 * MiB);
        float* SMALL = (float*)(ws + WS_SMALL); bf16* MEMN = (bf16*)(ws + WS_MEMN); bf16* KX = (bf16*)(ws + WS_KX); bf16* VXT = (bf16*)(ws + WS_VXT);
        bf16* KT = (bf16*)(ws + WS_KT); float* DG = (float*)(ws + WS_DG); bf16* TAIL = (bf16*)(ws + WS_DG + 1 * MiB);
        bf16* WA = (bf16*)(ws + WS_WA); bf16* WV = (bf16*)(ws + WS_WV); bf16* WOUT = (bf16*)(ws + WS_WOUT); bf16* WQ = (bf16*)(ws + WS_WQ); bf16* WKV = (bf16*)(ws + WS_WKV);
        bf16* WXO = (bf16*)(ws + WS_WXO); bf16* W1 = (bf16*)(ws + WS_W1); bf16* W2 = (bf16*)(ws + WS_W2);
        bf16* QX = BIG; bf16* SP = BIG + (size_t)T_ * 1024; bf16* OX = BIG + (size_t)2 * T_ * 1024;
        bf16* OATT = (bf16*)(ws + WS_BIG + 132 * MiB);

        const int layer = ph / NPL, k = ph % NPL;
        const bool even = !(layer & 1); const int li = layer >> 1;
        bool did = true; int nj = 0;
        const bool x_in = (layer == 0 && k <= 5);
        if (ph == NPH - 1) { PHASE_IDS
            rms_rows_from_bf16<true>(XR, a.in[30], nullptr, a.out, T_, gw, NGW, lane);
        } else if (k == 0) { PHASE_IDS
            LAS float* scr = (LAS float*)(lds + wave * 16384);
            const float* wq = a.in[24] + (size_t)layer * 1024 * 1024; const float* wkv = a.in[25] + (size_t)layer * 1024 * 2048; const float* wxo = a.in[26] + (size_t)layer * 1024 * 1024;
            const float* w1 = a.in[28] + (size_t)layer * 1024 * 4096; const float* w2 = a.in[29] + (size_t)layer * 4096 * 1024;
            const int I_Q = 16 * 32, I_KV = 16 * 64, I_XO = 16 * 32, I_1 = 16 * 128, I_2 = 64 * 32;
            const int I_A = even ? 16 * 144 : 16 * 64, I_V = 16 * 32, I_O = even ? 32 * 32 : 16 * 32;
            const int NIT = I_Q + I_KV + I_XO + I_1 + I_2 + I_A + I_V + I_O;
            for (int it = gw; it < NIT; it += NGW) {
                int r = it;
                if (r < I_Q) { conv_item(wq, 1024, 1024, WQ, 1024, 0, 0, scr, r, lane, a.in[22] + (size_t)layer * 1024); continue; } r -= I_Q;
                if (r < I_KV) { conv_item(wkv, 2048, 1024, WKV, 2048, 0, 0, scr, r, lane); continue; } r -= I_KV;
                if (r < I_XO) { conv_item(wxo, 1024, 1024, WXO, 1024, 0, 0, scr, r, lane); continue; } r -= I_XO;
                if (r < I_1) { conv_item(w1, 4096, 1024, W1, 4096, 0, 0, scr, r, lane, a.in[27] + (size_t)layer * 1024); continue; } r -= I_1;
                if (r < I_2) { conv_item(w2, 1024, 4096, W2, 1024, 0, 0, scr, r, lane); continue; } r -= I_2;
                if (even) {
                    const float* win = a.in[3] + (size_t)li * 1024 * 5408; const float* wout = a.in[13] + (size_t)li * 2048 * 1024;
                    if (r < I_A) { conv_item(win, 5408, 1024, WA, 4608, 1, 0, scr, r, lane, a.in[2] + (size_t)li * 1024); continue; } r -= I_A;
                    if (r < I_V) { conv_item(win, 5408, 1024, WV, 1024, 0, 3344, scr, r, lane, a.in[2] + (size_t)li * 1024); continue; } r -= I_V;
                    conv_item(wout, 1024, 2048, WOUT, 1024, 0, 0, scr, r, lane);
                } else {
                    const float* wqkv = a.in[15] + (size_t)li * 1024 * 3072; const float* wo = a.in[21] + (size_t)li * 1024 * 1024;
                    if (r < I_A) { conv_item(wqkv, 3072, 1024, WA, 2048, 0, 0, scr, r, lane, a.in[14] + (size_t)li * 1024); continue; } r -= I_A;
                    if (r < I_V) { conv_item(wqkv, 3072, 1024, WV, 1024, 0, 2048, scr, r, lane, a.in[14] + (size_t)li * 1024); continue; } r -= I_V;
                    conv_item(wo, 1024, 1024, WOUT, 1024, 0, 0, scr, r, lane);
                }
            }
            if (layer == 0) xb_rows(a.in[0], XR, SSQ_M, T_, gw, NGW, lane);
            rms_rows_bf16(a.in[1], a.in[23] + (size_t)layer * 1024, MEMN, 512, gw, NGW, lane);
            if (blk == 0 && tid < 64) ((float*)ws)[tid] = 0.f;
        } else if (k == 1) { nj = 4;
        } else if (k == 2) { PHASE_IDS
            if (even) { for (int u = blk; u < T_ / 128; u += G) prep_unit(u, BIG, SMALL, KT, DG, TAIL, a.in[10] + (size_t)li * 16 * 512, a.in[11] + (size_t)li * 512, a.in[6] + li * 16, a.in[7] + li * 16, a.in[4] + (size_t)li * 4 * 1280, a.in[5] + (size_t)li * 1280, lds, tid); }
            else {
                qk_norms(BIG, (float*)ws, gw, NGW, lane);
                xcd_barrier(xbar);
                {
                    const int x = blk & 7, j = blk >> 3, bb = (x >> 1) & 1, br = x & 1, grp = x >> 2;
#pragma unroll 1
                    for (int u = 0; u < 8; ++u) { const int s = u >> 1; const int head = grp ? (s == 0 ? 6 : s == 1 ? 4 : s == 2 ? 3 : 2) : (s == 0 ? 7 : s == 1 ? 5 : s == 2 ? 1 : 0);
                        attn_unit(bb, 2 * head + br, (u & 1) ? j : 63 - j, BIG, VT, OATT, (const float*)ws, lds, tid); }
                }
            }
        } else if (k == 3) { PHASE_IDS
            if (even) {
                for (int j = blk; j < 64; j += G) {
                    if (j < 32) ssd_chain(j >> 4, j & 15, BIG, SMALL, TAIL, a.in[8] + li * 16, lds, tid);
                    else { const int i2 = j - 32; gla_chain(i2 >> 4, (i2 >> 2) & 3, i2 & 3, BIG, KT, VT, DG, ORAW, lds, tid); }
                }
            } else combine_rows(OATT, XN, a.in[16] + li * 64, a.in[17] + li * 64, a.in[18] + li * 64, a.in[19] + li * 64, a.in[20] + li * 128, a.lam_init[li], gw, NGW, lane);
        } else if (k == 4) { PHASE_IDS
            if (even) gate_rows(BIG, ORAW, a.in[9] + (size_t)li * 1024, a.in[12] + (size_t)li * 256, gw, NGW, lane);
            else nj = 1;
        } else if (k == 5) { if (even) nj = 1; else did = false;
        } else if (k == 6) { did = false;
        } else if (k == 9) { did = false;
        } else if (k == 12) { did = false;
        } else nj = 1;
        for (int j = 0; j < nj; ++j) { PHASE_IDS
            pg8::Gemm g = mk_gemm(XN, WA, T_, 1024, 1024, 1024, 1024); pg8::EpiU e = mk_store(BIG, 1024, 0, 0, 1.f);
            if (k == 1) {
                if (j == 0) { if (even) { g = mk_gemm(XR, WA, T_, 4608, 1024, 1024, 1024); e = mk_store(BIG, PROJ_LD, 0, 0, 1.f); e.small_out = SMALL; e.small_pn = 17; }
                              else { g = mk_gemm(XR, WA, T_, 2048, 1024, 1024, 1024); e = mk_store(BIG, QK_LD, 0, 1024, 0.125f * 1.4426950408889634f); }
                              e.nssq = SSQ_M; e.nmode = 1; }
                else if (j == 1) { g = mk_gemm(WV, XR, 1024, T_, 1024, 1024, 1024); e = mk_store(VT, VT_LD, 0, 0, 1.f); e.nssq = SSQ_M; e.nmode = 2; }
                else if (j == 2) { g = mk_gemm(MEMN, WKV, 512, 1024, 1024, 1024, 1024); e = mk_store(KX, 1024, 0, 0, 1.f); }
                else { g = mk_gemm(WKV + (size_t)1024 * 1024, MEMN, 1024, 512, 1024, 1024, 1024); e = mk_store(VXT, 512, 0, 0, 1.f); }
            } else if (k == 4) { g = mk_gemm(XN, WOUT, T_, 1024, 1024, 1024, 1024); e = mk_res(nullptr, XR, XR, SSQ_X);
            } else if (k == 5) {
                g = mk_gemm(ORAW, WOUT, T_, 1024, 2048, 2048, 2048); e = mk_res(nullptr, XR, XR, SSQ_X);
            } else if (k == 7) { g = mk_gemm(XR, WQ, T_, 1024, 1024, 1024, 1024); e = mk_store(QX, 1024, 0, 1024, 0.0625f); e.nssq = SSQ_X; e.nmode = 1;
            } else if (k == 8) { g = mk_gemm(QX, KX, T_, 1024, 256, 1024, 1024); g.a_pn = 256; g.b_pn = 256; g.b_b = (long)256 * 1024; g.pm_per_b = 64; e = mk_store(SP, 1024, 0, 0, 1.f); e.smx = (PG8_LAS float*)(lds + 131072);
            } else if (k == 10) { g = mk_gemm(SP, VXT, T_, 1024, 256, 1024, 512); g.a_pn = 256; g.b_pn = (long)256 * 512; g.b_b = 256; g.pm_per_b = 64; e = mk_store(OX, 1024, 0, 0, 1.f);
            } else if (k == 11) { g = mk_gemm(OX, WXO, T_, 1024, 1024, 1024, 1024); e = mk_res(nullptr, XR, XR, SSQ_F);
            } else if (k == 13) { g = mk_gemm(XR, W1, T_, 4096, 1024, 1024, 1024); e = mk_store(BIG, 4096, 1, 0, 1.f); e.nssq = SSQ_F; e.nmode = 1;
            } else if (k == 14) { g = mk_gemm(BIG, W2, T_, 1024, 4096, 4096, 4096); e = mk_res(nullptr, XR, XR, SSQ_M); }
            pg8::StaticOrder S; S.init(g.M, g.N, G, (blk + 64 * j * (j >= 2)) % G);
            pg8::gemm_phase<pg8::EpiU, pg8::StaticOrder, true, true>(lds, g, S, e, tid);
        }
        if (did && ph + 1 < a.ph_hi) { if (ph == 0) grid.sync(); else xcd_barrier(xbar); }
    }
}

extern "C" void kernel_launch(void* const* d_in, const int* in_sizes, int n_in, void* d_out, int out_size, void* d_ws, size_t ws_size, hipStream_t stream) {
    static int grid = 0;
    if (grid == 0) {
        if (n_in != 31 || out_size != T_ * D_ || ws_size < WS_END) { fprintf(stderr, "kernel_launch: unexpected problem (n_in %d out %d ws %zu)\n", n_in, out_size, ws_size); grid = -1; return; }
        int dev = 0, cus = 0, per_cu = 0;
        hipGetDevice(&dev); hipDeviceGetAttribute(&cus, hipDeviceAttributeMultiprocessorCount, dev);
        if (hipFuncSetAttribute((const void*)mega_fwd, hipFuncAttributeMaxDynamicSharedMemorySize, LDS_BYTES) != hipSuccess) { fprintf(stderr, "kernel_launch: hipFuncSetAttribute failed\n"); grid = -1; return; }
        if (hipOccupancyMaxActiveBlocksPerMultiprocessor(&per_cu, (const void*)mega_fwd, 512, LDS_BYTES) != hipSuccess || per_cu < 1) { fprintf(stderr, "kernel_launch: occupancy query says %d\n", per_cu); per_cu = 1; }
        (void)hipGetLastError();
        grid = cus;
        if (grid != 256) { fprintf(stderr, "kernel_launch: built for a 256-CU device (got %d)\n", cus); grid = -1; return; }
    }
    if (grid < 0) return;
    Args a{};
    for (int i = 0; i < 31; ++i) a.in[i] = (const float*)d_in[i];
    a.out = (float*)d_out; a.ws = (unsigned char*)d_ws;
    a.lam_init[0] = (float)(0.8 - 0.6 * exp(-0.3 * 1.0)); a.lam_init[1] = (float)(0.8 - 0.6 * exp(-0.3 * 3.0));
    a.ph_lo = 0; a.ph_hi = NPH;
#ifdef PROBE_PREFIX
    {
        Args p = a; p.ph_hi = PROBE_PREFIX; void* pargs[] = {&p};
        (void)hipMemsetAsync(d_ws, 0, 65536, stream);
        (void)hipLaunchCooperativeKernel((const void*)mega_fwd, dim3(grid), dim3(512), pargs, LDS_BYTES, stream);
    }
#endif
    if (hipMemsetAsync(d_ws, 0, 65536, stream) != hipSuccess) { fprintf(stderr, "kernel_launch: memset failed\n"); return; }
    void* args[] = {&a};
    hipError_t e = hipLaunchCooperativeKernel((const void*)mega_fwd, dim3(grid), dim3(512), args, LDS_BYTES, stream);
    if (e != hipSuccess) fprintf(stderr, "cooperative launch failed: %s (grid %d)\n", hipGetErrorString(e), grid);
}
```

```cpp
#include <hip/hip_runtime.h>
#include <hip/hip_cooperative_groups.h>
#include <cstdio>
#include <cstdint>
#include <cmath>
namespace cg = cooperative_groups;

namespace pg8 {
#define PG8_LAS __attribute__((address_space(3)))
typedef unsigned short bf16_t;
typedef short bf16x8 __attribute__((ext_vector_type(8)));
typedef float f32x4 __attribute__((ext_vector_type(4)));
typedef unsigned u32x4 __attribute__((ext_vector_type(4)));
constexpr int BM = 256, BK = 64, HALF = 128, HTB = HALF * BK * 2, STAGE_BYTES = 8 * HTB, NXCD = 8, WGM = 8;

__host__ __device__ __forceinline__ int lds_byte(int r, int c) { const int st = (r >> 4) * 2 + (c >> 5), rr = r & 15, cc = c & 31, ob = rr * 64 + cc * 2; return st * 1024 + (ob ^ (((ob >> 9) & 1) << 5)); }
__host__ __device__ __forceinline__ void stage_rc(int b, int& R, int& C) { const int st = b / 1024, sb = b % 1024, swz = sb ^ (((sb >> 9) & 1) << 5); R = (st >> 1) * 16 + swz / 64; C = (st & 1) * 32 + (swz % 64) / 2; }
__host__ __device__ __forceinline__ int perm32(int rho) { const int n = rho >> 4, i = rho & 15; return 8 * (i >> 2) + 4 * n + (i & 3); }

struct Unit { int pm, pn; };
struct Gemm { const bf16_t* A; const bf16_t* Bt; int M, N, K, lda, ldb; long a_pn, b_pn, b_b; int pm_per_b; };

struct StaticOrder {
    int nM, nN, nwg, G, c;
    __host__ __device__ void init(int M, int N, int G_, int c_) { nM = M / BM; nN = N / BM; nwg = nM * nN; G = G_; c = c_; }
    __host__ __device__ bool next(int i, Unit& u) const {
        const long L = (long)i * G + c; if (L >= nwg) return false;
        int wgid = (int)L; { const int q = nwg / NXCD, r = nwg % NXCD, xcd = wgid % NXCD, off = wgid / NXCD; wgid = (xcd < r ? xcd * (q + 1) : r * (q + 1) + (xcd - r) * q) + off; }
        const int nig = WGM * nN, gid = wgid / nig, fm = gid * WGM, gsz = (nM - fm) < WGM ? (nM - fm) : WGM;
        u.pm = fm + ((wgid % nig) % gsz); u.pn = (wgid % nig) / gsz; return true;
    }
    __device__ __forceinline__ void ptrs(const Unit& u, const Gemm& g, const char*& a, const char*& b) const {
        a = (const char*)(g.A + (size_t)u.pm * BM * g.lda + (size_t)u.pn * g.a_pn);
        b = (const char*)(g.Bt + (size_t)u.pn * g.b_pn + (size_t)(u.pm / g.pm_per_b) * g.b_b);
    }
    __device__ __forceinline__ void a_ready(const Unit&) const {}
    __device__ __forceinline__ void done(const Unit&) const {}
};

__device__ __forceinline__ unsigned cvt_pk_bf16(float lo, float hi) { unsigned r; asm volatile("v_cvt_pk_bf16_f32 %0, %1, %2" : "=v"(r) : "v"(lo), "v"(hi)); return r; }

__device__ __forceinline__ float rstd16(const float* p) {
    const f32x4 a = *(const f32x4*)p, b = *(const f32x4*)(p + 4), c = *(const f32x4*)(p + 8), d = *(const f32x4*)(p + 12);
    const float s = (((a[0] + a[1]) + (a[2] + a[3])) + ((b[0] + b[1]) + (b[2] + b[3]))) + (((c[0] + c[1]) + (c[2] + c[3])) + ((d[0] + d[1]) + (d[2] + d[3])));
    return rsqrtf(s * (1.f / 1024.f) + 1e-5f);
}
struct EpiU {
    static constexpr bool PERM = true, AFTER_DRAIN = false;
    int mode;
    bf16_t* O; int ldc; int act; int scale_cols; float scale;
    float* small_out; int small_pn;
    PG8_LAS float* smx;
    float* ssq; const float* nssq; int nmode;
    const float* base; const bf16_t* baseb; bf16_t* outb;
    __device__ __forceinline__ void operator()(const f32x4 (&acc)[2][2][4][2], const Unit& u, int wr, int wc, int fr, int fq) const {
        const int row0 = u.pm * BM + wr * 64 + fr; const int col0 = u.pn * BM + wc * 32 + 8 * fq;
        if (mode == 0) {
            if (smx) {
#pragma unroll
                for (int ai = 0; ai < 2; ++ai)
#pragma unroll
                    for (int m = 0; m < 4; ++m) { float mx = -INFINITY;
#pragma unroll
                        for (int bj = 0; bj < 2; ++bj)
#pragma unroll
                            for (int n = 0; n < 2; ++n)
#pragma unroll
                                for (int e = 0; e < 4; ++e) mx = fmaxf(mx, acc[ai][bj][m][n][e]);
                        mx = fmaxf(mx, __shfl_xor(mx, 16)); mx = fmaxf(mx, __shfl_xor(mx, 32));
                        if (fq == 0) smx[(ai * HALF + wr * 64 + m * 16 + fr) * 4 + wc] = mx; }
                asm volatile("s_waitcnt lgkmcnt(0)\n\ts_barrier" ::: "memory");
#pragma unroll
                for (int ai = 0; ai < 2; ++ai)
#pragma unroll
                    for (int m = 0; m < 4; ++m) { const int rl = ai * HALF + wr * 64 + m * 16 + fr;
                        const f32x4 q4 = *(PG8_LAS f32x4*)(smx + rl * 4); const float mx = fmaxf(fmaxf(q4[0], q4[1]), fmaxf(q4[2], q4[3]));
                        float sm = 0.f;
#pragma unroll
                        for (int bj = 0; bj < 2; ++bj)
#pragma unroll
                            for (int n = 0; n < 2; ++n)
#pragma unroll
                                for (int e = 0; e < 4; ++e) sm += __expf(acc[ai][bj][m][n][e] - mx);
                        sm += __shfl_xor(sm, 16); sm += __shfl_xor(sm, 32);
                        if (fq == 0) smx[1024 + rl * 4 + wc] = sm; }
                asm volatile("s_waitcnt lgkmcnt(0)\n\ts_barrier" ::: "memory");
#pragma unroll
                for (int ai = 0; ai < 2; ++ai)
#pragma unroll
                    for (int m = 0; m < 4; ++m) { const int rl = ai * HALF + wr * 64 + m * 16 + fr;
                        const f32x4 q4 = *(PG8_LAS f32x4*)(smx + rl * 4); const float mx = fmaxf(fmaxf(q4[0], q4[1]), fmaxf(q4[2], q4[3]));
                        const f32x4 l4 = *(PG8_LAS f32x4*)(smx + 1024 + rl * 4); const float inv = 1.f / ((l4[0] + l4[1]) + (l4[2] + l4[3]));
                        bf16_t* rowp = O + (size_t)(row0 + ai * HALF + m * 16) * ldc + col0;
#pragma unroll
                        for (int bj = 0; bj < 2; ++bj) { f32x4 v0, v1;
#pragma unroll
                            for (int e = 0; e < 4; ++e) { v0[e] = __expf(acc[ai][bj][m][0][e] - mx) * inv; v1[e] = __expf(acc[ai][bj][m][1][e] - mx) * inv; }
                            u32x4 w; w.x = cvt_pk_bf16(v0[0], v0[1]); w.y = cvt_pk_bf16(v0[2], v0[3]); w.z = cvt_pk_bf16(v1[0], v1[1]); w.w = cvt_pk_bf16(v1[2], v1[3]);
                            *(u32x4*)(rowp + bj * HALF) = w; } }
                return;
            }
            if (small_out && u.pn == small_pn) {
                if (wc == 0) {
#pragma unroll
                    for (int ai = 0; ai < 2; ++ai)
#pragma unroll
                        for (int m = 0; m < 4; ++m) { const int rr = row0 + ai * HALF + m * 16; const float rsc = (nmode == 1) ? rstd16(nssq + (size_t)rr * 16) : 1.f;
                            float* p = small_out + (size_t)rr * 32 + 8 * fq; *(f32x4*)p = acc[ai][0][m][0] * rsc; *(f32x4*)(p + 4) = acc[ai][0][m][1] * rsc; }
                }
                return;
            }
            f32x4 csc[2][2];
#pragma unroll
            for (int bj = 0; bj < 2; ++bj)
#pragma unroll
                for (int e = 0; e < 4; ++e) { csc[bj][0][e] = (nmode == 2) ? rstd16(nssq + (size_t)(col0 + bj * HALF + e) * 16) : 1.f; csc[bj][1][e] = (nmode == 2) ? rstd16(nssq + (size_t)(col0 + bj * HALF + 4 + e) * 16) : 1.f; }
#pragma unroll
            for (int ai = 0; ai < 2; ++ai)
#pragma unroll
                for (int m = 0; m < 4; ++m) { bf16_t* rowp = O + (size_t)(row0 + ai * HALF + m * 16) * ldc + col0;
                    const float rsc = (nmode == 1) ? rstd16(nssq + (size_t)(row0 + ai * HALF + m * 16) * 16) : 1.f;
#pragma unroll
                    for (int bj = 0; bj < 2; ++bj) { f32x4 v0 = acc[ai][bj][m][0] * rsc * csc[bj][0], v1 = acc[ai][bj][m][1] * rsc * csc[bj][1];
                        if (act == 1) {
#pragma unroll
                            for (int e = 0; e < 4; ++e) { float t0 = fmaxf(v0[e], 0.f), t1 = fmaxf(v1[e], 0.f); v0[e] = t0 * t0; v1[e] = t1 * t1; } }
                        const float sc = (col0 + bj * HALF < scale_cols) ? scale : 1.f;
                        v0 = v0 * sc; v1 = v1 * sc; u32x4 w; w.x = cvt_pk_bf16(v0[0], v0[1]); w.y = cvt_pk_bf16(v0[2], v0[3]); w.z = cvt_pk_bf16(v1[0], v1[1]); w.w = cvt_pk_bf16(v1[2], v1[3]);
                        *(u32x4*)(rowp + bj * HALF) = w; } }
        } else {
#pragma unroll
            for (int ai = 0; ai < 2; ++ai)
#pragma unroll
                for (int m = 0; m < 4; ++m) { const size_t off = (size_t)(row0 + ai * HALF + m * 16) * ldc + col0; float ss = 0.f;
#pragma unroll
                    for (int bj = 0; bj < 2; ++bj) { f32x4 b0, b1;
                        if (baseb) { const u32x4 wv = *(const u32x4*)(baseb + off + bj * HALF);
                            b0 = (f32x4){__builtin_bit_cast(float, wv.x << 16), __builtin_bit_cast(float, wv.x & 0xffff0000u), __builtin_bit_cast(float, wv.y << 16), __builtin_bit_cast(float, wv.y & 0xffff0000u)};
                            b1 = (f32x4){__builtin_bit_cast(float, wv.z << 16), __builtin_bit_cast(float, wv.z & 0xffff0000u), __builtin_bit_cast(float, wv.w << 16), __builtin_bit_cast(float, wv.w & 0xffff0000u)}; }
                        else { const float* bp = base + off + bj * HALF; b0 = *(const f32x4*)bp; b1 = *(const f32x4*)(bp + 4); }
                        const f32x4 x0 = b0 + acc[ai][bj][m][0], x1 = b1 + acc[ai][bj][m][1];
                        u32x4 w; w.x = cvt_pk_bf16(x0[0], x0[1]); w.y = cvt_pk_bf16(x0[2], x0[3]); w.z = cvt_pk_bf16(x1[0], x1[1]); w.w = cvt_pk_bf16(x1[2], x1[3]);
                        *(u32x4*)(outb + off + bj * HALF) = w;
                        ss += (x0[0] * x0[0] + x0[1] * x0[1]) + (x0[2] * x0[2] + x0[3] * x0[3]) + (x1[0] * x1[0] + x1[1] * x1[1]) + (x1[2] * x1[2] + x1[3] * x1[3]); }
                    ss += __shfl_xor(ss, 16); ss += __shfl_xor(ss, 32);
                    if (fq == 0) ssq[(size_t)(row0 + ai * HALF + m * 16) * 16 + u.pn * 4 + wc] = ss;
                }
        }
    }
};

template <class Epi, class Sched, bool ALIGN_EPI = false, bool SP2 = false>
__device__ __forceinline__ void gemm_phase(PG8_LAS unsigned char* lds, const Gemm g, const Sched& S, const Epi& E, const int tid) {
    const int wid = __builtin_amdgcn_readfirstlane(tid >> 6), lane = tid & 63, wr = wid >> 2, wc = wid & 3, fr = lane & 15, fq = lane >> 4;
    const int K = g.K, nt = K / BK;
    unsigned voffA[2], voffB[2];
#pragma unroll
    for (int i = 0; i < 2; ++i) { int R, C; stage_rc(tid * 16 + i * 8192, R, C); const int Rb = Epi::PERM ? ((R & ~31) + perm32(R & 31)) : R;
        voffA[i] = (unsigned)(R * g.lda + C) * 2u; voffB[i] = (unsigned)(Rb * g.ldb + C) * 2u; }
    const size_t kstep = (size_t)(BK * 2);
    const size_t hstepA = (size_t)HALF * g.lda * 2, hstepB = (size_t)HALF * g.ldb * 2;
    const unsigned ldsw = (unsigned)wid * 1024u;
    const int aoff = lds_byte(wr * 64 + fr, fq * 8), boff = lds_byte(wc * 32 + fr, fq * 8);
#define PG8_SA(b, h) (((b) * 2 + (h)) * HTB)
#define PG8_SB(b, h) ((4 + (b) * 2 + (h)) * HTB)
#define PG8_STAGE(bufoff, gbase, voff) do { _Pragma("unroll") for (int _i = 0; _i < 2; ++_i) \
        __builtin_amdgcn_global_load_lds((const unsigned*)((const char*)(gbase) + (voff)[_i]), (PG8_LAS unsigned*)(lds + (bufoff) + ldsw + _i * 8192), 16, 0, 0); } while (0)
#define PG8_LDA(dst, b, h) do { _Pragma("unroll") for (int m = 0; m < 4; ++m) _Pragma("unroll") for (int k = 0; k < 2; ++k) dst[m][k] = *(const PG8_LAS bf16x8*)(lds + PG8_SA(b, h) + aoff + m * 2048 + k * 1024); } while (0)
#define PG8_LDB(dst, b, h) do { _Pragma("unroll") for (int n = 0; n < 2; ++n) _Pragma("unroll") for (int k = 0; k < 2; ++k) dst[n][k] = *(const PG8_LAS bf16x8*)(lds + PG8_SB(b, h) + boff + n * 2048 + k * 1024); } while (0)
#define PG8_MMA(ai, bj, At, Bt) do { __builtin_amdgcn_s_setprio(1); _Pragma("unroll") for (int m = 0; m < 4; ++m) _Pragma("unroll") for (int n = 0; n < 2; ++n) _Pragma("unroll") for (int k = 0; k < 2; ++k) \
        acc[ai][bj][m][n] = __builtin_amdgcn_mfma_f32_16x16x32_bf16(Bt[n][k], At[m][k], acc[ai][bj][m][n], 0, 0, 0); __builtin_amdgcn_s_setprio(0); } while (0)
#define PG8_WAIT_V(n) asm volatile("s_waitcnt vmcnt(" #n ")" ::: "memory")
#define PG8_WAIT_L(n) asm volatile("s_waitcnt lgkmcnt(" #n ")" ::: "memory")
#define PG8_BAR __builtin_amdgcn_s_barrier()
#define PG8_SCHED __builtin_amdgcn_sched_barrier(0)
    Unit cur, nxt; int ui = 0;
    if (!S.next(0, cur)) return;
    f32x4 acc[2][2][4][2];
#pragma unroll
    for (int a = 0; a < 2; ++a)
#pragma unroll
        for (int b = 0; b < 2; ++b)
#pragma unroll
            for (int m = 0; m < 4; ++m)
#pragma unroll
                for (int n = 0; n < 2; ++n) acc[a][b][m][n] = (f32x4){0.f, 0.f, 0.f, 0.f};
    bf16x8 At[4][2], B0[2][2], B1[2][2];
    const char* cA; const char* cB; S.ptrs(cur, g, cA, cB);
    S.a_ready(cur);
    if constexpr (SP2) {
        PG8_STAGE(PG8_SB(0, 0), cB, voffB); PG8_STAGE(PG8_SB(0, 1), cB + hstepB, voffB); PG8_STAGE(PG8_SA(0, 0), cA, voffA); PG8_STAGE(PG8_SA(0, 1), cA + hstepA, voffA);
        if (wr == 1) PG8_BAR;
        PG8_WAIT_V(2); PG8_BAR;
        PG8_STAGE(PG8_SB(1, 0), cB + kstep, voffB); PG8_STAGE(PG8_SA(1, 0), cA + kstep, voffA); PG8_STAGE(PG8_SB(1, 1), cB + hstepB + kstep, voffB);
        PG8_WAIT_V(6); PG8_BAR;
    } else {
        PG8_STAGE(PG8_SB(0, 0), cB, voffB); PG8_STAGE(PG8_SA(0, 0), cA, voffA); PG8_STAGE(PG8_SB(0, 1), cB + hstepB, voffB); PG8_STAGE(PG8_SA(0, 1), cA + hstepA, voffA);
        if (wr == 1) PG8_BAR;
        PG8_WAIT_V(4); PG8_BAR;
        PG8_STAGE(PG8_SB(1, 0), cB + kstep, voffB); PG8_STAGE(PG8_SA(1, 0), cA + kstep, voffA); PG8_STAGE(PG8_SB(1, 1), cB + hstepB + kstep, voffB);
        PG8_WAIT_V(6); PG8_BAR;
    }
    for (;;) {
        const bool has_next = S.next(ui + 1, nxt);
        const char* nA = cA; const char* nB = cB; if (has_next) S.ptrs(nxt, g, nA, nB);
        for (int t = 0; t < nt; t += 2) {
            const bool last = (t == nt - 2);
            const char* a1 = cA + (size_t)(t + 1) * kstep;
            const char* a2 = last ? nA : cA + (size_t)(t + 2) * kstep; const char* b2 = last ? nB : cB + (size_t)(t + 2) * kstep;
            const char* a3 = a2 + kstep; const char* b3 = b2 + kstep;
            if (last && has_next) S.a_ready(nxt);
            if constexpr (SP2) {
            PG8_LDB(B0, 0, 0); PG8_LDB(B1, 0, 1); PG8_SCHED; PG8_LDA(At, 0, 0); PG8_STAGE(PG8_SA(1, 1), a1 + hstepA, voffA);
            PG8_WAIT_V(8); PG8_WAIT_L(0); PG8_BAR; PG8_MMA(0, 0, At, B0); PG8_MMA(0, 1, At, B1); PG8_BAR; PG8_SCHED;
            PG8_LDA(At, 0, 1); PG8_STAGE(PG8_SB(0, 0), b2, voffB); PG8_STAGE(PG8_SB(0, 1), b2 + hstepB, voffB); PG8_STAGE(PG8_SA(0, 0), a2, voffA);
            PG8_WAIT_V(8); PG8_WAIT_L(0); PG8_BAR; PG8_MMA(1, 0, At, B0); PG8_MMA(1, 1, At, B1); PG8_BAR; PG8_SCHED;
            PG8_LDB(B0, 1, 0); PG8_LDB(B1, 1, 1); PG8_SCHED; PG8_LDA(At, 1, 0); PG8_STAGE(PG8_SA(0, 1), a2 + hstepA, voffA);
            PG8_WAIT_V(8); PG8_WAIT_L(0); PG8_BAR; PG8_MMA(0, 0, At, B0); PG8_MMA(0, 1, At, B1); PG8_BAR; PG8_SCHED;
            PG8_LDA(At, 1, 1); PG8_STAGE(PG8_SB(1, 0), b3, voffB); PG8_STAGE(PG8_SB(1, 1), b3 + hstepB, voffB); PG8_STAGE(PG8_SA(1, 0), a3, voffA);
            PG8_WAIT_V(8); PG8_WAIT_L(0); PG8_BAR; PG8_MMA(1, 0, At, B0); PG8_MMA(1, 1, At, B1); PG8_BAR; PG8_SCHED;
            } else {
            PG8_LDB(B0, 0, 0); PG8_SCHED; PG8_LDA(At, 0, 0); PG8_STAGE(PG8_SA(1, 1), a1 + hstepA, voffA);
            PG8_WAIT_L(8); PG8_BAR; PG8_WAIT_L(0); PG8_MMA(0, 0, At, B0); PG8_BAR; PG8_SCHED;
            PG8_LDB(B1, 0, 1); PG8_STAGE(PG8_SB(0, 0), b2, voffB);
            PG8_BAR; PG8_WAIT_L(0); PG8_MMA(0, 1, At, B1); PG8_BAR;
            PG8_LDA(At, 0, 1); PG8_STAGE(PG8_SA(0, 0), a2, voffA);
            PG8_BAR; PG8_WAIT_L(0); PG8_MMA(1, 0, At, B0); PG8_BAR; PG8_SCHED;
            PG8_STAGE(PG8_SB(0, 1), b2 + hstepB, voffB);
            PG8_WAIT_V(6); PG8_BAR; PG8_MMA(1, 1, At, B1); PG8_BAR;
            PG8_LDB(B0, 1, 0); PG8_SCHED; PG8_LDA(At, 1, 0); PG8_STAGE(PG8_SA(0, 1), a2 + hstepA, voffA);
            PG8_WAIT_L(8); PG8_BAR; PG8_WAIT_L(0); PG8_MMA(0, 0, At, B0); PG8_BAR; PG8_SCHED;
            PG8_LDB(B1, 1, 1); PG8_STAGE(PG8_SB(1, 0), b3, voffB);
            PG8_BAR; PG8_WAIT_L(0); PG8_MMA(0, 1, At, B1); PG8_BAR;
            PG8_LDA(At, 1, 1); PG8_STAGE(PG8_SA(1, 0), a3, voffA);
            PG8_BAR; PG8_WAIT_L(0); PG8_MMA(1, 0, At, B0); PG8_BAR; PG8_SCHED;
            PG8_STAGE(PG8_SB(1, 1), b3 + hstepB, voffB);
            PG8_WAIT_V(6); PG8_BAR; PG8_MMA(1, 1, At, B1); PG8_BAR;
            }
        }
        if constexpr (ALIGN_EPI) { if (wr == 0) PG8_BAR; }
        if constexpr (!Epi::AFTER_DRAIN) { E(acc, cur, wr, wc, fr, fq); S.done(cur); }
        if (!has_next) break;
#pragma unroll
        for (int a = 0; a < 2; ++a)
#pragma unroll
            for (int b = 0; b < 2; ++b)
#pragma unroll
                for (int m = 0; m < 4; ++m)
#pragma unroll
                    for (int n = 0; n < 2; ++n) acc[a][b][m][n] = (f32x4){0.f, 0.f, 0.f, 0.f};
        cur = nxt; cA = nA; cB = nB; ++ui;
        if constexpr (ALIGN_EPI) { if (wr == 1) PG8_BAR; }
    }
    PG8_WAIT_V(0);
    if constexpr (!ALIGN_EPI) { if (wr == 0) PG8_BAR; }
    PG8_BAR;
    if constexpr (Epi::AFTER_DRAIN) { E.fused(acc, cur, wr, wc, fr, fq, lds, wid, lane); S.done(cur); }
#undef PG8_SA
#undef PG8_SB
#undef PG8_STAGE
#undef PG8_LDA
#undef PG8_LDB
#undef PG8_MMA
#undef PG8_WAIT_V
#undef PG8_WAIT_L
#undef PG8_BAR
#undef PG8_SCHED
}
}

#define LAS __attribute__((address_space(3)))
#define DI __device__ __forceinline__
typedef unsigned short bf16;
typedef short bf16x8 __attribute__((ext_vector_type(8)));
typedef short s16x4 __attribute__((ext_vector_type(4)));
typedef float f32x4 __attribute__((ext_vector_type(4)));
typedef float f32x16 __attribute__((ext_vector_type(16)));
typedef unsigned u32x4 __attribute__((ext_vector_type(4)));
typedef unsigned u32x2 __attribute__((ext_vector_type(2)));
typedef LAS unsigned char* ldsp;

constexpr int T_ = 32768, L_ = 16384, D_ = 1024;
constexpr float EPS_ = 1e-5f;
constexpr size_t MiB = (size_t)1 << 20;
constexpr size_t WS_W = 1 * MiB;
constexpr size_t WS_WA = WS_W, WS_WV = WS_W + 9 * MiB, WS_WOUT = WS_W + 11 * MiB, WS_WQ = WS_W + 15 * MiB, WS_WKV = WS_W + 17 * MiB,
                 WS_WXO = WS_W + 21 * MiB, WS_W1 = WS_W + 23 * MiB, WS_W2 = WS_W + 31 * MiB;
constexpr size_t WS_XN = 40 * MiB, WS_KT = WS_XN, WS_DG = WS_XN + 33 * MiB;
constexpr size_t WS_BIG = 104 * MiB, WS_VT = 376 * MiB, WS_ORAW = 441 * MiB, WS_SMALL = 505 * MiB, WS_MEMN = 509 * MiB, WS_KX = 510 * MiB, WS_VXT = 511 * MiB, WS_END = 512 * MiB;
constexpr int PROJ_LD = 4352;
constexpr int PC_Z = 0, PC_XBC = 1024, PC_Q = 2304, PC_K = 2816, PC_R = 3328;
constexpr int LDS_BYTES = 140 * 1024;
constexpr int VT_LD = T_ + 64, KT_LD = T_ + 64, QK_LD = 2048 + 64;

DI unsigned f2bf(float f) { unsigned u = __builtin_bit_cast(unsigned, f); return (u + 0x7fffu + ((u >> 16) & 1u)) >> 16; }
typedef float f32x2_t __attribute__((ext_vector_type(2))); typedef __bf16 bf16x2_t __attribute__((ext_vector_type(2)));
DI unsigned pk2(float lo, float hi) { f32x2_t v = {lo, hi}; bf16x2_t b = __builtin_convertvector(v, bf16x2_t); return __builtin_bit_cast(unsigned, b); }
DI float bf2f(unsigned h) { return __builtin_bit_cast(float, h << 16); }
DI float bflo(unsigned w) { return __builtin_bit_cast(float, w << 16); }
DI float bfhi(unsigned w) { return __builtin_bit_cast(float, w & 0xffff0000u); }
DI float wave_sum(float v) {
#pragma unroll
    for (int o = 1; o < 64; o <<= 1) v += __shfl_xor(v, o);
    return v;
}
DI float wave_max(float v) {
#pragma unroll
    for (int o = 1; o < 64; o <<= 1) v = fmaxf(v, __shfl_xor(v, o));
    return v;
}
DI float siluf(float x) { return x * __builtin_amdgcn_rcpf(1.f + __builtin_amdgcn_exp2f(-1.4426950408889634f * x)); }
DI float softplusf(float x) {
    const float e = __expf(-fabsf(x));
    const float l = (e < 0.01f) ? e * (1.f - e * (0.5f - e * (1.f / 3.f))) : __logf(1.f + e);
    return fmaxf(x, 0.f) + l;
}
DI bf16x8 lds16(ldsp p, int off) { return *(LAS bf16x8*)(p + off); }
DI s16x4 lds8(ldsp p, int off) { return *(LAS s16x4*)(p + off); }
DI bf16x8 cat8(s16x4 a, s16x4 b) { return __builtin_shufflevector(a, b, 0, 1, 2, 3, 4, 5, 6, 7); }
DI f32x4 mfma16(bf16x8 a, bf16x8 b, f32x4 c) { return __builtin_amdgcn_mfma_f32_16x16x32_bf16(a, b, c, 0, 0, 0); }
DI f32x16 mfma32(bf16x8 a, bf16x8 b, f32x16 c) { return __builtin_amdgcn_mfma_f32_32x32x16_bf16(a, b, c, 0, 0, 0); }
DI int crow(int r, int hi) { return (r & 3) + 8 * (r >> 2) + 4 * hi; }
DI float max3f(float a, float b, float c) { float r; asm("v_max3_f32 %0, %1, %2, %3" : "=v"(r) : "v"(a), "v"(b), "v"(c)); return r; }
#define LDS_FENCE() asm volatile("s_waitcnt lgkmcnt(0)" ::: "memory")

DI void rms_rows_bf16(const float* x, const float* w, bf16* out, int nrows, int gw, int NGW, int lane) {
    for (int m = 2 * gw; m < nrows; m += 2 * NGW) {
        const f32x4* xr0 = (const f32x4*)(x + (size_t)m * D_) + lane; const f32x4* xr1 = xr0 + D_ / 4;
        f32x4 v0[4], v1[4]; float s0 = 0.f, s1 = 0.f;
#pragma unroll
        for (int j = 0; j < 4; ++j) { v0[j] = xr0[64 * j]; v1[j] = xr1[64 * j]; }
#pragma unroll
        for (int j = 0; j < 4; ++j) { s0 += (v0[j].x * v0[j].x + v0[j].y * v0[j].y) + (v0[j].z * v0[j].z + v0[j].w * v0[j].w); s1 += (v1[j].x * v1[j].x + v1[j].y * v1[j].y) + (v1[j].z * v1[j].z + v1[j].w * v1[j].w); }
#pragma unroll
        for (int o = 1; o < 64; o <<= 1) { s0 += __shfl_xor(s0, o); s1 += __shfl_xor(s1, o); }
        const float r0 = rsqrtf(s0 * (1.f / D_) + EPS_), r1 = rsqrtf(s1 * (1.f / D_) + EPS_);
        u32x2* o0 = (u32x2*)(out + (size_t)m * D_) + lane; u32x2* o1 = o0 + D_ / 4;
#pragma unroll
        for (int j = 0; j < 4; ++j) { const f32x4 wv = ((const f32x4*)w)[lane + 64 * j];
            u32x2 a, b; a.x = pk2(v0[j].x * r0 * wv.x, v0[j].y * r0 * wv.y); a.y = pk2(v0[j].z * r0 * wv.z, v0[j].w * r0 * wv.w);
            b.x = pk2(v1[j].x * r1 * wv.x, v1[j].y * r1 * wv.y); b.y = pk2(v1[j].z * r1 * wv.z, v1[j].w * r1 * wv.w);
            o0[64 * j] = a; o1[64 * j] = b; }
    }
}
template <bool TO_F32> DI void rms_rows_from_bf16(const bf16* x, const float* w, bf16* outb, float* outf, int nrows, int gw, int NGW, int lane) {
    f32x4 wv[4];
#pragma unroll
    for (int j = 0; j < 4; ++j) wv[j] = ((const f32x4*)(w + lane * 16))[j];
    for (int m = 2 * gw; m < nrows; m += 2 * NGW) {
        u32x4 ra[2], rb[2];
#pragma unroll
        for (int u = 0; u < 2; ++u) { const u32x4* p = (const u32x4*)(x + (size_t)(m + u) * D_ + lane * 16); ra[u] = p[0]; rb[u] = p[1]; }
#pragma unroll
        for (int u = 0; u < 2; ++u) {
            float v[16];
            v[0] = bflo(ra[u].x); v[1] = bfhi(ra[u].x); v[2] = bflo(ra[u].y); v[3] = bfhi(ra[u].y); v[4] = bflo(ra[u].z); v[5] = bfhi(ra[u].z); v[6] = bflo(ra[u].w); v[7] = bfhi(ra[u].w);
            v[8] = bflo(rb[u].x); v[9] = bfhi(rb[u].x); v[10] = bflo(rb[u].y); v[11] = bfhi(rb[u].y); v[12] = bflo(rb[u].z); v[13] = bfhi(rb[u].z); v[14] = bflo(rb[u].w); v[15] = bfhi(rb[u].w);
            float s = 0.f;
#pragma unroll
            for (int i = 0; i < 16; ++i) s += v[i] * v[i];
            const float r = rsqrtf(wave_sum(s) * (1.f / D_) + EPS_);
#pragma unroll
            for (int i = 0; i < 16; ++i) v[i] = v[i] * r * wv[i >> 2][i & 3];
            if (TO_F32) { f32x4* o = (f32x4*)(outf + (size_t)(m + u) * D_ + lane * 16);
#pragma unroll
                for (int j = 0; j < 4; ++j) o[j] = (f32x4){v[4 * j], v[4 * j + 1], v[4 * j + 2], v[4 * j + 3]}; }
            else { u32x4 a, b; a.x = pk2(v[0], v[1]); a.y = pk2(v[2], v[3]); a.z = pk2(v[4], v[5]); a.w = pk2(v[6], v[7]); b.x = pk2(v[8], v[9]); b.y = pk2(v[10], v[11]); b.z = pk2(v[12], v[13]); b.w = pk2(v[14], v[15]);
                u32x4* o = (u32x4*)(outb + (size_t)(m + u) * D_ + lane * 16); o[0] = a; o[1] = b; }
        }
    }
}
DI void xb_rows(const float* x, bf16* out, float* ssq, int nrows, int gw, int NGW, int lane) {
    for (int m = gw; m < nrows; m += NGW) {
        const f32x4* xr = (const f32x4*)(x + (size_t)m * D_) + lane;
        f32x4 v[4]; float s = 0.f;
#pragma unroll
        for (int j = 0; j < 4; ++j) { v[j] = xr[64 * j]; s += (v[j].x * v[j].x + v[j].y * v[j].y) + (v[j].z * v[j].z + v[j].w * v[j].w); }
        s = wave_sum(s);
        u32x2* o8 = (u32x2*)(out + (size_t)m * D_) + lane;
#pragma unroll
        for (int j = 0; j < 4; ++j) { u32x2 o; o.x = pk2(v[j].x, v[j].y); o.y = pk2(v[j].z, v[j].w); o8[64 * j] = o; }
        if (lane < 16) ssq[(size_t)m * 16 + lane] = (lane == 0) ? s : 0.f;
    }
}
DI void rms_rows_f32_inplace(float* x, const float* w, int nrows, int gw, int NGW, int lane) {
    for (int m = gw; m < nrows; m += NGW) {
        f32x4* xr = (f32x4*)(x + (size_t)m * D_) + lane;
        f32x4 v[4]; float s = 0.f;
#pragma unroll
        for (int j = 0; j < 4; ++j) { v[j] = xr[64 * j]; s += (v[j].x * v[j].x + v[j].y * v[j].y) + (v[j].z * v[j].z + v[j].w * v[j].w); }
        const float rstd = rsqrtf(wave_sum(s) * (1.f / D_) + EPS_);
#pragma unroll
        for (int j = 0; j < 4; ++j) { const f32x4 wv = ((const f32x4*)w)[lane + 64 * j]; xr[64 * j] = v[j] * rstd * wv; }
    }
}

DI int map_plain(int d, int off) { return d + off; }
DI int map_win(int d) { if (d < 2304) return d; if (d < 3328) return d + 16; if (d < 4352) return d + 1056; if (d < 4368) return d - 4352 + 2304; if (d < 4384) return d; return -1; }
DI void conv_item(const float* W, int ldn, int K, bf16* WT, int nrows, int mode, int off, LAS float* scr, int item, int lane, const float* kscale = nullptr) {
    const int nblk = nrows / 32, kb = item / nblk, nb = item % nblk, k0 = 64 * kb, n0 = 32 * nb;
    const int d = n0 + (lane & 31); const int sc = mode ? map_win(d) : map_plain(d, off);
#pragma unroll 32
    for (int i = 0; i < 32; ++i) { const int kk = 2 * i + (lane >> 5); scr[kk * 33 + (lane & 31)] = sc >= 0 ? W[(size_t)(k0 + kk) * ldn + sc] : 0.f; }
    LDS_FENCE();
    const int c = lane & 7;
    f32x4 ka = (f32x4){1.f, 1.f, 1.f, 1.f}, kb2 = ka;
    if (kscale) { ka = *(const f32x4*)(kscale + k0 + 8 * c); kb2 = *(const f32x4*)(kscale + k0 + 8 * c + 4); }
#pragma unroll
    for (int j = 0; j < 4; ++j) { const int n = (lane >> 3) + 8 * j; const LAS float* s = scr + (8 * c) * 33 + n;
        u32x4 o; o.x = pk2(s[0 * 33] * ka[0], s[1 * 33] * ka[1]); o.y = pk2(s[2 * 33] * ka[2], s[3 * 33] * ka[3]); o.z = pk2(s[4 * 33] * kb2[0], s[5 * 33] * kb2[1]); o.w = pk2(s[6 * 33] * kb2[2], s[7 * 33] * kb2[3]);
        *(u32x4*)(WT + (size_t)(n0 + n) * K + k0 + 8 * c) = o; }
    LDS_FENCE();
}

DI void prep_unit(int unit, bf16* PROJ, float* SMALL, bf16* KT, float* DG, bf16* TAIL, const float* gla_w2, const float* gla_b, const float* dt_bias, const float* a_log,
                  const float* conv_w, const float* conv_b, ldsp lds, int tid) {
    asm volatile("" : "+v"(tid));
    const int rowbase = unit * 128;
    LAS float* sm = (LAS float*)lds; LAS float* dtL = (LAS float*)(lds + 16384);
    for (int i = tid; i < 128 * 32 / 4; i += 512) ((LAS f32x4*)sm)[i] = ((const f32x4*)(SMALL + (size_t)rowbase * 32))[i];
    __syncthreads();
    if (tid < 16) {
        const int h = tid; const float a = -__expf(a_log[h]), bias = dt_bias[h]; float cum = 0.f;
        for (int tt = 0; tt < 128; ++tt) { const float dtv = softplusf(sm[tt * 32 + h] + bias); cum += dtv * a; dtL[tt * 16 + h] = dtv;
            SMALL[((size_t)rowbase + tt) * 32 + h] = dtv; SMALL[((size_t)rowbase + tt) * 32 + 16 + h] = cum; }
    }
    {   const int col = tid;
        float w2c[16];
#pragma unroll
        for (int r = 0; r < 16; ++r) w2c[r] = gla_w2[r * 512 + col];
        const float bcol = gla_b[col];
        for (int sub = 0; sub < 2; ++sub) {
            float cum = 0.f;
#pragma unroll 1
            for (int g8 = 0; g8 < 8; ++g8) {
                unsigned qk[8];
                { const bf16* pq = PROJ + ((size_t)rowbase + sub * 64 + g8 * 8) * PROJ_LD + col;
#pragma unroll
                  for (int e = 0; e < 8; ++e) qk[e] = (unsigned)pq[(size_t)e * PROJ_LD + PC_Q] | ((unsigned)pq[(size_t)e * PROJ_LD + PC_K] << 16); }
                float kt[8];
#pragma unroll
                for (int e = 0; e < 8; ++e) {
                    const int tt = sub * 64 + g8 * 8 + e; const size_t row = (size_t)rowbase + tt;
                    float x = bcol;
#pragma unroll
                    for (int r = 0; r < 16; ++r) x += sm[tt * 32 + 16 + r] * w2c[r];
                    const float lg = (fminf(x, 0.f) - __logf(1.f + __expf(-fabsf(x)))) * 0.0625f;
                    cum += lg;
                    const float qv = bflo(qk[e]), kv = bfhi(qk[e]);
                    PROJ[row * PROJ_LD + PC_Q + col] = (bf16)f2bf(qv * __expf(cum) * 0.08838834764831845f);
                    kt[e] = kv * __expf(-cum);
                    PROJ[row * PROJ_LD + PC_K + col] = (bf16)f2bf(kt[e]);
                }
                u32x4 o; o.x = pk2(kt[0], kt[1]); o.y = pk2(kt[2], kt[3]); o.z = pk2(kt[4], kt[5]); o.w = pk2(kt[6], kt[7]);
                *(u32x4*)(KT + (size_t)col * KT_LD + rowbase + sub * 64 + g8 * 8) = o;
            }
            DG[(size_t)((rowbase >> 6) + sub) * 512 + col] = __expf(cum);
        }
    }
    const int tin = rowbase & (L_ - 1);
    __syncthreads();
#pragma unroll 1
    for (int i = 4; i >= 0; --i) { const int it = tid + 512 * i, pair = it % 640, slab = it / 640, c0 = 2 * pair;
        unsigned rw[35];
        bf16* base = PROJ + ((size_t)rowbase + 32 * slab) * PROJ_LD + PC_XBC + c0;
#pragma unroll
        for (int j = 0; j < 35; ++j) rw[j] = (tin + 32 * slab - 3 + j >= 0) ? *(const unsigned*)(base + (ptrdiff_t)(j - 3) * PROJ_LD) : 0u;
        float cw0[4], cw1[4];
#pragma unroll
        for (int j = 0; j < 4; ++j) { cw0[j] = conv_w[j * 1280 + c0]; cw1[j] = conv_w[j * 1280 + c0 + 1]; }
        const float cb0 = conv_b[c0], cb1 = conv_b[c0 + 1];
        const bool isx = c0 < 1024; const int hh = (c0 >> 6) & 15;
        __syncthreads();
#pragma unroll
        for (int r = 0; r < 32; ++r) { float a0 = cb0, a1 = cb1;
#pragma unroll
            for (int j = 0; j < 4; ++j) { a0 += cw0[j] * bflo(rw[r + j]); a1 += cw1[j] * bfhi(rw[r + j]); }
            a0 = siluf(a0); a1 = siluf(a1);
            const int row = 32 * slab + r;
            if (isx) { const float d = dtL[row * 16 + hh]; a0 *= d; a1 *= d; }
            bf16* dst = (row >= 125) ? TAIL + ((size_t)unit * 3 + (row - 125)) * 1280 + c0 : base + (size_t)r * PROJ_LD;
            *(unsigned*)dst = pk2(a0, a1); }
    }
    __syncthreads();
}

#define BAR_LDS() asm volatile("s_waitcnt lgkmcnt(0)\n\ts_barrier" ::: "memory")
DI void ssd_chain(int b, int h, bf16* PROJ, const float* SMALL, const bf16* TAIL, const float* d_skip, ldsp lds, int tid) {
    constexpr int CS = 0, BS = 18432, BWT = 36864, XDT = 54272, MS = 71680, SS = 106496, CUML = 115712, DTL = 116224;
    asm volatile("" : "+v"(tid));
    const int lane = tid & 63, w = __builtin_amdgcn_readfirstlane(tid >> 6), quad = lane >> 4, l16 = lane & 15;
    const int g = h >> 3, cp = lane & 31, th = lane >> 5, tb = 16 * w + 8 * th;
    LAS float* cumL = (LAS float*)(lds + CUML); LAS float* dtL = (LAS float*)(lds + DTL);
    int ch[3]; ch[0] = h * 64 + 2 * cp; ch[1] = 1024 + g * 64 + 2 * cp; ch[2] = 1152 + g * 64 + 2 * cp;
    const float Dh = d_skip[h];
    const int pi = w >> 1, q = 16 * w + l16;
    f32x4 S[2]; S[0] = (f32x4){0.f, 0.f, 0.f, 0.f}; S[1] = S[0];
    unsigned raw[3][8]; float cmv[8], cum_last, cl_t = 0.f, dt_t = 0.f; u32x2 zz[4];
#define SSD_LOAD(c_) do { const size_t r0_ = (size_t)b * L_ + (size_t)(c_) * 128; \
        _Pragma("unroll") for (int i = 0; i < 8; ++i) cmv[i] = SMALL[(r0_ + tb + i) * 32 + 16 + h]; \
        cum_last = SMALL[(r0_ + 127) * 32 + 16 + h]; \
        if (tid < 128) { cl_t = SMALL[(r0_ + tid) * 32 + 16 + h]; dt_t = SMALL[(r0_ + tid) * 32 + h]; } \
        _Pragma("unroll") for (int arr = 0; arr < 3; ++arr) _Pragma("unroll") for (int i = 0; i < 8; ++i) { const int rr = tb + i; \
            const bf16* sp = (rr >= 125) ? TAIL + ((r0_ >> 7) * 3 + (rr - 125)) * 1280 + ch[arr] : PROJ + (r0_ + rr) * PROJ_LD + PC_XBC + ch[arr]; \
            raw[arr][i] = *(const unsigned*)sp; } \
        _Pragma("unroll") for (int pt = 0; pt < 4; ++pt) zz[pt] = *(const u32x2*)(PROJ + (r0_ + q) * PROJ_LD + PC_Z + h * 64 + 16 * pt + quad * 4); } while (0)
    SSD_LOAD(0);
    for (int c = 0; c < 128; ++c) {
        const size_t row0 = (size_t)b * L_ + (size_t)c * 128;
        if (tid < 128) { cumL[tid] = cl_t; dtL[tid] = dt_t; }
        {
            u32x4 v0, v1;
            v0.x = __builtin_amdgcn_perm(raw[0][1], raw[0][0], 0x05040100u); v0.y = __builtin_amdgcn_perm(raw[0][3], raw[0][2], 0x05040100u);
            v0.z = __builtin_amdgcn_perm(raw[0][5], raw[0][4], 0x05040100u); v0.w = __builtin_amdgcn_perm(raw[0][7], raw[0][6], 0x05040100u);
            v1.x = __builtin_amdgcn_perm(raw[0][1], raw[0][0], 0x07060302u); v1.y = __builtin_amdgcn_perm(raw[0][3], raw[0][2], 0x07060302u);
            v1.z = __builtin_amdgcn_perm(raw[0][5], raw[0][4], 0x07060302u); v1.w = __builtin_amdgcn_perm(raw[0][7], raw[0][6], 0x07060302u);
            *(LAS u32x4*)(lds + XDT + (2 * cp) * 272 + tb * 2) = v0; *(LAS u32x4*)(lds + XDT + (2 * cp + 1) * 272 + tb * 2) = v1;
        }
        {
            float o0[8], o1[8];
#pragma unroll
            for (int i = 0; i < 8; ++i) { *(LAS unsigned*)(lds + BS + (tb + i) * 144 + 4 * cp) = raw[1][i];
                const float wg = __expf(cum_last - cmv[i]); o0[i] = bflo(raw[1][i]) * wg; o1[i] = bfhi(raw[1][i]) * wg; }
            u32x4 v0, v1; v0.x = pk2(o0[0], o0[1]); v0.y = pk2(o0[2], o0[3]); v0.z = pk2(o0[4], o0[5]); v0.w = pk2(o0[6], o0[7]);
            v1.x = pk2(o1[0], o1[1]); v1.y = pk2(o1[2], o1[3]); v1.z = pk2(o1[4], o1[5]); v1.w = pk2(o1[6], o1[7]);
            *(LAS u32x4*)(lds + BWT + (2 * cp) * 272 + tb * 2) = v0; *(LAS u32x4*)(lds + BWT + (2 * cp + 1) * 272 + tb * 2) = v1;
        }
#pragma unroll
        for (int i = 0; i < 8; ++i) *(LAS unsigned*)(lds + CS + (tb + i) * 144 + 4 * cp) = raw[2][i];
        u32x2 zc[4];
#pragma unroll
        for (int pt = 0; pt < 4; ++pt) zc[pt] = zz[pt];
        if (c + 1 < 128) SSD_LOAD(c + 1);
        BAR_LDS();
        const float cq = cumL[q], dq = dtL[q];
        const int fo = quad * 16;
        {
            bf16x8 cb[2];
#pragma unroll
            for (int k = 0; k < 2; ++k) cb[k] = lds16(lds, CS + q * 144 + 64 * k + fo);
#pragma unroll
            for (int jh = 0; jh < 2; ++jh) {
                bf16x8 ba[4][2];
#pragma unroll
                for (int j4 = 0; j4 < 4; ++j4) if (4 * jh + j4 <= w) {
#pragma unroll
                    for (int k = 0; k < 2; ++k) ba[j4][k] = lds16(lds, BS + (16 * (4 * jh + j4) + l16) * 144 + 64 * k + fo); }
                __builtin_amdgcn_sched_barrier(0);
                f32x4 acc[4];
#pragma unroll
                for (int j4 = 0; j4 < 4; ++j4) { acc[j4] = (f32x4){0.f, 0.f, 0.f, 0.f};
                    if (4 * jh + j4 <= w) { acc[j4] = mfma16(ba[j4][0], cb[0], acc[j4]); acc[j4] = mfma16(ba[j4][1], cb[1], acc[j4]); } }
                __builtin_amdgcn_sched_barrier(0);
#pragma unroll
                for (int j4 = 0; j4 < 4; ++j4) {
                    const int s0 = 16 * (4 * jh + j4) + quad * 4;
                    const f32x4 cs = *(LAS f32x4*)(cumL + s0);
                    float v[4];
#pragma unroll
                    for (int jj = 0; jj < 4; ++jj) { const int s = s0 + jj; float t = (s <= q) ? acc[j4][jj] * __expf(cq - cs[jj]) : 0.f; if (s == q && dq > 0.f) t += Dh / dq; v[jj] = t; }
                    u32x2 o; o.x = pk2(v[0], v[1]); o.y = pk2(v[2], v[3]);
                    *(LAS u32x2*)(lds + MS + q * 272 + s0 * 2) = o;
                }
            }
        }
#pragma unroll
        for (int i = 0; i < 2; ++i) { const int ni = (w & 1) * 2 + i; u32x2 o; o.x = pk2(S[i][0], S[i][1]); o.y = pk2(S[i][2], S[i][3]);
            *(LAS u32x2*)(lds + SS + (16 * pi + l16) * 144 + (16 * ni + quad * 4) * 2) = o; }
        const float el = __expf(cumL[127]);
        BAR_LDS();
        const float eq = __expf(cq);
        {
            bf16x8 mb[4], cb[2];
#pragma unroll
            for (int ks = 0; ks < 4; ++ks) mb[ks] = lds16(lds, MS + q * 272 + 64 * ks + fo);
#pragma unroll
            for (int k = 0; k < 2; ++k) cb[k] = lds16(lds, CS + q * 144 + 64 * k + fo);
#pragma unroll
            for (int pt = 0; pt < 4; ++pt) {
                bf16x8 xa[4], sa[2];
#pragma unroll
                for (int ks = 0; ks < 4; ++ks) xa[ks] = lds16(lds, XDT + (16 * pt + l16) * 272 + 64 * ks + fo);
#pragma unroll
                for (int k = 0; k < 2; ++k) sa[k] = lds16(lds, SS + (16 * pt + l16) * 144 + 64 * k + fo);
                __builtin_amdgcn_sched_barrier(0);
                f32x4 y1 = (f32x4){0.f, 0.f, 0.f, 0.f}, y2 = y1;
#pragma unroll
                for (int ks = 0; ks < 4; ++ks) if (32 * ks < 16 * w + 16) y1 = mfma16(xa[ks], mb[ks], y1);
#pragma unroll
                for (int k = 0; k < 2; ++k) y2 = mfma16(sa[k], cb[k], y2);
                __builtin_amdgcn_sched_barrier(0);
                bf16* zp = PROJ + (row0 + q) * PROJ_LD + PC_Z + h * 64 + 16 * pt + quad * 4;
                const float z0 = bflo(zc[pt].x), z1 = bfhi(zc[pt].x), z2 = bflo(zc[pt].y), z3 = bfhi(zc[pt].y);
                u32x2 o; o.x = pk2((y1[0] + eq * y2[0]) * siluf(z0), (y1[1] + eq * y2[1]) * siluf(z1)); o.y = pk2((y1[2] + eq * y2[2]) * siluf(z2), (y1[3] + eq * y2[3]) * siluf(z3));
                *(u32x2*)zp = o;
            }
        }
        {
            bf16x8 xb[4], wa[2][4];
#pragma unroll
            for (int ks = 0; ks < 4; ++ks) xb[ks] = lds16(lds, XDT + (16 * pi + l16) * 272 + 64 * ks + fo);
#pragma unroll
            for (int i = 0; i < 2; ++i)
#pragma unroll
                for (int ks = 0; ks < 4; ++ks) wa[i][ks] = lds16(lds, BWT + (16 * ((w & 1) * 2 + i) + l16) * 272 + 64 * ks + fo);
            __builtin_amdgcn_sched_barrier(0);
            S[0] = S[0] * el; S[1] = S[1] * el;
#pragma unroll
            for (int ks = 0; ks < 4; ++ks) { S[0] = mfma16(wa[0][ks], xb[ks], S[0]); S[1] = mfma16(wa[1][ks], xb[ks], S[1]); }
        }
        BAR_LDS();
    }
#undef SSD_LOAD
}

DI void gla_chain(int b, int h, int vs, const bf16* PROJ, const bf16* KT, const bf16* VT, const float* DG, bf16* ORAW, ldsp lds, int tid) {
    constexpr int QS = 0, KS = 17408, KTS = 34816, VTS = 53248, PS = 62464, STS = 71680, DLO = 89088;
    asm volatile("" : "+v"(tid));
    const int lane = tid & 63, w = __builtin_amdgcn_readfirstlane(tid >> 6), quad = lane >> 4, l16 = lane & 15, qi = w >> 1;
    LAS float* dL = (LAS float*)(lds + DLO);
    f32x4 S[4];
#pragma unroll
    for (int i = 0; i < 4; ++i) S[i] = (f32x4){0.f, 0.f, 0.f, 0.f};
    u32x4 Aq[2], Ak[2], Akt[2], Av, Bq[2], Bk[2], Bkt[2], Bv; float Ad = 0.f, Bd = 0.f;
#define GLA_LOAD(c_, P) do { const size_t r0_ = (size_t)b * L_ + (size_t)(c_) * 64; \
        _Pragma("unroll") for (int i = 0; i < 2; ++i) { const int idx = tid + 512 * i, r = idx >> 4, cc = idx & 15; \
            P##q[i] = *(const u32x4*)(PROJ + (r0_ + r) * PROJ_LD + PC_Q + h * 128 + cc * 8); P##k[i] = *(const u32x4*)(PROJ + (r0_ + r) * PROJ_LD + PC_K + h * 128 + cc * 8); } \
        _Pragma("unroll") for (int i = 0; i < 2; ++i) { const int idx = tid + 512 * i, r = idx >> 3, cc = idx & 7; P##kt[i] = *(const u32x4*)(KT + (size_t)(h * 128 + r) * KT_LD + r0_ + cc * 8); } \
        { const int r = tid >> 3, cc = tid & 7; P##v = *(const u32x4*)(VT + (size_t)(h * 256 + vs * 64 + r) * VT_LD + r0_ + cc * 8); } \
        if (tid < 128) P##d = DG[(r0_ >> 6) * 512 + h * 128 + tid]; } while (0)
#define GLA_PUT(P) do { \
        _Pragma("unroll") for (int i = 0; i < 2; ++i) { const int idx = tid + 512 * i, r = idx >> 4, cc = idx & 15; \
            *(LAS u32x4*)(lds + QS + r * 272 + cc * 16) = P##q[i]; *(LAS u32x4*)(lds + KS + r * 272 + cc * 16) = P##k[i]; } \
        _Pragma("unroll") for (int i = 0; i < 2; ++i) { const int idx = tid + 512 * i, r = idx >> 3, cc = idx & 7; *(LAS u32x4*)(lds + KTS + r * 144 + cc * 16) = P##kt[i]; } \
        { const int r = tid >> 3, cc = tid & 7; *(LAS u32x4*)(lds + VTS + r * 144 + cc * 16) = P##v; } \
        if (tid < 128) dL[tid] = P##d; } while (0)
#define GLA_COMPUTE(c_) do { \
        const size_t row0 = (size_t)b * L_ + (size_t)(c_) * 64; \
        BAR_LDS(); \
        const int q = 16 * qi + l16; \
        const int fo = quad * 16; \
        { \
            bf16x8 fb[4], fa[2][4]; \
_Pragma("unroll") \
            for (int ks = 0; ks < 4; ++ks) fb[ks] = lds16(lds, QS + q * 272 + 64 * ks + fo); \
_Pragma("unroll") \
            for (int i = 0; i < 2; ++i) \
_Pragma("unroll") \
                for (int ks = 0; ks < 4; ++ks) fa[i][ks] = lds16(lds, KS + (16 * ((w & 1) * 2 + i) + l16) * 272 + 64 * ks + fo); \
            __builtin_amdgcn_sched_barrier(0); \
            f32x4 acc[2]; acc[0] = (f32x4){0.f, 0.f, 0.f, 0.f}; acc[1] = acc[0]; \
_Pragma("unroll") \
            for (int ks = 0; ks < 4; ++ks) { acc[0] = mfma16(fa[0][ks], fb[ks], acc[0]); acc[1] = mfma16(fa[1][ks], fb[ks], acc[1]); } \
            __builtin_amdgcn_sched_barrier(0); \
_Pragma("unroll") \
            for (int i = 0; i < 2; ++i) { const int s0 = 16 * ((w & 1) * 2 + i) + quad * 4; \
                u32x2 o; o.x = pk2(s0 <= q ? acc[i][0] : 0.f, s0 + 1 <= q ? acc[i][1] : 0.f); o.y = pk2(s0 + 2 <= q ? acc[i][2] : 0.f, s0 + 3 <= q ? acc[i][3] : 0.f); \
                *(LAS u32x2*)(lds + PS + q * 144 + s0 * 2) = o; } \
        } \
_Pragma("unroll") \
        for (int vt = 0; vt < 4; ++vt) { u32x2 o; o.x = pk2(S[vt][0], S[vt][1]); o.y = pk2(S[vt][2], S[vt][3]); \
            *(LAS u32x2*)(lds + STS + (16 * vt + l16) * 272 + (16 * w + quad * 4) * 2) = o; } \
        BAR_LDS(); \
        { \
            bf16x8 pb[2], qb4[4], va[2][2], sa[2][4], ka[2], vb[4][2]; \
_Pragma("unroll") \
            for (int ks = 0; ks < 2; ++ks) pb[ks] = lds16(lds, PS + q * 144 + 64 * ks + fo); \
_Pragma("unroll") \
            for (int ks = 0; ks < 4; ++ks) qb4[ks] = lds16(lds, QS + q * 272 + 64 * ks + fo); \
_Pragma("unroll") \
            for (int i = 0; i < 2; ++i) { const int vt = (w & 1) * 2 + i; \
_Pragma("unroll") \
                for (int ks = 0; ks < 2; ++ks) va[i][ks] = lds16(lds, VTS + (16 * vt + l16) * 144 + 64 * ks + fo); \
_Pragma("unroll") \
                for (int ks = 0; ks < 4; ++ks) sa[i][ks] = lds16(lds, STS + (16 * vt + l16) * 272 + 64 * ks + fo); } \
_Pragma("unroll") \
            for (int ks = 0; ks < 2; ++ks) ka[ks] = lds16(lds, KTS + (16 * w + l16) * 144 + 64 * ks + fo); \
_Pragma("unroll") \
            for (int vt = 0; vt < 4; ++vt) \
_Pragma("unroll") \
                for (int ks = 0; ks < 2; ++ks) vb[vt][ks] = lds16(lds, VTS + (16 * vt + l16) * 144 + 64 * ks + fo); \
            const f32x4 dv = *(LAS f32x4*)(dL + 16 * w + quad * 4); \
            __builtin_amdgcn_sched_barrier(0); \
            f32x4 o[2]; o[0] = (f32x4){0.f, 0.f, 0.f, 0.f}; o[1] = o[0]; \
_Pragma("unroll") \
            for (int ks = 0; ks < 2; ++ks) { o[0] = mfma16(va[0][ks], pb[ks], o[0]); o[1] = mfma16(va[1][ks], pb[ks], o[1]); } \
_Pragma("unroll") \
            for (int ks = 0; ks < 4; ++ks) { o[0] = mfma16(sa[0][ks], qb4[ks], o[0]); o[1] = mfma16(sa[1][ks], qb4[ks], o[1]); } \
_Pragma("unroll") \
            for (int ks = 0; ks < 2; ++ks) \
_Pragma("unroll") \
                for (int vt = 0; vt < 4; ++vt) S[vt] = mfma16(ka[ks], vb[vt][ks], S[vt]); \
            __builtin_amdgcn_sched_barrier(0); \
_Pragma("unroll") \
            for (int i = 0; i < 2; ++i) { const int vt = (w & 1) * 2 + i; u32x2 ov; ov.x = pk2(o[i][0], o[i][1]); ov.y = pk2(o[i][2], o[i][3]); \
                *(u32x2*)(ORAW + (row0 + q) * 2048 + 1024 + h * 256 + vs * 64 + 16 * vt + quad * 4) = ov; } \
_Pragma("unroll") \
            for (int vt = 0; vt < 4; ++vt) S[vt] = S[vt] * dv; \
        } \
        BAR_LDS(); \
    } while (0)
    GLA_LOAD(0, A); GLA_LOAD(1, B);
    for (int c = 0; c < 256; c += 2) {
        GLA_PUT(A); if (c + 2 < 256) GLA_LOAD(c + 2, A); GLA_COMPUTE(c);
        GLA_PUT(B); if (c + 3 < 256) GLA_LOAD(c + 3, B); GLA_COMPUTE(c + 1);
    }
#undef GLA_PUT
#undef GLA_COMPUTE
#undef GLA_LOAD
}

#define UNPACK16(a, b, v) do { v[0] = bflo(a.x); v[1] = bfhi(a.x); v[2] = bflo(a.y); v[3] = bfhi(a.y); v[4] = bflo(a.z); v[5] = bfhi(a.z); v[6] = bflo(a.w); v[7] = bfhi(a.w); \
    v[8] = bflo(b.x); v[9] = bfhi(b.x); v[10] = bflo(b.y); v[11] = bfhi(b.y); v[12] = bflo(b.z); v[13] = bfhi(b.z); v[14] = bflo(b.w); v[15] = bfhi(b.w); } while (0)
DI void gate_rows(bf16* PROJ, bf16* ORAW, const float* ssd_norm, const float* gla_norm, int gw, int NGW, int lane) {
    for (int t0 = 2 * gw; t0 < T_; t0 += 2 * NGW) {
        u32x4 ya[2], yb[2], oa[2], ob[2], ra[2], rb[2];
#pragma unroll
        for (int u = 0; u < 2; ++u) { const size_t t = (size_t)t0 + u;
            const bf16* yp = PROJ + t * PROJ_LD + PC_Z + lane * 16; const bf16* op = ORAW + t * 2048 + 1024 + lane * 16; const bf16* rp = PROJ + t * PROJ_LD + PC_R + lane * 16;
            ya[u] = *(const u32x4*)yp; yb[u] = *(const u32x4*)(yp + 8); oa[u] = *(const u32x4*)op; ob[u] = *(const u32x4*)(op + 8); ra[u] = *(const u32x4*)rp; rb[u] = *(const u32x4*)(rp + 8); }
#pragma unroll
        for (int u = 0; u < 2; ++u) { const size_t t = (size_t)t0 + u;
            {   float v[16]; UNPACK16(ya[u], yb[u], v);
                float s = 0.f;
#pragma unroll
                for (int i = 0; i < 16; ++i) s += v[i] * v[i];
#pragma unroll
                for (int o = 1; o < 32; o <<= 1) s += __shfl_xor(s, o);
                const float rstd = rsqrtf(s * (1.f / 512.f) + EPS_);
                const float* nw = ssd_norm + lane * 16;
#pragma unroll
                for (int i = 0; i < 16; ++i) v[i] = v[i] * rstd * nw[i];
                u32x4 a, b; a.x = pk2(v[0], v[1]); a.y = pk2(v[2], v[3]); a.z = pk2(v[4], v[5]); a.w = pk2(v[6], v[7]); b.x = pk2(v[8], v[9]); b.y = pk2(v[10], v[11]); b.z = pk2(v[12], v[13]); b.w = pk2(v[14], v[15]);
                bf16* yp = ORAW + t * 2048 + lane * 16; *(u32x4*)yp = a; *(u32x4*)(yp + 8) = b; }
            {   float v[16], r[16]; UNPACK16(oa[u], ob[u], v); UNPACK16(ra[u], rb[u], r);
                float s = 0.f;
#pragma unroll
                for (int i = 0; i < 16; ++i) s += v[i] * v[i];
#pragma unroll
                for (int o = 1; o < 16; o <<= 1) s += __shfl_xor(s, o);
                const float rstd = rsqrtf(s * (1.f / 256.f) + EPS_);
                const float* nw = gla_norm + (lane & 15) * 16;
#pragma unroll
                for (int i = 0; i < 16; ++i) v[i] = v[i] * rstd * nw[i] * siluf(r[i]);
                u32x4 a, b; a.x = pk2(v[0], v[1]); a.y = pk2(v[2], v[3]); a.z = pk2(v[4], v[5]); a.w = pk2(v[6], v[7]); b.x = pk2(v[8], v[9]); b.y = pk2(v[10], v[11]); b.z = pk2(v[12], v[13]); b.w = pk2(v[14], v[15]);
                bf16* op = ORAW + t * 2048 + 1024 + lane * 16; *(u32x4*)op = a; *(u32x4*)(op + 8) = b; }
        }
    }
}

DI void attn_unit(int b, int ph, int qb, const bf16* QK, const bf16* VT, bf16* OATT, const float* NORMS, ldsp lds, int tid) {
    asm volatile("" : "+v"(tid));
    constexpr int KBUF = 9216, VBUF = 18432, KOFF = 0, VOFF = 2 * KBUF, WSOFF = 2 * KBUF + 2 * VBUF;
    const int lane = tid & 63, w = tid >> 6, r32 = lane & 31, hi = lane >> 5;
    const int q0 = qb * 256, head = ph >> 1;
    const size_t rowb = (size_t)b * L_;
    const float cs = exp2f(-(float)(head + 1)) * 1.4426950408889634f;
    LAS float* wsf = (LAS float*)(lds + WSOFF) + w * 64;
    bf16x8 qf[4];
    { const bf16* qp = QK + (rowb + q0 + 32 * w + r32) * QK_LD + ph * 64 + 8 * hi;
#pragma unroll
      for (int ks = 0; ks < 4; ++ks) qf[ks] = *(const bf16x8*)(qp + 16 * ks); }
    asm volatile("s_waitcnt vmcnt(0)" : "+v"(qf[0]), "+v"(qf[1]), "+v"(qf[2]), "+v"(qf[3]) :: "memory");
    const int qpos = q0 + 32 * w + r32;
    const int rsw = ((r32 >> 3) & 1) * 8;
    f32x16 o[4];
#pragma unroll
    for (int d = 0; d < 4; ++d)
#pragma unroll
        for (int r = 0; r < 16; ++r) o[d][r] = 0.f;
    float l_run = 0.f;
    const float Bq = sqrtf(NORMS[b * 32 + ph] * NORMS[b * 32 + 16 + ph]);
    const float Wn = (150.f + 2.f * Bq) / cs;
    const float sk = ((float)(q0 - 63) - Wn) * (1.f / 64.f);
    int t_begin = (sk >= 0.f) ? (int)floorf(sk) + 1 : 0;
    t_begin = __builtin_amdgcn_readfirstlane(t_begin);
    const int t_end = (q0 + 256) / 64;
    float m_run = cs * (float)(64 * t_begin - q0);
    const int klane = r32 * 144 + 16 * hi, vlane = r32 * 144 + 16 * hi;
    const float cs_h = bf2f(pk2(cs, 0.f) & 0xffffu);
    const unsigned csw = (hi == 0) ? pk2(cs_h, cs - cs_h) : 0u;
    bf16x8 kext0, kext1;
    { u32x4 e0, e1; e0.x = (hi == 0) ? pk2((float)r32, (float)r32) : 0u; e0.y = (hi == 0) ? pk2(1.f, 1.f) : 0u; e0.z = 0u; e0.w = 0u;
      e1 = e0; e1.x = (hi == 0) ? pk2((float)(r32 + 32), (float)(r32 + 32)) : 0u; kext0 = __builtin_bit_cast(bf16x8, e0); kext1 = __builtin_bit_cast(bf16x8, e1); }
    const int kr = tid >> 3, kc = tid & 7;
    const bf16* ksrc = QK + (rowb + kr) * QK_LD + 1024 + ph * 64 + kc * 8;
    const bf16* vsrc0 = VT + (size_t)(head * 128 + kr) * VT_LD + rowb + kc * 8;
    const bf16* vsrc1 = VT + (size_t)(head * 128 + 64 + kr) * VT_LD + rowb + kc * 8;
    const int kdst = KOFF + kr * 144 + kc * 16, vdst0 = VOFF + kr * 144 + kc * 16, vdst1 = VOFF + (64 + kr) * 144 + kc * 16;
    u32x4 pk_, pv0, pv1;
    pk_ = *(const u32x4*)(ksrc + (size_t)t_begin * 64 * QK_LD); pv0 = *(const u32x4*)(vsrc0 + t_begin * 64); pv1 = *(const u32x4*)(vsrc1 + t_begin * 64);
    const int vp0 = (16 * (kc >> 1) + 4 * (kc & 1)) * 2, vp1 = vp0 + 16;
#define VSWZ(v) (v)
    __syncthreads();
    *(LAS u32x4*)(lds + kdst) = pk_;
    { *(LAS u32x2*)(lds + VOFF + kr * 144 + vp0) = (u32x2){pv0.x, pv0.y}; *(LAS u32x2*)(lds + VOFF + kr * 144 + vp1) = (u32x2){pv0.z, pv0.w};
      *(LAS u32x2*)(lds + VOFF + (64 + kr) * 144 + vp0) = (u32x2){pv1.x, pv1.y}; *(LAS u32x2*)(lds + VOFF + (64 + kr) * 144 + vp1) = (u32x2){pv1.z, pv1.w}; }
    __syncthreads();
#define ATTN_TILE(t_, buf_) do { \
        const int kbase = 64 * (t_); \
        if (kbase <= q0 + 32 * w + 31) { \
            const int kb = KOFF + (buf_) * KBUF + klane, vb = VOFF + (buf_) * VBUF + vlane; \
              \
            const float nm = cs * (float)(kbase - q0) - m_run; \
            const float nmh = bf2f(pk2(nm, 0.f) & 0xffffu); \
            u32x4 qe; qe.x = csw; qe.y = (hi == 0) ? pk2(nmh, nm - nmh) : 0u; qe.z = 0u; qe.w = 0u; \
            const bf16x8 qef = __builtin_bit_cast(bf16x8, qe); \
            bf16x8 kf0[4], kf1[4]; \
            _Pragma("unroll") \
            for (int ks = 0; ks < 4; ++ks) { kf0[ks] = lds16(lds, kb + 32 * ks); kf1[ks] = lds16(lds, kb + 32 * 144 + 32 * ks); } \
            __builtin_amdgcn_sched_barrier(0); \
            f32x16 s0, s1; \
            _Pragma("unroll") \
            for (int r = 0; r < 16; ++r) { s0[r] = 0.f; s1[r] = 0.f; } \
            s0 = mfma32(kext0, qef, s0); s1 = mfma32(kext1, qef, s1); \
            _Pragma("unroll") \
            for (int ks = 0; ks < 4; ++ks) { s0 = mfma32(kf0[ks], qf[ks], s0); s1 = mfma32(kf1[ks], qf[ks], s1); } \
            __builtin_amdgcn_sched_barrier(0); \
            asm volatile("s_nop 15\n\ts_nop 7" : "+v"(s0), "+v"(s1));     \
            if (kbase + 63 > q0 + 32 * w) { \
                _Pragma("unroll") \
                for (int r = 0; r < 16; ++r) { const int key = kbase + 4 * hi + (r & 3) + 8 * (r >> 2); if (key > qpos) s0[r] = -INFINITY; if (key + 32 > qpos) s1[r] = -INFINITY; } \
            } \
            float mx = s0[0], mx2 = s1[0]; \
            _Pragma("unroll") \
            for (int r = 1; r < 16; r += 2) { mx = max3f(mx, s0[r], s1[r]); if (r + 1 < 16) mx2 = max3f(mx2, s0[r + 1], s1[r + 1]); } \
            mx = max3f(mx, mx2, mx2); \
            mx = fmaxf(mx, __shfl_xor(mx, 32)); \
            if (__any(mx > 8.f)) { \
                const float dl = fmaxf(mx, 0.f); \
                const float alpha = __builtin_amdgcn_exp2f(-dl); \
                l_run *= alpha; m_run += dl; \
                _Pragma("unroll") \
                for (int r = 0; r < 16; ++r) { s0[r] -= dl; s1[r] -= dl; } \
                if (hi == 0) wsf[r32] = alpha; \
                LDS_FENCE(); \
                _Pragma("unroll") \
                for (int r = 0; r < 16; ++r) { const float a = wsf[crow(r, hi)]; \
                    _Pragma("unroll") \
                    for (int d = 0; d < 4; ++d) o[d][r] *= a; } \
            } \
            float rs = 0.f; \
            _Pragma("unroll") \
            for (int r = 0; r < 16; ++r) { s0[r] = __builtin_amdgcn_exp2f(s0[r]); s1[r] = __builtin_amdgcn_exp2f(s1[r]); rs += s0[r] + s1[r]; } \
            rs += __shfl_xor(rs, 32); \
            l_run += rs; \
            bf16x8 pa[2][2]; \
            _Pragma("unroll") \
            for (int s = 0; s < 2; ++s) { \
                u32x4 p0, p1; \
                p0.x = pk2(s0[8 * s + 0], s0[8 * s + 1]); p0.y = pk2(s0[8 * s + 2], s0[8 * s + 3]); p0.z = pk2(s0[8 * s + 4], s0[8 * s + 5]); p0.w = pk2(s0[8 * s + 6], s0[8 * s + 7]); \
                p1.x = pk2(s1[8 * s + 0], s1[8 * s + 1]); p1.y = pk2(s1[8 * s + 2], s1[8 * s + 3]); p1.z = pk2(s1[8 * s + 4], s1[8 * s + 5]); p1.w = pk2(s1[8 * s + 6], s1[8 * s + 7]); \
                pa[0][s] = __builtin_bit_cast(bf16x8, p0); pa[1][s] = __builtin_bit_cast(bf16x8, p1); \
            } \
            _Pragma("unroll") \
            for (int dh = 0; dh < 2; ++dh) { \
                bf16x8 vf[2][2][2]; \
                _Pragma("unroll") \
                for (int d2 = 0; d2 < 2; ++d2) \
                    _Pragma("unroll") \
                    for (int hf = 0; hf < 2; ++hf) \
                        _Pragma("unroll") \
                        for (int s = 0; s < 2; ++s) vf[d2][hf][s] = lds16(lds, vb + 4608 * (2 * dh + d2) + 64 * hf + 32 * s); \
                __builtin_amdgcn_sched_barrier(0); \
                _Pragma("unroll") \
                for (int hf = 0; hf < 2; ++hf) \
                    _Pragma("unroll") \
                    for (int s = 0; s < 2; ++s) \
                        _Pragma("unroll") \
                        for (int d2 = 0; d2 < 2; ++d2) o[2 * dh + d2] = mfma32(pa[hf][s], vf[d2][hf][s], o[2 * dh + d2]); \
                __builtin_amdgcn_sched_barrier(0); \
            } \
        } \
    } while (0)
#define ATTN_LOAD(t_, K_, V0_, V1_) do { K_ = *(const u32x4*)(ksrc + (size_t)(t_) * 64 * QK_LD); V0_ = *(const u32x4*)(vsrc0 + (t_) * 64); V1_ = *(const u32x4*)(vsrc1 + (t_) * 64); } while (0)
#define VT_PUT(off_, V_) do { *(LAS u32x2*)(lds + (off_) + vp0) = (u32x2){(V_).x, (V_).y}; *(LAS u32x2*)(lds + (off_) + vp1) = (u32x2){(V_).z, (V_).w}; } while (0)
#define ATTN_STORE(buf_, K_, V0_, V1_) do { *(LAS u32x4*)(lds + kdst + (buf_) * KBUF) = K_; VT_PUT(VOFF + (buf_) * VBUF + kr * 144, V0_); VT_PUT(VOFF + (buf_) * VBUF + (64 + kr) * 144, V1_); } while (0)
    u32x4 ak = pk_, av0 = pv0, av1 = pv1, bk = pk_, bv0 = pv0, bv1 = pv1;
    if (t_begin + 1 < t_end) ATTN_LOAD(t_begin + 1, ak, av0, av1);
    for (int t = t_begin; t < t_end; t += 2) {
        if (t + 2 < t_end) ATTN_LOAD(t + 2, bk, bv0, bv1);
        ATTN_TILE(t, 0);
        if (t + 1 < t_end) ATTN_STORE(1, ak, av0, av1);
        BAR_LDS();
        if (t + 1 < t_end) {
            if (t + 3 < t_end) ATTN_LOAD(t + 3, ak, av0, av1);
            ATTN_TILE(t + 1, 1);
            if (t + 2 < t_end) ATTN_STORE(0, bk, bv0, bv1);
            BAR_LDS();
        }
    }
#undef ATTN_TILE
#undef ATTN_LOAD
#undef ATTN_STORE
    LDS_FENCE();
    if (hi == 0) wsf[r32] = 1.f / l_run;
    LDS_FENCE();
    bf16* op = OATT + (rowb + q0 + 32 * w) * 2048 + ph * 128 + r32;
#pragma unroll
    for (int r = 0; r < 16; ++r) { const int qr = crow(r, hi); const float rl = wsf[qr];
#pragma unroll
        for (int d = 0; d < 4; ++d) op[(size_t)qr * 2048 + 32 * d] = (bf16)f2bf(o[d][r] * rl); }
#undef VSWZ
}

DI void qk_norms(const bf16* QK, float* NORMS, int gw, int NGW, int lane) {
    for (int b = 0; b < 2; ++b) {
        float mx = 0.f;
        for (int t = gw; t < L_; t += NGW) {
            const u32x4* p = (const u32x4*)(QK + ((size_t)b * L_ + t) * QK_LD + lane * 32);
            float s = 0.f;
#pragma unroll
            for (int i = 0; i < 4; ++i) { const u32x4 v = p[i];
                s += bflo(v.x) * bflo(v.x) + bfhi(v.x) * bfhi(v.x) + bflo(v.y) * bflo(v.y) + bfhi(v.y) * bfhi(v.y) + bflo(v.z) * bflo(v.z) + bfhi(v.z) * bfhi(v.z) + bflo(v.w) * bflo(v.w) + bfhi(v.w) * bfhi(v.w); }
            s += __shfl_xor(s, 1);
            mx = fmaxf(mx, s);
        }
        if (!(lane & 1)) atomicMax((unsigned*)NORMS + b * 32 + (lane >> 1), __float_as_uint(mx));
    }
}

DI void combine_rows(const bf16* OATT, bf16* OUT, const float* lq1, const float* lk1, const float* lq2, const float* lk2, const float* subln, float lam_init, int gw, int NGW, int lane) {
    const float e1 = __expf(wave_sum(lq1[lane] * lk1[lane])), e2 = __expf(wave_sum(lq2[lane] * lk2[lane]));
    const float lam = e1 - e2 + lam_init;
    const int head = lane >> 3, dv0 = (lane & 7) * 16;
    for (int t0 = 2 * gw; t0 < T_; t0 += 2 * NGW) {
        u32x4 A[2], B[2], C[2], Dd[2];
#pragma unroll
        for (int u = 0; u < 2; ++u) { const bf16* p1 = OATT + (size_t)(t0 + u) * 2048 + (2 * head) * 128 + dv0; const bf16* p2 = p1 + 128;
            A[u] = *(const u32x4*)p1; B[u] = *(const u32x4*)(p1 + 8); C[u] = *(const u32x4*)p2; Dd[u] = *(const u32x4*)(p2 + 8); }
#pragma unroll
        for (int u = 0; u < 2; ++u) {
            float v[16], q[16]; UNPACK16(A[u], B[u], v); UNPACK16(C[u], Dd[u], q);
            float s = 0.f;
#pragma unroll
            for (int i = 0; i < 16; ++i) { v[i] = v[i] - lam * q[i]; s += v[i] * v[i]; }
            s += __shfl_xor(s, 1); s += __shfl_xor(s, 2); s += __shfl_xor(s, 4);
            const float sc = rsqrtf(s * (1.f / 128.f) + EPS_) * (1.f - lam_init);
            const float* nw = subln + dv0;
            u32x4 oa, ob;
            oa.x = pk2(v[0] * sc * nw[0], v[1] * sc * nw[1]); oa.y = pk2(v[2] * sc * nw[2], v[3] * sc * nw[3]); oa.z = pk2(v[4] * sc * nw[4], v[5] * sc * nw[5]); oa.w = pk2(v[6] * sc * nw[6], v[7] * sc * nw[7]);
            ob.x = pk2(v[8] * sc * nw[8], v[9] * sc * nw[9]); ob.y = pk2(v[10] * sc * nw[10], v[11] * sc * nw[11]); ob.z = pk2(v[12] * sc * nw[12], v[13] * sc * nw[13]); ob.w = pk2(v[14] * sc * nw[14], v[15] * sc * nw[15]);
            bf16* qo = OUT + (size_t)(t0 + u) * 1024 + head * 128 + dv0;
            *(u32x4*)qo = oa; *(u32x4*)(qo + 8) = ob;
        }
    }
}

DI void softmax_rows256(bf16* S, int nrows, int gw, int NGW, int lane) {
    for (int r0 = gw * 4; r0 < nrows; r0 += NGW * 4) {
        u32x2 a[4];
#pragma unroll
        for (int i = 0; i < 4; ++i) a[i] = *((const u32x2*)(S + (size_t)(r0 + i) * 256) + lane);
#pragma unroll
        for (int i = 0; i < 4; ++i) {
            float v0 = bflo(a[i].x), v1 = bfhi(a[i].x), v2 = bflo(a[i].y), v3 = bfhi(a[i].y);
            const float mx = wave_max(fmaxf(fmaxf(v0, v1), fmaxf(v2, v3)));
            v0 = __expf(v0 - mx); v1 = __expf(v1 - mx); v2 = __expf(v2 - mx); v3 = __expf(v3 - mx);
            const float inv = 1.f / wave_sum((v0 + v1) + (v2 + v3));
            u32x2 o; o.x = pk2(v0 * inv, v1 * inv); o.y = pk2(v2 * inv, v3 * inv);
            *((u32x2*)(S + (size_t)(r0 + i) * 256) + lane) = o;
        }
    }
}

#define GAS __attribute__((address_space(1)))
#define XB_TMO      128
#define XB_XCNT(j)  (256  + 64 * (j))
#define XB_XSUB(j)  (1280 + 64 * (j))
#define XB_XGEN(j)  (2304 + 64 * (j))
#define XB_TOP      3328
#define XB_TOPGEN   3392
#define XCD_BAR_WORDS 3456
#define XB_SPIN_CAP (1u << 18)

__device__ __forceinline__ unsigned xb_ld(unsigned* p)              { return __hip_atomic_load(p, __ATOMIC_RELAXED, __HIP_MEMORY_SCOPE_AGENT); }
__device__ __forceinline__ unsigned xb_add(unsigned* p, unsigned v) { return __hip_atomic_fetch_add(p, v, __ATOMIC_RELAXED, __HIP_MEMORY_SCOPE_AGENT); }
__device__ __forceinline__ unsigned xb_xcc_id() { return (unsigned)__builtin_amdgcn_s_getreg((3 << 11) | 20) & 0xFu; }
#define XB_SPIN(cond, bar) do { unsigned _sp = 0; while (cond) { __builtin_amdgcn_s_sleep(1); \
    if ((++_sp & 255u) == 0u) { if (xb_ld(&(bar)[XB_TMO])) break; if (_sp > XB_SPIN_CAP) { atomicAdd(&(bar)[XB_TMO], 1u); break; } } } } while (0)

struct XcdBarrier {
    unsigned* bar; unsigned x;
    volatile LAS unsigned* st;
};

__device__ __forceinline__ XcdBarrier xcd_barrier_post(unsigned* bar, volatile LAS unsigned* st) {
    XcdBarrier b; b.bar = bar; b.x = xb_xcc_id(); b.st = st;
    if (threadIdx.x == 0) (void)xb_add(&bar[XB_XCNT(b.x)], 1u);
    return b;
}
__device__ __forceinline__ void xcd_barrier_complete(unsigned* bar, unsigned x, unsigned& nloc, unsigned& nx) {
    const unsigned G = gridDim.x * gridDim.y * gridDim.z;
    unsigned sum, cnt, mine, sp = 0u;
    for (;;) {
        sum = 0u; cnt = 0u; mine = 0u;
#pragma unroll
        for (unsigned j = 0; j < 16; ++j) { const unsigned c = xb_ld(&bar[XB_XCNT(j)]); sum += c; cnt += (c > 0u) ? 1u : 0u; mine = (j == x) ? c : mine; }
        if (sum == G) break;
        __builtin_amdgcn_s_sleep(1);
        if ((++sp & 255u) == 0u) { if (xb_ld(&bar[XB_TMO])) break; if (sp > XB_SPIN_CAP) { atomicAdd(&bar[XB_TMO], 1u); break; } }
    }
    nloc = mine > 0u ? mine : 1u; nx = cnt > 0u ? cnt : 1u;
}

__device__ __forceinline__ void xcd_barrier(const XcdBarrier& b) {
    asm volatile("s_waitcnt vmcnt(0)" ::: "memory");
    __syncthreads();
    if (threadIdx.x == 0) {
        unsigned* bar = b.bar;
        __builtin_amdgcn_s_waitcnt(0);
        unsigned nloc = b.st[0], nx = b.st[1];
        if (nloc == 0u) { xcd_barrier_complete(bar, b.x, nloc, nx); b.st[0] = nloc; b.st[1] = nx; }
        const unsigned old = xb_add(&bar[XB_XSUB(b.x)], 1u);
        const unsigned gen = old / nloc;
        if (old + 1u == (gen + 1u) * nloc) {
            __builtin_amdgcn_fence(__ATOMIC_RELEASE, "agent");
            asm volatile("s_waitcnt vmcnt(0)" ::: "memory");
            const unsigned og = xb_add(&bar[XB_TOP], 1u);
            const unsigned tg = og / nx;
            if (og + 1u == (tg + 1u) * nx) xb_add(&bar[XB_TOPGEN], 1u);
            else XB_SPIN(xb_ld(&bar[XB_TOPGEN]) == tg, bar);
            __builtin_amdgcn_fence(__ATOMIC_ACQUIRE, "agent");
            xb_add(&bar[XB_XGEN(b.x)], 1u);
            asm volatile("s_waitcnt vmcnt(0)" ::: "memory");
        } else {
            XB_SPIN(xb_ld(&bar[XB_XGEN(b.x)]) == gen, bar);
            __builtin_amdgcn_fence(__ATOMIC_ACQUIRE, "agent");
            asm volatile("s_waitcnt vmcnt(0)" ::: "memory");
        }
    }
    __syncthreads();
}

struct Args { const float* in[31]; float* out; unsigned char* ws; float lam_init[2]; int ph_lo, ph_hi; };
constexpr int NPL = 15, NPH = 4 * NPL + 1;

DI pg8::Gemm mk_gemm(const bf16* A, const bf16* Bt, int M, int N, int K, int lda, int ldb) {
    pg8::Gemm g; g.A = A; g.Bt = Bt; g.M = M; g.N = N; g.K = K; g.lda = lda; g.ldb = ldb; g.a_pn = 0; g.b_pn = (long)256 * ldb; g.b_b = 0; g.pm_per_b = 1 << 30; return g;
}
DI pg8::EpiU mk_store(bf16* O, int ldc, int act, int scale_cols, float scale) {
    pg8::EpiU e; e.mode = 0; e.O = O; e.ldc = ldc; e.act = act; e.scale_cols = scale_cols; e.scale = scale; e.small_out = nullptr; e.small_pn = -1; e.base = nullptr; e.baseb = nullptr; e.outb = nullptr; e.ssq = nullptr; e.nssq = nullptr; e.nmode = 0; e.smx = nullptr; return e;
}
DI pg8::EpiU mk_res(const float* base, const bf16* baseb, bf16* outb, float* ssq) {
    pg8::EpiU e; e.mode = 1; e.ssq = ssq; e.nssq = nullptr; e.nmode = 0; e.smx = nullptr; e.O = nullptr; e.ldc = D_; e.act = 0; e.scale_cols = 0; e.scale = 1.f; e.small_out = nullptr; e.small_pn = -1; e.base = base; e.baseb = baseb; e.outb = outb; return e;
}

__global__ void __launch_bounds__(512, 2) mega_fwd(Args a) {
    extern __shared__ __attribute__((aligned(16))) unsigned char lds_raw[];
    ldsp lds = (ldsp)lds_raw;
    cg::grid_group grid = cg::this_grid();
    volatile LAS unsigned* bst = (volatile LAS unsigned*)(lds + LDS_BYTES - 16);
    if (threadIdx.x < 4) bst[threadIdx.x] = 0u;
    __syncthreads();
    const XcdBarrier xbar = xcd_barrier_post((unsigned*)(a.ws + 4096), bst);
    const int G = gridDim.x, blk = blockIdx.x, NGW = G * 8;
    for (int ph = a.ph_lo; ph < a.ph_hi; ++ph) {
#define PHASE_IDS int tid = threadIdx.x; asm volatile("" : "+v"(tid)); const int lane = tid & 63, wave = __builtin_amdgcn_readfirstlane(tid >> 6), gw = blk * 8 + wave; (void)lane; (void)gw; (void)wave;
        unsigned char* ws = a.ws;
        bf16* XN = (bf16*)(ws + WS_XN); bf16* BIG = (bf16*)(ws + WS_BIG); bf16* VT = (bf16*)(ws + WS_VT); bf16* ORAW = (bf16*)a.out;   bf16* XR = (bf16*)(ws + WS_ORAW);
        float* SSQ_M = (float*)a.out; float* SSQ_X = (float*)(ws + WS_SMALL); float* SSQ_F = (float*)(ws + WS_SMALL + 2 * MiB);
        float* SMALL = (float*)(ws + WS_SMALL); bf16* MEMN = (bf16*)(ws + WS_MEMN); bf16* KX = (bf16*)(ws + WS_KX); bf16* VXT = (bf16*)(ws + WS_VXT);
        bf16* KT = (bf16*)(ws + WS_KT); float* DG = (float*)(ws + WS_DG); bf16* TAIL = (bf16*)(ws + WS_DG + 1 * MiB);
        bf16* WA = (bf16*)(ws + WS_WA); bf16* WV = (bf16*)(ws + WS_WV); bf16* WOUT = (bf16*)(ws + WS_WOUT); bf16* WQ = (bf16*)(ws + WS_WQ); bf16* WKV = (bf16*)(ws + WS_WKV);
        bf16* WXO = (bf16*)(ws + WS_WXO); bf16* W1 = (bf16*)(ws + WS_W1); bf16* W2 = (bf16*)(ws + WS_W2);
        bf16* QX = BIG; bf16* SP = BIG + (size_t)T_ * 1024; bf16* OX = BIG + (size_t)2 * T_ * 1024;
        bf16* OATT = (bf16*)(ws + WS_BIG + 132 * MiB);

        const int layer = ph / NPL, k = ph % NPL;
        const bool even = !(layer & 1); const int li = layer >> 1;
        bool did = true; int nj = 0;
        const bool x_in = (layer == 0 && k <= 5);
        if (ph == NPH - 1) { PHASE_IDS
            rms_rows_from_bf16<true>(XR, a.in[30], nullptr, a.out, T_, gw, NGW, lane);
        } else if (k == 0) { PHASE_IDS
            LAS float* scr = (LAS float*)(lds + wave * 16384);
            const float* wq = a.in[24] + (size_t)layer * 1024 * 1024; const float* wkv = a.in[25] + (size_t)layer * 1024 * 2048; const float* wxo = a.in[26] + (size_t)layer * 1024 * 1024;
            const float* w1 = a.in[28] + (size_t)layer * 1024 * 4096; const float* w2 = a.in[29] + (size_t)layer * 4096 * 1024;
            const int I_Q = 16 * 32, I_KV = 16 * 64, I_XO = 16 * 32, I_1 = 16 * 128, I_2 = 64 * 32;
            const int I_A = even ? 16 * 144 : 16 * 64, I_V = 16 * 32, I_O = even ? 32 * 32 : 16 * 32;
            const int NIT = I_Q + I_KV + I_XO + I_1 + I_2 + I_A + I_V + I_O;
            for (int it = gw; it < NIT; it += NGW) {
                int r = it;
                if (r < I_Q) { conv_item(wq, 1024, 1024, WQ, 1024, 0, 0, scr, r, lane, a.in[22] + (size_t)layer * 1024); continue; } r -= I_Q;
                if (r < I_KV) { conv_item(wkv, 2048, 1024, WKV, 2048, 0, 0, scr, r, lane); continue; } r -= I_KV;
                if (r < I_XO) { conv_item(wxo, 1024, 1024, WXO, 1024, 0, 0, scr, r, lane); continue; } r -= I_XO;
                if (r < I_1) { conv_item(w1, 4096, 1024, W1, 4096, 0, 0, scr, r, lane, a.in[27] + (size_t)layer * 1024); continue; } r -= I_1;
                if (r < I_2) { conv_item(w2, 1024, 4096, W2, 1024, 0, 0, scr, r, lane); continue; } r -= I_2;
                if (even) {
                    const float* win = a.in[3] + (size_t)li * 1024 * 5408; const float* wout = a.in[13] + (size_t)li * 2048 * 1024;
                    if (r < I_A) { conv_item(win, 5408, 1024, WA, 4608, 1, 0, scr, r, lane, a.in[2] + (size_t)li * 1024); continue; } r -= I_A;
                    if (r < I_V) { conv_item(win, 5408, 1024, WV, 1024, 0, 3344, scr, r, lane, a.in[2] + (size_t)li * 1024); continue; } r -= I_V;
                    conv_item(wout, 1024, 2048, WOUT, 1024, 0, 0, scr, r, lane);
                } else {
                    const float* wqkv = a.in[15] + (size_t)li * 1024 * 3072; const float* wo = a.in[21] + (size_t)li * 1024 * 1024;
                    if (r < I_A) { conv_item(wqkv, 3072, 1024, WA, 2048, 0, 0, scr, r, lane, a.in[14] + (size_t)li * 1024); continue; } r -= I_A;
                    if (r < I_V) { conv_item(wqkv, 3072, 1024, WV, 1024, 0, 2048, scr, r, lane, a.in[14] + (size_t)li * 1024); continue; } r -= I_V;
                    conv_item(wo, 1024, 1024, WOUT, 1024, 0, 0, scr, r, lane);
                }
            }
            if (layer == 0) xb_rows(a.in[0], XR, SSQ_M, T_, gw, NGW, lane);
            rms_rows_bf16(a.in[1], a.in[23] + (size_t)layer * 1024, MEMN, 512, gw, NGW, lane);
            if (blk == 0 && tid < 64) ((float*)ws)[tid] = 0.f;
        } else if (k == 1) { nj = 4;
        } else if (k == 2) { PHASE_IDS
            if (even) { for (int u = blk; u < T_ / 128; u += G) prep_unit(u, BIG, SMALL, KT, DG, TAIL, a.in[10] + (size_t)li * 16 * 512, a.in[11] + (size_t)li * 512, a.in[6] + li * 16, a.in[7] + li * 16, a.in[4] + (size_t)li * 4 * 1280, a.in[5] + (size_t)li * 1280, lds, tid); }
            else {
                qk_norms(BIG, (float*)ws, gw, NGW, lane);
                xcd_barrier(xbar);
                {
                    const int x = blk & 7, j = blk >> 3, bb = (x >> 1) & 1, br = x & 1, grp = x >> 2;
#pragma unroll 1
                    for (int u = 0; u < 8; ++u) { const int s = u >> 1; const int head = grp ? (s == 0 ? 6 : s == 1 ? 4 : s == 2 ? 3 : 2) : (s == 0 ? 7 : s == 1 ? 5 : s == 2 ? 1 : 0);
                        attn_unit(bb, 2 * head + br, (u & 1) ? j : 63 - j, BIG, VT, OATT, (const float*)ws, lds, tid); }
                }
            }
        } else if (k == 3) { PHASE_IDS
            if (even) {
                for (int j = blk; j < 64; j += G) {
                    if (j < 32) ssd_chain(j >> 4, j & 15, BIG, SMALL, TAIL, a.in[8] + li * 16, lds, tid);
                    else { const int i2 = j - 32; gla_chain(i2 >> 4, (i2 >> 2) & 3, i2 & 3, BIG, KT, VT, DG, ORAW, lds, tid); }
                }
            } else combine_rows(OATT, XN, a.in[16] + li * 64, a.in[17] + li * 64, a.in[18] + li * 64, a.in[19] + li * 64, a.in[20] + li * 128, a.lam_init[li], gw, NGW, lane);
        } else if (k == 4) { PHASE_IDS
            if (even) gate_rows(BIG, ORAW, a.in[9] + (size_t)li * 1024, a.in[12] + (size_t)li * 256, gw, NGW, lane);
            else nj = 1;
        } else if (k == 5) { if (even) nj = 1; else did = false;
        } else if (k == 6) { did = false;
        } else if (k == 9) { did = false;
        } else if (k == 12) { did = false;
        } else nj = 1;
        for (int j = 0; j < nj; ++j) { PHASE_IDS
            pg8::Gemm g = mk_gemm(XN, WA, T_, 1024, 1024, 1024, 1024); pg8::EpiU e = mk_store(BIG, 1024, 0, 0, 1.f);
            if (k == 1) {
                if (j == 0) { if (even) { g = mk_gemm(XR, WA, T_, 4608, 1024, 1024, 1024); e = mk_store(BIG, PROJ_LD, 0, 0, 1.f); e.small_out = SMALL; e.small_pn = 17; }
                              else { g = mk_gemm(XR, WA, T_, 2048, 1024, 1024, 1024); e = mk_store(BIG, QK_LD, 0, 1024, 0.125f * 1.4426950408889634f); }
                              e.nssq = SSQ_M; e.nmode = 1; }
                else if (j == 1) { g = mk_gemm(WV, XR, 1024, T_, 1024, 1024, 1024); e = mk_store(VT, VT_LD, 0, 0, 1.f); e.nssq = SSQ_M; e.nmode = 2; }
                else if (j == 2) { g = mk_gemm(MEMN, WKV, 512, 1024, 1024, 1024, 1024); e = mk_store(KX, 1024, 0, 0, 1.f); }
                else { g = mk_gemm(WKV + (size_t)1024 * 1024, MEMN, 1024, 512, 1024, 1024, 1024); e = mk_store(VXT, 512, 0, 0, 1.f); }
            } else if (k == 4) { g = mk_gemm(XN, WOUT, T_, 1024, 1024, 1024, 1024); e = mk_res(nullptr, XR, XR, SSQ_X);
            } else if (k == 5) {
                g = mk_gemm(ORAW, WOUT, T_, 1024, 2048, 2048, 2048); e = mk_res(nullptr, XR, XR, SSQ_X);
            } else if (k == 7) { g = mk_gemm(XR, WQ, T_, 1024, 1024, 1024, 1024); e = mk_store(QX, 1024, 0, 1024, 0.0625f); e.nssq = SSQ_X; e.nmode = 1;
            } else if (k == 8) { g = mk_gemm(QX, KX, T_, 1024, 256, 1024, 1024); g.a_pn = 256; g.b_pn = 256; g.b_b = (long)256 * 1024; g.pm_per_b = 64; e = mk_store(SP, 1024, 0, 0, 1.f); e.smx = (PG8_LAS float*)(lds + 131072);
            } else if (k == 10) { g = mk_gemm(SP, VXT, T_, 1024, 256, 1024, 512); g.a_pn = 256; g.b_pn = (long)256 * 512; g.b_b = 256; g.pm_per_b = 64; e = mk_store(OX, 1024, 0, 0, 1.f);
            } else if (k == 11) { g = mk_gemm(OX, WXO, T_, 1024, 1024, 1024, 1024); e = mk_res(nullptr, XR, XR, SSQ_F);
            } else if (k == 13) { g = mk_gemm(XR, W1, T_, 4096, 1024, 1024, 1024); e = mk_store(BIG, 4096, 1, 0, 1.f); e.nssq = SSQ_F; e.nmode = 1;
            } else if (k == 14) { g = mk_gemm(BIG, W2, T_, 1024, 4096, 4096, 4096); e = mk_res(nullptr, XR, XR, SSQ_M); }
            pg8::StaticOrder S; S.init(g.M, g.N, G, (blk + 64 * j * (j >= 2)) % G);
            pg8::gemm_phase<pg8::EpiU, pg8::StaticOrder, true, true>(lds, g, S, e, tid);
        }
        if (did && ph + 1 < a.ph_hi) { if (ph == 0) grid.sync(); else xcd_barrier(xbar); }
    }
}

extern "C" void kernel_launch(void* const* d_in, const int* in_sizes, int n_in, void* d_out, int out_size, void* d_ws, size_t ws_size, hipStream_t stream) {
    static int grid = 0;
    if (grid == 0) {
        if (n_in != 31 || out_size != T_ * D_ || ws_size < WS_END) { fprintf(stderr, "kernel_launch: unexpected problem (n_in %d out %d ws %zu)\n", n_in, out_size, ws_size); grid = -1; return; }
        int dev = 0, cus = 0, per_cu = 0;
        hipGetDevice(&dev); hipDeviceGetAttribute(&cus, hipDeviceAttributeMultiprocessorCount, dev);
        if (hipFuncSetAttribute((const void*)mega_fwd, hipFuncAttributeMaxDynamicSharedMemorySize, LDS_BYTES) != hipSuccess) { fprintf(stderr, "kernel_launch: hipFuncSetAttribute failed\n"); grid = -1; return; }
        if (hipOccupancyMaxActiveBlocksPerMultiprocessor(&per_cu, (const void*)mega_fwd, 512, LDS_BYTES) != hipSuccess || per_cu < 1) { fprintf(stderr, "kernel_launch: occupancy query says %d\n", per_cu); per_cu = 1; }
        (void)hipGetLastError();
        grid = cus;
        if (grid != 256) { fprintf(stderr, "kernel_launch: built for a 256-CU device (got %d)\n", cus); grid = -1; return; }
    }
    if (grid < 0) return;
    Args a{};
    for (int i = 0; i < 31; ++i) a.in[i] = (const float*)d_in[i];
    a.out = (float*)d_out; a.ws = (unsigned char*)d_ws;
    a.lam_init[0] = (float)(0.8 - 0.6 * exp(-0.3 * 1.0)); a.lam_init[1] = (float)(0.8 - 0.6 * exp(-0.3 * 3.0));
    a.ph_lo = 0; a.ph_hi = NPH;
#ifdef PROBE_PREFIX
    {
        Args p = a; p.ph_hi = PROBE_PREFIX; void* pargs[] = {&p};
        (void)hipMemsetAsync(d_ws, 0, 65536, stream);
        (void)hipLaunchCooperativeKernel((const void*)mega_fwd, dim3(grid), dim3(512), pargs, LDS_BYTES, stream);
    }
#endif
    if (hipMemsetAsync(d_ws, 0, 65536, stream) != hipSuccess) { fprintf(stderr, "kernel_launch: memset failed\n"); return; }
    void* args[] = {&a};
    hipError_t e = hipLaunchCooperativeKernel((const void*)mega_fwd, dim3(grid), dim3(512), args, LDS_BYTES, stream);
    if (e != hipSuccess) fprintf(stderr, "cooperative launch failed: %s (grid %d)\n", hipGetErrorString(e), grid);
}
```

```cpp
#include <hip/hip_runtime.h>
#include <hip/hip_cooperative_groups.h>
#include <cstdio>
#include <cstdint>
#include <cmath>
namespace cg = cooperative_groups;

namespace pg8 {
#define PG8_LAS __attribute__((address_space(3)))
typedef unsigned short bf16_t;
typedef short bf16x8 __attribute__((ext_vector_type(8)));
typedef float f32x4 __attribute__((ext_vector_type(4)));
typedef unsigned u32x4 __attribute__((ext_vector_type(4)));
constexpr int BM = 256, BK = 64, HALF = 128, HTB = HALF * BK * 2, STAGE_BYTES = 8 * HTB, NXCD = 8, WGM = 8;

__host__ __device__ __forceinline__ int lds_byte(int r, int c) { const int st = (r >> 4) * 2 + (c >> 5), rr = r & 15, cc = c & 31, ob = rr * 64 + cc * 2; return st * 1024 + (ob ^ (((ob >> 9) & 1) << 5)); }
__host__ __device__ __forceinline__ void stage_rc(int b, int& R, int& C) { const int st = b / 1024, sb = b % 1024, swz = sb ^ (((sb >> 9) & 1) << 5); R = (st >> 1) * 16 + swz / 64; C = (st & 1) * 32 + (swz % 64) / 2; }
__host__ __device__ __forceinline__ int perm32(int rho) { const int n = rho >> 4, i = rho & 15; return 8 * (i >> 2) + 4 * n + (i & 3); }

struct Unit { int pm, pn; };
struct Gemm { const bf16_t* A; const bf16_t* Bt; int M, N, K, lda, ldb; long a_pn, b_pn, b_b; int pm_per_b; };

struct StaticOrder {
    int nM, nN, nwg, G, c;
    __host__ __device__ void init(int M, int N, int G_, int c_) { nM = M / BM; nN = N / BM; nwg = nM * nN; G = G_; c = c_; }
    __host__ __device__ bool next(int i, Unit& u) const {
        const long L = (long)i * G + c; if (L >= nwg) return false;
        int wgid = (int)L; { const int q = nwg / NXCD, r = nwg % NXCD, xcd = wgid % NXCD, off = wgid / NXCD; wgid = (xcd < r ? xcd * (q + 1) : r * (q + 1) + (xcd - r) * q) + off; }
        const int nig = WGM * nN, gid = wgid / nig, fm = gid * WGM, gsz = (nM - fm) < WGM ? (nM - fm) : WGM;
        u.pm = fm + ((wgid % nig) % gsz); u.pn = (wgid % nig) / gsz; return true;
    }
    __device__ __forceinline__ void ptrs(const Unit& u, const Gemm& g, const char*& a, const char*& b) const {
        a = (const char*)(g.A + (size_t)u.pm * BM * g.lda + (size_t)u.pn * g.a_pn);
        b = (const char*)(g.Bt + (size_t)u.pn * g.b_pn + (size_t)(u.pm / g.pm_per_b) * g.b_b);
    }
    __device__ __forceinline__ void a_ready(const Unit&) const {}
    __device__ __forceinline__ void done(const Unit&) const {}
};

__device__ __forceinline__ unsigned cvt_pk_bf16(float lo, float hi) { unsigned r; asm volatile("v_cvt_pk_bf16_f32 %0, %1, %2" : "=v"(r) : "v"(lo), "v"(hi)); return r; }

__device__ __forceinline__ float rstd16(const float* p) {
    const f32x4 a = *(const f32x4*)p, b = *(const f32x4*)(p + 4), c = *(const f32x4*)(p + 8), d = *(const f32x4*)(p + 12);
    const float s = (((a[0] + a[1]) + (a[2] + a[3])) + ((b[0] + b[1]) + (b[2] + b[3]))) + (((c[0] + c[1]) + (c[2] + c[3])) + ((d[0] + d[1]) + (d[2] + d[3])));
    return rsqrtf(s * (1.f / 1024.f) + 1e-5f);
}
struct EpiU {
    static constexpr bool PERM = true, AFTER_DRAIN = false;
    int mode;
    bf16_t* O; int ldc; int act; int scale_cols; float scale;
    float* small_out; int small_pn;
    PG8_LAS float* smx;
    float* ssq; const float* nssq; int nmode;
    const float* base; const bf16_t* baseb; bf16_t* outb;
    __device__ __forceinline__ void operator()(const f32x4 (&acc)[2][2][4][2], const Unit& u, int wr, int wc, int fr, int fq) const {
        const int row0 = u.pm * BM + wr * 64 + fr; const int col0 = u.pn * BM + wc * 32 + 8 * fq;
        if (mode == 0) {
            if (smx) {
#pragma unroll
                for (int ai = 0; ai < 2; ++ai)
#pragma unroll
                    for (int m = 0; m < 4; ++m) { float mx = -INFINITY;
#pragma unroll
                        for (int bj = 0; bj < 2; ++bj)
#pragma unroll
                            for (int n = 0; n < 2; ++n)
#pragma unroll
                                for (int e = 0; e < 4; ++e) mx = fmaxf(mx, acc[ai][bj][m][n][e]);
                        mx = fmaxf(mx, __shfl_xor(mx, 16)); mx = fmaxf(mx, __shfl_xor(mx, 32));
                        if (fq == 0) smx[(ai * HALF + wr * 64 + m * 16 + fr) * 4 + wc] = mx; }
                asm volatile("s_waitcnt lgkmcnt(0)\n\ts_barrier" ::: "memory");
#pragma unroll
                for (int ai = 0; ai < 2; ++ai)
#pragma unroll
                    for (int m = 0; m < 4; ++m) { const int rl = ai * HALF + wr * 64 + m * 16 + fr;
                        const f32x4 q4 = *(PG8_LAS f32x4*)(smx + rl * 4); const float mx = fmaxf(fmaxf(q4[0], q4[1]), fmaxf(q4[2], q4[3]));
                        float sm = 0.f;
#pragma unroll
                        for (int bj = 0; bj < 2; ++bj)
#pragma unroll
                            for (int n = 0; n < 2; ++n)
#pragma unroll
                                for (int e = 0; e < 4; ++e) sm += __expf(acc[ai][bj][m][n][e] - mx);
                        sm += __shfl_xor(sm, 16); sm += __shfl_xor(sm, 32);
                        if (fq == 0) smx[1024 + rl * 4 + wc] = sm; }
                asm volatile("s_waitcnt lgkmcnt(0)\n\ts_barrier" ::: "memory");
#pragma unroll
                for (int ai = 0; ai < 2; ++ai)
#pragma unroll
                    for (int m = 0; m < 4; ++m) { const int rl = ai * HALF + wr * 64 + m * 16 + fr;
                        const f32x4 q4 = *(PG8_LAS f32x4*)(smx + rl * 4); const float mx = fmaxf(fmaxf(q4[0], q4[1]), fmaxf(q4[2], q4[3]));
                        const f32x4 l4 = *(PG8_LAS f32x4*)(smx + 1024 + rl * 4); const float inv = 1.f / ((l4[0] + l4[1]) + (l4[2] + l4[3]));
                        bf16_t* rowp = O + (size_t)(row0 + ai * HALF + m * 16) * ldc + col0;
#pragma unroll
                        for (int bj = 0; bj < 2; ++bj) { f32x4 v0, v1;
#pragma unroll
                            for (int e = 0; e < 4; ++e) { v0[e] = __expf(acc[ai][bj][m][0][e] - mx) * inv; v1[e] = __expf(acc[ai][bj][m][1][e] - mx) * inv; }
                            u32x4 w; w.x = cvt_pk_bf16(v0[0], v0[1]); w.y = cvt_pk_bf16(v0[2], v0[3]); w.z = cvt_pk_bf16(v1[0], v1[1]); w.w = cvt_pk_bf16(v1[2], v1[3]);
                            *(u32x4*)(rowp + bj * HALF) = w; } }
                return;
            }
            if (small_out && u.pn == small_pn) {
                if (wc == 0) {
#pragma unroll
                    for (int ai = 0; ai < 2; ++ai)
#pragma unroll
                        for (int m = 0; m < 4; ++m) { const int rr = row0 + ai * HALF + m * 16; const float rsc = (nmode == 1) ? rstd16(nssq + (size_t)rr * 16) : 1.f;
                            float* p = small_out + (size_t)rr * 32 + 8 * fq; *(f32x4*)p = acc[ai][0][m][0] * rsc; *(f32x4*)(p + 4) = acc[ai][0][m][1] * rsc; }
                }
                return;
            }
            f32x4 csc[2][2];
#pragma unroll
            for (int bj = 0; bj < 2; ++bj)
#pragma unroll
                for (int e = 0; e < 4; ++e) { csc[bj][0][e] = (nmode == 2) ? rstd16(nssq + (size_t)(col0 + bj * HALF + e) * 16) : 1.f; csc[bj][1][e] = (nmode == 2) ? rstd16(nssq + (size_t)(col0 + bj * HALF + 4 + e) * 16) : 1.f; }
#pragma unroll
            for (int ai = 0; ai < 2; ++ai)
#pragma unroll
                for (int m = 0; m < 4; ++m) { bf16_t* rowp = O + (size_t)(row0 + ai * HALF + m * 16) * ldc + col0;
                    const float rsc = (nmode == 1) ? rstd16(nssq + (size_t)(row0 + ai * HALF + m * 16) * 16) : 1.f;
#pragma unroll
                    for (int bj = 0; bj < 2; ++bj) { f32x4 v0 = acc[ai][bj][m][0] * rsc * csc[bj][0], v1 = acc[ai][bj][m][1] * rsc * csc[bj][1];
                        if (act == 1) {
#pragma unroll
                            for (int e = 0; e < 4; ++e) { float t0 = fmaxf(v0[e], 0.f), t1 = fmaxf(v1[e], 0.f); v0[e] = t0 * t0; v1[e] = t1 * t1; } }
                        const float sc = (col0 + bj * HALF < scale_cols) ? scale : 1.f;
                        v0 = v0 * sc; v1 = v1 * sc; u32x4 w; w.x = cvt_pk_bf16(v0[0], v0[1]); w.y = cvt_pk_bf16(v0[2], v0[3]); w.z = cvt_pk_bf16(v1[0], v1[1]); w.w = cvt_pk_bf16(v1[2], v1[3]);
                        *(u32x4*)(rowp + bj * HALF) = w; } }
        } else {
#pragma unroll
            for (int ai = 0; ai < 2; ++ai)
#pragma unroll
                for (int m = 0; m < 4; ++m) { const size_t off = (size_t)(row0 + ai * HALF + m * 16) * ldc + col0; float ss = 0.f;
#pragma unroll
                    for (int bj = 0; bj < 2; ++bj) { f32x4 b0, b1;
                        if (baseb) { const u32x4 wv = *(const u32x4*)(baseb + off + bj * HALF);
                            b0 = (f32x4){__builtin_bit_cast(float, wv.x << 16), __builtin_bit_cast(float, wv.x & 0xffff0000u), __builtin_bit_cast(float, wv.y << 16), __builtin_bit_cast(float, wv.y & 0xffff0000u)};
                            b1 = (f32x4){__builtin_bit_cast(float, wv.z << 16), __builtin_bit_cast(float, wv.z & 0xffff0000u), __builtin_bit_cast(float, wv.w << 16), __builtin_bit_cast(float, wv.w & 0xffff0000u)}; }
                        else { const float* bp = base + off + bj * HALF; b0 = *(const f32x4*)bp; b1 = *(const f32x4*)(bp + 4); }
                        const f32x4 x0 = b0 + acc[ai][bj][m][0], x1 = b1 + acc[ai][bj][m][1];
                        u32x4 w; w.x = cvt_pk_bf16(x0[0], x0[1]); w.y = cvt_pk_bf16(x0[2], x0[3]); w.z = cvt_pk_bf16(x1[0], x1[1]); w.w = cvt_pk_bf16(x1[2], x1[3]);
                        *(u32x4*)(outb + off + bj * HALF) = w;
                        ss += (x0[0] * x0[0] + x0[1] * x0[1]) + (x0[2] * x0[2] + x0[3] * x0[3]) + (x1[0] * x1[0] + x1[1] * x1[1]) + (x1[2] * x1[2] + x1[3] * x1[3]); }
                    ss += __shfl_xor(ss, 16); ss += __shfl_xor(ss, 32);
                    if (fq == 0) ssq[(size_t)(row0 + ai * HALF + m * 16) * 16 + u.pn * 4 + wc] = ss;
                }
        }
    }
};

template <class Epi, class Sched, bool ALIGN_EPI = false, bool SP2 = false>
__device__ __forceinline__ void gemm_phase(PG8_LAS unsigned char* lds, const Gemm g, const Sched& S, const Epi& E, const int tid) {
    const int wid = __builtin_amdgcn_readfirstlane(tid >> 6), lane = tid & 63, wr = wid >> 2, wc = wid & 3, fr = lane & 15, fq = lane >> 4;
    const int K = g.K, nt = K / BK;
    unsigned voffA[2], voffB[2];
#pragma unroll
    for (int i = 0; i < 2; ++i) { int R, C; stage_rc(tid * 16 + i * 8192, R, C); const int Rb = Epi::PERM ? ((R & ~31) + perm32(R & 31)) : R;
        voffA[i] = (unsigned)(R * g.lda + C) * 2u; voffB[i] = (unsigned)(Rb * g.ldb + C) * 2u; }
    const size_t kstep = (size_t)(BK * 2);
    const size_t hstepA = (size_t)HALF * g.lda * 2, hstepB = (size_t)HALF * g.ldb * 2;
    const unsigned ldsw = (unsigned)wid * 1024u;
    const int aoff = lds_byte(wr * 64 + fr, fq * 8), boff = lds_byte(wc * 32 + fr, fq * 8);
#define PG8_SA(b, h) (((b) * 2 + (h)) * HTB)
#define PG8_SB(b, h) ((4 + (b) * 2 + (h)) * HTB)
#define PG8_STAGE(bufoff, gbase, voff) do { _Pragma("unroll") for (int _i = 0; _i < 2; ++_i) \
        __builtin_amdgcn_global_load_lds((const unsigned*)((const char*)(gbase) + (voff)[_i]), (PG8_LAS unsigned*)(lds + (bufoff) + ldsw + _i * 8192), 16, 0, 0); } while (0)
#define PG8_LDA(dst, b, h) do { _Pragma("unroll") for (int m = 0; m < 4; ++m) _Pragma("unroll") for (int k = 0; k < 2; ++k) dst[m][k] = *(const PG8_LAS bf16x8*)(lds + PG8_SA(b, h) + aoff + m * 2048 + k * 1024); } while (0)
#define PG8_LDB(dst, b, h) do { _Pragma("unroll") for (int n = 0; n < 2; ++n) _Pragma("unroll") for (int k = 0; k < 2; ++k) dst[n][k] = *(const PG8_LAS bf16x8*)(lds + PG8_SB(b, h) + boff + n * 2048 + k * 1024); } while (0)
#define PG8_MMA(ai, bj, At, Bt) do { __builtin_amdgcn_s_setprio(1); _Pragma("unroll") for (int m = 0; m < 4; ++m) _Pragma("unroll") for (int n = 0; n < 2; ++n) _Pragma("unroll") for (int k = 0; k < 2; ++k) \
        acc[ai][bj][m][n] = __builtin_amdgcn_mfma_f32_16x16x32_bf16(Bt[n][k], At[m][k], acc[ai][bj][m][n], 0, 0, 0); __builtin_amdgcn_s_setprio(0); } while (0)
#define PG8_WAIT_V(n) asm volatile("s_waitcnt vmcnt(" #n ")" ::: "memory")
#define PG8_WAIT_L(n) asm volatile("s_waitcnt lgkmcnt(" #n ")" ::: "memory")
#define PG8_BAR __builtin_amdgcn_s_barrier()
#define PG8_SCHED __builtin_amdgcn_sched_barrier(0)
    Unit cur, nxt; int ui = 0;
    if (!S.next(0, cur)) return;
    f32x4 acc[2][2][4][2];
#pragma unroll
    for (int a = 0; a < 2; ++a)
#pragma unroll
        for (int b = 0; b < 2; ++b)
#pragma unroll
            for (int m = 0; m < 4; ++m)
#pragma unroll
                for (int n = 0; n < 2; ++n) acc[a][b][m][n] = (f32x4){0.f, 0.f, 0.f, 0.f};
    bf16x8 At[4][2], B0[2][2], B1[2][2];
    const char* cA; const char* cB; S.ptrs(cur, g, cA, cB);
    S.a_ready(cur);
    if constexpr (SP2) {
        PG8_STAGE(PG8_SB(0, 0), cB, voffB); PG8_STAGE(PG8_SB(0, 1), cB + hstepB, voffB); PG8_STAGE(PG8_SA(0, 0), cA, voffA); PG8_STAGE(PG8_SA(0, 1), cA + hstepA, voffA);
        if (wr == 1) PG8_BAR;
        PG8_WAIT_V(2); PG8_BAR;
        PG8_STAGE(PG8_SB(1, 0), cB + kstep, voffB); PG8_STAGE(PG8_SA(1, 0), cA + kstep, voffA); PG8_STAGE(PG8_SB(1, 1), cB + hstepB + kstep, voffB);
        PG8_WAIT_V(6); PG8_BAR;
    } else {
        PG8_STAGE(PG8_SB(0, 0), cB, voffB); PG8_STAGE(PG8_SA(0, 0), cA, voffA); PG8_STAGE(PG8_SB(0, 1), cB + hstepB, voffB); PG8_STAGE(PG8_SA(0, 1), cA + hstepA, voffA);
        if (wr == 1) PG8_BAR;
        PG8_WAIT_V(4); PG8_BAR;
        PG8_STAGE(PG8_SB(1, 0), cB + kstep, voffB); PG8_STAGE(PG8_SA(1, 0), cA + kstep, voffA); PG8_STAGE(PG8_SB(1, 1), cB + hstepB + kstep, voffB);
        PG8_WAIT_V(6); PG8_BAR;
    }
    for (;;) {
        const bool has_next = S.next(ui + 1, nxt);
        const char* nA = cA; const char* nB = cB; if (has_next) S.ptrs(nxt, g, nA, nB);
        for (int t = 0; t < nt; t += 2) {
            const bool last = (t == nt - 2);
            const char* a1 = cA + (size_t)(t + 1) * kstep;
            const char* a2 = last ? nA : cA + (size_t)(t + 2) * kstep; const char* b2 = last ? nB : cB + (size_t)(t + 2) * kstep;
            const char* a3 = a2 + kstep; const char* b3 = b2 + kstep;
            if (last && has_next) S.a_ready(nxt);
            if constexpr (SP2) {
            PG8_LDB(B0, 0, 0); PG8_LDB(B1, 0, 1); PG8_SCHED; PG8_LDA(At, 0, 0); PG8_STAGE(PG8_SA(1, 1), a1 + hstepA, voffA);
            PG8_WAIT_V(8); PG8_WAIT_L(0); PG8_BAR; PG8_MMA(0, 0, At, B0); PG8_MMA(0, 1, At, B1); PG8_BAR; PG8_SCHED;
            PG8_LDA(At, 0, 1); PG8_STAGE(PG8_SB(0, 0), b2, voffB); PG8_STAGE(PG8_SB(0, 1), b2 + hstepB, voffB); PG8_STAGE(PG8_SA(0, 0), a2, voffA);
            PG8_WAIT_V(8); PG8_WAIT_L(0); PG8_BAR; PG8_MMA(1, 0, At, B0); PG8_MMA(1, 1, At, B1); PG8_BAR; PG8_SCHED;
            PG8_LDB(B0, 1, 0); PG8_LDB(B1, 1, 1); PG8_SCHED; PG8_LDA(At, 1, 0); PG8_STAGE(PG8_SA(0, 1), a2 + hstepA, voffA);
            PG8_WAIT_V(8); PG8_WAIT_L(0); PG8_BAR; PG8_MMA(0, 0, At, B0); PG8_MMA(0, 1, At, B1); PG8_BAR; PG8_SCHED;
            PG8_LDA(At, 1, 1); PG8_STAGE(PG8_SB(1, 0), b3, voffB); PG8_STAGE(PG8_SB(1, 1), b3 + hstepB, voffB); PG8_STAGE(PG8_SA(1, 0), a3, voffA);
            PG8_WAIT_V(8); PG8_WAIT_L(0); PG8_BAR; PG8_MMA(1, 0, At, B0); PG8_MMA(1, 1, At, B1); PG8_BAR; PG8_SCHED;
            } else {
            PG8_LDB(B0, 0, 0); PG8_SCHED; PG8_LDA(At, 0, 0); PG8_STAGE(PG8_SA(1, 1), a1 + hstepA, voffA);
            PG8_WAIT_L(8); PG8_BAR; PG8_WAIT_L(0); PG8_MMA(0, 0, At, B0); PG8_BAR; PG8_SCHED;
            PG8_LDB(B1, 0, 1); PG8_STAGE(PG8_SB(0, 0), b2, voffB);
            PG8_BAR; PG8_WAIT_L(0); PG8_MMA(0, 1, At, B1); PG8_BAR;
            PG8_LDA(At, 0, 1); PG8_STAGE(PG8_SA(0, 0), a2, voffA);
            PG8_BAR; PG8_WAIT_L(0); PG8_MMA(1, 0, At, B0); PG8_BAR; PG8_SCHED;
            PG8_STAGE(PG8_SB(0, 1), b2 + hstepB, voffB);
            PG8_WAIT_V(6); PG8_BAR; PG8_MMA(1, 1, At, B1); PG8_BAR;
            PG8_LDB(B0, 1, 0); PG8_SCHED; PG8_LDA(At, 1, 0); PG8_STAGE(PG8_SA(0, 1), a2 + hstepA, voffA);
            PG8_WAIT_L(8); PG8_BAR; PG8_WAIT_L(0); PG8_MMA(0, 0, At, B0); PG8_BAR; PG8_SCHED;
            PG8_LDB(B1, 1, 1); PG8_STAGE(PG8_SB(1, 0), b3, voffB);
            PG8_BAR; PG8_WAIT_L(0); PG8_MMA(0, 1, At, B1); PG8_BAR;
            PG8_LDA(At, 1, 1); PG8_STAGE(PG8_SA(1, 0), a3, voffA);
            PG8_BAR; PG8_WAIT_L(0); PG8_MMA(1, 0, At, B0); PG8_BAR; PG8_SCHED;
            PG8_STAGE(PG8_SB(1, 1), b3 + hstepB, voffB);
            PG8_WAIT_V(6); PG8_BAR; PG8_MMA(1, 1, At, B1); PG8_BAR;
            }
        }
        if constexpr (ALIGN_EPI) { if (wr == 0) PG8_BAR; }
        if constexpr (!Epi::AFTER_DRAIN) { E(acc, cur, wr, wc, fr, fq); S.done(cur); }
        if (!has_next) break;
#pragma unroll
        for (int a = 0; a < 2; ++a)
#pragma unroll
            for (int b = 0; b < 2; ++b)
#pragma unroll
                for (int m = 0; m < 4; ++m)
#pragma unroll
                    for (int n = 0; n < 2; ++n) acc[a][b][m][n] = (f32x4){0.f, 0.f, 0.f, 0.f};
        cur = nxt; cA = nA; cB = nB; ++ui;
        if constexpr (ALIGN_EPI) { if (wr == 1) PG8_BAR; }
    }
    PG8_WAIT_V(0);
    if constexpr (!ALIGN_EPI) { if (wr == 0) PG8_BAR; }
    PG8_BAR;
    if constexpr (Epi::AFTER_DRAIN) { E.fused(acc, cur, wr, wc, fr, fq, lds, wid, lane); S.done(cur); }
#undef PG8_SA
#undef PG8_SB
#undef PG8_STAGE
#undef PG8_LDA
#undef PG8_LDB
#undef PG8_MMA
#undef PG8_WAIT_V
#undef PG8_WAIT_L
#undef PG8_BAR
#undef PG8_SCHED
}
}

#define LAS __attribute__((address_space(3)))
#define DI __device__ __forceinline__
typedef unsigned short bf16;
typedef short bf16x8 __attribute__((ext_vector_type(8)));
typedef short s16x4 __attribute__((ext_vector_type(4)));
typedef float f32x4 __attribute__((ext_vector_type(4)));
typedef float f32x16 __attribute__((ext_vector_type(16)));
typedef unsigned u32x4 __attribute__((ext_vector_type(4)));
typedef unsigned u32x2 __attribute__((ext_vector_type(2)));
typedef LAS unsigned char* ldsp;

constexpr int T_ = 32768, L_ = 16384, D_ = 1024;
constexpr float EPS_ = 1e-5f;
constexpr size_t MiB = (size_t)1 << 20;
constexpr size_t WS_W = 1 * MiB;
constexpr size_t WS_WA = WS_W, WS_WV = WS_W + 9 * MiB, WS_WOUT = WS_W + 11 * MiB, WS_WQ = WS_W + 15 * MiB, WS_WKV = WS_W + 17 * MiB,
                 WS_WXO = WS_W + 21 * MiB, WS_W1 = WS_W + 23 * MiB, WS_W2 = WS_W + 31 * MiB;
constexpr size_t WS_XN = 40 * MiB, WS_KT = WS_XN, WS_DG = WS_XN + 33 * MiB;
constexpr size_t WS_BIG = 104 * MiB, WS_VT = 376 * MiB, WS_ORAW = 441 * MiB, WS_SMALL = 505 * MiB, WS_MEMN = 509 * MiB, WS_KX = 510 * MiB, WS_VXT = 511 * MiB, WS_END = 512 * MiB;
constexpr int PROJ_LD = 4352;
constexpr int PC_Z = 0, PC_XBC = 1024, PC_Q = 2304, PC_K = 2816, PC_R = 3328;
constexpr int LDS_BYTES = 140 * 1024;
constexpr int VT_LD = T_ + 64, KT_LD = T_ + 64, QK_LD = 2048 + 64;

DI unsigned f2bf(float f) { unsigned u = __builtin_bit_cast(unsigned, f); return (u + 0x7fffu + ((u >> 16) & 1u)) >> 16; }
typedef float f32x2_t __attribute__((ext_vector_type(2))); typedef __bf16 bf16x2_t __attribute__((ext_vector_type(2)));
DI unsigned pk2(float lo, float hi) { f32x2_t v = {lo, hi}; bf16x2_t b = __builtin_convertvector(v, bf16x2_t); return __builtin_bit_cast(unsigned, b); }
DI float bf2f(unsigned h) { return __builtin_bit_cast(float, h << 16); }
DI float bflo(unsigned w) { return __builtin_bit_cast(float, w << 16); }
DI float bfhi(unsigned w) { return __builtin_bit_cast(float, w & 0xffff0000u); }
DI float wave_sum(float v) {
#pragma unroll
    for (int o = 1; o < 64; o <<= 1) v += __shfl_xor(v, o);
    return v;
}
DI float wave_max(float v) {
#pragma unroll
    for (int o = 1; o < 64; o <<= 1) v = fmaxf(v, __shfl_xor(v, o));
    return v;
}
DI float siluf(float x) { return x * __builtin_amdgcn_rcpf(1.f + __builtin_amdgcn_exp2f(-1.4426950408889634f * x)); }
DI float softplusf(float x) {
    const float e = __expf(-fabsf(x));
    const float l = (e < 0.01f) ? e * (1.f - e * (0.5f - e * (1.f / 3.f))) : __logf(1.f + e);
    return fmaxf(x, 0.f) + l;
}
DI bf16x8 lds16(ldsp p, int off) { return *(LAS bf16x8*)(p + off); }
DI s16x4 lds8(ldsp p, int off) { return *(LAS s16x4*)(p + off); }
DI bf16x8 cat8(s16x4 a, s16x4 b) { return __builtin_shufflevector(a, b, 0, 1, 2, 3, 4, 5, 6, 7); }
DI f32x4 mfma16(bf16x8 a, bf16x8 b, f32x4 c) { return __builtin_amdgcn_mfma_f32_16x16x32_bf16(a, b, c, 0, 0, 0); }
DI f32x16 mfma32(bf16x8 a, bf16x8 b, f32x16 c) { return __builtin_amdgcn_mfma_f32_32x32x16_bf16(a, b, c, 0, 0, 0); }
DI int crow(int r, int hi) { return (r & 3) + 8 * (r >> 2) + 4 * hi; }
DI float max3f(float a, float b, float c) { float r; asm("v_max3_f32 %0, %1, %2, %3" : "=v"(r) : "v"(a), "v"(b), "v"(c)); return r; }
#define LDS_FENCE() asm volatile("s_waitcnt lgkmcnt(0)" ::: "memory")

DI void rms_rows_bf16(const float* x, const float* w, bf16* out, int nrows, int gw, int NGW, int lane) {
    for (int m = 2 * gw; m < nrows; m += 2 * NGW) {
        const f32x4* xr0 = (const f32x4*)(x + (size_t)m * D_) + lane; const f32x4* xr1 = xr0 + D_ / 4;
        f32x4 v0[4], v1[4]; float s0 = 0.f, s1 = 0.f;
#pragma unroll
        for (int j = 0; j < 4; ++j) { v0[j] = xr0[64 * j]; v1[j] = xr1[64 * j]; }
#pragma unroll
        for (int j = 0; j < 4; ++j) { s0 += (v0[j].x * v0[j].x + v0[j].y * v0[j].y) + (v0[j].z * v0[j].z + v0[j].w * v0[j].w); s1 += (v1[j].x * v1[j].x + v1[j].y * v1[j].y) + (v1[j].z * v1[j].z + v1[j].w * v1[j].w); }
#pragma unroll
        for (int o = 1; o < 64; o <<= 1) { s0 += __shfl_xor(s0, o); s1 += __shfl_xor(s1, o); }
        const float r0 = rsqrtf(s0 * (1.f / D_) + EPS_), r1 = rsqrtf(s1 * (1.f / D_) + EPS_);
        u32x2* o0 = (u32x2*)(out + (size_t)m * D_) + lane; u32x2* o1 = o0 + D_ / 4;
#pragma unroll
        for (int j = 0; j < 4; ++j) { const f32x4 wv = ((const f32x4*)w)[lane + 64 * j];
            u32x2 a, b; a.x = pk2(v0[j].x * r0 * wv.x, v0[j].y * r0 * wv.y); a.y = pk2(v0[j].z * r0 * wv.z, v0[j].w * r0 * wv.w);
            b.x = pk2(v1[j].x * r1 * wv.x, v1[j].y * r1 * wv.y); b.y = pk2(v1[j].z * r1 * wv.z, v1[j].w * r1 * wv.w);
            o0[64 * j] = a; o1[64 * j] = b; }
    }
}
template <bool TO_F32> DI void rms_rows_from_bf16(const bf16* x, const float* w, bf16* outb, float* outf, int nrows, int gw, int NGW, int lane) {
    f32x4 wv[4];
#pragma unroll
    for (int j = 0; j < 4; ++j) wv[j] = ((const f32x4*)(w + lane * 16))[j];
    for (int m = 2 * gw; m < nrows; m += 2 * NGW) {
        u32x4 ra[2], rb[2];
#pragma unroll
        for (int u = 0; u < 2; ++u) { const u32x4* p = (const u32x4*)(x + (size_t)(m + u) * D_ + lane * 16); ra[u] = p[0]; rb[u] = p[1]; }
#pragma unroll
        for (int u = 0; u < 2; ++u) {
            float v[16];
            v[0] = bflo(ra[u].x); v[1] = bfhi(ra[u].x); v[2] = bflo(ra[u].y); v[3] = bfhi(ra[u].y); v[4] = bflo(ra[u].z); v[5] = bfhi(ra[u].z); v[6] = bflo(ra[u].w); v[7] = bfhi(ra[u].w);
            v[8] = bflo(rb[u].x); v[9] = bfhi(rb[u].x); v[10] = bflo(rb[u].y); v[11] = bfhi(rb[u].y); v[12] = bflo(rb[u].z); v[13] = bfhi(rb[u].z); v[14] = bflo(rb[u].w); v[15] = bfhi(rb[u].w);
            float s = 0.f;
#pragma unroll
            for (int i = 0; i < 16; ++i) s += v[i] * v[i];
            const float r = rsqrtf(wave_sum(s) * (1.f / D_) + EPS_);
#pragma unroll
            for (int i = 0; i < 16; ++i) v[i] = v[i] * r * wv[i >> 2][i & 3];
            if (TO_F32) { f32x4* o = (f32x4*)(outf + (size_t)(m + u) * D_ + lane * 16);
#pragma unroll
                for (int j = 0; j < 4; ++j) o[j] = (f32x4){v[4 * j], v[4 * j + 1], v[4 * j + 2], v[4 * j + 3]}; }
            else { u32x4 a, b; a.x = pk2(v[0], v[1]); a.y = pk2(v[2], v[3]); a.z = pk2(v[4], v[5]); a.w = pk2(v[6], v[7]); b.x = pk2(v[8], v[9]); b.y = pk2(v[10], v[11]); b.z = pk2(v[12], v[13]); b.w = pk2(v[14], v[15]);
                u32x4* o = (u32x4*)(outb + (size_t)(m + u) * D_ + lane * 16); o[0] = a; o[1] = b; }
        }
    }
}
DI void xb_rows(const float* x, bf16* out, float* ssq, int nrows, int gw, int NGW, int lane) {
    for (int m = gw; m < nrows; m += NGW) {
        const f32x4* xr = (const f32x4*)(x + (size_t)m * D_) + lane;
        f32x4 v[4]; float s = 0.f;
#pragma unroll
        for (int j = 0; j < 4; ++j) { v[j] = xr[64 * j]; s += (v[j].x * v[j].x + v[j].y * v[j].y) + (v[j].z * v[j].z + v[j].w * v[j].w); }
        s = wave_sum(s);
        u32x2* o8 = (u32x2*)(out + (size_t)m * D_) + lane;
#pragma unroll
        for (int j = 0; j < 4; ++j) { u32x2 o; o.x = pk2(v[j].x, v[j].y); o.y = pk2(v[j].z, v[j].w); o8[64 * j] = o; }
        if (lane < 16) ssq[(size_t)m * 16 + lane] = (lane == 0) ? s : 0.f;
    }
}
DI void rms_rows_f32_inplace(float* x, const float* w, int nrows, int gw, int NGW, int lane) {
    for (int m = gw; m < nrows; m += NGW) {
        f32x4* xr = (f32x4*)(x + (size_t)m * D_) + lane;
        f32x4 v[4]; float s = 0.f;
#pragma unroll
        for (int j = 0; j < 4; ++j) { v[j] = xr[64 * j]; s += (v[j].x * v[j].x + v[j].y * v[j].y) + (v[j].z * v[j].z + v[j].w * v[j].w); }
        const float rstd = rsqrtf(wave_sum(s) * (1.f / D_) + EPS_);
#pragma unroll
        for (int j = 0; j < 4; ++j) { const f32x4 wv = ((const f32x4*)w)[lane + 64 * j]; xr[64 * j] = v[j] * rstd * wv; }
    }
}

DI int map_plain(int d, int off) { return d + off; }
DI int map_win(int d) { if (d < 2304) return d; if (d < 3328) return d + 16; if (d < 4352) return d + 1056; if (d < 4368) return d - 4352 + 2304; if (d < 4384) return d; return -1; }
DI void conv_item(const float* W, int ldn, int K, bf16* WT, int nrows, int mode, int off, LAS float* scr, int item, int lane, const float* kscale = nullptr) {
    const int nblk = nrows / 32, kb = item / nblk, nb = item % nblk, k0 = 64 * kb, n0 = 32 * nb;
    const int d = n0 + (lane & 31); const int sc = mode ? map_win(d) : map_plain(d, off);
#pragma unroll 32
    for (int i = 0; i < 32; ++i) { const int kk = 2 * i + (lane >> 5); scr[kk * 33 + (lane & 31)] = sc >= 0 ? W[(size_t)(k0 + kk) * ldn + sc] : 0.f; }
    LDS_FENCE();
    const int c = lane & 7;
    f32x4 ka = (f32x4){1.f, 1.f, 1.f, 1.f}, kb2 = ka;
    if (kscale) { ka = *(const f32x4*)(kscale + k0 + 8 * c); kb2 = *(const f32x4*)(kscale + k0 + 8 * c + 4); }
#pragma unroll
    for (int j = 0; j < 4; ++j) { const int n = (lane >> 3) + 8 * j; const LAS float* s = scr + (8 * c) * 33 + n;
        u32x4 o; o.x = pk2(s[0 * 33] * ka[0], s[1 * 33] * ka[1]); o.y = pk2(s[2 * 33] * ka[2], s[3 * 33] * ka[3]); o.z = pk2(s[4 * 33] * kb2[0], s[5 * 33] * kb2[1]); o.w = pk2(s[6 * 33] * kb2[2], s[7 * 33] * kb2[3]);
        *(u32x4*)(WT + (size_t)(n0 + n) * K + k0 + 8 * c) = o; }
    LDS_FENCE();
}

DI void prep_unit(int unit, bf16* PROJ, float* SMALL, bf16* KT, float* DG, bf16* TAIL, const float* gla_w2, const float* gla_b, const float* dt_bias, const float* a_log,
                  const float* conv_w, const float* conv_b, ldsp lds, int tid) {
    asm volatile("" : "+v"(tid));
    const int rowbase = unit * 128;
    LAS float* sm = (LAS float*)lds; LAS float* dtL = (LAS float*)(lds + 16384);
    for (int i = tid; i < 128 * 32 / 4; i += 512) ((LAS f32x4*)sm)[i] = ((const f32x4*)(SMALL + (size_t)rowbase * 32))[i];
    __syncthreads();
    if (tid < 16) {
        const int h = tid; const float a = -__expf(a_log[h]), bias = dt_bias[h]; float cum = 0.f;
        for (int tt = 0; tt < 128; ++tt) { const float dtv = softplusf(sm[tt * 32 + h] + bias); cum += dtv * a; dtL[tt * 16 + h] = dtv;
            SMALL[((size_t)rowbase + tt) * 32 + h] = dtv; SMALL[((size_t)rowbase + tt) * 32 + 16 + h] = cum; }
    }
    {   const int col = tid;
        float w2c[16];
#pragma unroll
        for (int r = 0; r < 16; ++r) w2c[r] = gla_w2[r * 512 + col];
        const float bcol = gla_b[col];
        for (int sub = 0; sub < 2; ++sub) {
            float cum = 0.f;
#pragma unroll 1
            for (int g8 = 0; g8 < 8; ++g8) {
                unsigned qk[8];
                { const bf16* pq = PROJ + ((size_t)rowbase + sub * 64 + g8 * 8) * PROJ_LD + col;
#pragma unroll
                  for (int e = 0; e < 8; ++e) qk[e] = (unsigned)pq[(size_t)e * PROJ_LD + PC_Q] | ((unsigned)pq[(size_t)e * PROJ_LD + PC_K] << 16); }
                float kt[8];
#pragma unroll
                for (int e = 0; e < 8; ++e) {
                    const int tt = sub * 64 + g8 * 8 + e; const size_t row = (size_t)rowbase + tt;
                    float x = bcol;
#pragma unroll
                    for (int r = 0; r < 16; ++r) x += sm[tt * 32 + 16 + r] * w2c[r];
                    const float lg = (fminf(x, 0.f) - __logf(1.f + __expf(-fabsf(x)))) * 0.0625f;
                    cum += lg;
                    const float qv = bflo(qk[e]), kv = bfhi(qk[e]);
                    PROJ[row * PROJ_LD + PC_Q + col] = (bf16)f2bf(qv * __expf(cum) * 0.08838834764831845f);
                    kt[e] = kv * __expf(-cum);
                    PROJ[row * PROJ_LD + PC_K + col] = (bf16)f2bf(kt[e]);
                }
                u32x4 o; o.x = pk2(kt[0], kt[1]); o.y = pk2(kt[2], kt[3]); o.z = pk2(kt[4], kt[5]); o.w = pk2(kt[6], kt[7]);
                *(u32x4*)(KT + (size_t)col * KT_LD + rowbase + sub * 64 + g8 * 8) = o;
            }
            DG[(size_t)((rowbase >> 6) + sub) * 512 + col] = __expf(cum);
        }
    }
    const int tin = rowbase & (L_ - 1);
    __syncthreads();
#pragma unroll 1
    for (int i = 4; i >= 0; --i) { const int it = tid + 512 * i, pair = it % 640, slab = it / 640, c0 = 2 * pair;
        unsigned rw[35];
        bf16* base = PROJ + ((size_t)rowbase + 32 * slab) * PROJ_LD + PC_XBC + c0;
#pragma unroll
        for (int j = 0; j < 35; ++j) rw[j] = (tin + 32 * slab - 3 + j >= 0) ? *(const unsigned*)(base + (ptrdiff_t)(j - 3) * PROJ_LD) : 0u;
        float cw0[4], cw1[4];
#pragma unroll
        for (int j = 0; j < 4; ++j) { cw0[j] = conv_w[j * 1280 + c0]; cw1[j] = conv_w[j * 1280 + c0 + 1]; }
        const float cb0 = conv_b[c0], cb1 = conv_b[c0 + 1];
        const bool isx = c0 < 1024; const int hh = (c0 >> 6) & 15;
        __syncthreads();
#pragma unroll
        for (int r = 0; r < 32; ++r) { float a0 = cb0, a1 = cb1;
#pragma unroll
            for (int j = 0; j < 4; ++j) { a0 += cw0[j] * bflo(rw[r + j]); a1 += cw1[j] * bfhi(rw[r + j]); }
            a0 = siluf(a0); a1 = siluf(a1);
            const int row = 32 * slab + r;
            if (isx) { const float d = dtL[row * 16 + hh]; a0 *= d; a1 *= d; }
            bf16* dst = (row >= 125) ? TAIL + ((size_t)unit * 3 + (row - 125)) * 1280 + c0 : base + (size_t)r * PROJ_LD;
            *(unsigned*)dst = pk2(a0, a1); }
    }
    __syncthreads();
}

#define BAR_LDS() asm volatile("s_waitcnt lgkmcnt(0)\n\ts_barrier" ::: "memory")
DI void ssd_chain(int b, int h, bf16* PROJ, const float* SMALL, const bf16* TAIL, const float* d_skip, ldsp lds, int tid) {
    constexpr int CS = 0, BS = 18432, BWT = 36864, XDT = 54272, MS = 71680, SS = 106496, CUML = 115712, DTL = 116224;
    asm volatile("" : "+v"(tid));
    const int lane = tid & 63, w = __builtin_amdgcn_readfirstlane(tid >> 6), quad = lane >> 4, l16 = lane & 15;
    const int g = h >> 3, cp = lane & 31, th = lane >> 5, tb = 16 * w + 8 * th;
    LAS float* cumL = (LAS float*)(lds + CUML); LAS float* dtL = (LAS float*)(lds + DTL);
    int ch[3]; ch[0] = h * 64 + 2 * cp; ch[1] = 1024 + g * 64 + 2 * cp; ch[2] = 1152 + g * 64 + 2 * cp;
    const float Dh = d_skip[h];
    const int pi = w >> 1, q = 16 * w + l16;
    f32x4 S[2]; S[0] = (f32x4){0.f, 0.f, 0.f, 0.f}; S[1] = S[0];
    unsigned raw[3][8]; float cmv[8], cum_last, cl_t = 0.f, dt_t = 0.f; u32x2 zz[4];
#define SSD_LOAD(c_) do { const size_t r0_ = (size_t)b * L_ + (size_t)(c_) * 128; \
        _Pragma("unroll") for (int i = 0; i < 8; ++i) cmv[i] = SMALL[(r0_ + tb + i) * 32 + 16 + h]; \
        cum_last = SMALL[(r0_ + 127) * 32 + 16 + h]; \
        if (tid < 128) { cl_t = SMALL[(r0_ + tid) * 32 + 16 + h]; dt_t = SMALL[(r0_ + tid) * 32 + h]; } \
        _Pragma("unroll") for (int arr = 0; arr < 3; ++arr) _Pragma("unroll") for (int i = 0; i < 8; ++i) { const int rr = tb + i; \
            const bf16* sp = (rr >= 125) ? TAIL + ((r0_ >> 7) * 3 + (rr - 125)) * 1280 + ch[arr] : PROJ + (r0_ + rr) * PROJ_LD + PC_XBC + ch[arr]; \
            raw[arr][i] = *(const unsigned*)sp; } \
        _Pragma("unroll") for (int pt = 0; pt < 4; ++pt) zz[pt] = *(const u32x2*)(PROJ + (r0_ + q) * PROJ_LD + PC_Z + h * 64 + 16 * pt + quad * 4); } while (0)
    SSD_LOAD(0);
    for (int c = 0; c < 128; ++c) {
        const size_t row0 = (size_t)b * L_ + (size_t)c * 128;
        if (tid < 128) { cumL[tid] = cl_t; dtL[tid] = dt_t; }
        {
            u32x4 v0, v1;
            v0.x = __builtin_amdgcn_perm(raw[0][1], raw[0][0], 0x05040100u); v0.y = __builtin_amdgcn_perm(raw[0][3], raw[0][2], 0x05040100u);
            v0.z = __builtin_amdgcn_perm(raw[0][5], raw[0][4], 0x05040100u); v0.w = __builtin_amdgcn_perm(raw[0][7], raw[0][6], 0x05040100u);
            v1.x = __builtin_amdgcn_perm(raw[0][1], raw[0][0], 0x07060302u); v1.y = __builtin_amdgcn_perm(raw[0][3], raw[0][2], 0x07060302u);
            v1.z = __builtin_amdgcn_perm(raw[0][5], raw[0][4], 0x07060302u); v1.w = __builtin_amdgcn_perm(raw[0][7], raw[0][6], 0x07060302u);
            *(LAS u32x4*)(lds + XDT + (2 * cp) * 272 + tb * 2) = v0; *(LAS u32x4*)(lds + XDT + (2 * cp + 1) * 272 + tb * 2) = v1;
        }
        {
            float o0[8], o1[8];
#pragma unroll
            for (int i = 0; i < 8; ++i) { *(LAS unsigned*)(lds + BS + (tb + i) * 144 + 4 * cp) = raw[1][i];
                const float wg = __expf(cum_last - cmv[i]); o0[i] = bflo(raw[1][i]) * wg; o1[i] = bfhi(raw[1][i]) * wg; }
            u32x4 v0, v1; v0.x = pk2(o0[0], o0[1]); v0.y = pk2(o0[2], o0[3]); v0.z = pk2(o0[4], o0[5]); v0.w = pk2(o0[6], o0[7]);
            v1.x = pk2(o1[0], o1[1]); v1.y = pk2(o1[2], o1[3]); v1.z = pk2(o1[4], o1[5]); v1.w = pk2(o1[6], o1[7]);
            *(LAS u32x4*)(lds + BWT + (2 * cp) * 272 + tb * 2) = v0; *(LAS u32x4*)(lds + BWT + (2 * cp + 1) * 272 + tb * 2) = v1;
        }
#pragma unroll
        for (int i = 0; i < 8; ++i) *(LAS unsigned*)(lds + CS + (tb + i) * 144 + 4 * cp) = raw[2][i];
        u32x2 zc[4];
#pragma unroll
        for (int pt = 0; pt < 4; ++pt) zc[pt] = zz[pt];
        if (c + 1 < 128) SSD_LOAD(c + 1);
        BAR_LDS();
        const float cq = cumL[q], dq = dtL[q];
        const int fo = quad * 16;
        {
            bf16x8 cb[2];
#pragma unroll
            for (int k = 0; k < 2; ++k) cb[k] = lds16(lds, CS + q * 144 + 64 * k + fo);
#pragma unroll
            for (int jh = 0; jh < 2; ++jh) {
                bf16x8 ba[4][2];
#pragma unroll
                for (int j4 = 0; j4 < 4; ++j4) if (4 * jh + j4 <= w) {
#pragma unroll
                    for (int k = 0; k < 2; ++k) ba[j4][k] = lds16(lds, BS + (16 * (4 * jh + j4) + l16) * 144 + 64 * k + fo); }
                __builtin_amdgcn_sched_barrier(0);
                f32x4 acc[4];
#pragma unroll
                for (int j4 = 0; j4 < 4; ++j4) { acc[j4] = (f32x4){0.f, 0.f, 0.f, 0.f};
                    if (4 * jh + j4 <= w) { acc[j4] = mfma16(ba[j4][0], cb[0], acc[j4]); acc[j4] = mfma16(ba[j4][1], cb[1], acc[j4]); } }
                __builtin_amdgcn_sched_barrier(0);
#pragma unroll
                for (int j4 = 0; j4 < 4; ++j4) {
                    const int s0 = 16 * (4 * jh + j4) + quad * 4;
                    const f32x4 cs = *(LAS f32x4*)(cumL + s0);
                    float v[4];
#pragma unroll
                    for (int jj = 0; jj < 4; ++jj) { const int s = s0 + jj; float t = (s <= q) ? acc[j4][jj] * __expf(cq - cs[jj]) : 0.f; if (s == q && dq > 0.f) t += Dh / dq; v[jj] = t; }
                    u32x2 o; o.x = pk2(v[0], v[1]); o.y = pk2(v[2], v[3]);
                    *(LAS u32x2*)(lds + MS + q * 272 + s0 * 2) = o;
                }
            }
        }
#pragma unroll
        for (int i = 0; i < 2; ++i) { const int ni = (w & 1) * 2 + i; u32x2 o; o.x = pk2(S[i][0], S[i][1]); o.y = pk2(S[i][2], S[i][3]);
            *(LAS u32x2*)(lds + SS + (16 * pi + l16) * 144 + (16 * ni + quad * 4) * 2) = o; }
        const float el = __expf(cumL[127]);
        BAR_LDS();
        const float eq = __expf(cq);
        {
            bf16x8 mb[4], cb[2];
#pragma unroll
            for (int ks = 0; ks < 4; ++ks) mb[ks] = lds16(lds, MS + q * 272 + 64 * ks + fo);
#pragma unroll
            for (int k = 0; k < 2; ++k) cb[k] = lds16(lds, CS + q * 144 + 64 * k + fo);
#pragma unroll
            for (int pt = 0; pt < 4; ++pt) {
                bf16x8 xa[4], sa[2];
#pragma unroll
                for (int ks = 0; ks < 4; ++ks) xa[ks] = lds16(lds, XDT + (16 * pt + l16) * 272 + 64 * ks + fo);
#pragma unroll
                for (int k = 0; k < 2; ++k) sa[k] = lds16(lds, SS + (16 * pt + l16) * 144 + 64 * k + fo);
                __builtin_amdgcn_sched_barrier(0);
                f32x4 y1 = (f32x4){0.f, 0.f, 0.f, 0.f}, y2 = y1;
#pragma unroll
                for (int ks = 0; ks < 4; ++ks) if (32 * ks < 16 * w + 16) y1 = mfma16(xa[ks], mb[ks], y1);
#pragma unroll
                for (int k = 0; k < 2; ++k) y2 = mfma16(sa[k], cb[k], y2);
                __builtin_amdgcn_sched_barrier(0);
                bf16* zp = PROJ + (row0 + q) * PROJ_LD + PC_Z + h * 64 + 16 * pt + quad * 4;
                const float z0 = bflo(zc[pt].x), z1 = bfhi(zc[pt].x), z2 = bflo(zc[pt].y), z3 = bfhi(zc[pt].y);
                u32x2 o; o.x = pk2((y1[0] + eq * y2[0]) * siluf(z0), (y1[1] + eq * y2[1]) * siluf(z1)); o.y = pk2((y1[2] + eq * y2[2]) * siluf(z2), (y1[3] + eq * y2[3]) * siluf(z3));
                *(u32x2*)zp = o;
            }
        }
        {
            bf16x8 xb[4], wa[2][4];
#pragma unroll
            for (int ks = 0; ks < 4; ++ks) xb[ks] = lds16(lds, XDT + (16 * pi + l16) * 272 + 64 * ks + fo);
#pragma unroll
            for (int i = 0; i < 2; ++i)
#pragma unroll
                for (int ks = 0; ks < 4; ++ks) wa[i][ks] = lds16(lds, BWT + (16 * ((w & 1) * 2 + i) + l16) * 272 + 64 * ks + fo);
            __builtin_amdgcn_sched_barrier(0);
            S[0] = S[0] * el; S[1] = S[1] * el;
#pragma unroll
            for (int ks = 0; ks < 4; ++ks) { S[0] = mfma16(wa[0][ks], xb[ks], S[0]); S[1] = mfma16(wa[1][ks], xb[ks], S[1]); }
        }
        BAR_LDS();
    }
#undef SSD_LOAD
}

DI void gla_chain(int b, int h, int vs, const bf16* PROJ, const bf16* KT, const bf16* VT, const float* DG, bf16* ORAW, ldsp lds, int tid) {
    constexpr int QS = 0, KS = 17408, KTS = 34816, VTS = 53248, PS = 62464, STS = 71680, DLO = 89088;
    asm volatile("" : "+v"(tid));
    const int lane = tid & 63, w = __builtin_amdgcn_readfirstlane(tid >> 6), quad = lane >> 4, l16 = lane & 15, qi = w >> 1;
    LAS float* dL = (LAS float*)(lds + DLO);
    f32x4 S[4];
#pragma unroll
    for (int i = 0; i < 4; ++i) S[i] = (f32x4){0.f, 0.f, 0.f, 0.f};
    u32x4 Aq[2], Ak[2], Akt[2], Av, Bq[2], Bk[2], Bkt[2], Bv; float Ad = 0.f, Bd = 0.f;
#define GLA_LOAD(c_, P) do { const size_t r0_ = (size_t)b * L_ + (size_t)(c_) * 64; \
        _Pragma("unroll") for (int i = 0; i < 2; ++i) { const int idx = tid + 512 * i, r = idx >> 4, cc = idx & 15; \
            P##q[i] = *(const u32x4*)(PROJ + (r0_ + r) * PROJ_LD + PC_Q + h * 128 + cc * 8); P##k[i] = *(const u32x4*)(PROJ + (r0_ + r) * PROJ_LD + PC_K + h * 128 + cc * 8); } \
        _Pragma("unroll") for (int i = 0; i < 2; ++i) { const int idx = tid + 512 * i, r = idx >> 3, cc = idx & 7; P##kt[i] = *(const u32x4*)(KT + (size_t)(h * 128 + r) * KT_LD + r0_ + cc * 8); } \
        { const int r = tid >> 3, cc = tid & 7; P##v = *(const u32x4*)(VT + (size_t)(h * 256 + vs * 64 + r) * VT_LD + r0_ + cc * 8); } \
        if (tid < 128) P##d = DG[(r0_ >> 6) * 512 + h * 128 + tid]; } while (0)
#define GLA_PUT(P) do { \
        _Pragma("unroll") for (int i = 0; i < 2; ++i) { const int idx = tid + 512 * i, r = idx >> 4, cc = idx & 15; \
            *(LAS u32x4*)(lds + QS + r * 272 + cc * 16) = P##q[i]; *(LAS u32x4*)(lds + KS + r * 272 + cc * 16) = P##k[i]; } \
        _Pragma("unroll") for (int i = 0; i < 2; ++i) { const int idx = tid + 512 * i, r = idx >> 3, cc = idx & 7; *(LAS u32x4*)(lds + KTS + r * 144 + cc * 16) = P##kt[i]; } \
        { const int r = tid >> 3, cc = tid & 7; *(LAS u32x4*)(lds + VTS + r * 144 + cc * 16) = P##v; } \
        if (tid < 128) dL[tid] = P##d; } while (0)
#define GLA_COMPUTE(c_) do { \
        const size_t row0 = (size_t)b * L_ + (size_t)(c_) * 64; \
        BAR_LDS(); \
        const int q = 16 * qi + l16; \
        const int fo = quad * 16; \
        { \
            bf16x8 fb[4], fa[2][4]; \
_Pragma("unroll") \
            for (int ks = 0; ks < 4; ++ks) fb[ks] = lds16(lds, QS + q * 272 + 64 * ks + fo); \
_Pragma("unroll") \
            for (int i = 0; i < 2; ++i) \
_Pragma("unroll") \
                for (int ks = 0; ks < 4; ++ks) fa[i][ks] = lds16(lds, KS + (16 * ((w & 1) * 2 + i) + l16) * 272 + 64 * ks + fo); \
            __builtin_amdgcn_sched_barrier(0); \
            f32x4 acc[2]; acc[0] = (f32x4){0.f, 0.f, 0.f, 0.f}; acc[1] = acc[0]; \
_Pragma("unroll") \
            for (int ks = 0; ks < 4; ++ks) { acc[0] = mfma16(fa[0][ks], fb[ks], acc[0]); acc[1] = mfma16(fa[1][ks], fb[ks], acc[1]); } \
            __builtin_amdgcn_sched_barrier(0); \
_Pragma("unroll") \
            for (int i = 0; i < 2; ++i) { const int s0 = 16 * ((w & 1) * 2 + i) + quad * 4; \
                u32x2 o; o.x = pk2(s0 <= q ? acc[i][0] : 0.f, s0 + 1 <= q ? acc[i][1] : 0.f); o.y = pk2(s0 + 2 <= q ? acc[i][2] : 0.f, s0 + 3 <= q ? acc[i][3] : 0.f); \
                *(LAS u32x2*)(lds + PS + q * 144 + s0 * 2) = o; } \
        } \
_Pragma("unroll") \
        for (int vt = 0; vt < 4; ++vt) { u32x2 o; o.x = pk2(S[vt][0], S[vt][1]); o.y = pk2(S[vt][2], S[vt][3]); \
            *(LAS u32x2*)(lds + STS + (16 * vt + l16) * 272 + (16 * w + quad * 4) * 2) = o; } \
        BAR_LDS(); \
        { \
            bf16x8 pb[2], qb4[4], va[2][2], sa[2][4], ka[2], vb[4][2]; \
_Pragma("unroll") \
            for (int ks = 0; ks < 2; ++ks) pb[ks] = lds16(lds, PS + q * 144 + 64 * ks + fo); \
_Pragma("unroll") \
            for (int ks = 0; ks < 4; ++ks) qb4[ks] = lds16(lds, QS + q * 272 + 64 * ks + fo); \
_Pragma("unroll") \
            for (int i = 0; i < 2; ++i) { const int vt = (w & 1) * 2 + i; \
_Pragma("unroll") \
                for (int ks = 0; ks < 2; ++ks) va[i][ks] = lds16(lds, VTS + (16 * vt + l16) * 144 + 64 * ks + fo); \
_Pragma("unroll") \
                for (int ks = 0; ks < 4; ++ks) sa[i][ks] = lds16(lds, STS + (16 * vt + l16) * 272 + 64 * ks + fo); } \
_Pragma("unroll") \
            for (int ks = 0; ks < 2; ++ks) ka[ks] = lds16(lds, KTS + (16 * w + l16) * 144 + 64 * ks + fo); \
_Pragma("unroll") \
            for (int vt = 0; vt < 4; ++vt) \
_Pragma("unroll") \
                for (int ks = 0; ks < 2; ++ks) vb[vt][ks] = lds16(lds, VTS + (16 * vt + l16) * 144 + 64 * ks + fo); \
            const f32x4 dv = *(LAS f32x4*)(dL + 16 * w + quad * 4); \
            __builtin_amdgcn_sched_barrier(0); \
            f32x4 o[2]; o[0] = (f32x4){0.f, 0.f, 0.f, 0.f}; o[1] = o[0]; \
_Pragma("unroll") \
            for (int ks = 0; ks < 2; ++ks) { o[0] = mfma16(va[0][ks], pb[ks], o[0]); o[1] = mfma16(va[1][ks], pb[ks], o[1]); } \
_Pragma("unroll") \
            for (int ks = 0; ks < 4; ++ks) { o[0] = mfma16(sa[0][ks], qb4[ks], o[0]); o[1] = mfma16(sa[1][ks], qb4[ks], o[1]); } \
_Pragma("unroll") \
            for (int ks = 0; ks < 2; ++ks) \
_Pragma("unroll") \
                for (int vt = 0; vt < 4; ++vt) S[vt] = mfma16(ka[ks], vb[vt][ks], S[vt]); \
            __builtin_amdgcn_sched_barrier(0); \
_Pragma("unroll") \
            for (int i = 0; i < 2; ++i) { const int vt = (w & 1) * 2 + i; u32x2 ov; ov.x = pk2(o[i][0], o[i][1]); ov.y = pk2(o[i][2], o[i][3]); \
                *(u32x2*)(ORAW + (row0 + q) * 2048 + 1024 + h * 256 + vs * 64 + 16 * vt + quad * 4) = ov; } \
_Pragma("unroll") \
            for (int vt = 0; vt < 4; ++vt) S[vt] = S[vt] * dv; \
        } \
        BAR_LDS(); \
    } while (0)
    GLA_LOAD(0, A); GLA_LOAD(1, B);
    for (int c = 0; c < 256; c += 2) {
        GLA_PUT(A); if (c + 2 < 256) GLA_LOAD(c + 2, A); GLA_COMPUTE(c);
        GLA_PUT(B); if (c + 3 < 256) GLA_LOAD(c + 3, B); GLA_COMPUTE(c + 1);
    }
#undef GLA_PUT
#undef GLA_COMPUTE
#undef GLA_LOAD
}

#define UNPACK16(a, b, v) do { v[0] = bflo(a.x); v[1] = bfhi(a.x); v[2] = bflo(a.y); v[3] = bfhi(a.y); v[4] = bflo(a.z); v[5] = bfhi(a.z); v[6] = bflo(a.w); v[7] = bfhi(a.w); \
    v[8] = bflo(b.x); v[9] = bfhi(b.x); v[10] = bflo(b.y); v[11] = bfhi(b.y); v[12] = bflo(b.z); v[13] = bfhi(b.z); v[14] = bflo(b.w); v[15] = bfhi(b.w); } while (0)
DI void gate_rows(bf16* PROJ, bf16* ORAW, const float* ssd_norm, const float* gla_norm, int gw, int NGW, int lane) {
    for (int t0 = 2 * gw; t0 < T_; t0 += 2 * NGW) {
        u32x4 ya[2], yb[2], oa[2], ob[2], ra[2], rb[2];
#pragma unroll
        for (int u = 0; u < 2; ++u) { const size_t t = (size_t)t0 + u;
            const bf16* yp = PROJ + t * PROJ_LD + PC_Z + lane * 16; const bf16* op = ORAW + t * 2048 + 1024 + lane * 16; const bf16* rp = PROJ + t * PROJ_LD + PC_R + lane * 16;
            ya[u] = *(const u32x4*)yp; yb[u] = *(const u32x4*)(yp + 8); oa[u] = *(const u32x4*)op; ob[u] = *(const u32x4*)(op + 8); ra[u] = *(const u32x4*)rp; rb[u] = *(const u32x4*)(rp + 8); }
#pragma unroll
        for (int u = 0; u < 2; ++u) { const size_t t = (size_t)t0 + u;
            {   float v[16]; UNPACK16(ya[u], yb[u], v);
                float s = 0.f;
#pragma unroll
                for (int i = 0; i < 16; ++i) s += v[i] * v[i];
#pragma unroll
                for (int o = 1; o < 32; o <<= 1) s += __shfl_xor(s, o);
                const float rstd = rsqrtf(s * (1.f / 512.f) + EPS_);
                const float* nw = ssd_norm + lane * 16;
#pragma unroll
                for (int i = 0; i < 16; ++i) v[i] = v[i] * rstd * nw[i];
                u32x4 a, b; a.x = pk2(v[0], v[1]); a.y = pk2(v[2], v[3]); a.z = pk2(v[4], v[5]); a.w = pk2(v[6], v[7]); b.x = pk2(v[8], v[9]); b.y = pk2(v[10], v[11]); b.z = pk2(v[12], v[13]); b.w = pk2(v[14], v[15]);
                bf16* yp = ORAW + t * 2048 + lane * 16; *(u32x4*)yp = a; *(u32x4*)(yp + 8) = b; }
            {   float v[16], r[16]; UNPACK16(oa[u], ob[u], v); UNPACK16(ra[u], rb[u], r);
                float s = 0.f;
#pragma unroll
                for (int i = 0; i < 16; ++i) s += v[i] * v[i];
#pragma unroll
                for (int o = 1; o < 16; o <<= 1) s += __shfl_xor(s, o);
                const float rstd = rsqrtf(s * (1.f / 256.f) + EPS_);
                const float* nw = gla_norm + (lane & 15) * 16;
#pragma unroll
                for (int i = 0; i < 16; ++i) v[i] = v[i] * rstd * nw[i] * siluf(r[i]);
                u32x4 a, b; a.x = pk2(v[0], v[1]); a.y = pk2(v[2], v[3]); a.z = pk2(v[4], v[5]); a.w = pk2(v[6], v[7]); b.x = pk2(v[8], v[9]); b.y = pk2(v[10], v[11]); b.z = pk2(v[12], v[13]); b.w = pk2(v[14], v[15]);
                bf16* op = ORAW + t * 2048 + 1024 + lane * 16; *(u32x4*)op = a; *(u32x4*)(op + 8) = b; }
        }
    }
}

DI void attn_unit(int b, int ph, int qb, const bf16* QK, const bf16* VT, bf16* OATT, const float* NORMS, ldsp lds, int tid) {
    asm volatile("" : "+v"(tid));
    constexpr int KBUF = 9216, VBUF = 18432, KOFF = 0, VOFF = 2 * KBUF, WSOFF = 2 * KBUF + 2 * VBUF;
    const int lane = tid & 63, w = tid >> 6, r32 = lane & 31, hi = lane >> 5;
    const int q0 = qb * 256, head = ph >> 1;
    const size_t rowb = (size_t)b * L_;
    const float cs = exp2f(-(float)(head + 1)) * 1.4426950408889634f;
    LAS float* wsf = (LAS float*)(lds + WSOFF) + w * 64;
    bf16x8 qf[4];
    { const bf16* qp = QK + (rowb + q0 + 32 * w + r32) * QK_LD + ph * 64 + 8 * hi;
#pragma unroll
      for (int ks = 0; ks < 4; ++ks) qf[ks] = *(const bf16x8*)(qp + 16 * ks); }
    asm volatile("s_waitcnt vmcnt(0)" : "+v"(qf[0]), "+v"(qf[1]), "+v"(qf[2]), "+v"(qf[3]) :: "memory");
    const int qpos = q0 + 32 * w + r32;
    const int rsw = ((r32 >> 3) & 1) * 8;
    f32x16 o[4];
#pragma unroll
    for (int d = 0; d < 4; ++d)
#pragma unroll
        for (int r = 0; r < 16; ++r) o[d][r] = 0.f;
    float l_run = 0.f;
    const float Bq = sqrtf(NORMS[b * 32 + ph] * NORMS[b * 32 + 16 + ph]);
    const float Wn = (150.f + 2.f * Bq) / cs;
    const float sk = ((float)(q0 - 63) - Wn) * (1.f / 64.f);
    int t_begin = (sk >= 0.f) ? (int)floorf(sk) + 1 : 0;
    t_begin = __builtin_amdgcn_readfirstlane(t_begin);
    const int t_end = (q0 + 256) / 64;
    float m_run = cs * (float)(64 * t_begin - q0);
    const int klane = r32 * 144 + 16 * hi, vlane = r32 * 144 + 16 * hi;
    const float cs_h = bf2f(pk2(cs, 0.f) & 0xffffu);
    const unsigned csw = (hi == 0) ? pk2(cs_h, cs - cs_h) : 0u;
    bf16x8 kext0, kext1;
    { u32x4 e0, e1; e0.x = (hi == 0) ? pk2((float)r32, (float)r32) : 0u; e0.y = (hi == 0) ? pk2(1.f, 1.f) : 0u; e0.z = 0u; e0.w = 0u;
      e1 = e0; e1.x = (hi == 0) ? pk2((float)(r32 + 32), (float)(r32 + 32)) : 0u; kext0 = __builtin_bit_cast(bf16x8, e0); kext1 = __builtin_bit_cast(bf16x8, e1); }
    const int kr = tid >> 3, kc = tid & 7;
    const bf16* ksrc = QK + (rowb + kr) * QK_LD + 1024 + ph * 64 + kc * 8;
    const bf16* vsrc0 = VT + (size_t)(head * 128 + kr) * VT_LD + rowb + kc * 8;
    const bf16* vsrc1 = VT + (size_t)(head * 128 + 64 + kr) * VT_LD + rowb + kc * 8;
    const int kdst = KOFF + kr * 144 + kc * 16, vdst0 = VOFF + kr * 144 + kc * 16, vdst1 = VOFF + (64 + kr) * 144 + kc * 16;
    u32x4 pk_, pv0, pv1;
    pk_ = *(const u32x4*)(ksrc + (size_t)t_begin * 64 * QK_LD); pv0 = *(const u32x4*)(vsrc0 + t_begin * 64); pv1 = *(const u32x4*)(vsrc1 + t_begin * 64);
    const int vp0 = (16 * (kc >> 1) + 4 * (kc & 1)) * 2, vp1 = vp0 + 16;
#define VSWZ(v) (v)
    __syncthreads();
    *(LAS u32x4*)(lds + kdst) = pk_;
    { *(LAS u32x2*)(lds + VOFF + kr * 144 + vp0) = (u32x2){pv0.x, pv0.y}; *(LAS u32x2*)(lds + VOFF + kr * 144 + vp1) = (u32x2){pv0.z, pv0.w};
      *(LAS u32x2*)(lds + VOFF + (64 + kr) * 144 + vp0) = (u32x2){pv1.x, pv1.y}; *(LAS u32x2*)(lds + VOFF + (64 + kr) * 144 + vp1) = (u32x2){pv1.z, pv1.w}; }
    __syncthreads();
#define ATTN_TILE(t_, buf_) do { \
        const int kbase = 64 * (t_); \
        if (kbase <= q0 + 32 * w + 31) { \
            const int kb = KOFF + (buf_) * KBUF + klane, vb = VOFF + (buf_) * VBUF + vlane; \
              \
            const float nm = cs * (float)(kbase - q0) - m_run; \
            const float nmh = bf2f(pk2(nm, 0.f) & 0xffffu); \
            u32x4 qe; qe.x = csw; qe.y = (hi == 0) ? pk2(nmh, nm - nmh) : 0u; qe.z = 0u; qe.w = 0u; \
            const bf16x8 qef = __builtin_bit_cast(bf16x8, qe); \
            bf16x8 kf0[4], kf1[4]; \
            _Pragma("unroll") \
            for (int ks = 0; ks < 4; ++ks) { kf0[ks] = lds16(lds, kb + 32 * ks); kf1[ks] = lds16(lds, kb + 32 * 144 + 32 * ks); } \
            __builtin_amdgcn_sched_barrier(0); \
            f32x16 s0, s1; \
            _Pragma("unroll") \
            for (int r = 0; r < 16; ++r) { s0[r] = 0.f; s1[r] = 0.f; } \
            s0 = mfma32(kext0, qef, s0); s1 = mfma32(kext1, qef, s1); \
            _Pragma("unroll") \
            for (int ks = 0; ks < 4; ++ks) { s0 = mfma32(kf0[ks], qf[ks], s0); s1 = mfma32(kf1[ks], qf[ks], s1); } \
            __builtin_amdgcn_sched_barrier(0); \
            asm volatile("s_nop 15\n\ts_nop 7" : "+v"(s0), "+v"(s1));     \
            if (kbase + 63 > q0 + 32 * w) { \
                _Pragma("unroll") \
                for (int r = 0; r < 16; ++r) { const int key = kbase + 4 * hi + (r & 3) + 8 * (r >> 2); if (key > qpos) s0[r] = -INFINITY; if (key + 32 > qpos) s1[r] = -INFINITY; } \
            } \
            float mx = s0[0], mx2 = s1[0]; \
            _Pragma("unroll") \
            for (int r = 1; r < 16; r += 2) { mx = max3f(mx, s0[r], s1[r]); if (r + 1 < 16) mx2 = max3f(mx2, s0[r + 1], s1[r + 1]); } \
            mx = max3f(mx, mx2, mx2); \
            mx = fmaxf(mx, __shfl_xor(mx, 32)); \
            if (__any(mx > 16.f)) { \
                const float dl = fmaxf(mx, 0.f); \
                const float alpha = __builtin_amdgcn_exp2f(-dl); \
                l_run *= alpha; m_run += dl; \
                _Pragma("unroll") \
                for (int r = 0; r < 16; ++r) { s0[r] -= dl; s1[r] -= dl; } \
                if (hi == 0) wsf[r32] = alpha; \
                LDS_FENCE(); \
                _Pragma("unroll") \
                for (int r = 0; r < 16; ++r) { const float a = wsf[crow(r, hi)]; \
                    _Pragma("unroll") \
                    for (int d = 0; d < 4; ++d) o[d][r] *= a; } \
            } \
            float rs = 0.f; \
            _Pragma("unroll") \
            for (int r = 0; r < 16; ++r) { s0[r] = __builtin_amdgcn_exp2f(s0[r]); s1[r] = __builtin_amdgcn_exp2f(s1[r]); rs += s0[r] + s1[r]; } \
            rs += __shfl_xor(rs, 32); \
            l_run += rs; \
            bf16x8 pa[2][2]; \
            _Pragma("unroll") \
            for (int s = 0; s < 2; ++s) { \
                u32x4 p0, p1; \
                p0.x = pk2(s0[8 * s + 0], s0[8 * s + 1]); p0.y = pk2(s0[8 * s + 2], s0[8 * s + 3]); p0.z = pk2(s0[8 * s + 4], s0[8 * s + 5]); p0.w = pk2(s0[8 * s + 6], s0[8 * s + 7]); \
                p1.x = pk2(s1[8 * s + 0], s1[8 * s + 1]); p1.y = pk2(s1[8 * s + 2], s1[8 * s + 3]); p1.z = pk2(s1[8 * s + 4], s1[8 * s + 5]); p1.w = pk2(s1[8 * s + 6], s1[8 * s + 7]); \
                pa[0][s] = __builtin_bit_cast(bf16x8, p0); pa[1][s] = __builtin_bit_cast(bf16x8, p1); \
            } \
            _Pragma("unroll") \
            for (int dh = 0; dh < 2; ++dh) { \
                bf16x8 vf[2][2][2]; \
                _Pragma("unroll") \
                for (int d2 = 0; d2 < 2; ++d2) \
                    _Pragma("unroll") \
                    for (int hf = 0; hf < 2; ++hf) \
                        _Pragma("unroll") \
                        for (int s = 0; s < 2; ++s) vf[d2][hf][s] = lds16(lds, vb + 4608 * (2 * dh + d2) + 64 * hf + 32 * s); \
                __builtin_amdgcn_sched_barrier(0); \
                _Pragma("unroll") \
                for (int hf = 0; hf < 2; ++hf) \
                    _Pragma("unroll") \
                    for (int s = 0; s < 2; ++s) \
                        _Pragma("unroll") \
                        for (int d2 = 0; d2 < 2; ++d2) o[2 * dh + d2] = mfma32(pa[hf][s], vf[d2][hf][s], o[2 * dh + d2]); \
                __builtin_amdgcn_sched_barrier(0); \
            } \
        } \
    } while (0)
#define ATTN_LOAD(t_, K_, V0_, V1_) do { K_ = *(const u32x4*)(ksrc + (size_t)(t_) * 64 * QK_LD); V0_ = *(const u32x4*)(vsrc0 + (t_) * 64); V1_ = *(const u32x4*)(vsrc1 + (t_) * 64); } while (0)
#define VT_PUT(off_, V_) do { *(LAS u32x2*)(lds + (off_) + vp0) = (u32x2){(V_).x, (V_).y}; *(LAS u32x2*)(lds + (off_) + vp1) = (u32x2){(V_).z, (V_).w}; } while (0)
#define ATTN_STORE(buf_, K_, V0_, V1_) do { *(LAS u32x4*)(lds + kdst + (buf_) * KBUF) = K_; VT_PUT(VOFF + (buf_) * VBUF + kr * 144, V0_); VT_PUT(VOFF + (buf_) * VBUF + (64 + kr) * 144, V1_); } while (0)
    u32x4 ak = pk_, av0 = pv0, av1 = pv1, bk = pk_, bv0 = pv0, bv1 = pv1;
    if (t_begin + 1 < t_end) ATTN_LOAD(t_begin + 1, ak, av0, av1);
    for (int t = t_begin; t < t_end; t += 2) {
        if (t + 2 < t_end) ATTN_LOAD(t + 2, bk, bv0, bv1);
        ATTN_TILE(t, 0);
        if (t + 1 < t_end) ATTN_STORE(1, ak, av0, av1);
        BAR_LDS();
        if (t + 1 < t_end) {
            if (t + 3 < t_end) ATTN_LOAD(t + 3, ak, av0, av1);
            ATTN_TILE(t + 1, 1);
            if (t + 2 < t_end) ATTN_STORE(0, bk, bv0, bv1);
            BAR_LDS();
        }
    }
#undef ATTN_TILE
#undef ATTN_LOAD
#undef ATTN_STORE
    LDS_FENCE();
    if (hi == 0) wsf[r32] = 1.f / l_run;
    LDS_FENCE();
    bf16* op = OATT + (rowb + q0 + 32 * w) * 2048 + ph * 128 + r32;
#pragma unroll
    for (int r = 0; r < 16; ++r) { const int qr = crow(r, hi); const float rl = wsf[qr];
#pragma unroll
        for (int d = 0; d < 4; ++d) op[(size_t)qr * 2048 + 32 * d] = (bf16)f2bf(o[d][r] * rl); }
#undef VSWZ
}

DI void qk_norms(const bf16* QK, float* NORMS, int gw, int NGW, int lane) {
    for (int b = 0; b < 2; ++b) {
        float mx = 0.f;
        for (int t = gw; t < L_; t += NGW) {
            const u32x4* p = (const u32x4*)(QK + ((size_t)b * L_ + t) * QK_LD + lane * 32);
            float s = 0.f;
#pragma unroll
            for (int i = 0; i < 4; ++i) { const u32x4 v = p[i];
                s += bflo(v.x) * bflo(v.x) + bfhi(v.x) * bfhi(v.x) + bflo(v.y) * bflo(v.y) + bfhi(v.y) * bfhi(v.y) + bflo(v.z) * bflo(v.z) + bfhi(v.z) * bfhi(v.z) + bflo(v.w) * bflo(v.w) + bfhi(v.w) * bfhi(v.w); }
            s += __shfl_xor(s, 1);
            mx = fmaxf(mx, s);
        }
        if (!(lane & 1)) atomicMax((unsigned*)NORMS + b * 32 + (lane >> 1), __float_as_uint(mx));
    }
}

DI void combine_rows(const bf16* OATT, bf16* OUT, const float* lq1, const float* lk1, const float* lq2, const float* lk2, const float* subln, float lam_init, int gw, int NGW, int lane) {
    const float e1 = __expf(wave_sum(lq1[lane] * lk1[lane])), e2 = __expf(wave_sum(lq2[lane] * lk2[lane]));
    const float lam = e1 - e2 + lam_init;
    const int head = lane >> 3, dv0 = (lane & 7) * 16;
    for (int t0 = 2 * gw; t0 < T_; t0 += 2 * NGW) {
        u32x4 A[2], B[2], C[2], Dd[2];
#pragma unroll
        for (int u = 0; u < 2; ++u) { const bf16* p1 = OATT + (size_t)(t0 + u) * 2048 + (2 * head) * 128 + dv0; const bf16* p2 = p1 + 128;
            A[u] = *(const u32x4*)p1; B[u] = *(const u32x4*)(p1 + 8); C[u] = *(const u32x4*)p2; Dd[u] = *(const u32x4*)(p2 + 8); }
#pragma unroll
        for (int u = 0; u < 2; ++u) {
            float v[16], q[16]; UNPACK16(A[u], B[u], v); UNPACK16(C[u], Dd[u], q);
            float s = 0.f;
#pragma unroll
            for (int i = 0; i < 16; ++i) { v[i] = v[i] - lam * q[i]; s += v[i] * v[i]; }
            s += __shfl_xor(s, 1); s += __shfl_xor(s, 2); s += __shfl_xor(s, 4);
            const float sc = rsqrtf(s * (1.f / 128.f) + EPS_) * (1.f - lam_init);
            const float* nw = subln + dv0;
            u32x4 oa, ob;
            oa.x = pk2(v[0] * sc * nw[0], v[1] * sc * nw[1]); oa.y = pk2(v[2] * sc * nw[2], v[3] * sc * nw[3]); oa.z = pk2(v[4] * sc * nw[4], v[5] * sc * nw[5]); oa.w = pk2(v[6] * sc * nw[6], v[7] * sc * nw[7]);
            ob.x = pk2(v[8] * sc * nw[8], v[9] * sc * nw[9]); ob.y = pk2(v[10] * sc * nw[10], v[11] * sc * nw[11]); ob.z = pk2(v[12] * sc * nw[12], v[13] * sc * nw[13]); ob.w = pk2(v[14] * sc * nw[14], v[15] * sc * nw[15]);
            bf16* qo = OUT + (size_t)(t0 + u) * 1024 + head * 128 + dv0;
            *(u32x4*)qo = oa; *(u32x4*)(qo + 8) = ob;
        }
    }
}

DI void softmax_rows256(bf16* S, int nrows, int gw, int NGW, int lane) {
    for (int r0 = gw * 4; r0 < nrows; r0 += NGW * 4) {
        u32x2 a[4];
#pragma unroll
        for (int i = 0; i < 4; ++i) a[i] = *((const u32x2*)(S + (size_t)(r0 + i) * 256) + lane);
#pragma unroll
        for (int i = 0; i < 4; ++i) {
            float v0 = bflo(a[i].x), v1 = bfhi(a[i].x), v2 = bflo(a[i].y), v3 = bfhi(a[i].y);
            const float mx = wave_max(fmaxf(fmaxf(v0, v1), fmaxf(v2, v3)));
            v0 = __expf(v0 - mx); v1 = __expf(v1 - mx); v2 = __expf(v2 - mx); v3 = __expf(v3 - mx);
            const float inv = 1.f / wave_sum((v0 + v1) + (v2 + v3));
            u32x2 o; o.x = pk2(v0 * inv, v1 * inv); o.y = pk2(v2 * inv, v3 * inv);
            *((u32x2*)(S + (size_t)(r0 + i) * 256) + lane) = o;
        }
    }
}

#define GAS __attribute__((address_space(1)))
#define XB_TMO      128
#define XB_XCNT(j)  (256  + 64 * (j))
#define XB_XSUB(j)  (1280 + 64 * (j))
#define XB_XGEN(j)  (2304 + 64 * (j))
#define XB_TOP      3328
#define XB_TOPGEN   3392
#define XCD_BAR_WORDS 3456
#define XB_SPIN_CAP (1u << 18)

__device__ __forceinline__ unsigned xb_ld(unsigned* p)              { return __hip_atomic_load(p, __ATOMIC_RELAXED, __HIP_MEMORY_SCOPE_AGENT); }
__device__ __forceinline__ unsigned xb_add(unsigned* p, unsigned v) { return __hip_atomic_fetch_add(p, v, __ATOMIC_RELAXED, __HIP_MEMORY_SCOPE_AGENT); }
__device__ __forceinline__ unsigned xb_xcc_id() { return (unsigned)__builtin_amdgcn_s_getreg((3 << 11) | 20) & 0xFu; }
#define XB_SPIN(cond, bar) do { unsigned _sp = 0; while (cond) { __builtin_amdgcn_s_sleep(1); \
    if ((++_sp & 255u) == 0u) { if (xb_ld(&(bar)[XB_TMO])) break; if (_sp > XB_SPIN_CAP) { atomicAdd(&(bar)[XB_TMO], 1u); break; } } } } while (0)

struct XcdBarrier {
    unsigned* bar; unsigned x;
    volatile LAS unsigned* st;
};

__device__ __forceinline__ XcdBarrier xcd_barrier_post(unsigned* bar, volatile LAS unsigned* st) {
    XcdBarrier b; b.bar = bar; b.x = xb_xcc_id(); b.st = st;
    if (threadIdx.x == 0) (void)xb_add(&bar[XB_XCNT(b.x)], 1u);
    return b;
}
__device__ __forceinline__ void xcd_barrier_complete(unsigned* bar, unsigned x, unsigned& nloc, unsigned& nx) {
    const unsigned G = gridDim.x * gridDim.y * gridDim.z;
    unsigned sum, cnt, mine, sp = 0u;
    for (;;) {
        sum = 0u; cnt = 0u; mine = 0u;
#pragma unroll
        for (unsigned j = 0; j < 16; ++j) { const unsigned c = xb_ld(&bar[XB_XCNT(j)]); sum += c; cnt += (c > 0u) ? 1u : 0u; mine = (j == x) ? c : mine; }
        if (sum == G) break;
        __builtin_amdgcn_s_sleep(1);
        if ((++sp & 255u) == 0u) { if (xb_ld(&bar[XB_TMO])) break; if (sp > XB_SPIN_CAP) { atomicAdd(&bar[XB_TMO], 1u); break; } }
    }
    nloc = mine > 0u ? mine : 1u; nx = cnt > 0u ? cnt : 1u;
}

__device__ __forceinline__ void xcd_barrier(const XcdBarrier& b) {
    asm volatile("s_waitcnt vmcnt(0)" ::: "memory");
    __syncthreads();
    if (threadIdx.x == 0) {
        unsigned* bar = b.bar;
        __builtin_amdgcn_s_waitcnt(0);
        unsigned nloc = b.st[0], nx = b.st[1];
        if (nloc == 0u) { xcd_barrier_complete(bar, b.x, nloc, nx); b.st[0] = nloc; b.st[1] = nx; }
        const unsigned old = xb_add(&bar[XB_XSUB(b.x)], 1u);
        const unsigned gen = old / nloc;
        if (old + 1u == (gen + 1u) * nloc) {
            __builtin_amdgcn_fence(__ATOMIC_RELEASE, "agent");
            asm volatile("s_waitcnt vmcnt(0)" ::: "memory");
            const unsigned og = xb_add(&bar[XB_TOP], 1u);
            const unsigned tg = og / nx;
            if (og + 1u == (tg + 1u) * nx) xb_add(&bar[XB_TOPGEN], 1u);
            else XB_SPIN(xb_ld(&bar[XB_TOPGEN]) == tg, bar);
            __builtin_amdgcn_fence(__ATOMIC_ACQUIRE, "agent");
            xb_add(&bar[XB_XGEN(b.x)], 1u);
            asm volatile("s_waitcnt vmcnt(0)" ::: "memory");
        } else {
            XB_SPIN(xb_ld(&bar[XB_XGEN(b.x)]) == gen, bar);
            __builtin_amdgcn_fence(__ATOMIC_ACQUIRE, "agent");
            asm volatile("s_waitcnt vmcnt(0)" ::: "memory");
        }
    }
    __syncthreads();
}

struct Args { const float* in[31]; float* out; unsigned char* ws; float lam_init[2]; int ph_lo, ph_hi; };
constexpr int NPL = 15, NPH = 4 * NPL + 1;

DI pg8::Gemm mk_gemm(const bf16* A, const bf16* Bt, int M, int N, int K, int lda, int ldb) {
    pg8::Gemm g; g.A = A; g.Bt = Bt; g.M = M; g.N = N; g.K = K; g.lda = lda; g.ldb = ldb; g.a_pn = 0; g.b_pn = (long)256 * ldb; g.b_b = 0; g.pm_per_b = 1 << 30; return g;
}
DI pg8::EpiU mk_store(bf16* O, int ldc, int act, int scale_cols, float scale) {
    pg8::EpiU e; e.mode = 0; e.O = O; e.ldc = ldc; e.act = act; e.scale_cols = scale_cols; e.scale = scale; e.small_out = nullptr; e.small_pn = -1; e.base = nullptr; e.baseb = nullptr; e.outb = nullptr; e.ssq = nullptr; e.nssq = nullptr; e.nmode = 0; e.smx = nullptr; return e;
}
DI pg8::EpiU mk_res(const float* base, const bf16* baseb, bf16* outb, float* ssq) {
    pg8::EpiU e; e.mode = 1; e.ssq = ssq; e.nssq = nullptr; e.nmode = 0; e.smx = nullptr; e.O = nullptr; e.ldc = D_; e.act = 0; e.scale_cols = 0; e.scale = 1.f; e.small_out = nullptr; e.small_pn = -1; e.base = base; e.baseb = baseb; e.outb = outb; return e;
}

__global__ void __launch_bounds__(512, 2) mega_fwd(Args a) {
    extern __shared__ __attribute__((aligned(16))) unsigned char lds_raw[];
    ldsp lds = (ldsp)lds_raw;
    cg::grid_group grid = cg::this_grid();
    volatile LAS unsigned* bst = (volatile LAS unsigned*)(lds + LDS_BYTES - 16);
    if (threadIdx.x < 4) bst[threadIdx.x] = 0u;
    __syncthreads();
    const XcdBarrier xbar = xcd_barrier_post((unsigned*)(a.ws + 4096), bst);
    const int G = gridDim.x, blk = blockIdx.x, NGW = G * 8;
    for (int ph = a.ph_lo; ph < a.ph_hi; ++ph) {
#define PHASE_IDS int tid = threadIdx.x; asm volatile("" : "+v"(tid)); const int lane = tid & 63, wave = __builtin_amdgcn_readfirstlane(tid >> 6), gw = blk * 8 + wave; (void)lane; (void)gw; (void)wave;
        unsigned char* ws = a.ws;
        bf16* XN = (bf16*)(ws + WS_XN); bf16* BIG = (bf16*)(ws + WS_BIG); bf16* VT = (bf16*)(ws + WS_VT); bf16* ORAW = (bf16*)a.out;   bf16* XR = (bf16*)(ws + WS_ORAW);
        float* SSQ_M = (float*)a.out; float* SSQ_X = (float*)(ws + WS_SMALL); float* SSQ_F = (float*)(ws + WS_SMALL + 2 * MiB);
        float* SMALL = (float*)(ws + WS_SMALL); bf16* MEMN = (bf16*)(ws + WS_MEMN); bf16* KX = (bf16*)(ws + WS_KX); bf16* VXT = (bf16*)(ws + WS_VXT);
        bf16* KT = (bf16*)(ws + WS_KT); float* DG = (float*)(ws + WS_DG); bf16* TAIL = (bf16*)(ws + WS_DG + 1 * MiB);
        bf16* WA = (bf16*)(ws + WS_WA); bf16* WV = (bf16*)(ws + WS_WV); bf16* WOUT = (bf16*)(ws + WS_WOUT); bf16* WQ = (bf16*)(ws + WS_WQ); bf16* WKV = (bf16*)(ws + WS_WKV);
        bf16* WXO = (bf16*)(ws + WS_WXO); bf16* W1 = (bf16*)(ws + WS_W1); bf16* W2 = (bf16*)(ws + WS_W2);
        bf16* QX = BIG; bf16* SP = BIG + (size_t)T_ * 1024; bf16* OX = BIG + (size_t)2 * T_ * 1024;
        bf16* OATT = (bf16*)(ws + WS_BIG + 132 * MiB);

        const int layer = ph / NPL, k = ph % NPL;
        const bool even = !(layer & 1); const int li = layer >> 1;
        bool did = true; int nj = 0;
        const bool x_in = (layer == 0 && k <= 5);
        if (ph == NPH - 1) { PHASE_IDS
            rms_rows_from_bf16<true>(XR, a.in[30], nullptr, a.out, T_, gw, NGW, lane);
        } else if (k == 0) { PHASE_IDS
            LAS float* scr = (LAS float*)(lds + wave * 16384);
            const float* wq = a.in[24] + (size_t)layer * 1024 * 1024; const float* wkv = a.in[25] + (size_t)layer * 1024 * 2048; const float* wxo = a.in[26] + (size_t)layer * 1024 * 1024;
            const float* w1 = a.in[28] + (size_t)layer * 1024 * 4096; const float* w2 = a.in[29] + (size_t)layer * 4096 * 1024;
            const int I_Q = 16 * 32, I_KV = 16 * 64, I_XO = 16 * 32, I_1 = 16 * 128, I_2 = 64 * 32;
            const int I_A = even ? 16 * 144 : 16 * 64, I_V = 16 * 32, I_O = even ? 32 * 32 : 16 * 32;
            const int NIT = I_Q + I_KV + I_XO + I_1 + I_2 + I_A + I_V + I_O;
            for (int it = gw; it < NIT; it += NGW) {
                int r = it;
                if (r < I_Q) { conv_item(wq, 1024, 1024, WQ, 1024, 0, 0, scr, r, lane, a.in[22] + (size_t)layer * 1024); continue; } r -= I_Q;
                if (r < I_KV) { conv_item(wkv, 2048, 1024, WKV, 2048, 0, 0, scr, r, lane); continue; } r -= I_KV;
                if (r < I_XO) { conv_item(wxo, 1024, 1024, WXO, 1024, 0, 0, scr, r, lane); continue; } r -= I_XO;
                if (r < I_1) { conv_item(w1, 4096, 1024, W1, 4096, 0, 0, scr, r, lane, a.in[27] + (size_t)layer * 1024); continue; } r -= I_1;
                if (r < I_2) { conv_item(w2, 1024, 4096, W2, 1024, 0, 0, scr, r, lane); continue; } r -= I_2;
                if (even) {
                    const float* win = a.in[3] + (size_t)li * 1024 * 5408; const float* wout = a.in[13] + (size_t)li * 2048 * 1024;
                    if (r < I_A) { conv_item(win, 5408, 1024, WA, 4608, 1, 0, scr, r, lane, a.in[2] + (size_t)li * 1024); continue; } r -= I_A;
                    if (r < I_V) { conv_item(win, 5408, 1024, WV, 1024, 0, 3344, scr, r, lane, a.in[2] + (size_t)li * 1024); continue; } r -= I_V;
                    conv_item(wout, 1024, 2048, WOUT, 1024, 0, 0, scr, r, lane);
                } else {
                    const float* wqkv = a.in[15] + (size_t)li * 1024 * 3072; const float* wo = a.in[21] + (size_t)li * 1024 * 1024;
                    if (r < I_A) { conv_item(wqkv, 3072, 1024, WA, 2048, 0, 0, scr, r, lane, a.in[14] + (size_t)li * 1024); continue; } r -= I_A;
                    if (r < I_V) { conv_item(wqkv, 3072, 1024, WV, 1024, 0, 2048, scr, r, lane, a.in[14] + (size_t)li * 1024); continue; } r -= I_V;
                    conv_item(wo, 1024, 1024, WOUT, 1024, 0, 0, scr, r, lane);
                }
            }
            if (layer == 0) xb_rows(a.in[0], XR, SSQ_M, T_, gw, NGW, lane);
            rms_rows_bf16(a.in[1], a.in[23] + (size_t)layer * 1024, MEMN, 512, gw, NGW, lane);
            if (blk == 0 && tid < 64) ((float*)ws)[tid] = 0.f;
        } else if (k == 1) { nj = 4;
        } else if (k == 2) { PHASE_IDS
            if (even) { for (int u = blk; u < T_ / 128; u += G) prep_unit(u, BIG, SMALL, KT, DG, TAIL, a.in[10] + (size_t)li * 16 * 512, a.in[11] + (size_t)li * 512, a.in[6] + li * 16, a.in[7] + li * 16, a.in[4] + (size_t)li * 4 * 1280, a.in[5] + (size_t)li * 1280, lds, tid); }
            else {
                qk_norms(BIG, (float*)ws, gw, NGW, lane);
                xcd_barrier(xbar);
                {
                    const int x = blk & 7, j = blk >> 3, bb = (x >> 1) & 1, br = x & 1, grp = x >> 2;
#pragma unroll 1
                    for (int u = 0; u < 8; ++u) { const int s = u >> 1; const int head = grp ? (s == 0 ? 6 : s == 1 ? 4 : s == 2 ? 3 : 2) : (s == 0 ? 7 : s == 1 ? 5 : s == 2 ? 1 : 0);
                        attn_unit(bb, 2 * head + br, (u & 1) ? j : 63 - j, BIG, VT, OATT, (const float*)ws, lds, tid); }
                }
            }
        } else if (k == 3) { PHASE_IDS
            if (even) {
                for (int j = blk; j < 64; j += G) {
                    if (j < 32) ssd_chain(j >> 4, j & 15, BIG, SMALL, TAIL, a.in[8] + li * 16, lds, tid);
                    else { const int i2 = j - 32; gla_chain(i2 >> 4, (i2 >> 2) & 3, i2 & 3, BIG, KT, VT, DG, ORAW, lds, tid); }
                }
            } else combine_rows(OATT, XN, a.in[16] + li * 64, a.in[17] + li * 64, a.in[18] + li * 64, a.in[19] + li * 64, a.in[20] + li * 128, a.lam_init[li], gw, NGW, lane);
        } else if (k == 4) { PHASE_IDS
            if (even) gate_rows(BIG, ORAW, a.in[9] + (size_t)li * 1024, a.in[12] + (size_t)li * 256, gw, NGW, lane);
            else nj = 1;
        } else if (k == 5) { if (even) nj = 1; else did = false;
        } else if (k == 6) { did = false;
        } else if (k == 9) { did = false;
        } else if (k == 12) { did = false;
        } else nj = 1;
        for (int j = 0; j < nj; ++j) { PHASE_IDS
            pg8::Gemm g = mk_gemm(XN, WA, T_, 1024, 1024, 1024, 1024); pg8::EpiU e = mk_store(BIG, 1024, 0, 0, 1.f);
            if (k == 1) {
                if (j == 0) { if (even) { g = mk_gemm(XR, WA, T_, 4608, 1024, 1024, 1024); e = mk_store(BIG, PROJ_LD, 0, 0, 1.f); e.small_out = SMALL; e.small_pn = 17; }
                              else { g = mk_gemm(XR, WA, T_, 2048, 1024, 1024, 1024); e = mk_store(BIG, QK_LD, 0, 1024, 0.125f * 1.4426950408889634f); }
                              e.nssq = SSQ_M; e.nmode = 1; }
                else if (j == 1) { g = mk_gemm(WV, XR, 1024, T_, 1024, 1024, 1024); e = mk_store(VT, VT_LD, 0, 0, 1.f); e.nssq = SSQ_M; e.nmode = 2; }
                else if (j == 2) { g = mk_gemm(MEMN, WKV, 512, 1024, 1024, 1024, 1024); e = mk_store(KX, 1024, 0, 0, 1.f); }
                else { g = mk_gemm(WKV + (size_t)1024 * 1024, MEMN, 1024, 512, 1024, 1024, 1024); e = mk_store(VXT, 512, 0, 0, 1.f); }
            } else if (k == 4) { g = mk_gemm(XN, WOUT, T_, 1024, 1024, 1024, 1024); e = mk_res(nullptr, XR, XR, SSQ_X);
            } else if (k == 5) {
                g = mk_gemm(ORAW, WOUT, T_, 1024, 2048, 2048, 2048); e = mk_res(nullptr, XR, XR, SSQ_X);
            } else if (k == 7) { g = mk_gemm(XR, WQ, T_, 1024, 1024, 1024, 1024); e = mk_store(QX, 1024, 0, 1024, 0.0625f); e.nssq = SSQ_X; e.nmode = 1;
            } else if (k == 8) { g = mk_gemm(QX, KX, T_, 1024, 256, 1024, 1024); g.a_pn = 256; g.b_pn = 256; g.b_b = (long)256 * 1024; g.pm_per_b = 64; e = mk_store(SP, 1024, 0, 0, 1.f); e.smx = (PG8_LAS float*)(lds + 131072);
            } else if (k == 10) { g = mk_gemm(SP, VXT, T_, 1024, 256, 1024, 512); g.a_pn = 256; g.b_pn = (long)256 * 512; g.b_b = 256; g.pm_per_b = 64; e = mk_store(OX, 1024, 0, 0, 1.f);
            } else if (k == 11) { g = mk_gemm(OX, WXO, T_, 1024, 1024, 1024, 1024); e = mk_res(nullptr, XR, XR, SSQ_F);
            } else if (k == 13) { g = mk_gemm(XR, W1, T_, 4096, 1024, 1024, 1024); e = mk_store(BIG, 4096, 1, 0, 1.f); e.nssq = SSQ_F; e.nmode = 1;
            } else if (k == 14) { g = mk_gemm(BIG, W2, T_, 1024, 4096, 4096, 4096); e = mk_res(nullptr, XR, XR, SSQ_M); }
            pg8::StaticOrder S; S.init(g.M, g.N, G, (blk + 64 * j * (j >= 2)) % G);
            pg8::gemm_phase<pg8::EpiU, pg8::StaticOrder, true, true>(lds, g, S, e, tid);
        }
        if (did && ph + 1 < a.ph_hi) { if (ph == 0) grid.sync(); else xcd_barrier(xbar); }
    }
}

extern "C" void kernel_launch(void* const* d_in, const int* in_sizes, int n_in, void* d_out, int out_size, void* d_ws, size_t ws_size, hipStream_t stream) {
    static int grid = 0;
    if (grid == 0) {
        if (n_in != 31 || out_size != T_ * D_ || ws_size < WS_END) { fprintf(stderr, "kernel_launch: unexpected problem (n_in %d out %d ws %zu)\n", n_in, out_size, ws_size); grid = -1; return; }
        int dev = 0, cus = 0, per_cu = 0;
        hipGetDevice(&dev); hipDeviceGetAttribute(&cus, hipDeviceAttributeMultiprocessorCount, dev);
        if (hipFuncSetAttribute((const void*)mega_fwd, hipFuncAttributeMaxDynamicSharedMemorySize, LDS_BYTES) != hipSuccess) { fprintf(stderr, "kernel_launch: hipFuncSetAttribute failed\n"); grid = -1; return; }
        if (hipOccupancyMaxActiveBlocksPerMultiprocessor(&per_cu, (const void*)mega_fwd, 512, LDS_BYTES) != hipSuccess || per_cu < 1) { fprintf(stderr, "kernel_launch: occupancy query says %d\n", per_cu); per_cu = 1; }
        (void)hipGetLastError();
        grid = cus;
        if (grid != 256) { fprintf(stderr, "kernel_launch: built for a 256-CU device (got %d)\n", cus); grid = -1; return; }
    }
    if (grid < 0) return;
    Args a{};
    for (int i = 0; i < 31; ++i) a.in[i] = (const float*)d_in[i];
    a.out = (float*)d_out; a.ws = (unsigned char*)d_ws;
    a.lam_init[0] = (float)(0.8 - 0.6 * exp(-0.3 * 1.0)); a.lam_init[1] = (float)(0.8 - 0.6 * exp(-0.3 * 3.0));
    a.ph_lo = 0; a.ph_hi = NPH;
#ifdef PROBE_PREFIX
    {
        Args p = a; p.ph_hi = PROBE_PREFIX; void* pargs[] = {&p};
        (void)hipMemsetAsync(d_ws, 0, 65536, stream);
        (void)hipLaunchCooperativeKernel((const void*)mega_fwd, dim3(grid), dim3(512), pargs, LDS_BYTES, stream);
    }
#endif
    if (hipMemsetAsync(d_ws, 0, 65536, stream) != hipSuccess) { fprintf(stderr, "kernel_launch: memset failed\n"); return; }
    void* args[] = {&a};
    hipError_t e = hipLaunchCooperativeKernel((const void*)mega_fwd, dim3(grid), dim3(512), args, LDS_BYTES, stream);
    if (e != hipSuccess) fprintf(stderr, "cooperative launch failed: %s (grid %d)\n", hipGetErrorString(e), grid);
}
```

```cpp
#include <hip/hip_runtime.h>
#include <hip/hip_cooperative_groups.h>
#include <cstdio>
#include <cstdint>
#include <cmath>
namespace cg = cooperative_groups;

namespace pg8 {
#define PG8_LAS __attribute__((address_space(3)))
typedef unsigned short bf16_t;
typedef short bf16x8 __attribute__((ext_vector_type(8)));
typedef float f32x4 __attribute__((ext_vector_type(4)));
typedef unsigned u32x4 __attribute__((ext_vector_type(4)));
constexpr int BM = 256, BK = 64, HALF = 128, HTB = HALF * BK * 2, STAGE_BYTES = 8 * HTB, NXCD = 8, WGM = 8;

__host__ __device__ __forceinline__ int lds_byte(int r, int c) { const int st = (r >> 4) * 2 + (c >> 5), rr = r & 15, cc = c & 31, ob = rr * 64 + cc * 2; return st * 1024 + (ob ^ (((ob >> 9) & 1) << 5)); }
__host__ __device__ __forceinline__ void stage_rc(int b, int& R, int& C) { const int st = b / 1024, sb = b % 1024, swz = sb ^ (((sb >> 9) & 1) << 5); R = (st >> 1) * 16 + swz / 64; C = (st & 1) * 32 + (swz % 64) / 2; }
__host__ __device__ __forceinline__ int perm32(int rho) { const int n = rho >> 4, i = rho & 15; return 8 * (i >> 2) + 4 * n + (i & 3); }

struct Unit { int pm, pn; };
struct Gemm { const bf16_t* A; const bf16_t* Bt; int M, N, K, lda, ldb; long a_pn, b_pn, b_b; int pm_per_b; };

struct StaticOrder {
    int nM, nN, nwg, G, c;
    __host__ __device__ void init(int M, int N, int G_, int c_) { nM = M / BM; nN = N / BM; nwg = nM * nN; G = G_; c = c_; }
    __host__ __device__ bool next(int i, Unit& u) const {
        const long L = (long)i * G + c; if (L >= nwg) return false;
        int wgid = (int)L; { const int q = nwg / NXCD, r = nwg % NXCD, xcd = wgid % NXCD, off = wgid / NXCD; wgid = (xcd < r ? xcd * (q + 1) : r * (q + 1) + (xcd - r) * q) + off; }
        const int nig = WGM * nN, gid = wgid / nig, fm = gid * WGM, gsz = (nM - fm) < WGM ? (nM - fm) : WGM;
        u.pm = fm + ((wgid % nig) % gsz); u.pn = (wgid % nig) / gsz; return true;
    }
    __device__ __forceinline__ void ptrs(const Unit& u, const Gemm& g, const char*& a, const char*& b) const {
        a = (const char*)(g.A + (size_t)u.pm * BM * g.lda + (size_t)u.pn * g.a_pn);
        b = (const char*)(g.Bt + (size_t)u.pn * g.b_pn + (size_t)(u.pm / g.pm_per_b) * g.b_b);
    }
    __device__ __forceinline__ void a_ready(const Unit&) const {}
    __device__ __forceinline__ void done(const Unit&) const {}
};

__device__ __forceinline__ unsigned cvt_pk_bf16(float lo, float hi) { unsigned r; asm volatile("v_cvt_pk_bf16_f32 %0, %1, %2" : "=v"(r) : "v"(lo), "v"(hi)); return r; }

__device__ __forceinline__ float rstd16(const float* p) {
    const f32x4 a = *(const f32x4*)p, b = *(const f32x4*)(p + 4), c = *(const f32x4*)(p + 8), d = *(const f32x4*)(p + 12);
    const float s = (((a[0] + a[1]) + (a[2] + a[3])) + ((b[0] + b[1]) + (b[2] + b[3]))) + (((c[0] + c[1]) + (c[2] + c[3])) + ((d[0] + d[1]) + (d[2] + d[3])));
    return rsqrtf(s * (1.f / 1024.f) + 1e-5f);
}
struct EpiU {
    static constexpr bool PERM = true, AFTER_DRAIN = false;
    int mode;
    bf16_t* O; int ldc; int act; int scale_cols; float scale;
    float* small_out; int small_pn;
    PG8_LAS float* smx;
    float* ssq; const float* nssq; int nmode;
    const float* base; const bf16_t* baseb; bf16_t* outb;
    __device__ __forceinline__ void operator()(const f32x4 (&acc)[2][2][4][2], const Unit& u, int wr, int wc, int fr, int fq) const {
        const int row0 = u.pm * BM + wr * 64 + fr; const int col0 = u.pn * BM + wc * 32 + 8 * fq;
        if (mode == 0) {
            if (smx) {
#pragma unroll
                for (int ai = 0; ai < 2; ++ai)
#pragma unroll
                    for (int m = 0; m < 4; ++m) { float mx = -INFINITY;
#pragma unroll
                        for (int bj = 0; bj < 2; ++bj)
#pragma unroll
                            for (int n = 0; n < 2; ++n)
#pragma unroll
                                for (int e = 0; e < 4; ++e) mx = fmaxf(mx, acc[ai][bj][m][n][e]);
                        mx = fmaxf(mx, __shfl_xor(mx, 16)); mx = fmaxf(mx, __shfl_xor(mx, 32));
                        if (fq == 0) smx[(ai * HALF + wr * 64 + m * 16 + fr) * 4 + wc] = mx; }
                asm volatile("s_waitcnt lgkmcnt(0)\n\ts_barrier" ::: "memory");
#pragma unroll
                for (int ai = 0; ai < 2; ++ai)
#pragma unroll
                    for (int m = 0; m < 4; ++m) { const int rl = ai * HALF + wr * 64 + m * 16 + fr;
                        const f32x4 q4 = *(PG8_LAS f32x4*)(smx + rl * 4); const float mx = fmaxf(fmaxf(q4[0], q4[1]), fmaxf(q4[2], q4[3]));
                        float sm = 0.f;
#pragma unroll
                        for (int bj = 0; bj < 2; ++bj)
#pragma unroll
                            for (int n = 0; n < 2; ++n)
#pragma unroll
                                for (int e = 0; e < 4; ++e) sm += __expf(acc[ai][bj][m][n][e] - mx);
                        sm += __shfl_xor(sm, 16); sm += __shfl_xor(sm, 32);
                        if (fq == 0) smx[1024 + rl * 4 + wc] = sm; }
                asm volatile("s_waitcnt lgkmcnt(0)\n\ts_barrier" ::: "memory");
#pragma unroll
                for (int ai = 0; ai < 2; ++ai)
#pragma unroll
                    for (int m = 0; m < 4; ++m) { const int rl = ai * HALF + wr * 64 + m * 16 + fr;
                        const f32x4 q4 = *(PG8_LAS f32x4*)(smx + rl * 4); const float mx = fmaxf(fmaxf(q4[0], q4[1]), fmaxf(q4[2], q4[3]));
                        const f32x4 l4 = *(PG8_LAS f32x4*)(smx + 1024 + rl * 4); const float inv = 1.f / ((l4[0] + l4[1]) + (l4[2] + l4[3]));
                        bf16_t* rowp = O + (size_t)(row0 + ai * HALF + m * 16) * ldc + col0;
#pragma unroll
                        for (int bj = 0; bj < 2; ++bj) { f32x4 v0, v1;
#pragma unroll
                            for (int e = 0; e < 4; ++e) { v0[e] = __expf(acc[ai][bj][m][0][e] - mx) * inv; v1[e] = __expf(acc[ai][bj][m][1][e] - mx) * inv; }
                            u32x4 w; w.x = cvt_pk_bf16(v0[0], v0[1]); w.y = cvt_pk_bf16(v0[2], v0[3]); w.z = cvt_pk_bf16(v1[0], v1[1]); w.w = cvt_pk_bf16(v1[2], v1[3]);
                            *(u32x4*)(rowp + bj * HALF) = w; } }
                return;
            }
            if (small_out && u.pn == small_pn) {
                if (wc == 0) {
#pragma unroll
                    for (int ai = 0; ai < 2; ++ai)
#pragma unroll
                        for (int m = 0; m < 4; ++m) { const int rr = row0 + ai * HALF + m * 16; const float rsc = (nmode == 1) ? rstd16(nssq + (size_t)rr * 16) : 1.f;
                            float* p = small_out + (size_t)rr * 32 + 8 * fq; *(f32x4*)p = acc[ai][0][m][0] * rsc; *(f32x4*)(p + 4) = acc[ai][0][m][1] * rsc; }
                }
                return;
            }
            f32x4 csc[2][2];
#pragma unroll
            for (int bj = 0; bj < 2; ++bj)
#pragma unroll
                for (int e = 0; e < 4; ++e) { csc[bj][0][e] = (nmode == 2) ? rstd16(nssq + (size_t)(col0 + bj * HALF + e) * 16) : 1.f; csc[bj][1][e] = (nmode == 2) ? rstd16(nssq + (size_t)(col0 + bj * HALF + 4 + e) * 16) : 1.f; }
#pragma unroll
            for (int ai = 0; ai < 2; ++ai)
#pragma unroll
                for (int m = 0; m < 4; ++m) { bf16_t* rowp = O + (size_t)(row0 + ai * HALF + m * 16) * ldc + col0;
                    const float rsc = (nmode == 1) ? rstd16(nssq + (size_t)(row0 + ai * HALF + m * 16) * 16) : 1.f;
#pragma unroll
                    for (int bj = 0; bj < 2; ++bj) { f32x4 v0 = acc[ai][bj][m][0] * rsc * csc[bj][0], v1 = acc[ai][bj][m][1] * rsc * csc[bj][1];
                        if (act == 1) {
#pragma unroll
                            for (int e = 0; e < 4; ++e) { float t0 = fmaxf(v0[e], 0.f), t1 = fmaxf(v1[e], 0.f); v0[e] = t0 * t0; v1[e] = t1 * t1; } }
                        const float sc = (col0 + bj * HALF < scale_cols) ? scale : 1.f;
                        v0 = v0 * sc; v1 = v1 * sc; u32x4 w; w.x = cvt_pk_bf16(v0[0], v0[1]); w.y = cvt_pk_bf16(v0[2], v0[3]); w.z = cvt_pk_bf16(v1[0], v1[1]); w.w = cvt_pk_bf16(v1[2], v1[3]);
                        *(u32x4*)(rowp + bj * HALF) = w; } }
        } else {
#pragma unroll
            for (int ai = 0; ai < 2; ++ai)
#pragma unroll
                for (int m = 0; m < 4; ++m) { const size_t off = (size_t)(row0 + ai * HALF + m * 16) * ldc + col0; float ss = 0.f;
#pragma unroll
                    for (int bj = 0; bj < 2; ++bj) { f32x4 b0, b1;
                        if (baseb) { const u32x4 wv = *(const u32x4*)(baseb + off + bj * HALF);
                            b0 = (f32x4){__builtin_bit_cast(float, wv.x << 16), __builtin_bit_cast(float, wv.x & 0xffff0000u), __builtin_bit_cast(float, wv.y << 16), __builtin_bit_cast(float, wv.y & 0xffff0000u)};
                            b1 = (f32x4){__builtin_bit_cast(float, wv.z << 16), __builtin_bit_cast(float, wv.z & 0xffff0000u), __builtin_bit_cast(float, wv.w << 16), __builtin_bit_cast(float, wv.w & 0xffff0000u)}; }
                        else { const float* bp = base + off + bj * HALF; b0 = *(const f32x4*)bp; b1 = *(const f32x4*)(bp + 4); }
                        const f32x4 x0 = b0 + acc[ai][bj][m][0], x1 = b1 + acc[ai][bj][m][1];
                        u32x4 w; w.x = cvt_pk_bf16(x0[0], x0[1]); w.y = cvt_pk_bf16(x0[2], x0[3]); w.z = cvt_pk_bf16(x1[0], x1[1]); w.w = cvt_pk_bf16(x1[2], x1[3]);
                        *(u32x4*)(outb + off + bj * HALF) = w;
                        ss += (x0[0] * x0[0] + x0[1] * x0[1]) + (x0[2] * x0[2] + x0[3] * x0[3]) + (x1[0] * x1[0] + x1[1] * x1[1]) + (x1[2] * x1[2] + x1[3] * x1[3]); }
                    ss += __shfl_xor(ss, 16); ss += __shfl_xor(ss, 32);
                    if (fq == 0) ssq[(size_t)(row0 + ai * HALF + m * 16) * 16 + u.pn * 4 + wc] = ss;
                }
        }
    }
};

template <class Epi, class Sched, bool ALIGN_EPI = false, bool SP2 = false>
__device__ __forceinline__ void gemm_phase(PG8_LAS unsigned char* lds, const Gemm g, const Sched& S, const Epi& E, const int tid) {
    const int wid = __builtin_amdgcn_readfirstlane(tid >> 6), lane = tid & 63, wr = wid >> 2, wc = wid & 3, fr = lane & 15, fq = lane >> 4;
    const int K = g.K, nt = K / BK;
    unsigned voffA[2], voffB[2];
#pragma unroll
    for (int i = 0; i < 2; ++i) { int R, C; stage_rc(tid * 16 + i * 8192, R, C); const int Rb = Epi::PERM ? ((R & ~31) + perm32(R & 31)) : R;
        voffA[i] = (unsigned)(R * g.lda + C) * 2u; voffB[i] = (unsigned)(Rb * g.ldb + C) * 2u; }
    const size_t kstep = (size_t)(BK * 2);
    const size_t hstepA = (size_t)HALF * g.lda * 2, hstepB = (size_t)HALF * g.ldb * 2;
    const unsigned ldsw = (unsigned)wid * 1024u;
    const int aoff = lds_byte(wr * 64 + fr, fq * 8), boff = lds_byte(wc * 32 + fr, fq * 8);
#define PG8_SA(b, h) (((b) * 2 + (h)) * HTB)
#define PG8_SB(b, h) ((4 + (b) * 2 + (h)) * HTB)
#define PG8_STAGE(bufoff, gbase, voff) do { _Pragma("unroll") for (int _i = 0; _i < 2; ++_i) \
        __builtin_amdgcn_global_load_lds((const unsigned*)((const char*)(gbase) + (voff)[_i]), (PG8_LAS unsigned*)(lds + (bufoff) + ldsw + _i * 8192), 16, 0, 0); } while (0)
#define PG8_LDA(dst, b, h) do { _Pragma("unroll") for (int m = 0; m < 4; ++m) _Pragma("unroll") for (int k = 0; k < 2; ++k) dst[m][k] = *(const PG8_LAS bf16x8*)(lds + PG8_SA(b, h) + aoff + m * 2048 + k * 1024); } while (0)
#define PG8_LDB(dst, b, h) do { _Pragma("unroll") for (int n = 0; n < 2; ++n) _Pragma("unroll") for (int k = 0; k < 2; ++k) dst[n][k] = *(const PG8_LAS bf16x8*)(lds + PG8_SB(b, h) + boff + n * 2048 + k * 1024); } while (0)
#define PG8_MMA(ai, bj, At, Bt) do { __builtin_amdgcn_s_setprio(1); _Pragma("unroll") for (int m = 0; m < 4; ++m) _Pragma("unroll") for (int n = 0; n < 2; ++n) _Pragma("unroll") for (int k = 0; k < 2; ++k) \
        acc[ai][bj][m][n] = __builtin_amdgcn_mfma_f32_16x16x32_bf16(Bt[n][k], At[m][k], acc[ai][bj][m][n], 0, 0, 0); __builtin_amdgcn_s_setprio(0); } while (0)
#define PG8_WAIT_V(n) asm volatile("s_waitcnt vmcnt(" #n ")" ::: "memory")
#define PG8_WAIT_L(n) asm volatile("s_waitcnt lgkmcnt(" #n ")" ::: "memory")
#define PG8_BAR __builtin_amdgcn_s_barrier()
#define PG8_SCHED __builtin_amdgcn_sched_barrier(0)
    Unit cur, nxt; int ui = 0;
    if (!S.next(0, cur)) return;
    f32x4 acc[2][2][4][2];
#pragma unroll
    for (int a = 0; a < 2; ++a)
#pragma unroll
        for (int b = 0; b < 2; ++b)
#pragma unroll
            for (int m = 0; m < 4; ++m)
#pragma unroll
                for (int n = 0; n < 2; ++n) acc[a][b][m][n] = (f32x4){0.f, 0.f, 0.f, 0.f};
    bf16x8 At[4][2], B0[2][2], B1[2][2];
    const char* cA; const char* cB; S.ptrs(cur, g, cA, cB);
    S.a_ready(cur);
    if constexpr (SP2) {
        PG8_STAGE(PG8_SB(0, 0), cB, voffB); PG8_STAGE(PG8_SB(0, 1), cB + hstepB, voffB); PG8_STAGE(PG8_SA(0, 0), cA, voffA); PG8_STAGE(PG8_SA(0, 1), cA + hstepA, voffA);
        if (wr == 1) PG8_BAR;
        PG8_WAIT_V(2); PG8_BAR;
        PG8_STAGE(PG8_SB(1, 0), cB + kstep, voffB); PG8_STAGE(PG8_SA(1, 0), cA + kstep, voffA); PG8_STAGE(PG8_SB(1, 1), cB + hstepB + kstep, voffB);
        PG8_WAIT_V(6); PG8_BAR;
    } else {
        PG8_STAGE(PG8_SB(0, 0), cB, voffB); PG8_STAGE(PG8_SA(0, 0), cA, voffA); PG8_STAGE(PG8_SB(0, 1), cB + hstepB, voffB); PG8_STAGE(PG8_SA(0, 1), cA + hstepA, voffA);
        if (wr == 1) PG8_BAR;
        PG8_WAIT_V(4); PG8_BAR;
        PG8_STAGE(PG8_SB(1, 0), cB + kstep, voffB); PG8_STAGE(PG8_SA(1, 0), cA + kstep, voffA); PG8_STAGE(PG8_SB(1, 1), cB + hstepB + kstep, voffB);
        PG8_WAIT_V(6); PG8_BAR;
    }
    for (;;) {
        const bool has_next = S.next(ui + 1, nxt);
        const char* nA = cA; const char* nB = cB; if (has_next) S.ptrs(nxt, g, nA, nB);
        for (int t = 0; t < nt; t += 2) {
            const bool last = (t == nt - 2);
            const char* a1 = cA + (size_t)(t + 1) * kstep;
            const char* a2 = last ? nA : cA + (size_t)(t + 2) * kstep; const char* b2 = last ? nB : cB + (size_t)(t + 2) * kstep;
            const char* a3 = a2 + kstep; const char* b3 = b2 + kstep;
            if (last && has_next) S.a_ready(nxt);
            if constexpr (SP2) {
            PG8_LDB(B0, 0, 0); PG8_LDB(B1, 0, 1); PG8_SCHED; PG8_LDA(At, 0, 0); PG8_STAGE(PG8_SA(1, 1), a1 + hstepA, voffA);
            PG8_WAIT_V(8); PG8_WAIT_L(0); PG8_BAR; PG8_MMA(0, 0, At, B0); PG8_MMA(0, 1, At, B1); PG8_BAR; PG8_SCHED;
            PG8_LDA(At, 0, 1); PG8_STAGE(PG8_SB(0, 0), b2, voffB); PG8_STAGE(PG8_SB(0, 1), b2 + hstepB, voffB); PG8_STAGE(PG8_SA(0, 0), a2, voffA);
            PG8_WAIT_V(8); PG8_WAIT_L(0); PG8_BAR; PG8_MMA(1, 0, At, B0); PG8_MMA(1, 1, At, B1); PG8_BAR; PG8_SCHED;
            PG8_LDB(B0, 1, 0); PG8_LDB(B1, 1, 1); PG8_SCHED; PG8_LDA(At, 1, 0); PG8_STAGE(PG8_SA(0, 1), a2 + hstepA, voffA);
            PG8_WAIT_V(8); PG8_WAIT_L(0); PG8_BAR; PG8_MMA(0, 0, At, B0); PG8_MMA(0, 1, At, B1); PG8_BAR; PG8_SCHED;
            PG8_LDA(At, 1, 1); PG8_STAGE(PG8_SB(1, 0), b3, voffB); PG8_STAGE(PG8_SB(1, 1), b3 + hstepB, voffB); PG8_STAGE(PG8_SA(1, 0), a3, voffA);
            PG8_WAIT_V(8); PG8_WAIT_L(0); PG8_BAR; PG8_MMA(1, 0, At, B0); PG8_MMA(1, 1, At, B1); PG8_BAR; PG8_SCHED;
            } else {
            PG8_LDB(B0, 0, 0); PG8_SCHED; PG8_LDA(At, 0, 0); PG8_STAGE(PG8_SA(1, 1), a1 + hstepA, voffA);
            PG8_WAIT_L(8); PG8_BAR; PG8_WAIT_L(0); PG8_MMA(0, 0, At, B0); PG8_BAR; PG8_SCHED;
            PG8_LDB(B1, 0, 1); PG8_STAGE(PG8_SB(0, 0), b2, voffB);
            PG8_BAR; PG8_WAIT_L(0); PG8_MMA(0, 1, At, B1); PG8_BAR;
            PG8_LDA(At, 0, 1); PG8_STAGE(PG8_SA(0, 0), a2, voffA);
            PG8_BAR; PG8_WAIT_L(0); PG8_MMA(1, 0, At, B0); PG8_BAR; PG8_SCHED;
            PG8_STAGE(PG8_SB(0, 1), b2 + hstepB, voffB);
            PG8_WAIT_V(6); PG8_BAR; PG8_MMA(1, 1, At, B1); PG8_BAR;
            PG8_LDB(B0, 1, 0); PG8_SCHED; PG8_LDA(At, 1, 0); PG8_STAGE(PG8_SA(0, 1), a2 + hstepA, voffA);
            PG8_WAIT_L(8); PG8_BAR; PG8_WAIT_L(0); PG8_MMA(0, 0, At, B0); PG8_BAR; PG8_SCHED;
            PG8_LDB(B1, 1, 1); PG8_STAGE(PG8_SB(1, 0), b3, voffB);
            PG8_BAR; PG8_WAIT_L(0); PG8_MMA(0, 1, At, B1); PG8_BAR;
            PG8_LDA(At, 1, 1); PG8_STAGE(PG8_SA(1, 0), a3, voffA);
            PG8_BAR; PG8_WAIT_L(0); PG8_MMA(1, 0, At, B0); PG8_BAR; PG8_SCHED;
            PG8_STAGE(PG8_SB(1, 1), b3 + hstepB, voffB);
            PG8_WAIT_V(6); PG8_BAR; PG8_MMA(1, 1, At, B1); PG8_BAR;
            }
        }
        if constexpr (ALIGN_EPI) { if (wr == 0) PG8_BAR; }
        if constexpr (!Epi::AFTER_DRAIN) { E(acc, cur, wr, wc, fr, fq); S.done(cur); }
        if (!has_next) break;
#pragma unroll
        for (int a = 0; a < 2; ++a)
#pragma unroll
            for (int b = 0; b < 2; ++b)
#pragma unroll
                for (int m = 0; m < 4; ++m)
#pragma unroll
                    for (int n = 0; n < 2; ++n) acc[a][b][m][n] = (f32x4){0.f, 0.f, 0.f, 0.f};
        cur = nxt; cA = nA; cB = nB; ++ui;
        if constexpr (ALIGN_EPI) { if (wr == 1) PG8_BAR; }
    }
    PG8_WAIT_V(0);
    if constexpr (!ALIGN_EPI) { if (wr == 0) PG8_BAR; }
    PG8_BAR;
    if constexpr (Epi::AFTER_DRAIN) { E.fused(acc, cur, wr, wc, fr, fq, lds, wid, lane); S.done(cur); }
#undef PG8_SA
#undef PG8_SB
#undef PG8_STAGE
#undef PG8_LDA
#undef PG8_LDB
#undef PG8_MMA
#undef PG8_WAIT_V
#undef PG8_WAIT_L
#undef PG8_BAR
#undef PG8_SCHED
}
}

#define LAS __attribute__((address_space(3)))
#define DI __device__ __forceinline__
typedef unsigned short bf16;
typedef short bf16x8 __attribute__((ext_vector_type(8)));
typedef short s16x4 __attribute__((ext_vector_type(4)));
typedef float f32x4 __attribute__((ext_vector_type(4)));
typedef float f32x16 __attribute__((ext_vector_type(16)));
typedef unsigned u32x4 __attribute__((ext_vector_type(4)));
typedef unsigned u32x2 __attribute__((ext_vector_type(2)));
typedef LAS unsigned char* ldsp;

constexpr int T_ = 32768, L_ = 16384, D_ = 1024;
constexpr float EPS_ = 1e-5f;
constexpr size_t MiB = (size_t)1 << 20;
constexpr size_t WS_W = 1 * MiB;
constexpr size_t WS_WA = WS_W, WS_WV = WS_W + 9 * MiB, WS_WOUT = WS_W + 11 * MiB, WS_WQ = WS_W + 15 * MiB, WS_WKV = WS_W + 17 * MiB,
                 WS_WXO = WS_W + 21 * MiB, WS_W1 = WS_W + 23 * MiB, WS_W2 = WS_W + 31 * MiB;
constexpr size_t WS_XN = 40 * MiB, WS_KT = WS_XN, WS_DG = WS_XN + 33 * MiB;
constexpr size_t WS_BIG = 104 * MiB, WS_VT = 376 * MiB, WS_ORAW = 441 * MiB, WS_SMALL = 505 * MiB, WS_MEMN = 509 * MiB, WS_KX = 510 * MiB, WS_VXT = 511 * MiB, WS_END = 512 * MiB;
constexpr int PROJ_LD = 4352;
constexpr int PC_Z = 0, PC_XBC = 1024, PC_Q = 2304, PC_K = 2816, PC_R = 3328;
constexpr int LDS_BYTES = 140 * 1024;
constexpr int VT_LD = T_ + 64, KT_LD = T_ + 64, QK_LD = 2048 + 64;

DI unsigned f2bf(float f) { unsigned u = __builtin_bit_cast(unsigned, f); return (u + 0x7fffu + ((u >> 16) & 1u)) >> 16; }
typedef float f32x2_t __attribute__((ext_vector_type(2))); typedef __bf16 bf16x2_t __attribute__((ext_vector_type(2)));
DI unsigned pk2(float lo, float hi) { f32x2_t v = {lo, hi}; bf16x2_t b = __builtin_convertvector(v, bf16x2_t); return __builtin_bit_cast(unsigned, b); }
DI float bf2f(unsigned h) { return __builtin_bit_cast(float, h << 16); }
DI float bflo(unsigned w) { return __builtin_bit_cast(float, w << 16); }
DI float bfhi(unsigned w) { return __builtin_bit_cast(float, w & 0xffff0000u); }
DI float wave_sum(float v) {
#pragma unroll
    for (int o = 1; o < 64; o <<= 1) v += __shfl_xor(v, o);
    return v;
}
DI float wave_max(float v) {
#pragma unroll
    for (int o = 1; o < 64; o <<= 1) v = fmaxf(v, __shfl_xor(v, o));
    return v;
}
DI float siluf(float x) { return x * __builtin_amdgcn_rcpf(1.f + __builtin_amdgcn_exp2f(-1.4426950408889634f * x)); }
DI float softplusf(float x) {
    const float e = __expf(-fabsf(x));
    const float l = (e < 0.01f) ? e * (1.f - e * (0.5f - e * (1.f / 3.f))) : __logf(1.f + e);
    return fmaxf(x, 0.f) + l;
}
DI bf16x8 lds16(ldsp p, int off) { return *(LAS bf16x8*)(p + off); }
DI s16x4 lds8(ldsp p, int off) { return *(LAS s16x4*)(p + off); }
DI bf16x8 cat8(s16x4 a, s16x4 b) { return __builtin_shufflevector(a, b, 0, 1, 2, 3, 4, 5, 6, 7); }
DI f32x4 mfma16(bf16x8 a, bf16x8 b, f32x4 c) { return __builtin_amdgcn_mfma_f32_16x16x32_bf16(a, b, c, 0, 0, 0); }
DI f32x16 mfma32(bf16x8 a, bf16x8 b, f32x16 c) { return __builtin_amdgcn_mfma_f32_32x32x16_bf16(a, b, c, 0, 0, 0); }
DI int crow(int r, int hi) { return (r & 3) + 8 * (r >> 2) + 4 * hi; }
DI float max3f(float a, float b, float c) { float r; asm("v_max3_f32 %0, %1, %2, %3" : "=v"(r) : "v"(a), "v"(b), "v"(c)); return r; }
#define LDS_FENCE() asm volatile("s_waitcnt lgkmcnt(0)" ::: "memory")

DI void rms_rows_bf16(const float* x, const float* w, bf16* out, int nrows, int gw, int NGW, int lane) {
    for (int m = 2 * gw; m < nrows; m += 2 * NGW) {
        const f32x4* xr0 = (const f32x4*)(x + (size_t)m * D_) + lane; const f32x4* xr1 = xr0 + D_ / 4;
        f32x4 v0[4], v1[4]; float s0 = 0.f, s1 = 0.f;
#pragma unroll
        for (int j = 0; j < 4; ++j) { v0[j] = xr0[64 * j]; v1[j] = xr1[64 * j]; }
#pragma unroll
        for (int j = 0; j < 4; ++j) { s0 += (v0[j].x * v0[j].x + v0[j].y * v0[j].y) + (v0[j].z * v0[j].z + v0[j].w * v0[j].w); s1 += (v1[j].x * v1[j].x + v1[j].y * v1[j].y) + (v1[j].z * v1[j].z + v1[j].w * v1[j].w); }
#pragma unroll
        for (int o = 1; o < 64; o <<= 1) { s0 += __shfl_xor(s0, o); s1 += __shfl_xor(s1, o); }
        const float r0 = rsqrtf(s0 * (1.f / D_) + EPS_), r1 = rsqrtf(s1 * (1.f / D_) + EPS_);
        u32x2* o0 = (u32x2*)(out + (size_t)m * D_) + lane; u32x2* o1 = o0 + D_ / 4;
#pragma unroll
        for (int j = 0; j < 4; ++j) { const f32x4 wv = ((const f32x4*)w)[lane + 64 * j];
            u32x2 a, b; a.x = pk2(v0[j].x * r0 * wv.x, v0[j].y * r0 * wv.y); a.y = pk2(v0[j].z * r0 * wv.z, v0[j].w * r0 * wv.w);
            b.x = pk2(v1[j].x * r1 * wv.x, v1[j].y * r1 * wv.y); b.y = pk2(v1[j].z * r1 * wv.z, v1[j].w * r1 * wv.w);
            o0[64 * j] = a; o1[64 * j] = b; }
    }
}
template <bool TO_F32> DI void rms_rows_from_bf16(const bf16* x, const float* w, bf16* outb, float* outf, int nrows, int gw, int NGW, int lane) {
    f32x4 wv[4];
#pragma unroll
    for (int j = 0; j < 4; ++j) wv[j] = ((const f32x4*)(w + lane * 16))[j];
    for (int m = 2 * gw; m < nrows; m += 2 * NGW) {
        u32x4 ra[2], rb[2];
#pragma unroll
        for (int u = 0; u < 2; ++u) { const u32x4* p = (const u32x4*)(x + (size_t)(m + u) * D_ + lane * 16); ra[u] = p[0]; rb[u] = p[1]; }
#pragma unroll
        for (int u = 0; u < 2; ++u) {
            float v[16];
            v[0] = bflo(ra[u].x); v[1] = bfhi(ra[u].x); v[2] = bflo(ra[u].y); v[3] = bfhi(ra[u].y); v[4] = bflo(ra[u].z); v[5] = bfhi(ra[u].z); v[6] = bflo(ra[u].w); v[7] = bfhi(ra[u].w);
            v[8] = bflo(rb[u].x); v[9] = bfhi(rb[u].x); v[10] = bflo(rb[u].y); v[11] = bfhi(rb[u].y); v[12] = bflo(rb[u].z); v[13] = bfhi(rb[u].z); v[14] = bflo(rb[u].w); v[15] = bfhi(rb[u].w);
            float s = 0.f;
#pragma unroll
            for (int i = 0; i < 16; ++i) s += v[i] * v[i];
            const float r = rsqrtf(wave_sum(s) * (1.f / D_) + EPS_);
#pragma unroll
            for (int i = 0; i < 16; ++i) v[i] = v[i] * r * wv[i >> 2][i & 3];
            if (TO_F32) { f32x4* o = (f32x4*)(outf + (size_t)(m + u) * D_ + lane * 16);
#pragma unroll
                for (int j = 0; j < 4; ++j) o[j] = (f32x4){v[4 * j], v[4 * j + 1], v[4 * j + 2], v[4 * j + 3]}; }
            else { u32x4 a, b; a.x = pk2(v[0], v[1]); a.y = pk2(v[2], v[3]); a.z = pk2(v[4], v[5]); a.w = pk2(v[6], v[7]); b.x = pk2(v[8], v[9]); b.y = pk2(v[10], v[11]); b.z = pk2(v[12], v[13]); b.w = pk2(v[14], v[15]);
                u32x4* o = (u32x4*)(outb + (size_t)(m + u) * D_ + lane * 16); o[0] = a; o[1] = b; }
        }
    }
}
DI void xb_rows(const float* x, bf16* out, float* ssq, int nrows, int gw, int NGW, int lane) {
    for (int m = gw; m < nrows; m += NGW) {
        const f32x4* xr = (const f32x4*)(x + (size_t)m * D_) + lane;
        f32x4 v[4]; float s = 0.f;
#pragma unroll
        for (int j = 0; j < 4; ++j) { v[j] = xr[64 * j]; s += (v[j].x * v[j].x + v[j].y * v[j].y) + (v[j].z * v[j].z + v[j].w * v[j].w); }
        s = wave_sum(s);
        u32x2* o8 = (u32x2*)(out + (size_t)m * D_) + lane;
#pragma unroll
        for (int j = 0; j < 4; ++j) { u32x2 o; o.x = pk2(v[j].x, v[j].y); o.y = pk2(v[j].z, v[j].w); o8[64 * j] = o; }
        if (lane < 16) ssq[(size_t)m * 16 + lane] = (lane == 0) ? s : 0.f;
    }
}
DI void rms_rows_f32_inplace(float* x, const float* w, int nrows, int gw, int NGW, int lane) {
    for (int m = gw; m < nrows; m += NGW) {
        f32x4* xr = (f32x4*)(x + (size_t)m * D_) + lane;
        f32x4 v[4]; float s = 0.f;
#pragma unroll
        for (int j = 0; j < 4; ++j) { v[j] = xr[64 * j]; s += (v[j].x * v[j].x + v[j].y * v[j].y) + (v[j].z * v[j].z + v[j].w * v[j].w); }
        const float rstd = rsqrtf(wave_sum(s) * (1.f / D_) + EPS_);
#pragma unroll
        for (int j = 0; j < 4; ++j) { const f32x4 wv = ((const f32x4*)w)[lane + 64 * j]; xr[64 * j] = v[j] * rstd * wv; }
    }
}

DI int map_plain(int d, int off) { return d + off; }
DI int map_win(int d) { if (d < 2304) return d; if (d < 3328) return d + 16; if (d < 4352) return d + 1056; if (d < 4368) return d - 4352 + 2304; if (d < 4384) return d; return -1; }
DI void conv_item(const float* W, int ldn, int K, bf16* WT, int nrows, int mode, int off, LAS float* scr, int item, int lane, const float* kscale = nullptr) {
    const int nblk = nrows / 32, kb = item / nblk, nb = item % nblk, k0 = 64 * kb, n0 = 32 * nb;
    const int d = n0 + (lane & 31); const int sc = mode ? map_win(d) : map_plain(d, off);
#pragma unroll 32
    for (int i = 0; i < 32; ++i) { const int kk = 2 * i + (lane >> 5); scr[kk * 33 + (lane & 31)] = sc >= 0 ? W[(size_t)(k0 + kk) * ldn + sc] : 0.f; }
    LDS_FENCE();
    const int c = lane & 7;
    f32x4 ka = (f32x4){1.f, 1.f, 1.f, 1.f}, kb2 = ka;
    if (kscale) { ka = *(const f32x4*)(kscale + k0 + 8 * c); kb2 = *(const f32x4*)(kscale + k0 + 8 * c + 4); }
#pragma unroll
    for (int j = 0; j < 4; ++j) { const int n = (lane >> 3) + 8 * j; const LAS float* s = scr + (8 * c) * 33 + n;
        u32x4 o; o.x = pk2(s[0 * 33] * ka[0], s[1 * 33] * ka[1]); o.y = pk2(s[2 * 33] * ka[2], s[3 * 33] * ka[3]); o.z = pk2(s[4 * 33] * kb2[0], s[5 * 33] * kb2[1]); o.w = pk2(s[6 * 33] * kb2[2], s[7 * 33] * kb2[3]);
        *(u32x4*)(WT + (size_t)(n0 + n) * K + k0 + 8 * c) = o; }
    LDS_FENCE();
}

DI void prep_unit(int unit, bf16* PROJ, float* SMALL, bf16* KT, float* DG, bf16* TAIL, const float* gla_w2, const float* gla_b, const float* dt_bias, const float* a_log,
                  const float* conv_w, const float* conv_b, ldsp lds, int tid) {
    asm volatile("" : "+v"(tid));
    const int rowbase = unit * 128;
    LAS float* sm = (LAS float*)lds; LAS float* dtL = (LAS float*)(lds + 16384);
    for (int i = tid; i < 128 * 32 / 4; i += 512) ((LAS f32x4*)sm)[i] = ((const f32x4*)(SMALL + (size_t)rowbase * 32))[i];
    __syncthreads();
    if (tid < 16) {
        const int h = tid; const float a = -__expf(a_log[h]), bias = dt_bias[h]; float cum = 0.f;
        for (int tt = 0; tt < 128; ++tt) { const float dtv = softplusf(sm[tt * 32 + h] + bias); cum += dtv * a; dtL[tt * 16 + h] = dtv;
            SMALL[((size_t)rowbase + tt) * 32 + h] = dtv; SMALL[((size_t)rowbase + tt) * 32 + 16 + h] = cum; }
    }
    {   const int col = tid;
        float w2c[16];
#pragma unroll
        for (int r = 0; r < 16; ++r) w2c[r] = gla_w2[r * 512 + col];
        const float bcol = gla_b[col];
        for (int sub = 0; sub < 2; ++sub) {
            float cum = 0.f;
#pragma unroll 1
            for (int g8 = 0; g8 < 8; ++g8) {
                unsigned qk[8];
                { const bf16* pq = PROJ + ((size_t)rowbase + sub * 64 + g8 * 8) * PROJ_LD + col;
#pragma unroll
                  for (int e = 0; e < 8; ++e) qk[e] = (unsigned)pq[(size_t)e * PROJ_LD + PC_Q] | ((unsigned)pq[(size_t)e * PROJ_LD + PC_K] << 16); }
                float kt[8];
#pragma unroll
                for (int e = 0; e < 8; ++e) {
                    const int tt = sub * 64 + g8 * 8 + e; const size_t row = (size_t)rowbase + tt;
                    float x = bcol;
#pragma unroll
                    for (int r = 0; r < 16; ++r) x += sm[tt * 32 + 16 + r] * w2c[r];
                    const float lg = (fminf(x, 0.f) - __logf(1.f + __expf(-fabsf(x)))) * 0.0625f;
                    cum += lg;
                    const float qv = bflo(qk[e]), kv = bfhi(qk[e]);
                    PROJ[row * PROJ_LD + PC_Q + col] = (bf16)f2bf(qv * __expf(cum) * 0.08838834764831845f);
                    kt[e] = kv * __expf(-cum);
                    PROJ[row * PROJ_LD + PC_K + col] = (bf16)f2bf(kt[e]);
                }
                u32x4 o; o.x = pk2(kt[0], kt[1]); o.y = pk2(kt[2], kt[3]); o.z = pk2(kt[4], kt[5]); o.w = pk2(kt[6], kt[7]);
                *(u32x4*)(KT + (size_t)col * KT_LD + rowbase + sub * 64 + g8 * 8) = o;
            }
            DG[(size_t)((rowbase >> 6) + sub) * 512 + col] = __expf(cum);
        }
    }
    const int tin = rowbase & (L_ - 1);
    __syncthreads();
#pragma unroll 1
    for (int i = 4; i >= 0; --i) { const int it = tid + 512 * i, pair = it % 640, slab = it / 640, c0 = 2 * pair;
        unsigned rw[35];
        bf16* base = PROJ + ((size_t)rowbase + 32 * slab) * PROJ_LD + PC_XBC + c0;
#pragma unroll
        for (int j = 0; j < 35; ++j) rw[j] = (tin + 32 * slab - 3 + j >= 0) ? *(const unsigned*)(base + (ptrdiff_t)(j - 3) * PROJ_LD) : 0u;
        float cw0[4], cw1[4];
#pragma unroll
        for (int j = 0; j < 4; ++j) { cw0[j] = conv_w[j * 1280 + c0]; cw1[j] = conv_w[j * 1280 + c0 + 1]; }
        const float cb0 = conv_b[c0], cb1 = conv_b[c0 + 1];
        const bool isx = c0 < 1024; const int hh = (c0 >> 6) & 15;
        __syncthreads();
#pragma unroll
        for (int r = 0; r < 32; ++r) { float a0 = cb0, a1 = cb1;
#pragma unroll
            for (int j = 0; j < 4; ++j) { a0 += cw0[j] * bflo(rw[r + j]); a1 += cw1[j] * bfhi(rw[r + j]); }
            a0 = siluf(a0); a1 = siluf(a1);
            const int row = 32 * slab + r;
            if (isx) { const float d = dtL[row * 16 + hh]; a0 *= d; a1 *= d; }
            bf16* dst = (row >= 125) ? TAIL + ((size_t)unit * 3 + (row - 125)) * 1280 + c0 : base + (size_t)r * PROJ_LD;
            *(unsigned*)dst = pk2(a0, a1); }
    }
    __syncthreads();
}

#define BAR_LDS() asm volatile("s_waitcnt lgkmcnt(0)\n\ts_barrier" ::: "memory")
DI void ssd_chain(int b, int h, bf16* PROJ, const float* SMALL, const bf16* TAIL, const float* d_skip, ldsp lds, int tid) {
    constexpr int CS = 0, BS = 18432, BWT = 36864, XDT = 54272, MS = 71680, SS = 106496, CUML = 115712, DTL = 116224;
    asm volatile("" : "+v"(tid));
    const int lane = tid & 63, w = __builtin_amdgcn_readfirstlane(tid >> 6), quad = lane >> 4, l16 = lane & 15;
    const int g = h >> 3, cp = lane & 31, th = lane >> 5, tb = 16 * w + 8 * th;
    LAS float* cumL = (LAS float*)(lds + CUML); LAS float* dtL = (LAS float*)(lds + DTL);
    int ch[3]; ch[0] = h * 64 + 2 * cp; ch[1] = 1024 + g * 64 + 2 * cp; ch[2] = 1152 + g * 64 + 2 * cp;
    const float Dh = d_skip[h];
    const int pi = w >> 1, q = 16 * w + l16;
    f32x4 S[2]; S[0] = (f32x4){0.f, 0.f, 0.f, 0.f}; S[1] = S[0];
    unsigned raw[3][8]; float cmv[8], cum_last, cl_t = 0.f, dt_t = 0.f; u32x2 zz[4];
#define SSD_LOAD(c_) do { const size_t r0_ = (size_t)b * L_ + (size_t)(c_) * 128; \
        _Pragma("unroll") for (int i = 0; i < 8; ++i) cmv[i] = SMALL[(r0_ + tb + i) * 32 + 16 + h]; \
        cum_last = SMALL[(r0_ + 127) * 32 + 16 + h]; \
        if (tid < 128) { cl_t = SMALL[(r0_ + tid) * 32 + 16 + h]; dt_t = SMALL[(r0_ + tid) * 32 + h]; } \
        _Pragma("unroll") for (int arr = 0; arr < 3; ++arr) _Pragma("unroll") for (int i = 0; i < 8; ++i) { const int rr = tb + i; \
            const bf16* sp = (rr >= 125) ? TAIL + ((r0_ >> 7) * 3 + (rr - 125)) * 1280 + ch[arr] : PROJ + (r0_ + rr) * PROJ_LD + PC_XBC + ch[arr]; \
            raw[arr][i] = *(const unsigned*)sp; } \
        _Pragma("unroll") for (int pt = 0; pt < 4; ++pt) zz[pt] = *(const u32x2*)(PROJ + (r0_ + q) * PROJ_LD + PC_Z + h * 64 + 16 * pt + quad * 4); } while (0)
    SSD_LOAD(0);
    for (int c = 0; c < 128; ++c) {
        const size_t row0 = (size_t)b * L_ + (size_t)c * 128;
        if (tid < 128) { cumL[tid] = cl_t; dtL[tid] = dt_t; }
        {
            u32x4 v0, v1;
            v0.x = __builtin_amdgcn_perm(raw[0][1], raw[0][0], 0x05040100u); v0.y = __builtin_amdgcn_perm(raw[0][3], raw[0][2], 0x05040100u);
            v0.z = __builtin_amdgcn_perm(raw[0][5], raw[0][4], 0x05040100u); v0.w = __builtin_amdgcn_perm(raw[0][7], raw[0][6], 0x05040100u);
            v1.x = __builtin_amdgcn_perm(raw[0][1], raw[0][0], 0x07060302u); v1.y = __builtin_amdgcn_perm(raw[0][3], raw[0][2], 0x07060302u);
            v1.z = __builtin_amdgcn_perm(raw[0][5], raw[0][4], 0x07060302u); v1.w = __builtin_amdgcn_perm(raw[0][7], raw[0][6], 0x07060302u);
            *(LAS u32x4*)(lds + XDT + (2 * cp) * 272 + tb * 2) = v0; *(LAS u32x4*)(lds + XDT + (2 * cp + 1) * 272 + tb * 2) = v1;
        }
        {
            float o0[8], o1[8];
#pragma unroll
            for (int i = 0; i < 8; ++i) { *(LAS unsigned*)(lds + BS + (tb + i) * 144 + 4 * cp) = raw[1][i];
                const float wg = __expf(cum_last - cmv[i]); o0[i] = bflo(raw[1][i]) * wg; o1[i] = bfhi(raw[1][i]) * wg; }
            u32x4 v0, v1; v0.x = pk2(o0[0], o0[1]); v0.y = pk2(o0[2], o0[3]); v0.z = pk2(o0[4], o0[5]); v0.w = pk2(o0[6], o0[7]);
            v1.x = pk2(o1[0], o1[1]); v1.y = pk2(o1[2], o1[3]); v1.z = pk2(o1[4], o1[5]); v1.w = pk2(o1[6], o1[7]);
            *(LAS u32x4*)(lds + BWT + (2 * cp) * 272 + tb * 2) = v0; *(LAS u32x4*)(lds + BWT + (2 * cp + 1) * 272 + tb * 2) = v1;
        }
#pragma unroll
        for (int i = 0; i < 8; ++i) *(LAS unsigned*)(lds + CS + (tb + i) * 144 + 4 * cp) = raw[2][i];
        u32x2 zc[4];
#pragma unroll
        for (int pt = 0; pt < 4; ++pt) zc[pt] = zz[pt];
        if (c + 1 < 128) SSD_LOAD(c + 1);
        BAR_LDS();
        const float cq = cumL[q], dq = dtL[q];
        const int fo = quad * 16;
        {
            bf16x8 cb[2];
#pragma unroll
            for (int k = 0; k < 2; ++k) cb[k] = lds16(lds, CS + q * 144 + 64 * k + fo);
#pragma unroll
            for (int jh = 0; jh < 2; ++jh) {
                bf16x8 ba[4][2];
#pragma unroll
                for (int j4 = 0; j4 < 4; ++j4) if (4 * jh + j4 <= w) {
#pragma unroll
                    for (int k = 0; k < 2; ++k) ba[j4][k] = lds16(lds, BS + (16 * (4 * jh + j4) + l16) * 144 + 64 * k + fo); }
                __builtin_amdgcn_sched_barrier(0);
                f32x4 acc[4];
#pragma unroll
                for (int j4 = 0; j4 < 4; ++j4) { acc[j4] = (f32x4){0.f, 0.f, 0.f, 0.f};
                    if (4 * jh + j4 <= w) { acc[j4] = mfma16(ba[j4][0], cb[0], acc[j4]); acc[j4] = mfma16(ba[j4][1], cb[1], acc[j4]); } }
                __builtin_amdgcn_sched_barrier(0);
#pragma unroll
                for (int j4 = 0; j4 < 4; ++j4) {
                    const int s0 = 16 * (4 * jh + j4) + quad * 4;
                    const f32x4 cs = *(LAS f32x4*)(cumL + s0);
                    float v[4];
#pragma unroll
                    for (int jj = 0; jj < 4; ++jj) { const int s = s0 + jj; float t = (s <= q) ? acc[j4][jj] * __expf(cq - cs[jj]) : 0.f; if (s == q && dq > 0.f) t += Dh / dq; v[jj] = t; }
                    u32x2 o; o.x = pk2(v[0], v[1]); o.y = pk2(v[2], v[3]);
                    *(LAS u32x2*)(lds + MS + q * 272 + s0 * 2) = o;
                }
            }
        }
#pragma unroll
        for (int i = 0; i < 2; ++i) { const int ni = (w & 1) * 2 + i; u32x2 o; o.x = pk2(S[i][0], S[i][1]); o.y = pk2(S[i][2], S[i][3]);
            *(LAS u32x2*)(lds + SS + (16 * pi + l16) * 144 + (16 * ni + quad * 4) * 2) = o; }
        const float el = __expf(cumL[127]);
        BAR_LDS();
        const float eq = __expf(cq);
        {
            bf16x8 mb[4], cb[2];
#pragma unroll
            for (int ks = 0; ks < 4; ++ks) mb[ks] = lds16(lds, MS + q * 272 + 64 * ks + fo);
#pragma unroll
            for (int k = 0; k < 2; ++k) cb[k] = lds16(lds, CS + q * 144 + 64 * k + fo);
#pragma unroll
            for (int pt = 0; pt < 4; ++pt) {
                bf16x8 xa[4], sa[2];
#pragma unroll
                for (int ks = 0; ks < 4; ++ks) xa[ks] = lds16(lds, XDT + (16 * pt + l16) * 272 + 64 * ks + fo);
#pragma unroll
                for (int k = 0; k < 2; ++k) sa[k] = lds16(lds, SS + (16 * pt + l16) * 144 + 64 * k + fo);
                __builtin_amdgcn_sched_barrier(0);
                f32x4 y1 = (f32x4){0.f, 0.f, 0.f, 0.f}, y2 = y1;
#pragma unroll
                for (int ks = 0; ks < 4; ++ks) if (32 * ks < 16 * w + 16) y1 = mfma16(xa[ks], mb[ks], y1);
#pragma unroll
                for (int k = 0; k < 2; ++k) y2 = mfma16(sa[k], cb[k], y2);
                __builtin_amdgcn_sched_barrier(0);
                bf16* zp = PROJ + (row0 + q) * PROJ_LD + PC_Z + h * 64 + 16 * pt + quad * 4;
                const float z0 = bflo(zc[pt].x), z1 = bfhi(zc[pt].x), z2 = bflo(zc[pt].y), z3 = bfhi(zc[pt].y);
                u32x2 o; o.x = pk2((y1[0] + eq * y2[0]) * siluf(z0), (y1[1] + eq * y2[1]) * siluf(z1)); o.y = pk2((y1[2] + eq * y2[2]) * siluf(z2), (y1[3] + eq * y2[3]) * siluf(z3));
                *(u32x2*)zp = o;
            }
        }
        {
            bf16x8 xb[4], wa[2][4];
#pragma unroll
            for (int ks = 0; ks < 4; ++ks) xb[ks] = lds16(lds, XDT + (16 * pi + l16) * 272 + 64 * ks + fo);
#pragma unroll
            for (int i = 0; i < 2; ++i)
#pragma unroll
                for (int ks = 0; ks < 4; ++ks) wa[i][ks] = lds16(lds, BWT + (16 * ((w & 1) * 2 + i) + l16) * 272 + 64 * ks + fo);
            __builtin_amdgcn_sched_barrier(0);
            S[0] = S[0] * el; S[1] = S[1] * el;
#pragma unroll
            for (int ks = 0; ks < 4; ++ks) { S[0] = mfma16(wa[0][ks], xb[ks], S[0]); S[1] = mfma16(wa[1][ks], xb[ks], S[1]); }
        }
        BAR_LDS();
    }
#undef SSD_LOAD
}

DI void gla_chain(int b, int h, int vs, const bf16* PROJ, const bf16* KT, const bf16* VT, const float* DG, bf16* ORAW, ldsp lds, int tid) {
    constexpr int QS = 0, KS = 17408, KTS = 34816, VTS = 53248, PS = 62464, STS = 71680, DLO = 89088;
    asm volatile("" : "+v"(tid));
    const int lane = tid & 63, w = __builtin_amdgcn_readfirstlane(tid >> 6), quad = lane >> 4, l16 = lane & 15, qi = w >> 1;
    LAS float* dL = (LAS float*)(lds + DLO);
    f32x4 S[4];
#pragma unroll
    for (int i = 0; i < 4; ++i) S[i] = (f32x4){0.f, 0.f, 0.f, 0.f};
    u32x4 Aq[2], Ak[2], Akt[2], Av, Bq[2], Bk[2], Bkt[2], Bv; float Ad = 0.f, Bd = 0.f;
#define GLA_LOAD(c_, P) do { const size_t r0_ = (size_t)b * L_ + (size_t)(c_) * 64; \
        _Pragma("unroll") for (int i = 0; i < 2; ++i) { const int idx = tid + 512 * i, r = idx >> 4, cc = idx & 15; \
            P##q[i] = *(const u32x4*)(PROJ + (r0_ + r) * PROJ_LD + PC_Q + h * 128 + cc * 8); P##k[i] = *(const u32x4*)(PROJ + (r0_ + r) * PROJ_LD + PC_K + h * 128 + cc * 8); } \
        _Pragma("unroll") for (int i = 0; i < 2; ++i) { const int idx = tid + 512 * i, r = idx >> 3, cc = idx & 7; P##kt[i] = *(const u32x4*)(KT + (size_t)(h * 128 + r) * KT_LD + r0_ + cc * 8); } \
        { const int r = tid >> 3, cc = tid & 7; P##v = *(const u32x4*)(VT + (size_t)(h * 256 + vs * 64 + r) * VT_LD + r0_ + cc * 8); } \
        if (tid < 128) P##d = DG[(r0_ >> 6) * 512 + h * 128 + tid]; } while (0)
#define GLA_PUT(P) do { \
        _Pragma("unroll") for (int i = 0; i < 2; ++i) { const int idx = tid + 512 * i, r = idx >> 4, cc = idx & 15; \
            *(LAS u32x4*)(lds + QS + r * 272 + cc * 16) = P##q[i]; *(LAS u32x4*)(lds + KS + r * 272 + cc * 16) = P##k[i]; } \
        _Pragma("unroll") for (int i = 0; i < 2; ++i) { const int idx = tid + 512 * i, r = idx >> 3, cc = idx & 7; *(LAS u32x4*)(lds + KTS + r * 144 + cc * 16) = P##kt[i]; } \
        { const int r = tid >> 3, cc = tid & 7; *(LAS u32x4*)(lds + VTS + r * 144 + cc * 16) = P##v; } \
        if (tid < 128) dL[tid] = P##d; } while (0)
#define GLA_COMPUTE(c_) do { \
        const size_t row0 = (size_t)b * L_ + (size_t)(c_) * 64; \
        BAR_LDS(); \
        const int q = 16 * qi + l16; \
        const int fo = quad * 16; \
        { \
            bf16x8 fb[4], fa[2][4]; \
_Pragma("unroll") \
            for (int ks = 0; ks < 4; ++ks) fb[ks] = lds16(lds, QS + q * 272 + 64 * ks + fo); \
_Pragma("unroll") \
            for (int i = 0; i < 2; ++i) \
_Pragma("unroll") \
                for (int ks = 0; ks < 4; ++ks) fa[i][ks] = lds16(lds, KS + (16 * ((w & 1) * 2 + i) + l16) * 272 + 64 * ks + fo); \
            __builtin_amdgcn_sched_barrier(0); \
            f32x4 acc[2]; acc[0] = (f32x4){0.f, 0.f, 0.f, 0.f}; acc[1] = acc[0]; \
_Pragma("unroll") \
            for (int ks = 0; ks < 4; ++ks) { acc[0] = mfma16(fa[0][ks], fb[ks], acc[0]); acc[1] = mfma16(fa[1][ks], fb[ks], acc[1]); } \
            __builtin_amdgcn_sched_barrier(0); \
_Pragma("unroll") \
            for (int i = 0; i < 2; ++i) { const int s0 = 16 * ((w & 1) * 2 + i) + quad * 4; \
                u32x2 o; o.x = pk2(s0 <= q ? acc[i][0] : 0.f, s0 + 1 <= q ? acc[i][1] : 0.f); o.y = pk2(s0 + 2 <= q ? acc[i][2] : 0.f, s0 + 3 <= q ? acc[i][3] : 0.f); \
                *(LAS u32x2*)(lds + PS + q * 144 + s0 * 2) = o; } \
        } \
_Pragma("unroll") \
        for (int vt = 0; vt < 4; ++vt) { u32x2 o; o.x = pk2(S[vt][0], S[vt][1]); o.y = pk2(S[vt][2], S[vt][3]); \
            *(LAS u32x2*)(lds + STS + (16 * vt + l16) * 272 + (16 * w + quad * 4) * 2) = o; } \
        BAR_LDS(); \
        { \
            bf16x8 pb[2], qb4[4], va[2][2], sa[2][4], ka[2], vb[4][2]; \
_Pragma("unroll") \
            for (int ks = 0; ks < 2; ++ks) pb[ks] = lds16(lds, PS + q * 144 + 64 * ks + fo); \
_Pragma("unroll") \
            for (int ks = 0; ks < 4; ++ks) qb4[ks] = lds16(lds, QS + q * 272 + 64 * ks + fo); \
_Pragma("unroll") \
            for (int i = 0; i < 2; ++i) { const int vt = (w & 1) * 2 + i; \
_Pragma("unroll") \
                for (int ks = 0; ks < 2; ++ks) va[i][ks] = lds16(lds, VTS + (16 * vt + l16) * 144 + 64 * ks + fo); \
_Pragma("unroll") \
                for (int ks = 0; ks < 4; ++ks) sa[i][ks] = lds16(lds, STS + (16 * vt + l16) * 272 + 64 * ks + fo); } \
_Pragma("unroll") \
            for (int ks = 0; ks < 2; ++ks) ka[ks] = lds16(lds, KTS + (16 * w + l16) * 144 + 64 * ks + fo); \
_Pragma("unroll") \
            for (int vt = 0; vt < 4; ++vt) \
_Pragma("unroll") \
                for (int ks = 0; ks < 2; ++ks) vb[vt][ks] = lds16(lds, VTS + (16 * vt + l16) * 144 + 64 * ks + fo); \
            const f32x4 dv = *(LAS f32x4*)(dL + 16 * w + quad * 4); \
            __builtin_amdgcn_sched_barrier(0); \
            f32x4 o[2]; o[0] = (f32x4){0.f, 0.f, 0.f, 0.f}; o[1] = o[0]; \
_Pragma("unroll") \
            for (int ks = 0; ks < 2; ++ks) { o[0] = mfma16(va[0][ks], pb[ks], o[0]); o[1] = mfma16(va[1][ks], pb[ks], o[1]); } \
_Pragma("unroll") \
            for (int ks = 0; ks < 4; ++ks) { o[0] = mfma16(sa[0][ks], qb4[ks], o[0]); o[1] = mfma16(sa[1][ks], qb4[ks], o[1]); } \
_Pragma("unroll") \
            for (int ks = 0; ks < 2; ++ks) \
_Pragma("unroll") \
                for (int vt = 0; vt < 4; ++vt) S[vt] = mfma16(ka[ks], vb[vt][ks], S[vt]); \
            __builtin_amdgcn_sched_barrier(0); \
_Pragma("unroll") \
            for (int i = 0; i < 2; ++i) { const int vt = (w & 1) * 2 + i; u32x2 ov; ov.x = pk2(o[i][0], o[i][1]); ov.y = pk2(o[i][2], o[i][3]); \
                *(u32x2*)(ORAW + (row0 + q) * 2048 + 1024 + h * 256 + vs * 64 + 16 * vt + quad * 4) = ov; } \
_Pragma("unroll") \
            for (int vt = 0; vt < 4; ++vt) S[vt] = S[vt] * dv; \
        } \
        BAR_LDS(); \
    } while (0)
    GLA_LOAD(0, A); GLA_LOAD(1, B);
    for (int c = 0; c < 256; c += 2) {
        GLA_PUT(A); if (c + 2 < 256) GLA_LOAD(c + 2, A); GLA_COMPUTE(c);
        GLA_PUT(B); if (c + 3 < 256) GLA_LOAD(c + 3, B); GLA_COMPUTE(c + 1);
    }
#undef GLA_PUT
#undef GLA_COMPUTE
#undef GLA_LOAD
}

#define UNPACK16(a, b, v) do { v[0] = bflo(a.x); v[1] = bfhi(a.x); v[2] = bflo(a.y); v[3] = bfhi(a.y); v[4] = bflo(a.z); v[5] = bfhi(a.z); v[6] = bflo(a.w); v[7] = bfhi(a.w); \
    v[8] = bflo(b.x); v[9] = bfhi(b.x); v[10] = bflo(b.y); v[11] = bfhi(b.y); v[12] = bflo(b.z); v[13] = bfhi(b.z); v[14] = bflo(b.w); v[15] = bfhi(b.w); } while (0)
DI void gate_rows(bf16* PROJ, bf16* ORAW, const float* ssd_norm, const float* gla_norm, int gw, int NGW, int lane) {
    for (int t0 = 2 * gw; t0 < T_; t0 += 2 * NGW) {
        u32x4 ya[2], yb[2], oa[2], ob[2], ra[2], rb[2];
#pragma unroll
        for (int u = 0; u < 2; ++u) { const size_t t = (size_t)t0 + u;
            const bf16* yp = PROJ + t * PROJ_LD + PC_Z + lane * 16; const bf16* op = ORAW + t * 2048 + 1024 + lane * 16; const bf16* rp = PROJ + t * PROJ_LD + PC_R + lane * 16;
            ya[u] = *(const u32x4*)yp; yb[u] = *(const u32x4*)(yp + 8); oa[u] = *(const u32x4*)op; ob[u] = *(const u32x4*)(op + 8); ra[u] = *(const u32x4*)rp; rb[u] = *(const u32x4*)(rp + 8); }
#pragma unroll
        for (int u = 0; u < 2; ++u) { const size_t t = (size_t)t0 + u;
            {   float v[16]; UNPACK16(ya[u], yb[u], v);
                float s = 0.f;
#pragma unroll
                for (int i = 0; i < 16; ++i) s += v[i] * v[i];
#pragma unroll
                for (int o = 1; o < 32; o <<= 1) s += __shfl_xor(s, o);
                const float rstd = rsqrtf(s * (1.f / 512.f) + EPS_);
                const float* nw = ssd_norm + lane * 16;
#pragma unroll
                for (int i = 0; i < 16; ++i) v[i] = v[i] * rstd * nw[i];
                u32x4 a, b; a.x = pk2(v[0], v[1]); a.y = pk2(v[2], v[3]); a.z = pk2(v[4], v[5]); a.w = pk2(v[6], v[7]); b.x = pk2(v[8], v[9]); b.y = pk2(v[10], v[11]); b.z = pk2(v[12], v[13]); b.w = pk2(v[14], v[15]);
                bf16* yp = ORAW + t * 2048 + lane * 16; *(u32x4*)yp = a; *(u32x4*)(yp + 8) = b; }
            {   float v[16], r[16]; UNPACK16(oa[u], ob[u], v); UNPACK16(ra[u], rb[u], r);
                float s = 0.f;
#pragma unroll
                for (int i = 0; i < 16; ++i) s += v[i] * v[i];
#pragma unroll
                for (int o = 1; o < 16; o <<= 1) s += __shfl_xor(s, o);
                const float rstd = rsqrtf(s * (1.f / 256.f) + EPS_);
                const float* nw = gla_norm + (lane & 15) * 16;
#pragma unroll
                for (int i = 0; i < 16; ++i) v[i] = v[i] * rstd * nw[i] * siluf(r[i]);
                u32x4 a, b; a.x = pk2(v[0], v[1]); a.y = pk2(v[2], v[3]); a.z = pk2(v[4], v[5]); a.w = pk2(v[6], v[7]); b.x = pk2(v[8], v[9]); b.y = pk2(v[10], v[11]); b.z = pk2(v[12], v[13]); b.w = pk2(v[14], v[15]);
                bf16* op = ORAW + t * 2048 + 1024 + lane * 16; *(u32x4*)op = a; *(u32x4*)(op + 8) = b; }
        }
    }
}

DI void attn_unit(int b, int ph, int qb, const bf16* QK, const bf16* VT, bf16* OATT, const float* NORMS, ldsp lds, int tid) {
    asm volatile("" : "+v"(tid));
    constexpr int KBUF = 9216, VBUF = 18432, KOFF = 0, VOFF = 2 * KBUF, WSOFF = 2 * KBUF + 2 * VBUF;
    const int lane = tid & 63, w = tid >> 6, r32 = lane & 31, hi = lane >> 5;
    const int q0 = qb * 256, head = ph >> 1;
    const size_t rowb = (size_t)b * L_;
    const float cs = exp2f(-(float)(head + 1)) * 1.4426950408889634f;
    LAS float* wsf = (LAS float*)(lds + WSOFF) + w * 64;
    bf16x8 qf[4];
    { const bf16* qp = QK + (rowb + q0 + 32 * w + r32) * QK_LD + ph * 64 + 8 * hi;
#pragma unroll
      for (int ks = 0; ks < 4; ++ks) qf[ks] = *(const bf16x8*)(qp + 16 * ks); }
    asm volatile("s_waitcnt vmcnt(0)" : "+v"(qf[0]), "+v"(qf[1]), "+v"(qf[2]), "+v"(qf[3]) :: "memory");
    const int qpos = q0 + 32 * w + r32;
    const int rsw = ((r32 >> 3) & 1) * 8;
    f32x16 o[4];
#pragma unroll
    for (int d = 0; d < 4; ++d)
#pragma unroll
        for (int r = 0; r < 16; ++r) o[d][r] = 0.f;
    float l_run = 0.f;
    const float Bq = sqrtf(NORMS[b * 32 + ph] * NORMS[b * 32 + 16 + ph]);
    const float Wn = (150.f + 2.f * Bq) / cs;
    const float sk = ((float)(q0 - 63) - Wn) * (1.f / 64.f);
    int t_begin = (sk >= 0.f) ? (int)floorf(sk) + 1 : 0;
    t_begin = __builtin_amdgcn_readfirstlane(t_begin);
    const int t_end = (q0 + 256) / 64;
    float m_run = cs * (float)(64 * t_begin - q0);
    const int klane = r32 * 144 + 16 * hi, vlane = r32 * 144 + 16 * hi;
    const float cs_h = bf2f(pk2(cs, 0.f) & 0xffffu);
    const unsigned csw = (hi == 0) ? pk2(cs_h, cs - cs_h) : 0u;
    bf16x8 kext0, kext1;
    { u32x4 e0, e1; e0.x = (hi == 0) ? pk2((float)r32, (float)r32) : 0u; e0.y = (hi == 0) ? pk2(1.f, 1.f) : 0u; e0.z = 0u; e0.w = 0u;
      e1 = e0; e1.x = (hi == 0) ? pk2((float)(r32 + 32), (float)(r32 + 32)) : 0u; kext0 = __builtin_bit_cast(bf16x8, e0); kext1 = __builtin_bit_cast(bf16x8, e1); }
    const int kr = tid >> 3, kc = tid & 7;
    const bf16* ksrc = QK + (rowb + kr) * QK_LD + 1024 + ph * 64 + kc * 8;
    const bf16* vsrc0 = VT + (size_t)(head * 128 + kr) * VT_LD + rowb + kc * 8;
    const bf16* vsrc1 = VT + (size_t)(head * 128 + 64 + kr) * VT_LD + rowb + kc * 8;
    const int kdst = KOFF + kr * 144 + kc * 16, vdst0 = VOFF + kr * 144 + kc * 16, vdst1 = VOFF + (64 + kr) * 144 + kc * 16;
    u32x4 pk_, pv0, pv1;
    pk_ = *(const u32x4*)(ksrc + (size_t)t_begin * 64 * QK_LD); pv0 = *(const u32x4*)(vsrc0 + t_begin * 64); pv1 = *(const u32x4*)(vsrc1 + t_begin * 64);
    const int vp0 = (16 * (kc >> 1) + 4 * (kc & 1)) * 2, vp1 = vp0 + 16;
#define VSWZ(v) (v)
    __syncthreads();
    *(LAS u32x4*)(lds + kdst) = pk_;
    { *(LAS u32x2*)(lds + VOFF + kr * 144 + vp0) = (u32x2){pv0.x, pv0.y}; *(LAS u32x2*)(lds + VOFF + kr * 144 + vp1) = (u32x2){pv0.z, pv0.w};
      *(LAS u32x2*)(lds + VOFF + (64 + kr) * 144 + vp0) = (u32x2){pv1.x, pv1.y}; *(LAS u32x2*)(lds + VOFF + (64 + kr) * 144 + vp1) = (u32x2){pv1.z, pv1.w}; }
    __syncthreads();
#define ATTN_TILE(t_, buf_) do { \
        const int kbase = 64 * (t_); \
        if (kbase <= q0 + 32 * w + 31) { \
            const int kb = KOFF + (buf_) * KBUF + klane, vb = VOFF + (buf_) * VBUF + vlane; \
              \
            const float nm = cs * (float)(kbase - q0) - m_run; \
            const float nmh = bf2f(pk2(nm, 0.f) & 0xffffu); \
            u32x4 qe; qe.x = csw; qe.y = (hi == 0) ? pk2(nmh, nm - nmh) : 0u; qe.z = 0u; qe.w = 0u; \
            const bf16x8 qef = __builtin_bit_cast(bf16x8, qe); \
            bf16x8 kf0[4], kf1[4]; \
            _Pragma("unroll") \
            for (int ks = 0; ks < 4; ++ks) { kf0[ks] = lds16(lds, kb + 32 * ks); kf1[ks] = lds16(lds, kb + 32 * 144 + 32 * ks); } \
            __builtin_amdgcn_sched_barrier(0); \
            f32x16 s0, s1; \
            _Pragma("unroll") \
            for (int r = 0; r < 16; ++r) { s0[r] = 0.f; s1[r] = 0.f; } \
            s0 = mfma32(kext0, qef, s0); s1 = mfma32(kext1, qef, s1); \
            _Pragma("unroll") \
            for (int ks = 0; ks < 4; ++ks) { s0 = mfma32(kf0[ks], qf[ks], s0); s1 = mfma32(kf1[ks], qf[ks], s1); } \
            __builtin_amdgcn_sched_barrier(0); \
            asm volatile("s_nop 15\n\ts_nop 7" : "+v"(s0), "+v"(s1));     \
            if (kbase + 63 > q0 + 32 * w) { \
                _Pragma("unroll") \
                for (int r = 0; r < 16; ++r) { const int key = kbase + 4 * hi + (r & 3) + 8 * (r >> 2); if (key > qpos) s0[r] = -INFINITY; if (key + 32 > qpos) s1[r] = -INFINITY; } \
            } \
            float mx = s0[0], mx2 = s1[0]; \
            _Pragma("unroll") \
            for (int r = 1; r < 16; r += 2) { mx = max3f(mx, s0[r], s1[r]); if (r + 1 < 16) mx2 = max3f(mx2, s0[r + 1], s1[r + 1]); } \
            mx = max3f(mx, mx2, mx2); \
            mx = fmaxf(mx, __shfl_xor(mx, 32)); \
            if (__any(mx > 32.f)) { \
                const float dl = fmaxf(mx, 0.f); \
                const float alpha = __builtin_amdgcn_exp2f(-dl); \
                l_run *= alpha; m_run += dl; \
                _Pragma("unroll") \
                for (int r = 0; r < 16; ++r) { s0[r] -= dl; s1[r] -= dl; } \
                if (hi == 0) wsf[r32] = alpha; \
                LDS_FENCE(); \
                _Pragma("unroll") \
                for (int r = 0; r < 16; ++r) { const float a = wsf[crow(r, hi)]; \
                    _Pragma("unroll") \
                    for (int d = 0; d < 4; ++d) o[d][r] *= a; } \
            } \
            float rs = 0.f; \
            _Pragma("unroll") \
            for (int r = 0; r < 16; ++r) { s0[r] = __builtin_amdgcn_exp2f(s0[r]); s1[r] = __builtin_amdgcn_exp2f(s1[r]); rs += s0[r] + s1[r]; } \
            rs += __shfl_xor(rs, 32); \
            l_run += rs; \
            bf16x8 pa[2][2]; \
            _Pragma("unroll") \
            for (int s = 0; s < 2; ++s) { \
                u32x4 p0, p1; \
                p0.x = pk2(s0[8 * s + 0], s0[8 * s + 1]); p0.y = pk2(s0[8 * s + 2], s0[8 * s + 3]); p0.z = pk2(s0[8 * s + 4], s0[8 * s + 5]); p0.w = pk2(s0[8 * s + 6], s0[8 * s + 7]); \
                p1.x = pk2(s1[8 * s + 0], s1[8 * s + 1]); p1.y = pk2(s1[8 * s + 2], s1[8 * s + 3]); p1.z = pk2(s1[8 * s + 4], s1[8 * s + 5]); p1.w = pk2(s1[8 * s + 6], s1[8 * s + 7]); \
                pa[0][s] = __builtin_bit_cast(bf16x8, p0); pa[1][s] = __builtin_bit_cast(bf16x8, p1); \
            } \
            _Pragma("unroll") \
            for (int dh = 0; dh < 2; ++dh) { \
                bf16x8 vf[2][2][2]; \
                _Pragma("unroll") \
                for (int d2 = 0; d2 < 2; ++d2) \
                    _Pragma("unroll") \
                    for (int hf = 0; hf < 2; ++hf) \
                        _Pragma("unroll") \
                        for (int s = 0; s < 2; ++s) vf[d2][hf][s] = lds16(lds, vb + 4608 * (2 * dh + d2) + 64 * hf + 32 * s); \
                __builtin_amdgcn_sched_barrier(0); \
                _Pragma("unroll") \
                for (int hf = 0; hf < 2; ++hf) \
                    _Pragma("unroll") \
                    for (int s = 0; s < 2; ++s) \
                        _Pragma("unroll") \
                        for (int d2 = 0; d2 < 2; ++d2) o[2 * dh + d2] = mfma32(pa[hf][s], vf[d2][hf][s], o[2 * dh + d2]); \
                __builtin_amdgcn_sched_barrier(0); \
            } \
        } \
    } while (0)
#define ATTN_LOAD(t_, K_, V0_, V1_) do { K_ = *(const u32x4*)(ksrc + (size_t)(t_) * 64 * QK_LD); V0_ = *(const u32x4*)(vsrc0 + (t_) * 64); V1_ = *(const u32x4*)(vsrc1 + (t_) * 64); } while (0)
#define VT_PUT(off_, V_) do { *(LAS u32x2*)(lds + (off_) + vp0) = (u32x2){(V_).x, (V_).y}; *(LAS u32x2*)(lds + (off_) + vp1) = (u32x2){(V_).z, (V_).w}; } while (0)
#define ATTN_STORE(buf_, K_, V0_, V1_) do { *(LAS u32x4*)(lds + kdst + (buf_) * KBUF) = K_; VT_PUT(VOFF + (buf_) * VBUF + kr * 144, V0_); VT_PUT(VOFF + (buf_) * VBUF + (64 + kr) * 144, V1_); } while (0)
    u32x4 ak = pk_, av0 = pv0, av1 = pv1, bk = pk_, bv0 = pv0, bv1 = pv1;
    if (t_begin + 1 < t_end) ATTN_LOAD(t_begin + 1, ak, av0, av1);
    for (int t = t_begin; t < t_end; t += 2) {
        if (t + 2 < t_end) ATTN_LOAD(t + 2, bk, bv0, bv1);
        ATTN_TILE(t, 0);
        if (t + 1 < t_end) ATTN_STORE(1, ak, av0, av1);
        BAR_LDS();
        if (t + 1 < t_end) {
            if (t + 3 < t_end) ATTN_LOAD(t + 3, ak, av0, av1);
            ATTN_TILE(t + 1, 1);
            if (t + 2 < t_end) ATTN_STORE(0, bk, bv0, bv1);
            BAR_LDS();
        }
    }
#undef ATTN_TILE
#undef ATTN_LOAD
#undef ATTN_STORE
    LDS_FENCE();
    if (hi == 0) wsf[r32] = 1.f / l_run;
    LDS_FENCE();
    bf16* op = OATT + (rowb + q0 + 32 * w) * 2048 + ph * 128 + r32;
#pragma unroll
    for (int r = 0; r < 16; ++r) { const int qr = crow(r, hi); const float rl = wsf[qr];
#pragma unroll
        for (int d = 0; d < 4; ++d) op[(size_t)qr * 2048 + 32 * d] = (bf16)f2bf(o[d][r] * rl); }
#undef VSWZ
}

DI void qk_norms(const bf16* QK, float* NORMS, int gw, int NGW, int lane) {
    for (int b = 0; b < 2; ++b) {
        float mx = 0.f;
        for (int t = gw; t < L_; t += NGW) {
            const u32x4* p = (const u32x4*)(QK + ((size_t)b * L_ + t) * QK_LD + lane * 32);
            float s = 0.f;
#pragma unroll
            for (int i = 0; i < 4; ++i) { const u32x4 v = p[i];
                s += bflo(v.x) * bflo(v.x) + bfhi(v.x) * bfhi(v.x) + bflo(v.y) * bflo(v.y) + bfhi(v.y) * bfhi(v.y) + bflo(v.z) * bflo(v.z) + bfhi(v.z) * bfhi(v.z) + bflo(v.w) * bflo(v.w) + bfhi(v.w) * bfhi(v.w); }
            s += __shfl_xor(s, 1);
            mx = fmaxf(mx, s);
        }
        if (!(lane & 1)) atomicMax((unsigned*)NORMS + b * 32 + (lane >> 1), __float_as_uint(mx));
    }
}

DI void combine_rows(const bf16* OATT, bf16* OUT, const float* lq1, const float* lk1, const float* lq2, const float* lk2, const float* subln, float lam_init, int gw, int NGW, int lane) {
    const float e1 = __expf(wave_sum(lq1[lane] * lk1[lane])), e2 = __expf(wave_sum(lq2[lane] * lk2[lane]));
    const float lam = e1 - e2 + lam_init;
    const int head = lane >> 3, dv0 = (lane & 7) * 16;
    for (int t0 = 2 * gw; t0 < T_; t0 += 2 * NGW) {
        u32x4 A[2], B[2], C[2], Dd[2];
#pragma unroll
        for (int u = 0; u < 2; ++u) { const bf16* p1 = OATT + (size_t)(t0 + u) * 2048 + (2 * head) * 128 + dv0; const bf16* p2 = p1 + 128;
            A[u] = *(const u32x4*)p1; B[u] = *(const u32x4*)(p1 + 8); C[u] = *(const u32x4*)p2; Dd[u] = *(const u32x4*)(p2 + 8); }
#pragma unroll
        for (int u = 0; u < 2; ++u) {
            float v[16], q[16]; UNPACK16(A[u], B[u], v); UNPACK16(C[u], Dd[u], q);
            float s = 0.f;
#pragma unroll
            for (int i = 0; i < 16; ++i) { v[i] = v[i] - lam * q[i]; s += v[i] * v[i]; }
            s += __shfl_xor(s, 1); s += __shfl_xor(s, 2); s += __shfl_xor(s, 4);
            const float sc = rsqrtf(s * (1.f / 128.f) + EPS_) * (1.f - lam_init);
            const float* nw = subln + dv0;
            u32x4 oa, ob;
            oa.x = pk2(v[0] * sc * nw[0], v[1] * sc * nw[1]); oa.y = pk2(v[2] * sc * nw[2], v[3] * sc * nw[3]); oa.z = pk2(v[4] * sc * nw[4], v[5] * sc * nw[5]); oa.w = pk2(v[6] * sc * nw[6], v[7] * sc * nw[7]);
            ob.x = pk2(v[8] * sc * nw[8], v[9] * sc * nw[9]); ob.y = pk2(v[10] * sc * nw[10], v[11] * sc * nw[11]); ob.z = pk2(v[12] * sc * nw[12], v[13] * sc * nw[13]); ob.w = pk2(v[14] * sc * nw[14], v[15] * sc * nw[15]);
            bf16* qo = OUT + (size_t)(t0 + u) * 1024 + head * 128 + dv0;
            *(u32x4*)qo = oa; *(u32x4*)(qo + 8) = ob;
        }
    }
}

DI void softmax_rows256(bf16* S, int nrows, int gw, int NGW, int lane) {
    for (int r0 = gw * 4; r0 < nrows; r0 += NGW * 4) {
        u32x2 a[4];
#pragma unroll
        for (int i = 0; i < 4; ++i) a[i] = *((const u32x2*)(S + (size_t)(r0 + i) * 256) + lane);
#pragma unroll
        for (int i = 0; i < 4; ++i) {
            float v0 = bflo(a[i].x), v1 = bfhi(a[i].x), v2 = bflo(a[i].y), v3 = bfhi(a[i].y);
            const float mx = wave_max(fmaxf(fmaxf(v0, v1), fmaxf(v2, v3)));
            v0 = __expf(v0 - mx); v1 = __expf(v1 - mx); v2 = __expf(v2 - mx); v3 = __expf(v3 - mx);
            const float inv = 1.f / wave_sum((v0 + v1) + (v2 + v3));
            u32x2 o; o.x = pk2(v0 * inv, v1 * inv); o.y = pk2(v2 * inv, v3 * inv);
            *((u32x2*)(S + (size_t)(r0 + i) * 256) + lane) = o;
        }
    }
}

#define GAS __attribute__((address_space(1)))
#define XB_TMO      128
#define XB_XCNT(j)  (256  + 64 * (j))
#define XB_XSUB(j)  (1280 + 64 * (j))
#define XB_XGEN(j)  (2304 + 64 * (j))
#define XB_TOP      3328
#define XB_TOPGEN   3392
#define XCD_BAR_WORDS 3456
#define XB_SPIN_CAP (1u << 18)

__device__ __forceinline__ unsigned xb_ld(unsigned* p)              { return __hip_atomic_load(p, __ATOMIC_RELAXED, __HIP_MEMORY_SCOPE_AGENT); }
__device__ __forceinline__ unsigned xb_add(unsigned* p, unsigned v) { return __hip_atomic_fetch_add(p, v, __ATOMIC_RELAXED, __HIP_MEMORY_SCOPE_AGENT); }
__device__ __forceinline__ unsigned xb_xcc_id() { return (unsigned)__builtin_amdgcn_s_getreg((3 << 11) | 20) & 0xFu; }
#define XB_SPIN(cond, bar) do { unsigned _sp = 0; while (cond) { __builtin_amdgcn_s_sleep(1); \
    if ((++_sp & 255u) == 0u) { if (xb_ld(&(bar)[XB_TMO])) break; if (_sp > XB_SPIN_CAP) { atomicAdd(&(bar)[XB_TMO], 1u); break; } } } } while (0)

struct XcdBarrier {
    unsigned* bar; unsigned x;
    volatile LAS unsigned* st;
};

__device__ __forceinline__ XcdBarrier xcd_barrier_post(unsigned* bar, volatile LAS unsigned* st) {
    XcdBarrier b; b.bar = bar; b.x = xb_xcc_id(); b.st = st;
    if (threadIdx.x == 0) (void)xb_add(&bar[XB_XCNT(b.x)], 1u);
    return b;
}
__device__ __forceinline__ void xcd_barrier_complete(unsigned* bar, unsigned x, unsigned& nloc, unsigned& nx) {
    const unsigned G = gridDim.x * gridDim.y * gridDim.z;
    unsigned sum, cnt, mine, sp = 0u;
    for (;;) {
        sum = 0u; cnt = 0u; mine = 0u;
#pragma unroll
        for (unsigned j = 0; j < 16; ++j) { const unsigned c = xb_ld(&bar[XB_XCNT(j)]); sum += c; cnt += (c > 0u) ? 1u : 0u; mine = (j == x) ? c : mine; }
        if (sum == G) break;
        __builtin_amdgcn_s_sleep(1);
        if ((++sp & 255u) == 0u) { if (xb_ld(&bar[XB_TMO])) break; if (sp > XB_SPIN_CAP) { atomicAdd(&bar[XB_TMO], 1u); break; } }
    }
    nloc = mine > 0u ? mine : 1u; nx = cnt > 0u ? cnt : 1u;
}

__device__ __forceinline__ void xcd_barrier(const XcdBarrier& b) {
    asm volatile("s_waitcnt vmcnt(0)" ::: "memory");
    __syncthreads();
    if (threadIdx.x == 0) {
        unsigned* bar = b.bar;
        __builtin_amdgcn_s_waitcnt(0);
        unsigned nloc = b.st[0], nx = b.st[1];
        if (nloc == 0u) { xcd_barrier_complete(bar, b.x, nloc, nx); b.st[0] = nloc; b.st[1] = nx; }
        const unsigned old = xb_add(&bar[XB_XSUB(b.x)], 1u);
        const unsigned gen = old / nloc;
        if (old + 1u == (gen + 1u) * nloc) {
            __builtin_amdgcn_fence(__ATOMIC_RELEASE, "agent");
            asm volatile("s_waitcnt vmcnt(0)" ::: "memory");
            const unsigned og = xb_add(&bar[XB_TOP], 1u);
            const unsigned tg = og / nx;
            if (og + 1u == (tg + 1u) * nx) xb_add(&bar[XB_TOPGEN], 1u);
            else XB_SPIN(xb_ld(&bar[XB_TOPGEN]) == tg, bar);
            __builtin_amdgcn_fence(__ATOMIC_ACQUIRE, "agent");
            xb_add(&bar[XB_XGEN(b.x)], 1u);
            asm volatile("s_waitcnt vmcnt(0)" ::: "memory");
        } else {
            XB_SPIN(xb_ld(&bar[XB_XGEN(b.x)]) == gen, bar);
            __builtin_amdgcn_fence(__ATOMIC_ACQUIRE, "agent");
            asm volatile("s_waitcnt vmcnt(0)" ::: "memory");
        }
    }
    __syncthreads();
}

struct Args { const float* in[31]; float* out; unsigned char* ws; float lam_init[2]; int ph_lo, ph_hi; };
constexpr int NPL = 15, NPH = 4 * NPL + 1;

DI pg8::Gemm mk_gemm(const bf16* A, const bf16* Bt, int M, int N, int K, int lda, int ldb) {
    pg8::Gemm g; g.A = A; g.Bt = Bt; g.M = M; g.N = N; g.K = K; g.lda = lda; g.ldb = ldb; g.a_pn = 0; g.b_pn = (long)256 * ldb; g.b_b = 0; g.pm_per_b = 1 << 30; return g;
}
DI pg8::EpiU mk_store(bf16* O, int ldc, int act, int scale_cols, float scale) {
    pg8::EpiU e; e.mode = 0; e.O = O; e.ldc = ldc; e.act = act; e.scale_cols = scale_cols; e.scale = scale; e.small_out = nullptr; e.small_pn = -1; e.base = nullptr; e.baseb = nullptr; e.outb = nullptr; e.ssq = nullptr; e.nssq = nullptr; e.nmode = 0; e.smx = nullptr; return e;
}
DI pg8::EpiU mk_res(const float* base, const bf16* baseb, bf16* outb, float* ssq) {
    pg8::EpiU e; e.mode = 1; e.ssq = ssq; e.nssq = nullptr; e.nmode = 0; e.smx = nullptr; e.O = nullptr; e.ldc = D_; e.act = 0; e.scale_cols = 0; e.scale = 1.f; e.small_out = nullptr; e.small_pn = -1; e.base = base; e.baseb = baseb; e.outb = outb; return e;
}

__global__ void __launch_bounds__(512, 2) mega_fwd(Args a) {
    extern __shared__ __attribute__((aligned(16))) unsigned char lds_raw[];
    ldsp lds = (ldsp)lds_raw;
    cg::grid_group grid = cg::this_grid();
    volatile LAS unsigned* bst = (volatile LAS unsigned*)(lds + LDS_BYTES - 16);
    if (threadIdx.x < 4) bst[threadIdx.x] = 0u;
    __syncthreads();
    const XcdBarrier xbar = xcd_barrier_post((unsigned*)(a.ws + 4096), bst);
    const int G = gridDim.x, blk = blockIdx.x, NGW = G * 8;
    for (int ph = a.ph_lo; ph < a.ph_hi; ++ph) {
#define PHASE_IDS int tid = threadIdx.x; asm volatile("" : "+v"(tid)); const int lane = tid & 63, wave = __builtin_amdgcn_readfirstlane(tid >> 6), gw = blk * 8 + wave; (void)lane; (void)gw; (void)wave;
        unsigned char* ws = a.ws;
        bf16* XN = (bf16*)(ws + WS_XN); bf16* BIG = (bf16*)(ws + WS_BIG); bf16* VT = (bf16*)(ws + WS_VT); bf16* ORAW = (bf16*)a.out;   bf16* XR = (bf16*)(ws + WS_ORAW);
        float* SSQ_M = (float*)a.out; float* SSQ_X = (float*)(ws + WS_SMALL); float* SSQ_F = (float*)(ws + WS_SMALL + 2 * MiB);
        float* SMALL = (float*)(ws + WS_SMALL); bf16* MEMN = (bf16*)(ws + WS_MEMN); bf16* KX = (bf16*)(ws + WS_KX); bf16* VXT = (bf16*)(ws + WS_VXT);
        bf16* KT = (bf16*)(ws + WS_KT); float* DG = (float*)(ws + WS_DG); bf16* TAIL = (bf16*)(ws + WS_DG + 1 * MiB);
        bf16* WA = (bf16*)(ws + WS_WA); bf16* WV = (bf16*)(ws + WS_WV); bf16* WOUT = (bf16*)(ws + WS_WOUT); bf16* WQ = (bf16*)(ws + WS_WQ); bf16* WKV = (bf16*)(ws + WS_WKV);
        bf16* WXO = (bf16*)(ws + WS_WXO); bf16* W1 = (bf16*)(ws + WS_W1); bf16* W2 = (bf16*)(ws + WS_W2);
        bf16* QX = BIG; bf16* SP = BIG + (size_t)T_ * 1024; bf16* OX = BIG + (size_t)2 * T_ * 1024;
        bf16* OATT = (bf16*)(ws + WS_BIG + 132 * MiB);

        const int layer = ph / NPL, k = ph % NPL;
        const bool even = !(layer & 1); const int li = layer >> 1;
        bool did = true; int nj = 0;
        const bool x_in = (layer == 0 && k <= 5);
        if (ph == NPH - 1) { PHASE_IDS
            rms_rows_from_bf16<true>(XR, a.in[30], nullptr, a.out, T_, gw, NGW, lane);
        } else if (k == 0) { PHASE_IDS
            LAS float* scr = (LAS float*)(lds + wave * 16384);
            const float* wq = a.in[24] + (size_t)layer * 1024 * 1024; const float* wkv = a.in[25] + (size_t)layer * 1024 * 2048; const float* wxo = a.in[26] + (size_t)layer * 1024 * 1024;
            const float* w1 = a.in[28] + (size_t)layer * 1024 * 4096; const float* w2 = a.in[29] + (size_t)layer * 4096 * 1024;
            const int I_Q = 16 * 32, I_KV = 16 * 64, I_XO = 16 * 32, I_1 = 16 * 128, I_2 = 64 * 32;
            const int I_A = even ? 16 * 144 : 16 * 64, I_V = 16 * 32, I_O = even ? 32 * 32 : 16 * 32;
            const int NIT = I_Q + I_KV + I_XO + I_1 + I_2 + I_A + I_V + I_O;
            for (int it = gw; it < NIT; it += NGW) {
                int r = it;
                if (r < I_Q) { conv_item(wq, 1024, 1024, WQ, 1024, 0, 0, scr, r, lane, a.in[22] + (size_t)layer * 1024); continue; } r -= I_Q;
                if (r < I_KV) { conv_item(wkv, 2048, 1024, WKV, 2048, 0, 0, scr, r, lane); continue; } r -= I_KV;
                if (r < I_XO) { conv_item(wxo, 1024, 1024, WXO, 1024, 0, 0, scr, r, lane); continue; } r -= I_XO;
                if (r < I_1) { conv_item(w1, 4096, 1024, W1, 4096, 0, 0, scr, r, lane, a.in[27] + (size_t)layer * 1024); continue; } r -= I_1;
                if (r < I_2) { conv_item(w2, 1024, 4096, W2, 1024, 0, 0, scr, r, lane); continue; } r -= I_2;
                if (even) {
                    const float* win = a.in[3] + (size_t)li * 1024 * 5408; const float* wout = a.in[13] + (size_t)li * 2048 * 1024;
                    if (r < I_A) { conv_item(win, 5408, 1024, WA, 4608, 1, 0, scr, r, lane, a.in[2] + (size_t)li * 1024); continue; } r -= I_A;
                    if (r < I_V) { conv_item(win, 5408, 1024, WV, 1024, 0, 3344, scr, r, lane, a.in[2] + (size_t)li * 1024); continue; } r -= I_V;
                    conv_item(wout, 1024, 2048, WOUT, 1024, 0, 0, scr, r, lane);
                } else {
                    const float* wqkv = a.in[15] + (size_t)li * 1024 * 3072; const float* wo = a.in[21] + (size_t)li * 1024 * 1024;
                    if (r < I_A) { conv_item(wqkv, 3072, 1024, WA, 2048, 0, 0, scr, r, lane, a.in[14] + (size_t)li * 1024); continue; } r -= I_A;
                    if (r < I_V) { conv_item(wqkv, 3072, 1024, WV, 1024, 0, 2048, scr, r, lane, a.in[14] + (size_t)li * 1024); continue; } r -= I_V;
                    conv_item(wo, 1024, 1024, WOUT, 1024, 0, 0, scr, r, lane);
                }
            }
            if (layer == 0) xb_rows(a.in[0], XR, SSQ_M, T_, gw, NGW, lane);
            rms_rows_bf16(a.in[1], a.in[23] + (size_t)layer * 1024, MEMN, 512, gw, NGW, lane);
            if (blk == 0 && tid < 64) ((float*)ws)[tid] = 0.f;
        } else if (k == 1) { nj = 4;
        } else if (k == 2) { PHASE_IDS
            if (even) { for (int u = blk; u < T_ / 128; u += G) prep_unit(u, BIG, SMALL, KT, DG, TAIL, a.in[10] + (size_t)li * 16 * 512, a.in[11] + (size_t)li * 512, a.in[6] + li * 16, a.in[7] + li * 16, a.in[4] + (size_t)li * 4 * 1280, a.in[5] + (size_t)li * 1280, lds, tid); }
            else {
                qk_norms(BIG, (float*)ws, gw, NGW, lane);
                xcd_barrier(xbar);
                {
                    const int x = blk & 7, j = blk >> 3, bb = (x >> 1) & 1, br = x & 1, grp = x >> 2;
#pragma unroll 1
                    for (int u = 0; u < 8; ++u) { const int s = u >> 1; const int head = grp ? (s == 0 ? 6 : s == 1 ? 4 : s == 2 ? 3 : 2) : (s == 0 ? 7 : s == 1 ? 5 : s == 2 ? 1 : 0);
                        attn_unit(bb, 2 * head + br, (u & 1) ? j : 63 - j, BIG, VT, OATT, (const float*)ws, lds, tid); }
                }
            }
        } else if (k == 3) { PHASE_IDS
            if (even) {
                for (int j = blk; j < 64; j += G) {
                    if (j < 32) ssd_chain(j >> 4, j & 15, BIG, SMALL, TAIL, a.in[8] + li * 16, lds, tid);
                    else { const int i2 = j - 32; gla_chain(i2 >> 4, (i2 >> 2) & 3, i2 & 3, BIG, KT, VT, DG, ORAW, lds, tid); }
                }
            } else combine_rows(OATT, XN, a.in[16] + li * 64, a.in[17] + li * 64, a.in[18] + li * 64, a.in[19] + li * 64, a.in[20] + li * 128, a.lam_init[li], gw, NGW, lane);
        } else if (k == 4) { PHASE_IDS
            if (even) gate_rows(BIG, ORAW, a.in[9] + (size_t)li * 1024, a.in[12] + (size_t)li * 256, gw, NGW, lane);
            else nj = 1;
        } else if (k == 5) { if (even) nj = 1; else did = false;
        } else if (k == 6) { did = false;
        } else if (k == 9) { did = false;
        } else if (k == 12) { did = false;
        } else nj = 1;
        for (int j = 0; j < nj; ++j) { PHASE_IDS
            pg8::Gemm g = mk_gemm(XN, WA, T_, 1024, 1024, 1024, 1024); pg8::EpiU e = mk_store(BIG, 1024, 0, 0, 1.f);
            if (k == 1) {
                if (j == 0) { if (even) { g = mk_gemm(XR, WA, T_, 4608, 1024, 1024, 1024); e = mk_store(BIG, PROJ_LD, 0, 0, 1.f); e.small_out = SMALL; e.small_pn = 17; }
                              else { g = mk_gemm(XR, WA, T_, 2048, 1024, 1024, 1024); e = mk_store(BIG, QK_LD, 0, 1024, 0.125f * 1.4426950408889634f); }
                              e.nssq = SSQ_M; e.nmode = 1; }
                else if (j == 1) { g = mk_gemm(WV, XR, 1024, T_, 1024, 1024, 1024); e = mk_store(VT, VT_LD, 0, 0, 1.f); e.nssq = SSQ_M; e.nmode = 2; }
                else if (j == 2) { g = mk_gemm(MEMN, WKV, 512, 1024, 1024, 1024, 1024); e = mk_store(KX, 1024, 0, 0, 1.f); }
                else { g = mk_gemm(WKV + (size_t)1024 * 1024, MEMN, 1024, 512, 1024, 1024, 1024); e = mk_store(VXT, 512, 0, 0, 1.f); }
            } else if (k == 4) { g = mk_gemm(XN, WOUT, T_, 1024, 1024, 1024, 1024); e = mk_res(nullptr, XR, XR, SSQ_X);
            } else if (k == 5) {
                g = mk_gemm(ORAW, WOUT, T_, 1024, 2048, 2048, 2048); e = mk_res(nullptr, XR, XR, SSQ_X);
            } else if (k == 7) { g = mk_gemm(XR, WQ, T_, 1024, 1024, 1024, 1024); e = mk_store(QX, 1024, 0, 1024, 0.0625f); e.nssq = SSQ_X; e.nmode = 1;
            } else if (k == 8) { g = mk_gemm(QX, KX, T_, 1024, 256, 1024, 1024); g.a_pn = 256; g.b_pn = 256; g.b_b = (long)256 * 1024; g.pm_per_b = 64; e = mk_store(SP, 1024, 0, 0, 1.f); e.smx = (PG8_LAS float*)(lds + 131072);
            } else if (k == 10) { g = mk_gemm(SP, VXT, T_, 1024, 256, 1024, 512); g.a_pn = 256; g.b_pn = (long)256 * 512; g.b_b = 256; g.pm_per_b = 64; e = mk_store(OX, 1024, 0, 0, 1.f);
            } else if (k == 11) { g = mk_gemm(OX, WXO, T_, 1024, 1024, 1024, 1024); e = mk_res(nullptr, XR, XR, SSQ_F);
            } else if (k == 13) { g = mk_gemm(XR, W1, T_, 4096, 1024, 1024, 1024); e = mk_store(BIG, 4096, 1, 0, 1.f); e.nssq = SSQ_F; e.nmode = 1;
            } else if (k == 14) { g = mk_gemm(BIG, W2, T_, 1024, 4096, 4096, 4096); e = mk_res(nullptr, XR, XR, SSQ_M); }
            pg8::StaticOrder S; S.init(g.M, g.N, G, (blk + 64 * j * (j >= 2)) % G);
            pg8::gemm_phase<pg8::EpiU, pg8::StaticOrder, true, true>(lds, g, S, e, tid);
        }
        if (did && ph + 1 < a.ph_hi) { if (ph == 0) grid.sync(); else xcd_barrier(xbar); }
    }
}

extern "C" void kernel_launch(void* const* d_in, const int* in_sizes, int n_in, void* d_out, int out_size, void* d_ws, size_t ws_size, hipStream_t stream) {
    static int grid = 0;
    if (grid == 0) {
        if (n_in != 31 || out_size != T_ * D_ || ws_size < WS_END) { fprintf(stderr, "kernel_launch: unexpected problem (n_in %d out %d ws %zu)\n", n_in, out_size, ws_size); grid = -1; return; }
        int dev = 0, cus = 0, per_cu = 0;
        hipGetDevice(&dev); hipDeviceGetAttribute(&cus, hipDeviceAttributeMultiprocessorCount, dev);
        if (hipFuncSetAttribute((const void*)mega_fwd, hipFuncAttributeMaxDynamicSharedMemorySize, LDS_BYTES) != hipSuccess) { fprintf(stderr, "kernel_launch: hipFuncSetAttribute failed\n"); grid = -1; return; }
        if (hipOccupancyMaxActiveBlocksPerMultiprocessor(&per_cu, (const void*)mega_fwd, 512, LDS_BYTES) != hipSuccess || per_cu < 1) { fprintf(stderr, "kernel_launch: occupancy query says %d\n", per_cu); per_cu = 1; }
        (void)hipGetLastError();
        grid = cus;
        if (grid != 256) { fprintf(stderr, "kernel_launch: built for a 256-CU device (got %d)\n", cus); grid = -1; return; }
    }
    if (grid < 0) return;
    Args a{};
    for (int i = 0; i < 31; ++i) a.in[i] = (const float*)d_in[i];
    a.out = (float*)d_out; a.ws = (unsigned char*)d_ws;
    a.lam_init[0] = (float)(0.8 - 0.6 * exp(-0.3 * 1.0)); a.lam_init[1] = (float)(0.8 - 0.6 * exp(-0.3 * 3.0));
    a.ph_lo = 0; a.ph_hi = NPH;
#ifdef PROBE_PREFIX
    {
        Args p = a; p.ph_hi = PROBE_PREFIX; void* pargs[] = {&p};
        (void)hipMemsetAsync(d_ws, 0, 65536, stream);
        (void)hipLaunchCooperativeKernel((const void*)mega_fwd, dim3(grid), dim3(512), pargs, LDS_BYTES, stream);
    }
#endif
    if (hipMemsetAsync(d_ws, 0, 65536, stream) != hipSuccess) { fprintf(stderr, "kernel_launch: memset failed\n"); return; }
    void* args[] = {&a};
    hipError_t e = hipLaunchCooperativeKernel((const void*)mega_fwd, dim3(grid), dim3(512), args, LDS_BYTES, stream);
    if (e != hipSuccess) fprintf(stderr, "cooperative launch failed: %s (grid %d)\n", hipGetErrorString(e), grid);
}
```

```cpp
#include <hip/hip_runtime.h>
#include <hip/hip_cooperative_groups.h>
#include <cstdio>
#include <cstdint>
#include <cmath>
namespace cg = cooperative_groups;

namespace pg8 {
#define PG8_LAS __attribute__((address_space(3)))
typedef unsigned short bf16_t;
typedef short bf16x8 __attribute__((ext_vector_type(8)));
typedef float f32x4 __attribute__((ext_vector_type(4)));
typedef unsigned u32x4 __attribute__((ext_vector_type(4)));
constexpr int BM = 256, BK = 64, HALF = 128, HTB = HALF * BK * 2, STAGE_BYTES = 8 * HTB, NXCD = 8, WGM = 8;

__host__ __device__ __forceinline__ int lds_byte(int r, int c) { const int st = (r >> 4) * 2 + (c >> 5), rr = r & 15, cc = c & 31, ob = rr * 64 + cc * 2; return st * 1024 + (ob ^ (((ob >> 9) & 1) << 5)); }
__host__ __device__ __forceinline__ void stage_rc(int b, int& R, int& C) { const int st = b / 1024, sb = b % 1024, swz = sb ^ (((sb >> 9) & 1) << 5); R = (st >> 1) * 16 + swz / 64; C = (st & 1) * 32 + (swz % 64) / 2; }
__host__ __device__ __forceinline__ int perm32(int rho) { const int n = rho >> 4, i = rho & 15; return 8 * (i >> 2) + 4 * n + (i & 3); }

struct Unit { int pm, pn; };
struct Gemm { const bf16_t* A; const bf16_t* Bt; int M, N, K, lda, ldb; long a_pn, b_pn, b_b; int pm_per_b; };

struct StaticOrder {
    int nM, nN, nwg, G, c;
    __host__ __device__ void init(int M, int N, int G_, int c_) { nM = M / BM; nN = N / BM; nwg = nM * nN; G = G_; c = c_; }
    __host__ __device__ bool next(int i, Unit& u) const {
        const long L = (long)i * G + c; if (L >= nwg) return false;
        int wgid = (int)L; { const int q = nwg / NXCD, r = nwg % NXCD, xcd = wgid % NXCD, off = wgid / NXCD; wgid = (xcd < r ? xcd * (q + 1) : r * (q + 1) + (xcd - r) * q) + off; }
        const int nig = WGM * nN, gid = wgid / nig, fm = gid * WGM, gsz = (nM - fm) < WGM ? (nM - fm) : WGM;
        u.pm = fm + ((wgid % nig) % gsz); u.pn = (wgid % nig) / gsz; return true;
    }
    __device__ __forceinline__ void ptrs(const Unit& u, const Gemm& g, const char*& a, const char*& b) const {
        a = (const char*)(g.A + (size_t)u.pm * BM * g.lda + (size_t)u.pn * g.a_pn);
        b = (const char*)(g.Bt + (size_t)u.pn * g.b_pn + (size_t)(u.pm / g.pm_per_b) * g.b_b);
    }
    __device__ __forceinline__ void a_ready(const Unit&) const {}
    __device__ __forceinline__ void done(const Unit&) const {}
};

__device__ __forceinline__ unsigned cvt_pk_bf16(float lo, float hi) { unsigned r; asm volatile("v_cvt_pk_bf16_f32 %0, %1, %2" : "=v"(r) : "v"(lo), "v"(hi)); return r; }

__device__ __forceinline__ float rstd16(const float* p) {
    const f32x4 a = *(const f32x4*)p, b = *(const f32x4*)(p + 4), c = *(const f32x4*)(p + 8), d = *(const f32x4*)(p + 12);
    const float s = (((a[0] + a[1]) + (a[2] + a[3])) + ((b[0] + b[1]) + (b[2] + b[3]))) + (((c[0] + c[1]) + (c[2] + c[3])) + ((d[0] + d[1]) + (d[2] + d[3])));
    return rsqrtf(s * (1.f / 1024.f) + 1e-5f);
}
struct EpiU {
    static constexpr bool PERM = true, AFTER_DRAIN = false;
    int mode;
    bf16_t* O; int ldc; int act; int scale_cols; float scale;
    float* small_out; int small_pn;
    PG8_LAS float* smx;
    float* ssq; const float* nssq; int nmode;
    const float* base; const bf16_t* baseb; bf16_t* outb;
    __device__ __forceinline__ void operator()(const f32x4 (&acc)[2][2][4][2], const Unit& u, int wr, int wc, int fr, int fq) const {
        const int row0 = u.pm * BM + wr * 64 + fr; const int col0 = u.pn * BM + wc * 32 + 8 * fq;
        if (mode == 0) {
            if (smx) {
#pragma unroll
                for (int ai = 0; ai < 2; ++ai)
#pragma unroll
                    for (int m = 0; m < 4; ++m) { float mx = -INFINITY;
#pragma unroll
                        for (int bj = 0; bj < 2; ++bj)
#pragma unroll
                            for (int n = 0; n < 2; ++n)
#pragma unroll
                                for (int e = 0; e < 4; ++e) mx = fmaxf(mx, acc[ai][bj][m][n][e]);
                        mx = fmaxf(mx, __shfl_xor(mx, 16)); mx = fmaxf(mx, __shfl_xor(mx, 32));
                        if (fq == 0) smx[(ai * HALF + wr * 64 + m * 16 + fr) * 4 + wc] = mx; }
                asm volatile("s_waitcnt lgkmcnt(0)\n\ts_barrier" ::: "memory");
#pragma unroll
                for (int ai = 0; ai < 2; ++ai)
#pragma unroll
                    for (int m = 0; m < 4; ++m) { const int rl = ai * HALF + wr * 64 + m * 16 + fr;
                        const f32x4 q4 = *(PG8_LAS f32x4*)(smx + rl * 4); const float mx = fmaxf(fmaxf(q4[0], q4[1]), fmaxf(q4[2], q4[3]));
                        float sm = 0.f;
#pragma unroll
                        for (int bj = 0; bj < 2; ++bj)
#pragma unroll
                            for (int n = 0; n < 2; ++n)
#pragma unroll
                                for (int e = 0; e < 4; ++e) sm += __expf(acc[ai][bj][m][n][e] - mx);
                        sm += __shfl_xor(sm, 16); sm += __shfl_xor(sm, 32);
                        if (fq == 0) smx[1024 + rl * 4 + wc] = sm; }
                asm volatile("s_waitcnt lgkmcnt(0)\n\ts_barrier" ::: "memory");
#pragma unroll
                for (int ai = 0; ai < 2; ++ai)
#pragma unroll
                    for (int m = 0; m < 4; ++m) { const int rl = ai * HALF + wr * 64 + m * 16 + fr;
                        const f32x4 q4 = *(PG8_LAS f32x4*)(smx + rl * 4); const float mx = fmaxf(fmaxf(q4[0], q4[1]), fmaxf(q4[2], q4[3]));
                        const f32x4 l4 = *(PG8_LAS f32x4*)(smx + 1024 + rl * 4); const float inv = 1.f / ((l4[0] + l4[1]) + (l4[2] + l4[3]));
                        bf16_t* rowp = O + (size_t)(row0 + ai * HALF + m * 16) * ldc + col0;
#pragma unroll
                        for (int bj = 0; bj < 2; ++bj) { f32x4 v0, v1;
#pragma unroll
                            for (int e = 0; e < 4; ++e) { v0[e] = __expf(acc[ai][bj][m][0][e] - mx) * inv; v1[e] = __expf(acc[ai][bj][m][1][e] - mx) * inv; }
                            u32x4 w; w.x = cvt_pk_bf16(v0[0], v0[1]); w.y = cvt_pk_bf16(v0[2], v0[3]); w.z = cvt_pk_bf16(v1[0], v1[1]); w.w = cvt_pk_bf16(v1[2], v1[3]);
                            *(u32x4*)(rowp + bj * HALF) = w; } }
                return;
            }
            if (small_out && u.pn == small_pn) {
                if (wc == 0) {
#pragma unroll
                    for (int ai = 0; ai < 2; ++ai)
#pragma unroll
                        for (int m = 0; m < 4; ++m) { const int rr = row0 + ai * HALF + m * 16; const float rsc = (nmode == 1) ? rstd16(nssq + (size_t)rr * 16) : 1.f;
                            float* p = small_out + (size_t)rr * 32 + 8 * fq; *(f32x4*)p = acc[ai][0][m][0] * rsc; *(f32x4*)(p + 4) = acc[ai][0][m][1] * rsc; }
                }
                return;
            }
            f32x4 csc[2][2];
#pragma unroll
            for (int bj = 0; bj < 2; ++bj)
#pragma unroll
                for (int e = 0; e < 4; ++e) { csc[bj][0][e] = (nmode == 2) ? rstd16(nssq + (size_t)(col0 + bj * HALF + e) * 16) : 1.f; csc[bj][1][e] = (nmode == 2) ? rstd16(nssq + (size_t)(col0 + bj * HALF + 4 + e) * 16) : 1.f; }
#pragma unroll
            for (int ai = 0; ai < 2; ++ai)
#pragma unroll
                for (int m = 0; m < 4; ++m) { bf16_t* rowp = O + (size_t)(row0 + ai * HALF + m * 16) * ldc + col0;
                    const float rsc = (nmode == 1) ? rstd16(nssq + (size_t)(row0 + ai * HALF + m * 16) * 16) : 1.f;
#pragma unroll
                    for (int bj = 0; bj < 2; ++bj) { f32x4 v0 = acc[ai][bj][m][0] * rsc * csc[bj][0], v1 = acc[ai][bj][m][1] * rsc * csc[bj][1];
                        if (act == 1) {
#pragma unroll
                            for (int e = 0; e < 4; ++e) { float t0 = fmaxf(v0[e], 0.f), t1 = fmaxf(v1[e], 0.f); v0[e] = t0 * t0; v1[e] = t1 * t1; } }
                        const float sc = (col0 + bj * HALF < scale_cols) ? scale : 1.f;
                        v0 = v0 * sc; v1 = v1 * sc; u32x4 w; w.x = cvt_pk_bf16(v0[0], v0[1]); w.y = cvt_pk_bf16(v0[2], v0[3]); w.z = cvt_pk_bf16(v1[0], v1[1]); w.w = cvt_pk_bf16(v1[2], v1[3]);
                        *(u32x4*)(rowp + bj * HALF) = w; } }
        } else {
#pragma unroll
            for (int ai = 0; ai < 2; ++ai)
#pragma unroll
                for (int m = 0; m < 4; ++m) { const size_t off = (size_t)(row0 + ai * HALF + m * 16) * ldc + col0; float ss = 0.f;
#pragma unroll
                    for (int bj = 0; bj < 2; ++bj) { f32x4 b0, b1;
                        if (baseb) { const u32x4 wv = *(const u32x4*)(baseb + off + bj * HALF);
                            b0 = (f32x4){__builtin_bit_cast(float, wv.x << 16), __builtin_bit_cast(float, wv.x & 0xffff0000u), __builtin_bit_cast(float, wv.y << 16), __builtin_bit_cast(float, wv.y & 0xffff0000u)};
                            b1 = (f32x4){__builtin_bit_cast(float, wv.z << 16), __builtin_bit_cast(float, wv.z & 0xffff0000u), __builtin_bit_cast(float, wv.w << 16), __builtin_bit_cast(float, wv.w & 0xffff0000u)}; }
                        else { const float* bp = base + off + bj * HALF; b0 = *(const f32x4*)bp; b1 = *(const f32x4*)(bp + 4); }
                        const f32x4 x0 = b0 + acc[ai][bj][m][0], x1 = b1 + acc[ai][bj][m][1];
                        u32x4 w; w.x = cvt_pk_bf16(x0[0], x0[1]); w.y = cvt_pk_bf16(x0[2], x0[3]); w.z = cvt_pk_bf16(x1[0], x1[1]); w.w = cvt_pk_bf16(x1[2], x1[3]);
                        *(u32x4*)(outb + off + bj * HALF) = w;
                        ss += (x0[0] * x0[0] + x0[1] * x0[1]) + (x0[2] * x0[2] + x0[3] * x0[3]) + (x1[0] * x1[0] + x1[1] * x1[1]) + (x1[2] * x1[2] + x1[3] * x1[3]); }
                    ss += __shfl_xor(ss, 16); ss += __shfl_xor(ss, 32);
                    if (fq == 0) ssq[(size_t)(row0 + ai * HALF + m * 16) * 16 + u.pn * 4 + wc] = ss;
                }
        }
    }
};

template <class Epi, class Sched, bool ALIGN_EPI = false, bool SP2 = false>
__device__ __forceinline__ void gemm_phase(PG8_LAS unsigned char* lds, const Gemm g, const Sched& S, const Epi& E, const int tid) {
    const int wid = __builtin_amdgcn_readfirstlane(tid >> 6), lane = tid & 63, wr = wid >> 2, wc = wid & 3, fr = lane & 15, fq = lane >> 4;
    const int K = g.K, nt = K / BK;
    unsigned voffA[2], voffB[2];
#pragma unroll
    for (int i = 0; i < 2; ++i) { int R, C; stage_rc(tid * 16 + i * 8192, R, C); const int Rb = Epi::PERM ? ((R & ~31) + perm32(R & 31)) : R;
        voffA[i] = (unsigned)(R * g.lda + C) * 2u; voffB[i] = (unsigned)(Rb * g.ldb + C) * 2u; }
    const size_t kstep = (size_t)(BK * 2);
    const size_t hstepA = (size_t)HALF * g.lda * 2, hstepB = (size_t)HALF * g.ldb * 2;
    const unsigned ldsw = (unsigned)wid * 1024u;
    const int aoff = lds_byte(wr * 64 + fr, fq * 8), boff = lds_byte(wc * 32 + fr, fq * 8);
#define PG8_SA(b, h) (((b) * 2 + (h)) * HTB)
#define PG8_SB(b, h) ((4 + (b) * 2 + (h)) * HTB)
#define PG8_STAGE(bufoff, gbase, voff) do { _Pragma("unroll") for (int _i = 0; _i < 2; ++_i) \
        __builtin_amdgcn_global_load_lds((const unsigned*)((const char*)(gbase) + (voff)[_i]), (PG8_LAS unsigned*)(lds + (bufoff) + ldsw + _i * 8192), 16, 0, 0); } while (0)
#define PG8_LDA(dst, b, h) do { _Pragma("unroll") for (int m = 0; m < 4; ++m) _Pragma("unroll") for (int k = 0; k < 2; ++k) dst[m][k] = *(const PG8_LAS bf16x8*)(lds + PG8_SA(b, h) + aoff + m * 2048 + k * 1024); } while (0)
#define PG8_LDB(dst, b, h) do { _Pragma("unroll") for (int n = 0; n < 2; ++n) _Pragma("unroll") for (int k = 0; k < 2; ++k) dst[n][k] = *(const PG8_LAS bf16x8*)(lds + PG8_SB(b, h) + boff + n * 2048 + k * 1024); } while (0)
#define PG8_MMA(ai, bj, At, Bt) do { __builtin_amdgcn_s_setprio(1); _Pragma("unroll") for (int m = 0; m < 4; ++m) _Pragma("unroll") for (int n = 0; n < 2; ++n) _Pragma("unroll") for (int k = 0; k < 2; ++k) \
        acc[ai][bj][m][n] = __builtin_amdgcn_mfma_f32_16x16x32_bf16(Bt[n][k], At[m][k], acc[ai][bj][m][n], 0, 0, 0); __builtin_amdgcn_s_setprio(0); } while (0)
#define PG8_WAIT_V(n) asm volatile("s_waitcnt vmcnt(" #n ")" ::: "memory")
#define PG8_WAIT_L(n) asm volatile("s_waitcnt lgkmcnt(" #n ")" ::: "memory")
#define PG8_BAR __builtin_amdgcn_s_barrier()
#define PG8_SCHED __builtin_amdgcn_sched_barrier(0)
    Unit cur, nxt; int ui = 0;
    if (!S.next(0, cur)) return;
    f32x4 acc[2][2][4][2];
#pragma unroll
    for (int a = 0; a < 2; ++a)
#pragma unroll
        for (int b = 0; b < 2; ++b)
#pragma unroll
            for (int m = 0; m < 4; ++m)
#pragma unroll
                for (int n = 0; n < 2; ++n) acc[a][b][m][n] = (f32x4){0.f, 0.f, 0.f, 0.f};
    bf16x8 At[4][2], B0[2][2], B1[2][2];
    const char* cA; const char* cB; S.ptrs(cur, g, cA, cB);
    S.a_ready(cur);
    if constexpr (SP2) {
        PG8_STAGE(PG8_SB(0, 0), cB, voffB); PG8_STAGE(PG8_SB(0, 1), cB + hstepB, voffB); PG8_STAGE(PG8_SA(0, 0), cA, voffA); PG8_STAGE(PG8_SA(0, 1), cA + hstepA, voffA);
        if (wr == 1) PG8_BAR;
        PG8_WAIT_V(2); PG8_BAR;
        PG8_STAGE(PG8_SB(1, 0), cB + kstep, voffB); PG8_STAGE(PG8_SA(1, 0), cA + kstep, voffA); PG8_STAGE(PG8_SB(1, 1), cB + hstepB + kstep, voffB);
        PG8_WAIT_V(6); PG8_BAR;
    } else {
        PG8_STAGE(PG8_SB(0, 0), cB, voffB); PG8_STAGE(PG8_SA(0, 0), cA, voffA); PG8_STAGE(PG8_SB(0, 1), cB + hstepB, voffB); PG8_STAGE(PG8_SA(0, 1), cA + hstepA, voffA);
        if (wr == 1) PG8_BAR;
        PG8_WAIT_V(4); PG8_BAR;
        PG8_STAGE(PG8_SB(1, 0), cB + kstep, voffB); PG8_STAGE(PG8_SA(1, 0), cA + kstep, voffA); PG8_STAGE(PG8_SB(1, 1), cB + hstepB + kstep, voffB);
        PG8_WAIT_V(6); PG8_BAR;
    }
    for (;;) {
        const bool has_next = S.next(ui + 1, nxt);
        const char* nA = cA; const char* nB = cB; if (has_next) S.ptrs(nxt, g, nA, nB);
        for (int t = 0; t < nt; t += 2) {
            const bool last = (t == nt - 2);
            const char* a1 = cA + (size_t)(t + 1) * kstep;
            const char* a2 = last ? nA : cA + (size_t)(t + 2) * kstep; const char* b2 = last ? nB : cB + (size_t)(t + 2) * kstep;
            const char* a3 = a2 + kstep; const char* b3 = b2 + kstep;
            if (last && has_next) S.a_ready(nxt);
            if constexpr (SP2) {
            PG8_LDB(B0, 0, 0); PG8_LDB(B1, 0, 1); PG8_SCHED; PG8_LDA(At, 0, 0); PG8_STAGE(PG8_SA(1, 1), a1 + hstepA, voffA);
            PG8_WAIT_V(8); PG8_WAIT_L(0); PG8_BAR; PG8_MMA(0, 0, At, B0); PG8_MMA(0, 1, At, B1); PG8_BAR; PG8_SCHED;
            PG8_LDA(At, 0, 1); PG8_STAGE(PG8_SB(0, 0), b2, voffB); PG8_STAGE(PG8_SB(0, 1), b2 + hstepB, voffB); PG8_STAGE(PG8_SA(0, 0), a2, voffA);
            PG8_WAIT_V(8); PG8_WAIT_L(0); PG8_BAR; PG8_MMA(1, 0, At, B0); PG8_MMA(1, 1, At, B1); PG8_BAR; PG8_SCHED;
            PG8_LDB(B0, 1, 0); PG8_LDB(B1, 1, 1); PG8_SCHED; PG8_LDA(At, 1, 0); PG8_STAGE(PG8_SA(0, 1), a2 + hstepA, voffA);
            PG8_WAIT_V(8); PG8_WAIT_L(0); PG8_BAR; PG8_MMA(0, 0, At, B0); PG8_MMA(0, 1, At, B1); PG8_BAR; PG8_SCHED;
            PG8_LDA(At, 1, 1); PG8_STAGE(PG8_SB(1, 0), b3, voffB); PG8_STAGE(PG8_SB(1, 1), b3 + hstepB, voffB); PG8_STAGE(PG8_SA(1, 0), a3, voffA);
            PG8_WAIT_V(8); PG8_WAIT_L(0); PG8_BAR; PG8_MMA(1, 0, At, B0); PG8_MMA(1, 1, At, B1); PG8_BAR; PG8_SCHED;
            } else {
            PG8_LDB(B0, 0, 0); PG8_SCHED; PG8_LDA(At, 0, 0); PG8_STAGE(PG8_SA(1, 1), a1 + hstepA, voffA);
            PG8_WAIT_L(8); PG8_BAR; PG8_WAIT_L(0); PG8_MMA(0, 0, At, B0); PG8_BAR; PG8_SCHED;
            PG8_LDB(B1, 0, 1); PG8_STAGE(PG8_SB(0, 0), b2, voffB);
            PG8_BAR; PG8_WAIT_L(0); PG8_MMA(0, 1, At, B1); PG8_BAR;
            PG8_LDA(At, 0, 1); PG8_STAGE(PG8_SA(0, 0), a2, voffA);
            PG8_BAR; PG8_WAIT_L(0); PG8_MMA(1, 0, At, B0); PG8_BAR; PG8_SCHED;
            PG8_STAGE(PG8_SB(0, 1), b2 + hstepB, voffB);
            PG8_WAIT_V(6); PG8_BAR; PG8_MMA(1, 1, At, B1); PG8_BAR;
            PG8_LDB(B0, 1, 0); PG8_SCHED; PG8_LDA(At, 1, 0); PG8_STAGE(PG8_SA(0, 1), a2 + hstepA, voffA);
            PG8_WAIT_L(8); PG8_BAR; PG8_WAIT_L(0); PG8_MMA(0, 0, At, B0); PG8_BAR; PG8_SCHED;
            PG8_LDB(B1, 1, 1); PG8_STAGE(PG8_SB(1, 0), b3, voffB);
            PG8_BAR; PG8_WAIT_L(0); PG8_MMA(0, 1, At, B1); PG8_BAR;
            PG8_LDA(At, 1, 1); PG8_STAGE(PG8_SA(1, 0), a3, voffA);
            PG8_BAR; PG8_WAIT_L(0); PG8_MMA(1, 0, At, B0); PG8_BAR; PG8_SCHED;
            PG8_STAGE(PG8_SB(1, 1), b3 + hstepB, voffB);
            PG8_WAIT_V(6); PG8_BAR; PG8_MMA(1, 1, At, B1); PG8_BAR;
            }
        }
        if constexpr (ALIGN_EPI) { if (wr == 0) PG8_BAR; }
        if constexpr (!Epi::AFTER_DRAIN) { E(acc, cur, wr, wc, fr, fq); S.done(cur); }
        if (!has_next) break;
#pragma unroll
        for (int a = 0; a < 2; ++a)
#pragma unroll
            for (int b = 0; b < 2; ++b)
#pragma unroll
                for (int m = 0; m < 4; ++m)
#pragma unroll
                    for (int n = 0; n < 2; ++n) acc[a][b][m][n] = (f32x4){0.f, 0.f, 0.f, 0.f};
        cur = nxt; cA = nA; cB = nB; ++ui;
        if constexpr (ALIGN_EPI) { if (wr == 1) PG8_BAR; }
    }
    PG8_WAIT_V(0);
    if constexpr (!ALIGN_EPI) { if (wr == 0) PG8_BAR; }
    PG8_BAR;
    if constexpr (Epi::AFTER_DRAIN) { E.fused(acc, cur, wr, wc, fr, fq, lds, wid, lane); S.done(cur); }
#undef PG8_SA
#undef PG8_SB
#undef PG8_STAGE
#undef PG8_LDA
#undef PG8_LDB
#undef PG8_MMA
#undef PG8_WAIT_V
#undef PG8_WAIT_L
#undef PG8_BAR
#undef PG8_SCHED
}
}

#define LAS __attribute__((address_space(3)))
#define DI __device__ __forceinline__
typedef unsigned short bf16;
typedef short bf16x8 __attribute__((ext_vector_type(8)));
typedef short s16x4 __attribute__((ext_vector_type(4)));
typedef float f32x4 __attribute__((ext_vector_type(4)));
typedef float f32x16 __attribute__((ext_vector_type(16)));
typedef unsigned u32x4 __attribute__((ext_vector_type(4)));
typedef unsigned u32x2 __attribute__((ext_vector_type(2)));
typedef LAS unsigned char* ldsp;

constexpr int T_ = 32768, L_ = 16384, D_ = 1024;
constexpr float EPS_ = 1e-5f;
constexpr size_t MiB = (size_t)1 << 20;
constexpr size_t WS_W = 1 * MiB;
constexpr size_t WS_WA = WS_W, WS_WV = WS_W + 9 * MiB, WS_WOUT = WS_W + 11 * MiB, WS_WQ = WS_W + 15 * MiB, WS_WKV = WS_W + 17 * MiB,
                 WS_WXO = WS_W + 21 * MiB, WS_W1 = WS_W + 23 * MiB, WS_W2 = WS_W + 31 * MiB;
constexpr size_t WS_XN = 40 * MiB, WS_KT = WS_XN, WS_DG = WS_XN + 33 * MiB;
constexpr size_t WS_BIG = 104 * MiB, WS_VT = 376 * MiB, WS_ORAW = 441 * MiB, WS_SMALL = 505 * MiB, WS_MEMN = 509 * MiB, WS_KX = 510 * MiB, WS_VXT = 511 * MiB, WS_END = 512 * MiB;
constexpr int PROJ_LD = 4352;
constexpr int PC_Z = 0, PC_XBC = 1024, PC_Q = 2304, PC_K = 2816, PC_R = 3328;
constexpr int LDS_BYTES = 140 * 1024;
constexpr int VT_LD = T_ + 64, KT_LD = T_ + 64, QK_LD = 2048 + 64;

DI unsigned f2bf(float f) { unsigned u = __builtin_bit_cast(unsigned, f); return (u + 0x7fffu + ((u >> 16) & 1u)) >> 16; }
typedef float f32x2_t __attribute__((ext_vector_type(2))); typedef __bf16 bf16x2_t __attribute__((ext_vector_type(2)));
DI unsigned pk2(float lo, float hi) { f32x2_t v = {lo, hi}; bf16x2_t b = __builtin_convertvector(v, bf16x2_t); return __builtin_bit_cast(unsigned, b); }
DI float bf2f(unsigned h) { return __builtin_bit_cast(float, h << 16); }
DI float bflo(unsigned w) { return __builtin_bit_cast(float, w << 16); }
DI float bfhi(unsigned w) { return __builtin_bit_cast(float, w & 0xffff0000u); }
DI float wave_sum(float v) {
#pragma unroll
    for (int o = 1; o < 64; o <<= 1) v += __shfl_xor(v, o);
    return v;
}
DI float wave_max(float v) {
#pragma unroll
    for (int o = 1; o < 64; o <<= 1) v = fmaxf(v, __shfl_xor(v, o));
    return v;
}
DI float siluf(float x) { return x * __builtin_amdgcn_rcpf(1.f + __builtin_amdgcn_exp2f(-1.4426950408889634f * x)); }
DI float softplusf(float x) {
    const float e = __expf(-fabsf(x));
    const float l = (e < 0.01f) ? e * (1.f - e * (0.5f - e * (1.f / 3.f))) : __logf(1.f + e);
    return fmaxf(x, 0.f) + l;
}
DI bf16x8 lds16(ldsp p, int off) { return *(LAS bf16x8*)(p + off); }
DI s16x4 lds8(ldsp p, int off) { return *(LAS s16x4*)(p + off); }
DI bf16x8 cat8(s16x4 a, s16x4 b) { return __builtin_shufflevector(a, b, 0, 1, 2, 3, 4, 5, 6, 7); }
DI f32x4 mfma16(bf16x8 a, bf16x8 b, f32x4 c) { return __builtin_amdgcn_mfma_f32_16x16x32_bf16(a, b, c, 0, 0, 0); }
DI f32x16 mfma32(bf16x8 a, bf16x8 b, f32x16 c) { return __builtin_amdgcn_mfma_f32_32x32x16_bf16(a, b, c, 0, 0, 0); }
DI int crow(int r, int hi) { return (r & 3) + 8 * (r >> 2) + 4 * hi; }
DI float max3f(float a, float b, float c) { float r; asm("v_max3_f32 %0, %1, %2, %3" : "=v"(r) : "v"(a), "v"(b), "v"(c)); return r; }
#define LDS_FENCE() asm volatile("s_waitcnt lgkmcnt(0)" ::: "memory")

DI void rms_rows_bf16(const float* x, const float* w, bf16* out, int nrows, int gw, int NGW, int lane) {
    for (int m = 2 * gw; m < nrows; m += 2 * NGW) {
        const f32x4* xr0 = (const f32x4*)(x + (size_t)m * D_) + lane; const f32x4* xr1 = xr0 + D_ / 4;
        f32x4 v0[4], v1[4]; float s0 = 0.f, s1 = 0.f;
#pragma unroll
        for (int j = 0; j < 4; ++j) { v0[j] = xr0[64 * j]; v1[j] = xr1[64 * j]; }
#pragma unroll
        for (int j = 0; j < 4; ++j) { s0 += (v0[j].x * v0[j].x + v0[j].y * v0[j].y) + (v0[j].z * v0[j].z + v0[j].w * v0[j].w); s1 += (v1[j].x * v1[j].x + v1[j].y * v1[j].y) + (v1[j].z * v1[j].z + v1[j].w * v1[j].w); }
#pragma unroll
        for (int o = 1; o < 64; o <<= 1) { s0 += __shfl_xor(s0, o); s1 += __shfl_xor(s1, o); }
        const float r0 = rsqrtf(s0 * (1.f / D_) + EPS_), r1 = rsqrtf(s1 * (1.f / D_) + EPS_);
        u32x2* o0 = (u32x2*)(out + (size_t)m * D_) + lane; u32x2* o1 = o0 + D_ / 4;
#pragma unroll
        for (int j = 0; j < 4; ++j) { const f32x4 wv = ((const f32x4*)w)[lane + 64 * j];
            u32x2 a, b; a.x = pk2(v0[j].x * r0 * wv.x, v0[j].y * r0 * wv.y); a.y = pk2(v0[j].z * r0 * wv.z, v0[j].w * r0 * wv.w);
            b.x = pk2(v1[j].x * r1 * wv.x, v1[j].y * r1 * wv.y); b.y = pk2(v1[j].z * r1 * wv.z, v1[j].w * r1 * wv.w);
            o0[64 * j] = a; o1[64 * j] = b; }
    }
}
template <bool TO_F32> DI void rms_rows_from_bf16(const bf16* x, const float* w, bf16* outb, float* outf, int nrows, int gw, int NGW, int lane) {
    f32x4 wv[4];
#pragma unroll
    for (int j = 0; j < 4; ++j) wv[j] = ((const f32x4*)(w + lane * 16))[j];
    for (int m = 2 * gw; m < nrows; m += 2 * NGW) {
        u32x4 ra[2], rb[2];
#pragma unroll
        for (int u = 0; u < 2; ++u) { const u32x4* p = (const u32x4*)(x + (size_t)(m + u) * D_ + lane * 16); ra[u] = p[0]; rb[u] = p[1]; }
#pragma unroll
        for (int u = 0; u < 2; ++u) {
            float v[16];
            v[0] = bflo(ra[u].x); v[1] = bfhi(ra[u].x); v[2] = bflo(ra[u].y); v[3] = bfhi(ra[u].y); v[4] = bflo(ra[u].z); v[5] = bfhi(ra[u].z); v[6] = bflo(ra[u].w); v[7] = bfhi(ra[u].w);
            v[8] = bflo(rb[u].x); v[9] = bfhi(rb[u].x); v[10] = bflo(rb[u].y); v[11] = bfhi(rb[u].y); v[12] = bflo(rb[u].z); v[13] = bfhi(rb[u].z); v[14] = bflo(rb[u].w); v[15] = bfhi(rb[u].w);
            float s = 0.f;
#pragma unroll
            for (int i = 0; i < 16; ++i) s += v[i] * v[i];
            const float r = rsqrtf(wave_sum(s) * (1.f / D_) + EPS_);
#pragma unroll
            for (int i = 0; i < 16; ++i) v[i] = v[i] * r * wv[i >> 2][i & 3];
            if (TO_F32) { f32x4* o = (f32x4*)(outf + (size_t)(m + u) * D_ + lane * 16);
#pragma unroll
                for (int j = 0; j < 4; ++j) o[j] = (f32x4){v[4 * j], v[4 * j + 1], v[4 * j + 2], v[4 * j + 3]}; }
            else { u32x4 a, b; a.x = pk2(v[0], v[1]); a.y = pk2(v[2], v[3]); a.z = pk2(v[4], v[5]); a.w = pk2(v[6], v[7]); b.x = pk2(v[8], v[9]); b.y = pk2(v[10], v[11]); b.z = pk2(v[12], v[13]); b.w = pk2(v[14], v[15]);
                u32x4* o = (u32x4*)(outb + (size_t)(m + u) * D_ + lane * 16); o[0] = a; o[1] = b; }
        }
    }
}
DI void xb_rows(const float* x, bf16* out, float* ssq, int nrows, int gw, int NGW, int lane) {
    for (int m = gw; m < nrows; m += NGW) {
        const f32x4* xr = (const f32x4*)(x + (size_t)m * D_) + lane;
        f32x4 v[4]; float s = 0.f;
#pragma unroll
        for (int j = 0; j < 4; ++j) { v[j] = xr[64 * j]; s += (v[j].x * v[j].x + v[j].y * v[j].y) + (v[j].z * v[j].z + v[j].w * v[j].w); }
        s = wave_sum(s);
        u32x2* o8 = (u32x2*)(out + (size_t)m * D_) + lane;
#pragma unroll
        for (int j = 0; j < 4; ++j) { u32x2 o; o.x = pk2(v[j].x, v[j].y); o.y = pk2(v[j].z, v[j].w); o8[64 * j] = o; }
        if (lane < 16) ssq[(size_t)m * 16 + lane] = (lane == 0) ? s : 0.f;
    }
}
DI void rms_rows_f32_inplace(float* x, const float* w, int nrows, int gw, int NGW, int lane) {
    for (int m = gw; m < nrows; m += NGW) {
        f32x4* xr = (f32x4*)(x + (size_t)m * D_) + lane;
        f32x4 v[4]; float s = 0.f;
#pragma unroll
        for (int j = 0; j < 4; ++j) { v[j] = xr[64 * j]; s += (v[j].x * v[j].x + v[j].y * v[j].y) + (v[j].z * v[j].z + v[j].w * v[j].w); }
        const float rstd = rsqrtf(wave_sum(s) * (1.f / D_) + EPS_);
#pragma unroll
        for (int j = 0; j < 4; ++j) { const f32x4 wv = ((const f32x4*)w)[lane + 64 * j]; xr[64 * j] = v[j] * rstd * wv; }
    }
}

DI int map_plain(int d, int off) { return d + off; }
DI int map_win(int d) { if (d < 2304) return d; if (d < 3328) return d + 16; if (d < 4352) return d + 1056; if (d < 4368) return d - 4352 + 2304; if (d < 4384) return d; return -1; }
DI void conv_item(const float* W, int ldn, int K, bf16* WT, int nrows, int mode, int off, LAS float* scr, int item, int lane, const float* kscale = nullptr) {
    const int nblk = nrows / 32, kb = item / nblk, nb = item % nblk, k0 = 64 * kb, n0 = 32 * nb;
    const int d = n0 + (lane & 31); const int sc = mode ? map_win(d) : map_plain(d, off);
#pragma unroll 32
    for (int i = 0; i < 32; ++i) { const int kk = 2 * i + (lane >> 5); scr[kk * 33 + (lane & 31)] = sc >= 0 ? W[(size_t)(k0 + kk) * ldn + sc] : 0.f; }
    LDS_FENCE();
    const int c = lane & 7;
    f32x4 ka = (f32x4){1.f, 1.f, 1.f, 1.f}, kb2 = ka;
    if (kscale) { ka = *(const f32x4*)(kscale + k0 + 8 * c); kb2 = *(const f32x4*)(kscale + k0 + 8 * c + 4); }
#pragma unroll
    for (int j = 0; j < 4; ++j) { const int n = (lane >> 3) + 8 * j; const LAS float* s = scr + (8 * c) * 33 + n;
        u32x4 o; o.x = pk2(s[0 * 33] * ka[0], s[1 * 33] * ka[1]); o.y = pk2(s[2 * 33] * ka[2], s[3 * 33] * ka[3]); o.z = pk2(s[4 * 33] * kb2[0], s[5 * 33] * kb2[1]); o.w = pk2(s[6 * 33] * kb2[2], s[7 * 33] * kb2[3]);
        *(u32x4*)(WT + (size_t)(n0 + n) * K + k0 + 8 * c) = o; }
    LDS_FENCE();
}

DI void prep_unit(int unit, bf16* PROJ, float* SMALL, bf16* KT, float* DG, bf16* TAIL, const float* gla_w2, const float* gla_b, const float* dt_bias, const float* a_log,
                  const float* conv_w, const float* conv_b, ldsp lds, int tid) {
    asm volatile("" : "+v"(tid));
    const int rowbase = unit * 128;
    LAS float* sm = (LAS float*)lds; LAS float* dtL = (LAS float*)(lds + 16384);
    for (int i = tid; i < 128 * 32 / 4; i += 512) ((LAS f32x4*)sm)[i] = ((const f32x4*)(SMALL + (size_t)rowbase * 32))[i];
    __syncthreads();
    if (tid < 16) {
        const int h = tid; const float a = -__expf(a_log[h]), bias = dt_bias[h]; float cum = 0.f;
        for (int tt = 0; tt < 128; ++tt) { const float dtv = softplusf(sm[tt * 32 + h] + bias); cum += dtv * a; dtL[tt * 16 + h] = dtv;
            SMALL[((size_t)rowbase + tt) * 32 + h] = dtv; SMALL[((size_t)rowbase + tt) * 32 + 16 + h] = cum; }
    }
    {   const int col = tid;
        float w2c[16];
#pragma unroll
        for (int r = 0; r < 16; ++r) w2c[r] = gla_w2[r * 512 + col];
        const float bcol = gla_b[col];
        for (int sub = 0; sub < 2; ++sub) {
            float cum = 0.f;
#pragma unroll 1
            for (int g8 = 0; g8 < 8; ++g8) {
                unsigned qk[8];
                { const bf16* pq = PROJ + ((size_t)rowbase + sub * 64 + g8 * 8) * PROJ_LD + col;
#pragma unroll
                  for (int e = 0; e < 8; ++e) qk[e] = (unsigned)pq[(size_t)e * PROJ_LD + PC_Q] | ((unsigned)pq[(size_t)e * PROJ_LD + PC_K] << 16); }
                float kt[8];
#pragma unroll
                for (int e = 0; e < 8; ++e) {
                    const int tt = sub * 64 + g8 * 8 + e; const size_t row = (size_t)rowbase + tt;
                    float x = bcol;
#pragma unroll
                    for (int r = 0; r < 16; ++r) x += sm[tt * 32 + 16 + r] * w2c[r];
                    const float lg = (fminf(x, 0.f) - __logf(1.f + __expf(-fabsf(x)))) * 0.0625f;
                    cum += lg;
                    const float qv = bflo(qk[e]), kv = bfhi(qk[e]);
                    PROJ[row * PROJ_LD + PC_Q + col] = (bf16)f2bf(qv * __expf(cum) * 0.08838834764831845f);
                    kt[e] = kv * __expf(-cum);
                    PROJ[row * PROJ_LD + PC_K + col] = (bf16)f2bf(kt[e]);
                }
                u32x4 o; o.x = pk2(kt[0], kt[1]); o.y = pk2(kt[2], kt[3]); o.z = pk2(kt[4], kt[5]); o.w = pk2(kt[6], kt[7]);
                *(u32x4*)(KT + (size_t)col * KT_LD + rowbase + sub * 64 + g8 * 8) = o;
            }
            DG[(size_t)((rowbase >> 6) + sub) * 512 + col] = __expf(cum);
        }
    }
    const int tin = rowbase & (L_ - 1);
    __syncthreads();
#pragma unroll 1
    for (int i = 4; i >= 0; --i) { const int it = tid + 512 * i, pair = it % 640, slab = it / 640, c0 = 2 * pair;
        unsigned rw[35];
        bf16* base = PROJ + ((size_t)rowbase + 32 * slab) * PROJ_LD + PC_XBC + c0;
#pragma unroll
        for (int j = 0; j < 35; ++j) rw[j] = (tin + 32 * slab - 3 + j >= 0) ? *(const unsigned*)(base + (ptrdiff_t)(j - 3) * PROJ_LD) : 0u;
        float cw0[4], cw1[4];
#pragma unroll
        for (int j = 0; j < 4; ++j) { cw0[j] = conv_w[j * 1280 + c0]; cw1[j] = conv_w[j * 1280 + c0 + 1]; }
        const float cb0 = conv_b[c0], cb1 = conv_b[c0 + 1];
        const bool isx = c0 < 1024; const int hh = (c0 >> 6) & 15;
        __syncthreads();
#pragma unroll
        for (int r = 0; r < 32; ++r) { float a0 = cb0, a1 = cb1;
#pragma unroll
            for (int j = 0; j < 4; ++j) { a0 += cw0[j] * bflo(rw[r + j]); a1 += cw1[j] * bfhi(rw[r + j]); }
            a0 = siluf(a0); a1 = siluf(a1);
            const int row = 32 * slab + r;
            if (isx) { const float d = dtL[row * 16 + hh]; a0 *= d; a1 *= d; }
            bf16* dst = (row >= 125) ? TAIL + ((size_t)unit * 3 + (row - 125)) * 1280 + c0 : base + (size_t)r * PROJ_LD;
            *(unsigned*)dst = pk2(a0, a1); }
    }
    __syncthreads();
}

#define BAR_LDS() asm volatile("s_waitcnt lgkmcnt(0)\n\ts_barrier" ::: "memory")
DI void ssd_chain(int b, int h, bf16* PROJ, const float* SMALL, const bf16* TAIL, const float* d_skip, ldsp lds, int tid) {
    constexpr int CS = 0, BS = 18432, BWT = 36864, XDT = 54272, MS = 71680, SS = 106496, CUML = 115712, DTL = 116224;
    asm volatile("" : "+v"(tid));
    const int lane = tid & 63, w = __builtin_amdgcn_readfirstlane(tid >> 6), quad = lane >> 4, l16 = lane & 15;
    const int g = h >> 3, cp = lane & 31, th = lane >> 5, tb = 16 * w + 8 * th;
    LAS float* cumL = (LAS float*)(lds + CUML); LAS float* dtL = (LAS float*)(lds + DTL);
    int ch[3]; ch[0] = h * 64 + 2 * cp; ch[1] = 1024 + g * 64 + 2 * cp; ch[2] = 1152 + g * 64 + 2 * cp;
    const float Dh = d_skip[h];
    const int pi = w >> 1, q = 16 * w + l16;
    f32x4 S[2]; S[0] = (f32x4){0.f, 0.f, 0.f, 0.f}; S[1] = S[0];
    unsigned raw[3][8]; float cmv[8], cum_last, cl_t = 0.f, dt_t = 0.f; u32x2 zz[4];
#define SSD_LOAD(c_) do { const size_t r0_ = (size_t)b * L_ + (size_t)(c_) * 128; \
        _Pragma("unroll") for (int i = 0; i < 8; ++i) cmv[i] = SMALL[(r0_ + tb + i) * 32 + 16 + h]; \
        cum_last = SMALL[(r0_ + 127) * 32 + 16 + h]; \
        if (tid < 128) { cl_t = SMALL[(r0_ + tid) * 32 + 16 + h]; dt_t = SMALL[(r0_ + tid) * 32 + h]; } \
        _Pragma("unroll") for (int arr = 0; arr < 3; ++arr) _Pragma("unroll") for (int i = 0; i < 8; ++i) { const int rr = tb + i; \
            const bf16* sp = (rr >= 125) ? TAIL + ((r0_ >> 7) * 3 + (rr - 125)) * 1280 + ch[arr] : PROJ + (r0_ + rr) * PROJ_LD + PC_XBC + ch[arr]; \
            raw[arr][i] = *(const unsigned*)sp; } \
        _Pragma("unroll") for (int pt = 0; pt < 4; ++pt) zz[pt] = *(const u32x2*)(PROJ + (r0_ + q) * PROJ_LD + PC_Z + h * 64 + 16 * pt + quad * 4); } while (0)
    SSD_LOAD(0);
    for (int c = 0; c < 128; ++c) {
        const size_t row0 = (size_t)b * L_ + (size_t)c * 128;
        if (tid < 128) { cumL[tid] = cl_t; dtL[tid] = dt_t; }
        {
            u32x4 v0, v1;
            v0.x = __builtin_amdgcn_perm(raw[0][1], raw[0][0], 0x05040100u); v0.y = __builtin_amdgcn_perm(raw[0][3], raw[0][2], 0x05040100u);
            v0.z = __builtin_amdgcn_perm(raw[0][5], raw[0][4], 0x05040100u); v0.w = __builtin_amdgcn_perm(raw[0][7], raw[0][6], 0x05040100u);
            v1.x = __builtin_amdgcn_perm(raw[0][1], raw[0][0], 0x07060302u); v1.y = __builtin_amdgcn_perm(raw[0][3], raw[0][2], 0x07060302u);
            v1.z = __builtin_amdgcn_perm(raw[0][5], raw[0][4], 0x07060302u); v1.w = __builtin_amdgcn_perm(raw[0][7], raw[0][6], 0x07060302u);
            *(LAS u32x4*)(lds + XDT + (2 * cp) * 272 + tb * 2) = v0; *(LAS u32x4*)(lds + XDT + (2 * cp + 1) * 272 + tb * 2) = v1;
        }
        {
            float o0[8], o1[8];
#pragma unroll
            for (int i = 0; i < 8; ++i) { *(LAS unsigned*)(lds + BS + (tb + i) * 144 + 4 * cp) = raw[1][i];
                const float wg = __expf(cum_last - cmv[i]); o0[i] = bflo(raw[1][i]) * wg; o1[i] = bfhi(raw[1][i]) * wg; }
            u32x4 v0, v1; v0.x = pk2(o0[0], o0[1]); v0.y = pk2(o0[2], o0[3]); v0.z = pk2(o0[4], o0[5]); v0.w = pk2(o0[6], o0[7]);
            v1.x = pk2(o1[0], o1[1]); v1.y = pk2(o1[2], o1[3]); v1.z = pk2(o1[4], o1[5]); v1.w = pk2(o1[6], o1[7]);
            *(LAS u32x4*)(lds + BWT + (2 * cp) * 272 + tb * 2) = v0; *(LAS u32x4*)(lds + BWT + (2 * cp + 1) * 272 + tb * 2) = v1;
        }
#pragma unroll
        for (int i = 0; i < 8; ++i) *(LAS unsigned*)(lds + CS + (tb + i) * 144 + 4 * cp) = raw[2][i];
        u32x2 zc[4];
#pragma unroll
        for (int pt = 0; pt < 4; ++pt) zc[pt] = zz[pt];
        if (c + 1 < 128) SSD_LOAD(c + 1);
        BAR_LDS();
        const float cq = cumL[q], dq = dtL[q];
        const int fo = quad * 16;
        {
            bf16x8 cb[2];
#pragma unroll
            for (int k = 0; k < 2; ++k) cb[k] = lds16(lds, CS + q * 144 + 64 * k + fo);
#pragma unroll
            for (int jh = 0; jh < 2; ++jh) {
                bf16x8 ba[4][2];
#pragma unroll
                for (int j4 = 0; j4 < 4; ++j4) if (4 * jh + j4 <= w) {
#pragma unroll
                    for (int k = 0; k < 2; ++k) ba[j4][k] = lds16(lds, BS + (16 * (4 * jh + j4) + l16) * 144 + 64 * k + fo); }
                __builtin_amdgcn_sched_barrier(0);
                f32x4 acc[4];
#pragma unroll
                for (int j4 = 0; j4 < 4; ++j4) { acc[j4] = (f32x4){0.f, 0.f, 0.f, 0.f};
                    if (4 * jh + j4 <= w) { acc[j4] = mfma16(ba[j4][0], cb[0], acc[j4]); acc[j4] = mfma16(ba[j4][1], cb[1], acc[j4]); } }
                __builtin_amdgcn_sched_barrier(0);
#pragma unroll
                for (int j4 = 0; j4 < 4; ++j4) {
                    const int s0 = 16 * (4 * jh + j4) + quad * 4;
                    const f32x4 cs = *(LAS f32x4*)(cumL + s0);
                    float v[4];
#pragma unroll
                    for (int jj = 0; jj < 4; ++jj) { const int s = s0 + jj; float t = (s <= q) ? acc[j4][jj] * __expf(cq - cs[jj]) : 0.f; if (s == q && dq > 0.f) t += Dh / dq; v[jj] = t; }
                    u32x2 o; o.x = pk2(v[0], v[1]); o.y = pk2(v[2], v[3]);
                    *(LAS u32x2*)(lds + MS + q * 272 + s0 * 2) = o;
                }
            }
        }
#pragma unroll
        for (int i = 0; i < 2; ++i) { const int ni = (w & 1) * 2 + i; u32x2 o; o.x = pk2(S[i][0], S[i][1]); o.y = pk2(S[i][2], S[i][3]);
            *(LAS u32x2*)(lds + SS + (16 * pi + l16) * 144 + (16 * ni + quad * 4) * 2) = o; }
        const float el = __expf(cumL[127]);
        BAR_LDS();
        const float eq = __expf(cq);
        {
            bf16x8 mb[4], cb[2];
#pragma unroll
            for (int ks = 0; ks < 4; ++ks) mb[ks] = lds16(lds, MS + q * 272 + 64 * ks + fo);
#pragma unroll
            for (int k = 0; k < 2; ++k) cb[k] = lds16(lds, CS + q * 144 + 64 * k + fo);
#pragma unroll
            for (int pt = 0; pt < 4; ++pt) {
                bf16x8 xa[4], sa[2];
#pragma unroll
                for (int ks = 0; ks < 4; ++ks) xa[ks] = lds16(lds, XDT + (16 * pt + l16) * 272 + 64 * ks + fo);
#pragma unroll
                for (int k = 0; k < 2; ++k) sa[k] = lds16(lds, SS + (16 * pt + l16) * 144 + 64 * k + fo);
                __builtin_amdgcn_sched_barrier(0);
                f32x4 y1 = (f32x4){0.f, 0.f, 0.f, 0.f}, y2 = y1;
#pragma unroll
                for (int ks = 0; ks < 4; ++ks) if (32 * ks < 16 * w + 16) y1 = mfma16(xa[ks], mb[ks], y1);
#pragma unroll
                for (int k = 0; k < 2; ++k) y2 = mfma16(sa[k], cb[k], y2);
                __builtin_amdgcn_sched_barrier(0);
                bf16* zp = PROJ + (row0 + q) * PROJ_LD + PC_Z + h * 64 + 16 * pt + quad * 4;
                const float z0 = bflo(zc[pt].x), z1 = bfhi(zc[pt].x), z2 = bflo(zc[pt].y), z3 = bfhi(zc[pt].y);
                u32x2 o; o.x = pk2((y1[0] + eq * y2[0]) * siluf(z0), (y1[1] + eq * y2[1]) * siluf(z1)); o.y = pk2((y1[2] + eq * y2[2]) * siluf(z2), (y1[3] + eq * y2[3]) * siluf(z3));
                *(u32x2*)zp = o;
            }
        }
        {
            bf16x8 xb[4], wa[2][4];
#pragma unroll
            for (int ks = 0; ks < 4; ++ks) xb[ks] = lds16(lds, XDT + (16 * pi + l16) * 272 + 64 * ks + fo);
#pragma unroll
            for (int i = 0; i < 2; ++i)
#pragma unroll
                for (int ks = 0; ks < 4; ++ks) wa[i][ks] = lds16(lds, BWT + (16 * ((w & 1) * 2 + i) + l16) * 272 + 64 * ks + fo);
            __builtin_amdgcn_sched_barrier(0);
            S[0] = S[0] * el; S[1] = S[1] * el;
#pragma unroll
            for (int ks = 0; ks < 4; ++ks) { S[0] = mfma16(wa[0][ks], xb[ks], S[0]); S[1] = mfma16(wa[1][ks], xb[ks], S[1]); }
        }
        BAR_LDS();
    }
#undef SSD_LOAD
}

DI void gla_chain(int b, int h, int vs, const bf16* PROJ, const bf16* KT, const bf16* VT, const float* DG, bf16* ORAW, ldsp lds, int tid) {
    constexpr int QS = 0, KS = 17408, KTS = 34816, VTS = 53248, PS = 62464, STS = 71680, DLO = 89088;
    asm volatile("" : "+v"(tid));
    const int lane = tid & 63, w = __builtin_amdgcn_readfirstlane(tid >> 6), quad = lane >> 4, l16 = lane & 15, qi = w >> 1;
    LAS float* dL = (LAS float*)(lds + DLO);
    f32x4 S[4];
#pragma unroll
    for (int i = 0; i < 4; ++i) S[i] = (f32x4){0.f, 0.f, 0.f, 0.f};
    u32x4 Aq[2], Ak[2], Akt[2], Av, Bq[2], Bk[2], Bkt[2], Bv; float Ad = 0.f, Bd = 0.f;
#define GLA_LOAD(c_, P) do { const size_t r0_ = (size_t)b * L_ + (size_t)(c_) * 64; \
        _Pragma("unroll") for (int i = 0; i < 2; ++i) { const int idx = tid + 512 * i, r = idx >> 4, cc = idx & 15; \
            P##q[i] = *(const u32x4*)(PROJ + (r0_ + r) * PROJ_LD + PC_Q + h * 128 + cc * 8); P##k[i] = *(const u32x4*)(PROJ + (r0_ + r) * PROJ_LD + PC_K + h * 128 + cc * 8); } \
        _Pragma("unroll") for (int i = 0; i < 2; ++i) { const int idx = tid + 512 * i, r = idx >> 3, cc = idx & 7; P##kt[i] = *(const u32x4*)(KT + (size_t)(h * 128 + r) * KT_LD + r0_ + cc * 8); } \
        { const int r = tid >> 3, cc = tid & 7; P##v = *(const u32x4*)(VT + (size_t)(h * 256 + vs * 64 + r) * VT_LD + r0_ + cc * 8); } \
        if (tid < 128) P##d = DG[(r0_ >> 6) * 512 + h * 128 + tid]; } while (0)
#define GLA_PUT(P) do { \
        _Pragma("unroll") for (int i = 0; i < 2; ++i) { const int idx = tid + 512 * i, r = idx >> 4, cc = idx & 15; \
            *(LAS u32x4*)(lds + QS + r * 272 + cc * 16) = P##q[i]; *(LAS u32x4*)(lds + KS + r * 272 + cc * 16) = P##k[i]; } \
        _Pragma("unroll") for (int i = 0; i < 2; ++i) { const int idx = tid + 512 * i, r = idx >> 3, cc = idx & 7; *(LAS u32x4*)(lds + KTS + r * 144 + cc * 16) = P##kt[i]; } \
        { const int r = tid >> 3, cc = tid & 7; *(LAS u32x4*)(lds + VTS + r * 144 + cc * 16) = P##v; } \
        if (tid < 128) dL[tid] = P##d; } while (0)
#define GLA_COMPUTE(c_) do { \
        const size_t row0 = (size_t)b * L_ + (size_t)(c_) * 64; \
        BAR_LDS(); \
        const int q = 16 * qi + l16; \
        const int fo = quad * 16; \
        { \
            bf16x8 fb[4], fa[2][4]; \
_Pragma("unroll") \
            for (int ks = 0; ks < 4; ++ks) fb[ks] = lds16(lds, QS + q * 272 + 64 * ks + fo); \
_Pragma("unroll") \
            for (int i = 0; i < 2; ++i) \
_Pragma("unroll") \
                for (int ks = 0; ks < 4; ++ks) fa[i][ks] = lds16(lds, KS + (16 * ((w & 1) * 2 + i) + l16) * 272 + 64 * ks + fo); \
            __builtin_amdgcn_sched_barrier(0); \
            f32x4 acc[2]; acc[0] = (f32x4){0.f, 0.f, 0.f, 0.f}; acc[1] = acc[0]; \
_Pragma("unroll") \
            for (int ks = 0; ks < 4; ++ks) { acc[0] = mfma16(fa[0][ks], fb[ks], acc[0]); acc[1] = mfma16(fa[1][ks], fb[ks], acc[1]); } \
            __builtin_amdgcn_sched_barrier(0); \
_Pragma("unroll") \
            for (int i = 0; i < 2; ++i) { const int s0 = 16 * ((w & 1) * 2 + i) + quad * 4; \
                u32x2 o; o.x = pk2(s0 <= q ? acc[i][0] : 0.f, s0 + 1 <= q ? acc[i][1] : 0.f); o.y = pk2(s0 + 2 <= q ? acc[i][2] : 0.f, s0 + 3 <= q ? acc[i][3] : 0.f); \
                *(LAS u32x2*)(lds + PS + q * 144 + s0 * 2) = o; } \
        } \
_Pragma("unroll") \
        for (int vt = 0; vt < 4; ++vt) { u32x2 o; o.x = pk2(S[vt][0], S[vt][1]); o.y = pk2(S[vt][2], S[vt][3]); \
            *(LAS u32x2*)(lds + STS + (16 * vt + l16) * 272 + (16 * w + quad * 4) * 2) = o; } \
        BAR_LDS(); \
        { \
            bf16x8 pb[2], qb4[4], va[2][2], sa[2][4], ka[2], vb[4][2]; \
_Pragma("unroll") \
            for (int ks = 0; ks < 2; ++ks) pb[ks] = lds16(lds, PS + q * 144 + 64 * ks + fo); \
_Pragma("unroll") \
            for (int ks = 0; ks < 4; ++ks) qb4[ks] = lds16(lds, QS + q * 272 + 64 * ks + fo); \
_Pragma("unroll") \
            for (int i = 0; i < 2; ++i) { const int vt = (w & 1) * 2 + i; \
_Pragma("unroll") \
                for (int ks = 0; ks < 2; ++ks) va[i][ks] = lds16(lds, VTS + (16 * vt + l16) * 144 + 64 * ks + fo); \
_Pragma("unroll") \
                for (int ks = 0; ks < 4; ++ks) sa[i][ks] = lds16(lds, STS + (16 * vt + l16) * 272 + 64 * ks + fo); } \
_Pragma("unroll") \
            for (int ks = 0; ks < 2; ++ks) ka[ks] = lds16(lds, KTS + (16 * w + l16) * 144 + 64 * ks + fo); \
_Pragma("unroll") \
            for (int vt = 0; vt < 4; ++vt) \
_Pragma("unroll") \
                for (int ks = 0; ks < 2; ++ks) vb[vt][ks] = lds16(lds, VTS + (16 * vt + l16) * 144 + 64 * ks + fo); \
            const f32x4 dv = *(LAS f32x4*)(dL + 16 * w + quad * 4); \
            __builtin_amdgcn_sched_barrier(0); \
            f32x4 o[2]; o[0] = (f32x4){0.f, 0.f, 0.f, 0.f}; o[1] = o[0]; \
_Pragma("unroll") \
            for (int ks = 0; ks < 2; ++ks) { o[0] = mfma16(va[0][ks], pb[ks], o[0]); o[1] = mfma16(va[1][ks], pb[ks], o[1]); } \
_Pragma("unroll") \
            for (int ks = 0; ks < 4; ++ks) { o[0] = mfma16(sa[0][ks], qb4[ks], o[0]); o[1] = mfma16(sa[1][ks], qb4[ks], o[1]); } \
_Pragma("unroll") \
            for (int ks = 0; ks < 2; ++ks) \
_Pragma("unroll") \
                for (int vt = 0; vt < 4; ++vt) S[vt] = mfma16(ka[ks], vb[vt][ks], S[vt]); \
            __builtin_amdgcn_sched_barrier(0); \
_Pragma("unroll") \
            for (int i = 0; i < 2; ++i) { const int vt = (w & 1) * 2 + i; u32x2 ov; ov.x = pk2(o[i][0], o[i][1]); ov.y = pk2(o[i][2], o[i][3]); \
                *(u32x2*)(ORAW + (row0 + q) * 2048 + 1024 + h * 256 + vs * 64 + 16 * vt + quad * 4) = ov; } \
_Pragma("unroll") \
            for (int vt = 0; vt < 4; ++vt) S[vt] = S[vt] * dv; \
        } \
        BAR_LDS(); \
    } while (0)
    GLA_LOAD(0, A); GLA_LOAD(1, B);
    for (int c = 0; c < 256; c += 2) {
        GLA_PUT(A); if (c + 2 < 256) GLA_LOAD(c + 2, A); GLA_COMPUTE(c);
        GLA_PUT(B); if (c + 3 < 256) GLA_LOAD(c + 3, B); GLA_COMPUTE(c + 1);
    }
#undef GLA_PUT
#undef GLA_COMPUTE
#undef GLA_LOAD
}

#define UNPACK16(a, b, v) do { v[0] = bflo(a.x); v[1] = bfhi(a.x); v[2] = bflo(a.y); v[3] = bfhi(a.y); v[4] = bflo(a.z); v[5] = bfhi(a.z); v[6] = bflo(a.w); v[7] = bfhi(a.w); \
    v[8] = bflo(b.x); v[9] = bfhi(b.x); v[10] = bflo(b.y); v[11] = bfhi(b.y); v[12] = bflo(b.z); v[13] = bfhi(b.z); v[14] = bflo(b.w); v[15] = bfhi(b.w); } while (0)
DI void gate_rows(bf16* PROJ, bf16* ORAW, const float* ssd_norm, const float* gla_norm, int gw, int NGW, int lane) {
    for (int t0 = 2 * gw; t0 < T_; t0 += 2 * NGW) {
        u32x4 ya[2], yb[2], oa[2], ob[2], ra[2], rb[2];
#pragma unroll
        for (int u = 0; u < 2; ++u) { const size_t t = (size_t)t0 + u;
            const bf16* yp = PROJ + t * PROJ_LD + PC_Z + lane * 16; const bf16* op = ORAW + t * 2048 + 1024 + lane * 16; const bf16* rp = PROJ + t * PROJ_LD + PC_R + lane * 16;
            ya[u] = *(const u32x4*)yp; yb[u] = *(const u32x4*)(yp + 8); oa[u] = *(const u32x4*)op; ob[u] = *(const u32x4*)(op + 8); ra[u] = *(const u32x4*)rp; rb[u] = *(const u32x4*)(rp + 8); }
#pragma unroll
        for (int u = 0; u < 2; ++u) { const size_t t = (size_t)t0 + u;
            {   float v[16]; UNPACK16(ya[u], yb[u], v);
                float s = 0.f;
#pragma unroll
                for (int i = 0; i < 16; ++i) s += v[i] * v[i];
#pragma unroll
                for (int o = 1; o < 32; o <<= 1) s += __shfl_xor(s, o);
                const float rstd = rsqrtf(s * (1.f / 512.f) + EPS_);
                const float* nw = ssd_norm + lane * 16;
#pragma unroll
                for (int i = 0; i < 16; ++i) v[i] = v[i] * rstd * nw[i];
                u32x4 a, b; a.x = pk2(v[0], v[1]); a.y = pk2(v[2], v[3]); a.z = pk2(v[4], v[5]); a.w = pk2(v[6], v[7]); b.x = pk2(v[8], v[9]); b.y = pk2(v[10], v[11]); b.z = pk2(v[12], v[13]); b.w = pk2(v[14], v[15]);
                bf16* yp = ORAW + t * 2048 + lane * 16; *(u32x4*)yp = a; *(u32x4*)(yp + 8) = b; }
            {   float v[16], r[16]; UNPACK16(oa[u], ob[u], v); UNPACK16(ra[u], rb[u], r);
                float s = 0.f;
#pragma unroll
                for (int i = 0; i < 16; ++i) s += v[i] * v[i];
#pragma unroll
                for (int o = 1; o < 16; o <<= 1) s += __shfl_xor(s, o);
                const float rstd = rsqrtf(s * (1.f / 256.f) + EPS_);
                const float* nw = gla_norm + (lane & 15) * 16;
#pragma unroll
                for (int i = 0; i < 16; ++i) v[i] = v[i] * rstd * nw[i] * siluf(r[i]);
                u32x4 a, b; a.x = pk2(v[0], v[1]); a.y = pk2(v[2], v[3]); a.z = pk2(v[4], v[5]); a.w = pk2(v[6], v[7]); b.x = pk2(v[8], v[9]); b.y = pk2(v[10], v[11]); b.z = pk2(v[12], v[13]); b.w = pk2(v[14], v[15]);
                bf16* op = ORAW + t * 2048 + 1024 + lane * 16; *(u32x4*)op = a; *(u32x4*)(op + 8) = b; }
        }
    }
}

DI void attn_unit(int b, int ph, int qb, const bf16* QK, const bf16* VT, bf16* OATT, const float* NORMS, ldsp lds, int tid) {
    asm volatile("" : "+v"(tid));
    constexpr int KBUF = 9216, VBUF = 18432, KOFF = 0, VOFF = 2 * KBUF, WSOFF = 2 * KBUF + 2 * VBUF;
    const int lane = tid & 63, w = tid >> 6, r32 = lane & 31, hi = lane >> 5;
    const int q0 = qb * 256, head = ph >> 1;
    const size_t rowb = (size_t)b * L_;
    const float cs = exp2f(-(float)(head + 1)) * 1.4426950408889634f;
    LAS float* wsf = (LAS float*)(lds + WSOFF) + w * 64;
    bf16x8 qf[4];
    { const bf16* qp = QK + (rowb + q0 + 32 * w + r32) * QK_LD + ph * 64 + 8 * hi;
#pragma unroll
      for (int ks = 0; ks < 4; ++ks) qf[ks] = *(const bf16x8*)(qp + 16 * ks); }
    asm volatile("s_waitcnt vmcnt(0)" : "+v"(qf[0]), "+v"(qf[1]), "+v"(qf[2]), "+v"(qf[3]) :: "memory");
    const int qpos = q0 + 32 * w + r32;
    const int rsw = ((r32 >> 3) & 1) * 8;
    f32x16 o[4];
#pragma unroll
    for (int d = 0; d < 4; ++d)
#pragma unroll
        for (int r = 0; r < 16; ++r) o[d][r] = 0.f;
    float l_run = 0.f;
    const float Bq = sqrtf(NORMS[b * 32 + ph] * NORMS[b * 32 + 16 + ph]);
    const float Wn = (150.f + 2.f * Bq) / cs;
    const float sk = ((float)(q0 - 63) - Wn) * (1.f / 64.f);
    int t_begin = (sk >= 0.f) ? (int)floorf(sk) + 1 : 0;
    t_begin = __builtin_amdgcn_readfirstlane(t_begin);
    const int t_end = (q0 + 256) / 64;
    float m_run = cs * (float)(64 * t_begin - q0);
    const int klane = r32 * 144 + 16 * hi, vlane = r32 * 144 + 16 * hi;
    const float cs_h = bf2f(pk2(cs, 0.f) & 0xffffu);
    const unsigned csw = (hi == 0) ? pk2(cs_h, cs - cs_h) : 0u;
    bf16x8 kext0, kext1;
    { u32x4 e0, e1; e0.x = (hi == 0) ? pk2((float)r32, (float)r32) : 0u; e0.y = (hi == 0) ? pk2(1.f, 1.f) : 0u; e0.z = 0u; e0.w = 0u;
      e1 = e0; e1.x = (hi == 0) ? pk2((float)(r32 + 32), (float)(r32 + 32)) : 0u; kext0 = __builtin_bit_cast(bf16x8, e0); kext1 = __builtin_bit_cast(bf16x8, e1); }
    const int kr = tid >> 3, kc = tid & 7;
    const bf16* ksrc = QK + (rowb + kr) * QK_LD + 1024 + ph * 64 + kc * 8;
    const bf16* vsrc0 = VT + (size_t)(head * 128 + kr) * VT_LD + rowb + kc * 8;
    const bf16* vsrc1 = VT + (size_t)(head * 128 + 64 + kr) * VT_LD + rowb + kc * 8;
    const int kdst = KOFF + kr * 144 + kc * 16, vdst0 = VOFF + kr * 144 + kc * 16, vdst1 = VOFF + (64 + kr) * 144 + kc * 16;
    u32x4 pk_, pv0, pv1;
    pk_ = *(const u32x4*)(ksrc + (size_t)t_begin * 64 * QK_LD); pv0 = *(const u32x4*)(vsrc0 + t_begin * 64); pv1 = *(const u32x4*)(vsrc1 + t_begin * 64);
    const int vp0 = (16 * (kc >> 1) + 4 * (kc & 1)) * 2, vp1 = vp0 + 16;
#define VSWZ(v) (v)
    __syncthreads();
    *(LAS u32x4*)(lds + kdst) = pk_;
    { *(LAS u32x2*)(lds + VOFF + kr * 144 + vp0) = (u32x2){pv0.x, pv0.y}; *(LAS u32x2*)(lds + VOFF + kr * 144 + vp1) = (u32x2){pv0.z, pv0.w};
      *(LAS u32x2*)(lds + VOFF + (64 + kr) * 144 + vp0) = (u32x2){pv1.x, pv1.y}; *(LAS u32x2*)(lds + VOFF + (64 + kr) * 144 + vp1) = (u32x2){pv1.z, pv1.w}; }
    __syncthreads();
#define ATTN_TILE(t_, buf_) do { \
        const int kbase = 64 * (t_); \
        if (kbase <= q0 + 32 * w + 31) { \
            const int kb = KOFF + (buf_) * KBUF + klane, vb = VOFF + (buf_) * VBUF + vlane; \
              \
            const float nm = cs * (float)(kbase - q0) - m_run; \
            const float nmh = bf2f(pk2(nm, 0.f) & 0xffffu); \
            u32x4 qe; qe.x = csw; qe.y = (hi == 0) ? pk2(nmh, nm - nmh) : 0u; qe.z = 0u; qe.w = 0u; \
            const bf16x8 qef = __builtin_bit_cast(bf16x8, qe); \
            bf16x8 kf0[4], kf1[4]; \
            _Pragma("unroll") \
            for (int ks = 0; ks < 4; ++ks) { kf0[ks] = lds16(lds, kb + 32 * ks); kf1[ks] = lds16(lds, kb + 32 * 144 + 32 * ks); } \
            __builtin_amdgcn_sched_barrier(0); \
            f32x16 s0, s1; \
            _Pragma("unroll") \
            for (int r = 0; r < 16; ++r) { s0[r] = 0.f; s1[r] = 0.f; } \
            s0 = mfma32(kext0, qef, s0); s1 = mfma32(kext1, qef, s1); \
            _Pragma("unroll") \
            for (int ks = 0; ks < 4; ++ks) { s0 = mfma32(kf0[ks], qf[ks], s0); s1 = mfma32(kf1[ks], qf[ks], s1); } \
            __builtin_amdgcn_sched_barrier(0); \
            asm volatile("s_nop 15\n\ts_nop 7" : "+v"(s0), "+v"(s1));     \
            if (kbase + 63 > q0 + 32 * w) { \
                _Pragma("unroll") \
                for (int r = 0; r < 16; ++r) { const int key = kbase + 4 * hi + (r & 3) + 8 * (r >> 2); if (key > qpos) s0[r] = -INFINITY; if (key + 32 > qpos) s1[r] = -INFINITY; } \
            } \
            float mx = s0[0], mx2 = s1[0]; \
            _Pragma("unroll") \
            for (int r = 1; r < 16; r += 2) { mx = max3f(mx, s0[r], s1[r]); if (r + 1 < 16) mx2 = max3f(mx2, s0[r + 1], s1[r + 1]); } \
            mx = max3f(mx, mx2, mx2); \
            mx = fmaxf(mx, __shfl_xor(mx, 32)); \
            if (__any(mx > 64.f)) { \
                const float dl = fmaxf(mx, 0.f); \
                const float alpha = __builtin_amdgcn_exp2f(-dl); \
                l_run *= alpha; m_run += dl; \
                _Pragma("unroll") \
                for (int r = 0; r < 16; ++r) { s0[r] -= dl; s1[r] -= dl; } \
                if (hi == 0) wsf[r32] = alpha; \
                LDS_FENCE(); \
                _Pragma("unroll") \
                for (int r = 0; r < 16; ++r) { const float a = wsf[crow(r, hi)]; \
                    _Pragma("unroll") \
                    for (int d = 0; d < 4; ++d) o[d][r] *= a; } \
            } \
            float rs = 0.f; \
            _Pragma("unroll") \
            for (int r = 0; r < 16; ++r) { s0[r] = __builtin_amdgcn_exp2f(s0[r]); s1[r] = __builtin_amdgcn_exp2f(s1[r]); rs += s0[r] + s1[r]; } \
            rs += __shfl_xor(rs, 32); \
            l_run += rs; \
            bf16x8 pa[2][2]; \
            _Pragma("unroll") \
            for (int s = 0; s < 2; ++s) { \
                u32x4 p0, p1; \
                p0.x = pk2(s0[8 * s + 0], s0[8 * s + 1]); p0.y = pk2(s0[8 * s + 2], s0[8 * s + 3]); p0.z = pk2(s0[8 * s + 4], s0[8 * s + 5]); p0.w = pk2(s0[8 * s + 6], s0[8 * s + 7]); \
                p1.x = pk2(s1[8 * s + 0], s1[8 * s + 1]); p1.y = pk2(s1[8 * s + 2], s1[8 * s + 3]); p1.z = pk2(s1[8 * s + 4], s1[8 * s + 5]); p1.w = pk2(s1[8 * s + 6], s1[8 * s + 7]); \
                pa[0][s] = __builtin_bit_cast(bf16x8, p0); pa[1][s] = __builtin_bit_cast(bf16x8, p1); \
            } \
            _Pragma("unroll") \
            for (int dh = 0; dh < 2; ++dh) { \
                bf16x8 vf[2][2][2]; \
                _Pragma("unroll") \
                for (int d2 = 0; d2 < 2; ++d2) \
                    _Pragma("unroll") \
                    for (int hf = 0; hf < 2; ++hf) \
                        _Pragma("unroll") \
                        for (int s = 0; s < 2; ++s) vf[d2][hf][s] = lds16(lds, vb + 4608 * (2 * dh + d2) + 64 * hf + 32 * s); \
                __builtin_amdgcn_sched_barrier(0); \
                _Pragma("unroll") \
                for (int hf = 0; hf < 2; ++hf) \
                    _Pragma("unroll") \
                    for (int s = 0; s < 2; ++s) \
                        _Pragma("unroll") \
                        for (int d2 = 0; d2 < 2; ++d2) o[2 * dh + d2] = mfma32(pa[hf][s], vf[d2][hf][s], o[2 * dh + d2]); \
                __builtin_amdgcn_sched_barrier(0); \
            } \
        } \
    } while (0)
#define ATTN_LOAD(t_, K_, V0_, V1_) do { K_ = *(const u32x4*)(ksrc + (size_t)(t_) * 64 * QK_LD); V0_ = *(const u32x4*)(vsrc0 + (t_) * 64); V1_ = *(const u32x4*)(vsrc1 + (t_) * 64); } while (0)
#define VT_PUT(off_, V_) do { *(LAS u32x2*)(lds + (off_) + vp0) = (u32x2){(V_).x, (V_).y}; *(LAS u32x2*)(lds + (off_) + vp1) = (u32x2){(V_).z, (V_).w}; } while (0)
#define ATTN_STORE(buf_, K_, V0_, V1_) do { *(LAS u32x4*)(lds + kdst + (buf_) * KBUF) = K_; VT_PUT(VOFF + (buf_) * VBUF + kr * 144, V0_); VT_PUT(VOFF + (buf_) * VBUF + (64 + kr) * 144, V1_); } while (0)
    u32x4 ak = pk_, av0 = pv0, av1 = pv1, bk = pk_, bv0 = pv0, bv1 = pv1;
    if (t_begin + 1 < t_end) ATTN_LOAD(t_begin + 1, ak, av0, av1);
    for (int t = t_begin; t < t_end; t += 2) {
        if (t + 2 < t_end) ATTN_LOAD(t + 2, bk, bv0, bv1);
        ATTN_TILE(t, 0);
        if (t + 1 < t_end) ATTN_STORE(1, ak, av0, av1);
        BAR_LDS();
        if (t + 1 < t_end) {
            if (t + 3 < t_end) ATTN_LOAD(t + 3, ak, av0, av1);
            ATTN_TILE(t + 1, 1);
            if (t + 2 < t_end) ATTN_STORE(0, bk, bv0, bv1);
            BAR_LDS();
        }
    }
#undef ATTN_TILE
#undef ATTN_LOAD
#undef ATTN_STORE
    LDS_FENCE();
    if (hi == 0) wsf[r32] = 1.f / l_run;
    LDS_FENCE();
    bf16* op = OATT + (rowb + q0 + 32 * w) * 2048 + ph * 128 + r32;
#pragma unroll
    for (int r = 0; r < 16; ++r) { const int qr = crow(r, hi); const float rl = wsf[qr];
#pragma unroll
        for (int d = 0; d < 4; ++d) op[(size_t)qr * 2048 + 32 * d] = (bf16)f2bf(o[d][r] * rl); }
#undef VSWZ
}

DI void qk_norms(const bf16* QK, float* NORMS, int gw, int NGW, int lane) {
    for (int b = 0; b < 2; ++b) {
        float mx = 0.f;
        for (int t = gw; t < L_; t += NGW) {
            const u32x4* p = (const u32x4*)(QK + ((size_t)b * L_ + t) * QK_LD + lane * 32);
            float s = 0.f;
#pragma unroll
            for (int i = 0; i < 4; ++i) { const u32x4 v = p[i];
                s += bflo(v.x) * bflo(v.x) + bfhi(v.x) * bfhi(v.x) + bflo(v.y) * bflo(v.y) + bfhi(v.y) * bfhi(v.y) + bflo(v.z) * bflo(v.z) + bfhi(v.z) * bfhi(v.z) + bflo(v.w) * bflo(v.w) + bfhi(v.w) * bfhi(v.w); }
            s += __shfl_xor(s, 1);
            mx = fmaxf(mx, s);
        }
        if (!(lane & 1)) atomicMax((unsigned*)NORMS + b * 32 + (lane >> 1), __float_as_uint(mx));
    }
}

DI void combine_rows(const bf16* OATT, bf16* OUT, const float* lq1, const float* lk1, const float* lq2, const float* lk2, const float* subln, float lam_init, int gw, int NGW, int lane) {
    const float e1 = __expf(wave_sum(lq1[lane] * lk1[lane])), e2 = __expf(wave_sum(lq2[lane] * lk2[lane]));
    const float lam = e1 - e2 + lam_init;
    const int head = lane >> 3, dv0 = (lane & 7) * 16;
    for (int t0 = 2 * gw; t0 < T_; t0 += 2 * NGW) {
        u32x4 A[2], B[2], C[2], Dd[2];
#pragma unroll
        for (int u = 0; u < 2; ++u) { const bf16* p1 = OATT + (size_t)(t0 + u) * 2048 + (2 * head) * 128 + dv0; const bf16* p2 = p1 + 128;
            A[u] = *(const u32x4*)p1; B[u] = *(const u32x4*)(p1 + 8); C[u] = *(const u32x4*)p2; Dd[u] = *(const u32x4*)(p2 + 8); }
#pragma unroll
        for (int u = 0; u < 2; ++u) {
            float v[16], q[16]; UNPACK16(A[u], B[u], v); UNPACK16(C[u], Dd[u], q);
            float s = 0.f;
#pragma unroll
            for (int i = 0; i < 16; ++i) { v[i] = v[i] - lam * q[i]; s += v[i] * v[i]; }
            s += __shfl_xor(s, 1); s += __shfl_xor(s, 2); s += __shfl_xor(s, 4);
            const float sc = rsqrtf(s * (1.f / 128.f) + EPS_) * (1.f - lam_init);
            const float* nw = subln + dv0;
            u32x4 oa, ob;
            oa.x = pk2(v[0] * sc * nw[0], v[1] * sc * nw[1]); oa.y = pk2(v[2] * sc * nw[2], v[3] * sc * nw[3]); oa.z = pk2(v[4] * sc * nw[4], v[5] * sc * nw[5]); oa.w = pk2(v[6] * sc * nw[6], v[7] * sc * nw[7]);
            ob.x = pk2(v[8] * sc * nw[8], v[9] * sc * nw[9]); ob.y = pk2(v[10] * sc * nw[10], v[11] * sc * nw[11]); ob.z = pk2(v[12] * sc * nw[12], v[13] * sc * nw[13]); ob.w = pk2(v[14] * sc * nw[14], v[15] * sc * nw[15]);
            bf16* qo = OUT + (size_t)(t0 + u) * 1024 + head * 128 + dv0;
            *(u32x4*)qo = oa; *(u32x4*)(qo + 8) = ob;
        }
    }
}

DI void softmax_rows256(bf16* S, int nrows, int gw, int NGW, int lane) {
    for (int r0 = gw * 4; r0 < nrows; r0 += NGW * 4) {
        u32x2 a[4];
#pragma unroll
        for (int i = 0; i < 4; ++i) a[i] = *((const u32x2*)(S + (size_t)(r0 + i) * 256) + lane);
#pragma unroll
        for (int i = 0; i < 4; ++i) {
            float v0 = bflo(a[i].x), v1 = bfhi(a[i].x), v2 = bflo(a[i].y), v3 = bfhi(a[i].y);
            const float mx = wave_max(fmaxf(fmaxf(v0, v1), fmaxf(v2, v3)));
            v0 = __expf(v0 - mx); v1 = __expf(v1 - mx); v2 = __expf(v2 - mx); v3 = __expf(v3 - mx);
            const float inv = 1.f / wave_sum((v0 + v1) + (v2 + v3));
            u32x2 o; o.x = pk2(v0 * inv, v1 * inv); o.y = pk2(v2 * inv, v3 * inv);
            *((u32x2*)(S + (size_t)(r0 + i) * 256) + lane) = o;
        }
    }
}

#define GAS __attribute__((address_space(1)))
#define XB_TMO      128
#define XB_XCNT(j)  (256  + 64 * (j))
#define XB_XSUB(j)  (1280 + 64 * (j))
#define XB_XGEN(j)  (2304 + 64 * (j))
#define XB_TOP      3328
#define XB_TOPGEN   3392
#define XCD_BAR_WORDS 3456
#define XB_SPIN_CAP (1u << 18)

__device__ __forceinline__ unsigned xb_ld(unsigned* p)              { return __hip_atomic_load(p, __ATOMIC_RELAXED, __HIP_MEMORY_SCOPE_AGENT); }
__device__ __forceinline__ unsigned xb_add(unsigned* p, unsigned v) { return __hip_atomic_fetch_add(p, v, __ATOMIC_RELAXED, __HIP_MEMORY_SCOPE_AGENT); }
__device__ __forceinline__ unsigned xb_xcc_id() { return (unsigned)__builtin_amdgcn_s_getreg((3 << 11) | 20) & 0xFu; }
#define XB_SPIN(cond, bar) do { unsigned _sp = 0; while (cond) { __builtin_amdgcn_s_sleep(1); \
    if ((++_sp & 255u) == 0u) { if (xb_ld(&(bar)[XB_TMO])) break; if (_sp > XB_SPIN_CAP) { atomicAdd(&(bar)[XB_TMO], 1u); break; } } } } while (0)

struct XcdBarrier {
    unsigned* bar; unsigned x;
    volatile LAS unsigned* st;
};

__device__ __forceinline__ XcdBarrier xcd_barrier_post(unsigned* bar, volatile LAS unsigned* st) {
    XcdBarrier b; b.bar = bar; b.x = xb_xcc_id(); b.st = st;
    if (threadIdx.x == 0) (void)xb_add(&bar[XB_XCNT(b.x)], 1u);
    return b;
}
__device__ __forceinline__ void xcd_barrier_complete(unsigned* bar, unsigned x, unsigned& nloc, unsigned& nx) {
    const unsigned G = gridDim.x * gridDim.y * gridDim.z;
    unsigned sum, cnt, mine, sp = 0u;
    for (;;) {
        sum = 0u; cnt = 0u; mine = 0u;
#pragma unroll
        for (unsigned j = 0; j < 16; ++j) { const unsigned c = xb_ld(&bar[XB_XCNT(j)]); sum += c; cnt += (c > 0u) ? 1u : 0u; mine = (j == x) ? c : mine; }
        if (sum == G) break;
        __builtin_amdgcn_s_sleep(1);
        if ((++sp & 255u) == 0u) { if (xb_ld(&bar[XB_TMO])) break; if (sp > XB_SPIN_CAP) { atomicAdd(&bar[XB_TMO], 1u); break; } }
    }
    nloc = mine > 0u ? mine : 1u; nx = cnt > 0u ? cnt : 1u;
}

__device__ __forceinline__ void xcd_barrier(const XcdBarrier& b) {
    asm volatile("s_waitcnt vmcnt(0)" ::: "memory");
    __syncthreads();
    if (threadIdx.x == 0) {
        unsigned* bar = b.bar;
        __builtin_amdgcn_s_waitcnt(0);
        unsigned nloc = b.st[0], nx = b.st[1];
        if (nloc == 0u) { xcd_barrier_complete(bar, b.x, nloc, nx); b.st[0] = nloc; b.st[1] = nx; }
        const unsigned old = xb_add(&bar[XB_XSUB(b.x)], 1u);
        const unsigned gen = old / nloc;
        if (old + 1u == (gen + 1u) * nloc) {
            __builtin_amdgcn_fence(__ATOMIC_RELEASE, "agent");
            asm volatile("s_waitcnt vmcnt(0)" ::: "memory");
            const unsigned og = xb_add(&bar[XB_TOP], 1u);
            const unsigned tg = og / nx;
            if (og + 1u == (tg + 1u) * nx) xb_add(&bar[XB_TOPGEN], 1u);
            else XB_SPIN(xb_ld(&bar[XB_TOPGEN]) == tg, bar);
            __builtin_amdgcn_fence(__ATOMIC_ACQUIRE, "agent");
            xb_add(&bar[XB_XGEN(b.x)], 1u);
            asm volatile("s_waitcnt vmcnt(0)" ::: "memory");
        } else {
            XB_SPIN(xb_ld(&bar[XB_XGEN(b.x)]) == gen, bar);
            __builtin_amdgcn_fence(__ATOMIC_ACQUIRE, "agent");
            asm volatile("s_waitcnt vmcnt(0)" ::: "memory");
        }
    }
    __syncthreads();
}

struct Args { const float* in[31]; float* out; unsigned char* ws; float lam_init[2]; int ph_lo, ph_hi; };
constexpr int NPL = 15, NPH = 4 * NPL + 1;

DI pg8::Gemm mk_gemm(const bf16* A, const bf16* Bt, int M, int N, int K, int lda, int ldb) {
    pg8::Gemm g; g.A = A; g.Bt = Bt; g.M = M; g.N = N; g.K = K; g.lda = lda; g.ldb = ldb; g.a_pn = 0; g.b_pn = (long)256 * ldb; g.b_b = 0; g.pm_per_b = 1 << 30; return g;
}
DI pg8::EpiU mk_store(bf16* O, int ldc, int act, int scale_cols, float scale) {
    pg8::EpiU e; e.mode = 0; e.O = O; e.ldc = ldc; e.act = act; e.scale_cols = scale_cols; e.scale = scale; e.small_out = nullptr; e.small_pn = -1; e.base = nullptr; e.baseb = nullptr; e.outb = nullptr; e.ssq = nullptr; e.nssq = nullptr; e.nmode = 0; e.smx = nullptr; return e;
}
DI pg8::EpiU mk_res(const float* base, const bf16* baseb, bf16* outb, float* ssq) {
    pg8::EpiU e; e.mode = 1; e.ssq = ssq; e.nssq = nullptr; e.nmode = 0; e.smx = nullptr; e.O = nullptr; e.ldc = D_; e.act = 0; e.scale_cols = 0; e.scale = 1.f; e.small_out = nullptr; e.small_pn = -1; e.base = base; e.baseb = baseb; e.outb = outb; return e;
}

__global__ void __launch_bounds__(512, 2) mega_fwd(Args a) {
    extern __shared__ __attribute__((aligned(16))) unsigned char lds_raw[];
    ldsp lds = (ldsp)lds_raw;
    cg::grid_group grid = cg::this_grid();
    volatile LAS unsigned* bst = (volatile LAS unsigned*)(lds + LDS_BYTES - 16);
    if (threadIdx.x < 4) bst[threadIdx.x] = 0u;
    __syncthreads();
    const XcdBarrier xbar = xcd_barrier_post((unsigned*)(a.ws + 4096), bst);
    const int G = gridDim.x, blk = blockIdx.x, NGW = G * 8;
    for (int ph = a.ph_lo; ph < a.ph_hi; ++ph) {
#define PHASE_IDS int tid = threadIdx.x; asm volatile("" : "+v"(tid)); const int lane = tid & 63, wave = __builtin_amdgcn_readfirstlane(tid >> 6), gw = blk * 8 + wave; (void)lane; (void)gw; (void)wave;
        unsigned char* ws = a.ws;
        bf16* XN = (bf16*)(ws + WS_XN); bf16* BIG = (bf16*)(ws + WS_BIG); bf16* VT = (bf16*)(ws + WS_VT); bf16* ORAW = (bf16*)a.out;   bf16* XR = (bf16*)(ws + WS_ORAW);
        float* SSQ_M = (float*)a.out; float* SSQ_X = (float*)(ws + WS_SMALL); float* SSQ_F = (float*)(ws + WS_SMALL + 2 * MiB);
        float* SMALL = (float*)(ws + WS_SMALL); bf16* MEMN = (bf16*)(ws + WS_MEMN); bf16* KX = (bf16*)(ws + WS_KX); bf16* VXT = (bf16*)(ws + WS_VXT);
        bf16* KT = (bf16*)(ws + WS_KT); float* DG = (float*)(ws + WS_DG); bf16* TAIL = (bf16*)(ws + WS_DG + 1 * MiB);
        bf16* WA = (bf16*)(ws + WS_WA); bf16* WV = (bf16*)(ws + WS_WV); bf16* WOUT = (bf16*)(ws + WS_WOUT); bf16* WQ = (bf16*)(ws + WS_WQ); bf16* WKV = (bf16*)(ws + WS_WKV);
        bf16* WXO = (bf16*)(ws + WS_WXO); bf16* W1 = (bf16*)(ws + WS_W1); bf16* W2 = (bf16*)(ws + WS_W2);
        bf16* QX = BIG; bf16* SP = BIG + (size_t)T_ * 1024; bf16* OX = BIG + (size_t)2 * T_ * 1024;
        bf16* OATT = (bf16*)(ws + WS_BIG + 132 * MiB);

        const int layer = ph / NPL, k = ph % NPL;
        const bool even = !(layer & 1); const int li = layer >> 1;
        bool did = true; int nj = 0;
        const bool x_in = (layer == 0 && k <= 5);
        if (ph == NPH - 1) { PHASE_IDS
            rms_rows_from_bf16<true>(XR, a.in[30], nullptr, a.out, T_, gw, NGW, lane);
        } else if (k == 0) { PHASE_IDS
            LAS float* scr = (LAS float*)(lds + wave * 16384);
            const float* wq = a.in[24] + (size_t)layer * 1024 * 1024; const float* wkv = a.in[25] + (size_t)layer * 1024 * 2048; const float* wxo = a.in[26] + (size_t)layer * 1024 * 1024;
            const float* w1 = a.in[28] + (size_t)layer * 1024 * 4096; const float* w2 = a.in[29] + (size_t)layer * 4096 * 1024;
            const int I_Q = 16 * 32, I_KV = 16 * 64, I_XO = 16 * 32, I_1 = 16 * 128, I_2 = 64 * 32;
            const int I_A = even ? 16 * 144 : 16 * 64, I_V = 16 * 32, I_O = even ? 32 * 32 : 16 * 32;
            const int NIT = I_Q + I_KV + I_XO + I_1 + I_2 + I_A + I_V + I_O;
            for (int it = gw; it < NIT; it += NGW) {
                int r = it;
                if (r < I_Q) { conv_item(wq, 1024, 1024, WQ, 1024, 0, 0, scr, r, lane, a.in[22] + (size_t)layer * 1024); continue; } r -= I_Q;
                if (r < I_KV) { conv_item(wkv, 2048, 1024, WKV, 2048, 0, 0, scr, r, lane); continue; } r -= I_KV;
                if (r < I_XO) { conv_item(wxo, 1024, 1024, WXO, 1024, 0, 0, scr, r, lane); continue; } r -= I_XO;
                if (r < I_1) { conv_item(w1, 4096, 1024, W1, 4096, 0, 0, scr, r, lane, a.in[27] + (size_t)layer * 1024); continue; } r -= I_1;
                if (r < I_2) { conv_item(w2, 1024, 4096, W2, 1024, 0, 0, scr, r, lane); continue; } r -= I_2;
                if (even) {
                    const float* win = a.in[3] + (size_t)li * 1024 * 5408; const float* wout = a.in[13] + (size_t)li * 2048 * 1024;
                    if (r < I_A) { conv_item(win, 5408, 1024, WA, 4608, 1, 0, scr, r, lane, a.in[2] + (size_t)li * 1024); continue; } r -= I_A;
                    if (r < I_V) { conv_item(win, 5408, 1024, WV, 1024, 0, 3344, scr, r, lane, a.in[2] + (size_t)li * 1024); continue; } r -= I_V;
                    conv_item(wout, 1024, 2048, WOUT, 1024, 0, 0, scr, r, lane);
                } else {
                    const float* wqkv = a.in[15] + (size_t)li * 1024 * 3072; const float* wo = a.in[21] + (size_t)li * 1024 * 1024;
                    if (r < I_A) { conv_item(wqkv, 3072, 1024, WA, 2048, 0, 0, scr, r, lane, a.in[14] + (size_t)li * 1024); continue; } r -= I_A;
                    if (r < I_V) { conv_item(wqkv, 3072, 1024, WV, 1024, 0, 2048, scr, r, lane, a.in[14] + (size_t)li * 1024); continue; } r -= I_V;
                    conv_item(wo, 1024, 1024, WOUT, 1024, 0, 0, scr, r, lane);
                }
            }
            if (layer == 0) xb_rows(a.in[0], XR, SSQ_M, T_, gw, NGW, lane);
            rms_rows_bf16(a.in[1], a.in[23] + (size_t)layer * 1024, MEMN, 512, gw, NGW, lane);
            if (blk == 0 && tid < 64) ((float*)ws)[tid] = 0.f;
        } else if (k == 1) { nj = 4;
        } else if (k == 2) { PHASE_IDS
            if (even) { for (int u = blk; u < T_ / 128; u += G) prep_unit(u, BIG, SMALL, KT, DG, TAIL, a.in[10] + (size_t)li * 16 * 512, a.in[11] + (size_t)li * 512, a.in[6] + li * 16, a.in[7] + li * 16, a.in[4] + (size_t)li * 4 * 1280, a.in[5] + (size_t)li * 1280, lds, tid); }
            else {
                qk_norms(BIG, (float*)ws, gw, NGW, lane);
                xcd_barrier(xbar);
                {
                    const int x = blk & 7, j = blk >> 3, bb = (x >> 1) & 1, br = x & 1, grp = x >> 2;
#pragma unroll 1
                    for (int u = 0; u < 8; ++u) { const int s = u >> 1; const int head = grp ? (s == 0 ? 6 : s == 1 ? 4 : s == 2 ? 3 : 2) : (s == 0 ? 7 : s == 1 ? 5 : s == 2 ? 1 : 0);
                        attn_unit(bb, 2 * head + br, (u & 1) ? j : 63 - j, BIG, VT, OATT, (const float*)ws, lds, tid); }
                }
            }
        } else if (k == 3) { PHASE_IDS
            if (even) {
                for (int j = blk; j < 64; j += G) {
                    if (j < 32) ssd_chain(j >> 4, j & 15, BIG, SMALL, TAIL, a.in[8] + li * 16, lds, tid);
                    else { const int i2 = j - 32; gla_chain(i2 >> 4, (i2 >> 2) & 3, i2 & 3, BIG, KT, VT, DG, ORAW, lds, tid); }
                }
            } else combine_rows(OATT, XN, a.in[16] + li * 64, a.in[17] + li * 64, a.in[18] + li * 64, a.in[19] + li * 64, a.in[20] + li * 128, a.lam_init[li], gw, NGW, lane);
        } else if (k == 4) { PHASE_IDS
            if (even) gate_rows(BIG, ORAW, a.in[9] + (size_t)li * 1024, a.in[12] + (size_t)li * 256, gw, NGW, lane);
            else nj = 1;
        } else if (k == 5) { if (even) nj = 1; else did = false;
        } else if (k == 6) { did = false;
        } else if (k == 9) { did = false;
        } else if (k == 12) { did = false;
        } else nj = 1;
        for (int j = 0; j < nj; ++j) { PHASE_IDS
            pg8::Gemm g = mk_gemm(XN, WA, T_, 1024, 1024, 1024, 1024); pg8::EpiU e = mk_store(BIG, 1024, 0, 0, 1.f);
            if (k == 1) {
                if (j == 0) { if (even) { g = mk_gemm(XR, WA, T_, 4608, 1024, 1024, 1024); e = mk_store(BIG, PROJ_LD, 0, 0, 1.f); e.small_out = SMALL; e.small_pn = 17; }
                              else { g = mk_gemm(XR, WA, T_, 2048, 1024, 1024, 1024); e = mk_store(BIG, QK_LD, 0, 1024, 0.125f * 1.4426950408889634f); }
                              e.nssq = SSQ_M; e.nmode = 1; }
                else if (j == 1) { g = mk_gemm(WV, XR, 1024, T_, 1024, 1024, 1024); e = mk_store(VT, VT_LD, 0, 0, 1.f); e.nssq = SSQ_M; e.nmode = 2; }
                else if (j == 2) { g = mk_gemm(MEMN, WKV, 512, 1024, 1024, 1024, 1024); e = mk_store(KX, 1024, 0, 0, 1.f); }
                else { g = mk_gemm(WKV + (size_t)1024 * 1024, MEMN, 1024, 512, 1024, 1024, 1024); e = mk_store(VXT, 512, 0, 0, 1.f); }
            } else if (k == 4) { g = mk_gemm(XN, WOUT, T_, 1024, 1024, 1024, 1024); e = mk_res(nullptr, XR, XR, SSQ_X);
            } else if (k == 5) {
                g = mk_gemm(ORAW, WOUT, T_, 1024, 2048, 2048, 2048); e = mk_res(nullptr, XR, XR, SSQ_X);
            } else if (k == 7) { g = mk_gemm(XR, WQ, T_, 1024, 1024, 1024, 1024); e = mk_store(QX, 1024, 0, 1024, 0.0625f); e.nssq = SSQ_X; e.nmode = 1;
            } else if (k == 8) { g = mk_gemm(QX, KX, T_, 1024, 256, 1024, 1024); g.a_pn = 256; g.b_pn = 256; g.b_b = (long)256 * 1024; g.pm_per_b = 64; e = mk_store(SP, 1024, 0, 0, 1.f); e.smx = (PG8_LAS float*)(lds + 131072);
            } else if (k == 10) { g = mk_gemm(SP, VXT, T_, 1024, 256, 1024, 512); g.a_pn = 256; g.b_pn = (long)256 * 512; g.b_b = 256; g.pm_per_b = 64; e = mk_store(OX, 1024, 0, 0, 1.f);
            } else if (k == 11) { g = mk_gemm(OX, WXO, T_, 1024, 1024, 1024, 1024); e = mk_res(nullptr, XR, XR, SSQ_F);
            } else if (k == 13) { g = mk_gemm(XR, W1, T_, 4096, 1024, 1024, 1024); e = mk_store(BIG, 4096, 1, 0, 1.f); e.nssq = SSQ_F; e.nmode = 1;
            } else if (k == 14) { g = mk_gemm(BIG, W2, T_, 1024, 4096, 4096, 4096); e = mk_res(nullptr, XR, XR, SSQ_M); }
            pg8::StaticOrder S; S.init(g.M, g.N, G, (blk + 64 * j * (j >= 2)) % G);
            pg8::gemm_phase<pg8::EpiU, pg8::StaticOrder, true, true>(lds, g, S, e, tid);
        }
        if (did && ph + 1 < a.ph_hi) { if (ph == 0) grid.sync(); else xcd_barrier(xbar); }
    }
}

extern "C" void kernel_launch(void* const* d_in, const int* in_sizes, int n_in, void* d_out, int out_size, void* d_ws, size_t ws_size, hipStream_t stream) {
    static int grid = 0;
    if (grid == 0) {
        if (n_in != 31 || out_size != T_ * D_ || ws_size < WS_END) { fprintf(stderr, "kernel_launch: unexpected problem (n_in %d out %d ws %zu)\n", n_in, out_size, ws_size); grid = -1; return; }
        int dev = 0, cus = 0, per_cu = 0;
        hipGetDevice(&dev); hipDeviceGetAttribute(&cus, hipDeviceAttributeMultiprocessorCount, dev);
        if (hipFuncSetAttribute((const void*)mega_fwd, hipFuncAttributeMaxDynamicSharedMemorySize, LDS_BYTES) != hipSuccess) { fprintf(stderr, "kernel_launch: hipFuncSetAttribute failed\n"); grid = -1; return; }
        if (hipOccupancyMaxActiveBlocksPerMultiprocessor(&per_cu, (const void*)mega_fwd, 512, LDS_BYTES) != hipSuccess || per_cu < 1) { fprintf(stderr, "kernel_launch: occupancy query says %d\n", per_cu); per_cu = 1; }
        (void)hipGetLastError();
        grid = cus;
        if (grid != 256) { fprintf(stderr, "kernel_launch: built for a 256-CU device (got %d)\n", cus); grid = -1; return; }
    }
    if (grid < 0) return;
    Args a{};
    for (int i = 0; i < 31; ++i) a.in[i] = (const float*)d_in[i];
    a.out = (float*)d_out; a.ws = (unsigned char*)d_ws;
    a.lam_init[0] = (float)(0.8 - 0.6 * exp(-0.3 * 1.0)); a.lam_init[1] = (float)(0.8 - 0.6 * exp(-0.3 * 3.0));
    a.ph_lo = 0; a.ph_hi = NPH;
#ifdef PROBE_PREFIX
    {
        Args p = a; p.ph_hi = PROBE_PREFIX; void* pargs[] = {&p};
        (void)hipMemsetAsync(d_ws, 0, 65536, stream);
        (void)hipLaunchCooperativeKernel((const void*)mega_fwd, dim3(grid), dim3(512), pargs, LDS_BYTES, stream);
    }
#endif
    if (hipMemsetAsync(d_ws, 0, 65536, stream) != hipSuccess) { fprintf(stderr, "kernel_launch: memset failed\n"); return; }
    void* args[] = {&a};
    hipError_t e = hipLaunchCooperativeKernel((const void*)mega_fwd, dim3(grid), dim3(512), args, LDS_BYTES, stream);
    if (e != hipSuccess) fprintf(stderr, "cooperative launch failed: %s (grid %d)\n", hipGetErrorString(e), grid);
}
```
